# Optimizing an MI355X kernel written in HIP

```python
import jax, jax.numpy as jnp
from jax import lax
import numpy as np

D_MODEL = 1024
BATCH = 4
SEQ = 8192
DEPTH = 4
DEC_BATCH = 32
DEC_SEQ = 16
PAST_LEN = 2048

CHUNK = 64
Q_BLOCK = 128
SB_BLOCK = 128
A_HEADS = 4
A_NOPE = 64
A_ROPE = 32
A_V = 128
A_KV_RANK = 256
ROPE_THETA = 10000.0
B_HEADS = 4
B_HEAD_DIM = 64
FORGET_BIAS_INIT = 2.0
C_HEADS = 4
C_HEAD_DIM = 64

A_WIDTH = A_HEADS * A_V
B_WIDTH = B_HEADS * B_HEAD_DIM
C_WIDTH = C_HEADS * C_HEAD_DIM
D_MIX = A_WIDTH + B_WIDTH + C_WIDTH
A_SCALE = (A_NOPE + A_ROPE) ** -0.5
B_SCALE = B_HEAD_DIM ** -0.5
C_SCALE = C_HEAD_DIM ** -0.5
IN_SIZES = (A_HEADS * A_NOPE, A_HEADS * A_ROPE, A_KV_RANK, A_ROPE,
            B_WIDTH, B_WIDTH, B_WIDTH, B_HEADS,
            C_WIDTH, C_WIDTH, C_WIDTH, D_MIX)
IN_COLS = int(sum(IN_SIZES))
IN_SPLITS = tuple(int(v) for v in np.cumsum(IN_SIZES)[:-1])
GROUP_SPLITS = (A_WIDTH, A_WIDTH + B_WIDTH)
NORM_EPS = 1e-6
NEG_INF = -1e30

kernel_name = 'hybrid_mla_fox_stickbreak_stream_step'


def rmsnorm(x, g):
    xf = x.astype(jnp.float32)
    y = xf * lax.rsqrt(jnp.mean(xf * xf, axis=-1, keepdims=True) + NORM_EPS)
    return (y * g.astype(jnp.float32)).astype(x.dtype)


def rope(x, pos):
    half = x.shape[-1] // 2
    inv = ROPE_THETA ** (-jnp.arange(half, dtype=jnp.float32) / half)
    ang = pos.astype(jnp.float32)[:, None] * inv[None, :]
    ang = ang.reshape((ang.shape[0],) + (1,) * (x.ndim - 3) + (half,))
    cos, sin = jnp.cos(ang), jnp.sin(ang)
    xf = x.astype(jnp.float32)
    x1, x2 = xf[..., :half], xf[..., half:]
    return jnp.concatenate([x1 * cos - x2 * sin, x1 * sin + x2 * cos], axis=-1).astype(x.dtype)


def exclusive_suffix_sum(lk):
    L = lk.shape[-1]
    nk = -(-L // SB_BLOCK)
    pad = nk * SB_BLOCK - L
    lkp = jnp.pad(lk, ((0, 0), (0, 0), (0, 0), (0, pad))).reshape(lk.shape[:3] + (nk, SB_BLOCK))
    idx = jnp.arange(SB_BLOCK)
    tri = (idx[:, None] > idx[None, :]).astype(lk.dtype)
    within = jnp.einsum('bhqnj,js->bhqns', lkp, tri)
    bidx = jnp.arange(nk)
    btri = (bidx[:, None] > bidx[None, :]).astype(lk.dtype)
    later = jnp.einsum('bhqm,mn->bhqn', jnp.sum(lkp, axis=-1), btri)
    return (within + later[..., None]).reshape(lk.shape[:3] + (nk * SB_BLOCK,))[..., :L]


def project(h, pos, w_in, kv_norm, forget_bias):
    B, T, _ = h.shape
    (a_qn, a_qr, a_ckv, a_kr, b_q, b_k, b_v, b_f,
     c_q, c_k, c_v, gate) = jnp.split(h @ w_in, IN_SPLITS, axis=-1)
    a_qn = a_qn.reshape(B, T, A_HEADS, A_NOPE)
    a_qr = rope(a_qr.reshape(B, T, A_HEADS, A_ROPE), pos)
    a_ckv = rmsnorm(a_ckv, kv_norm)
    a_kr = rope(a_kr, pos)
    b_q = b_q.reshape(B, T, B_HEADS, B_HEAD_DIM)
    b_k = b_k.reshape(B, T, B_HEADS, B_HEAD_DIM)
    b_v = b_v.reshape(B, T, B_HEADS, B_HEAD_DIM)
    b_logf = jax.nn.log_sigmoid(b_f.astype(jnp.float32) + forget_bias.astype(jnp.float32))
    c_q = c_q.reshape(B, T, C_HEADS, C_HEAD_DIM)
    c_k = c_k.reshape(B, T, C_HEADS, C_HEAD_DIM)
    c_v = c_v.reshape(B, T, C_HEADS, C_HEAD_DIM)
    return (a_qn, a_qr, a_ckv, a_kr, b_q, b_k, b_v, b_logf, c_q, c_k, c_v, gate)


def attend_block(queries, keys, q_pos, k_pos):
    a_qn, a_qr, b_q, b_Fq, c_q = queries
    a_k, a_kr, a_v, b_k, b_v, b_Fk, c_k, c_v = keys
    B, Tq = a_qn.shape[0], a_qn.shape[1]
    s = (jnp.einsum('bqhd,bkhd->bhqk', a_qn, a_k)
         + jnp.einsum('bqhr,bkr->bhqk', a_qr, a_kr)).astype(jnp.float32)
    chunk_ok = (k_pos[None, :] // CHUNK) <= (q_pos[:, None] // CHUNK)
    p = jax.nn.softmax(jnp.where(chunk_ok, s, NEG_INF), axis=-1)
    o_a = jnp.einsum('bhqk,bkhd->bqhd', p.astype(a_v.dtype), a_v)
    causal = k_pos[None, :] <= q_pos[:, None]
    decay = jnp.transpose(b_Fq, (0, 2, 1))[:, :, :, None] - jnp.transpose(b_Fk, (0, 2, 1))[:, :, None, :]
    s = jnp.einsum('bqhd,bkhd->bhqk', b_q, b_k).astype(jnp.float32) + decay
    p = jax.nn.softmax(jnp.where(causal, s, NEG_INF), axis=-1)
    o_b = jnp.einsum('bhqk,bkhd->bqhd', p.astype(b_v.dtype), b_v)
    strict = k_pos[None, :] < q_pos[:, None]
    z = jnp.einsum('bqhd,bkhd->bhqk', c_q, c_k).astype(jnp.float32)
    log_keep = jnp.where(strict, jax.nn.log_sigmoid(-z), 0.0)
    log_after = exclusive_suffix_sum(log_keep)
    w = jnp.exp(jnp.where(strict, z + log_keep + log_after, NEG_INF))
    o_c = jnp.einsum('bhqk,bkhd->bqhd', w.astype(c_v.dtype), c_v)
    return jnp.concatenate([o_a.reshape(B, Tq, A_WIDTH), o_b.reshape(B, Tq, B_WIDTH),
                            o_c.reshape(B, Tq, C_WIDTH)], axis=-1)


def merge_groups(o, gate, out_norm, w_out):
    oa, ob, oc = jnp.split(o, GROUP_SPLITS, axis=-1)
    ga, gb, gc = jnp.split(out_norm, GROUP_SPLITS, axis=-1)
    normed = jnp.concatenate([rmsnorm(oa, ga), rmsnorm(ob, gb), rmsnorm(oc, gc)], axis=-1)
    return (normed * jax.nn.silu(gate)) @ w_out


def layer(x, pos, past, norm_pre, norm_post, w_in, kv_norm, w_uk, w_uv, forget_bias, out_norm, w_out):
    B, T, _ = x.shape
    h = rmsnorm(x, norm_pre)
    (a_qn, a_qr, a_ckv, a_kr, b_q, b_k, b_v, b_logf,
     c_q, c_k, c_v, gate) = project(h, pos, w_in, kv_norm, forget_bias)
    rows = (a_ckv, a_kr, b_k, b_v, b_logf, c_k, c_v)
    if past is None:
        full = rows
        k_pos = pos
    else:
        full = tuple(jnp.concatenate([pc.astype(r.dtype), r], axis=1) for pc, r in zip(past, rows))
        k_pos = jnp.arange(full[0].shape[1], dtype=jnp.int32)
    f_ckv, f_kr, f_bk, f_bv, f_logf, f_ck, f_cv = full
    a_k = jnp.einsum('bkr,rhd->bkhd', f_ckv, w_uk)
    a_v = jnp.einsum('bkr,rhd->bkhd', f_ckv, w_uv)
    F = lax.cumsum(f_logf.astype(jnp.float32), axis=1)
    Fq = F[:, F.shape[1] - T:]
    keys = (a_k, f_kr, a_v, f_bk, f_bv, F, f_ck, f_cv)
    queries = (a_qn * A_SCALE, a_qr * A_SCALE, b_q * B_SCALE, Fq, c_q * C_SCALE)
    if past is None:
        outs = []
        for i in range(T // Q_BLOCK):
            q0, q1 = i * Q_BLOCK, (i + 1) * Q_BLOCK
            outs.append(attend_block(tuple(t[:, q0:q1] for t in queries),
                                     tuple(t[:, :q1] for t in keys), pos[q0:q1], k_pos[:q1]))
        o = jnp.concatenate(outs, axis=1)
    else:
        o = attend_block(queries, keys, pos, k_pos)
    y = merge_groups(o, gate, out_norm, w_out)
    return x + rmsnorm(y, norm_post), rows


def setup_inputs(seed: int = 0) -> dict:
    key = jax.random.key(seed)
    ks = jax.random.split(key, 20)
    f32 = jnp.float32
    nrm = lambda k, shape, scale=1.0: scale * jax.random.normal(k, shape, f32)
    return {
        'x_prompt': nrm(ks[0], (BATCH, SEQ, D_MODEL)),
        'x_sample': nrm(ks[1], (DEC_BATCH, DEC_SEQ, D_MODEL)),
        'cache_mla_ckv': nrm(ks[2], (DEPTH, DEC_BATCH, PAST_LEN, A_KV_RANK)),
        'cache_mla_kpe': nrm(ks[3], (DEPTH, DEC_BATCH, PAST_LEN, A_ROPE)),
        'cache_fox_k': nrm(ks[4], (DEPTH, DEC_BATCH, PAST_LEN, B_HEADS, B_HEAD_DIM)),
        'cache_fox_v': nrm(ks[5], (DEPTH, DEC_BATCH, PAST_LEN, B_HEADS, B_HEAD_DIM)),
        'cache_fox_logf': jax.nn.log_sigmoid(FORGET_BIAS_INIT + nrm(ks[6], (DEPTH, DEC_BATCH, PAST_LEN, B_HEADS))),
        'cache_sb_k': nrm(ks[7], (DEPTH, DEC_BATCH, PAST_LEN, C_HEADS, C_HEAD_DIM)),
        'cache_sb_v': nrm(ks[8], (DEPTH, DEC_BATCH, PAST_LEN, C_HEADS, C_HEAD_DIM)),
        'norm_pre': 1.0 + nrm(ks[9], (DEPTH, D_MODEL), 0.05),
        'norm_post': 1.0 + nrm(ks[10], (DEPTH, D_MODEL), 0.05),
        'w_in': nrm(ks[11], (DEPTH, D_MODEL, IN_COLS), D_MODEL ** -0.5),
        'mla_kv_norm': 1.0 + nrm(ks[12], (DEPTH, A_KV_RANK), 0.05),
        'mla_w_uk': nrm(ks[13], (DEPTH, A_KV_RANK, A_HEADS, A_NOPE), A_KV_RANK ** -0.5),
        'mla_w_uv': nrm(ks[14], (DEPTH, A_KV_RANK, A_HEADS, A_V), A_KV_RANK ** -0.5),
        'fox_forget_bias': FORGET_BIAS_INIT + nrm(ks[15], (DEPTH, B_HEADS), 0.1),
        'out_norm': 1.0 + nrm(ks[16], (DEPTH, D_MIX), 0.05),
        'w_out': nrm(ks[17], (DEPTH, D_MIX, D_MODEL), D_MIX ** -0.5),
    }


def reference(x_prompt, x_sample, cache_mla_ckv, cache_mla_kpe, cache_fox_k, cache_fox_v,
              cache_fox_logf, cache_sb_k, cache_sb_v, norm_pre, norm_post, w_in, mla_kv_norm,
              mla_w_uk, mla_w_uv, fox_forget_bias, out_norm, w_out):
    past_len = cache_mla_ckv.shape[2]
    pos_p = jnp.arange(x_prompt.shape[1], dtype=jnp.int32)
    pos_s = past_len + jnp.arange(x_sample.shape[1], dtype=jnp.int32)
    xp, xs = x_prompt, x_sample
    rows_p, rows_s = [], []
    for l in range(DEPTH):
        wl = (norm_pre[l], norm_post[l], w_in[l], mla_kv_norm[l], mla_w_uk[l], mla_w_uv[l],
              fox_forget_bias[l], out_norm[l], w_out[l])
        xp, rp = layer(xp, pos_p, None, *wl)
        past = (cache_mla_ckv[l], cache_mla_kpe[l], cache_fox_k[l], cache_fox_v[l],
                cache_fox_logf[l], cache_sb_k[l], cache_sb_v[l])
        xs, rs = layer(xs, pos_s, past, *wl)
        rows_p.append(rp)
        rows_s.append(rs)
    st = lambda rows, i: jnp.stack([r[i] for r in rows], axis=0)
    return (xp, xs,
            st(rows_p, 0), st(rows_p, 1), st(rows_p, 2), st(rows_p, 3), st(rows_p, 4), st(rows_p, 5), st(rows_p, 6),
            st(rows_s, 0), st(rows_s, 1), st(rows_s, 2), st(rows_s, 3), st(rows_s, 4), st(rows_s, 5), st(rows_s, 6))
```

```cpp
#include <hip/hip_runtime.h>
#include <cstdio>
#include <cstdint>
namespace pg8 {
#define PG8_LAS __attribute__((address_space(3)))
typedef unsigned short bf16_t;
typedef short bf16x8 __attribute__((ext_vector_type(8)));
typedef float f32x4 __attribute__((ext_vector_type(4)));
typedef unsigned u32x4 __attribute__((ext_vector_type(4)));
constexpr int BM = 256, BK = 64, HALF = 128, HTB = HALF * BK * 2  , STAGE_BYTES = 8 * HTB, NXCD = 8, WGM = 8;

__host__ __device__ __forceinline__ int lds_byte(int r, int c) { const int st = (r >> 4) * 2 + (c >> 5), rr = r & 15, cc = c & 31, ob = rr * 64 + cc * 2; return st * 1024 + (ob ^ (((ob >> 9) & 1) << 5)); }
__host__ __device__ __forceinline__ void stage_rc(int b, int& R, int& C) { const int st = b / 1024, sb = b % 1024, swz = sb ^ (((sb >> 9) & 1) << 5); R = (st >> 1) * 16 + swz / 64; C = (st & 1) * 32 + (swz % 64) / 2; }
__host__ __device__ __forceinline__ int perm32(int rho) { const int n = rho >> 4, i = rho & 15; return 8 * (i >> 2) + 4 * n + (i & 3); }

struct Unit { int pm, pn; };
struct Gemm { const bf16_t* A; const bf16_t* Bt; int M, N, K; };

struct StaticOrder {
    int nM, nN, nwg, G, c;
    __host__ __device__ void init(int M, int N, int G_, int c_) { nM = M / BM; nN = N / BM; nwg = nM * nN; G = G_; c = c_; }
    __host__ __device__ bool next(int i, Unit& u) const {
        const long L = (long)i * G + c; if (L >= nwg) return false;
        int wgid = (int)L; { const int q = nwg / NXCD, r = nwg % NXCD, xcd = wgid % NXCD, off = wgid / NXCD; wgid = (xcd < r ? xcd * (q + 1) : r * (q + 1) + (xcd - r) * q) + off; }
        const int nig = WGM * nN, gid = wgid / nig, fm = gid * WGM, gsz = (nM - fm) < WGM ? (nM - fm) : WGM;
        u.pm = fm + ((wgid % nig) % gsz); u.pn = (wgid % nig) / gsz; return true;
    }
    __device__ __forceinline__ void a_ready(const Unit&) const {}
    __device__ __forceinline__ void done(const Unit&) const {}
};

__device__ __forceinline__ unsigned cvt_pk_bf16(float lo, float hi) { unsigned r; asm volatile("v_cvt_pk_bf16_f32 %0, %1, %2" : "=v"(r) : "v"(lo), "v"(hi)); return r; }
typedef float f32x2 __attribute__((ext_vector_type(2)));
template <class Epi, class Sched, bool ALIGN_EPI = false, bool SP2 = false>
__device__ __forceinline__ void gemm_phase(PG8_LAS unsigned char* lds, const Gemm g, const Sched& S, const Epi& E) {
    int tid_ = threadIdx.x; asm volatile("" : "+v"(tid_));
    const int tid = tid_, wid = __builtin_amdgcn_readfirstlane(tid >> 6), lane = tid & 63, wr = wid >> 2, wc = wid & 3, fr = lane & 15, fq = lane >> 4;
    const int K = g.K, nt = K / BK;
    unsigned voffA[2], voffB[2];
#pragma unroll
    for (int i = 0; i < 2; ++i) { int R, C; stage_rc(tid * 16 + i * 8192, R, C); const int Rb = Epi::PERM ? ((R & ~31) + perm32(R & 31)) : R;
        voffA[i] = (unsigned)(R * K + C) * 2u; voffB[i] = (unsigned)(Rb * K + C) * 2u; }
    const size_t kstep = (size_t)(BK * 2);
    const size_t hstep = (size_t)HALF * K * 2;
    const size_t tstep = 2 * hstep;
    const unsigned ldsw = (unsigned)wid * 1024u;
    const int aoff = lds_byte(wr * 64 + fr, fq * 8), boff = lds_byte(wc * 32 + fr, fq * 8);
#define PG8_SA(b, h) (((b) * 2 + (h)) * HTB)
#define PG8_SB(b, h) ((4 + (b) * 2 + (h)) * HTB)
#define PG8_STAGE(bufoff, gbase, voff) do { _Pragma("unroll") for (int _i = 0; _i < 2; ++_i) \
        __builtin_amdgcn_global_load_lds((const unsigned*)((const char*)(gbase) + (voff)[_i]), (PG8_LAS unsigned*)(lds + (bufoff) + ldsw + _i * 8192), 16, 0, 0); } while (0)
#define PG8_LDA(dst, b, h) do { _Pragma("unroll") for (int m = 0; m < 4; ++m) _Pragma("unroll") for (int k = 0; k < 2; ++k) dst[m][k] = *(const PG8_LAS bf16x8*)(lds + PG8_SA(b, h) + aoff + m * 2048 + k * 1024); } while (0)
#define PG8_LDB(dst, b, h) do { _Pragma("unroll") for (int n = 0; n < 2; ++n) _Pragma("unroll") for (int k = 0; k < 2; ++k) dst[n][k] = *(const PG8_LAS bf16x8*)(lds + PG8_SB(b, h) + boff + n * 2048 + k * 1024); } while (0)
#define PG8_MMA(ai, bj, At, Bt) do { __builtin_amdgcn_s_setprio(1); _Pragma("unroll") for (int m = 0; m < 4; ++m) _Pragma("unroll") for (int n = 0; n < 2; ++n) _Pragma("unroll") for (int k = 0; k < 2; ++k) \
        acc[ai][bj][m][n] = __builtin_amdgcn_mfma_f32_16x16x32_bf16(Bt[n][k], At[m][k], acc[ai][bj][m][n], 0, 0, 0); __builtin_amdgcn_s_setprio(0); } while (0)
#define PG8_WAIT_V(n) asm volatile("s_waitcnt vmcnt(" #n ")" ::: "memory")
#define PG8_WAIT_L(n) asm volatile("s_waitcnt lgkmcnt(" #n ")" ::: "memory")
#define PG8_BAR __builtin_amdgcn_s_barrier()
#define PG8_SCHED __builtin_amdgcn_sched_barrier(0)
    Unit cur, nxt; int ui = 0;
    if (!S.next(0, cur)) return;
    f32x4 acc[2][2][4][2];
#pragma unroll
    for (int a = 0; a < 2; ++a)
#pragma unroll
        for (int b = 0; b < 2; ++b)
#pragma unroll
            for (int m = 0; m < 4; ++m)
#pragma unroll
                for (int n = 0; n < 2; ++n) acc[a][b][m][n] = (f32x4){0.f, 0.f, 0.f, 0.f};
    bf16x8 At[4][2], B0[2][2], B1[2][2];
    const char* cA = (const char*)g.A + (size_t)cur.pm * tstep; const char* cB = (const char*)g.Bt + (size_t)cur.pn * tstep;
    S.a_ready(cur);
    if constexpr (Epi::MID) E.prep(cur, 0, tid);
    if constexpr (SP2) {
        PG8_STAGE(PG8_SB(0, 0), cB, voffB); PG8_STAGE(PG8_SB(0, 1), cB + hstep, voffB); PG8_STAGE(PG8_SA(0, 0), cA, voffA); PG8_STAGE(PG8_SA(0, 1), cA + hstep, voffA);
        if (wr == 1) PG8_BAR;
        PG8_WAIT_V(2); PG8_BAR;
        PG8_STAGE(PG8_SB(1, 0), cB + kstep, voffB); PG8_STAGE(PG8_SA(1, 0), cA + kstep, voffA); PG8_STAGE(PG8_SB(1, 1), cB + hstep + kstep, voffB);
        PG8_WAIT_V(6); PG8_BAR;
    } else {
        PG8_STAGE(PG8_SB(0, 0), cB, voffB); PG8_STAGE(PG8_SA(0, 0), cA, voffA); PG8_STAGE(PG8_SB(0, 1), cB + hstep, voffB); PG8_STAGE(PG8_SA(0, 1), cA + hstep, voffA);
        if (wr == 1) PG8_BAR;
        PG8_WAIT_V(4); PG8_BAR;
        PG8_STAGE(PG8_SB(1, 0), cB + kstep, voffB); PG8_STAGE(PG8_SA(1, 0), cA + kstep, voffA); PG8_STAGE(PG8_SB(1, 1), cB + hstep + kstep, voffB);
        PG8_WAIT_V(6); PG8_BAR;
    }
    for (;;) {
        const bool has_next = S.next(ui + 1, nxt);
        const char* nA = has_next ? (const char*)g.A + (size_t)nxt.pm * tstep : cA; const char* nB = has_next ? (const char*)g.Bt + (size_t)nxt.pn * tstep : cB;
        for (int t = 0; t < nt; t += 2) {
            if constexpr (Epi::MID) { if (t == Epi::MID_T0 || t == Epi::MID_T1) E.mid(acc, ui & 1, t == Epi::MID_T0 ? 0 : 1, wr, fr); }
            const bool last = (t == nt - 2);
            const char* a1 = cA + (size_t)(t + 1) * kstep;
            const char* a2 = last ? nA : cA + (size_t)(t + 2) * kstep; const char* b2 = last ? nB : cB + (size_t)(t + 2) * kstep;
            const char* a3 = a2 + kstep; const char* b3 = b2 + kstep;
            if (last && has_next) S.a_ready(nxt);
            if constexpr (SP2) {
            PG8_LDB(B0, 0, 0); PG8_LDB(B1, 0, 1); PG8_SCHED; PG8_LDA(At, 0, 0); PG8_STAGE(PG8_SA(1, 1), a1 + hstep, voffA);
            PG8_WAIT_V(8); PG8_WAIT_L(0); PG8_BAR; PG8_MMA(0, 0, At, B0); PG8_MMA(0, 1, At, B1); PG8_BAR; PG8_SCHED;
            PG8_LDA(At, 0, 1); PG8_STAGE(PG8_SB(0, 0), b2, voffB); PG8_STAGE(PG8_SB(0, 1), b2 + hstep, voffB); PG8_STAGE(PG8_SA(0, 0), a2, voffA);
            PG8_WAIT_V(8); PG8_WAIT_L(0); PG8_BAR; PG8_MMA(1, 0, At, B0); PG8_MMA(1, 1, At, B1); PG8_BAR; PG8_SCHED;
            PG8_LDB(B0, 1, 0); PG8_LDB(B1, 1, 1); PG8_SCHED; PG8_LDA(At, 1, 0); PG8_STAGE(PG8_SA(0, 1), a2 + hstep, voffA);
            PG8_WAIT_V(8); PG8_WAIT_L(0); PG8_BAR; PG8_MMA(0, 0, At, B0); PG8_MMA(0, 1, At, B1); PG8_BAR; PG8_SCHED;
            PG8_LDA(At, 1, 1); PG8_STAGE(PG8_SB(1, 0), b3, voffB); PG8_STAGE(PG8_SB(1, 1), b3 + hstep, voffB); PG8_STAGE(PG8_SA(1, 0), a3, voffA);
            PG8_WAIT_V(8); PG8_WAIT_L(0); PG8_BAR; PG8_MMA(1, 0, At, B0); PG8_MMA(1, 1, At, B1); PG8_BAR; PG8_SCHED;
            } else {
            PG8_LDB(B0, 0, 0); PG8_SCHED; PG8_LDA(At, 0, 0); PG8_STAGE(PG8_SA(1, 1), a1 + hstep, voffA);
            PG8_WAIT_L(8); PG8_BAR; PG8_WAIT_L(0); PG8_MMA(0, 0, At, B0); PG8_BAR; PG8_SCHED;
            PG8_LDB(B1, 0, 1); PG8_STAGE(PG8_SB(0, 0), b2, voffB);
            PG8_BAR; PG8_WAIT_L(0); PG8_MMA(0, 1, At, B1); PG8_BAR;
            PG8_LDA(At, 0, 1); PG8_STAGE(PG8_SA(0, 0), a2, voffA);
            PG8_BAR; PG8_WAIT_L(0); PG8_MMA(1, 0, At, B0); PG8_BAR; PG8_SCHED;
            PG8_STAGE(PG8_SB(0, 1), b2 + hstep, voffB);
            PG8_WAIT_V(6); PG8_BAR; PG8_MMA(1, 1, At, B1); PG8_BAR;
            PG8_LDB(B0, 1, 0); PG8_SCHED; PG8_LDA(At, 1, 0); PG8_STAGE(PG8_SA(0, 1), a2 + hstep, voffA);
            PG8_WAIT_L(8); PG8_BAR; PG8_WAIT_L(0); PG8_MMA(0, 0, At, B0); PG8_BAR; PG8_SCHED;
            PG8_LDB(B1, 1, 1); PG8_STAGE(PG8_SB(1, 0), b3, voffB);
            PG8_BAR; PG8_WAIT_L(0); PG8_MMA(0, 1, At, B1); PG8_BAR;
            PG8_LDA(At, 1, 1); PG8_STAGE(PG8_SA(1, 0), a3, voffA);
            PG8_BAR; PG8_WAIT_L(0); PG8_MMA(1, 0, At, B0); PG8_BAR; PG8_SCHED;
            PG8_STAGE(PG8_SB(1, 1), b3 + hstep, voffB);
            PG8_WAIT_V(6); PG8_BAR; PG8_MMA(1, 1, At, B1); PG8_BAR;
            }
        }
        if constexpr (ALIGN_EPI) { if (wr == 0) PG8_BAR; }
        if constexpr (Epi::MID) E.mid(acc, ui & 1, 2, wr, fr);
        if constexpr (!Epi::AFTER_DRAIN) { E(acc, cur, wr, wc, fr, fq); S.done(cur); }
        if constexpr (Epi::MID) { if (has_next) E.prep(nxt, (ui + 1) & 1, tid); }
        if (!has_next) break;
#pragma unroll
        for (int a = 0; a < 2; ++a)
#pragma unroll
            for (int b = 0; b < 2; ++b)
#pragma unroll
                for (int m = 0; m < 4; ++m)
#pragma unroll
                    for (int n = 0; n < 2; ++n) acc[a][b][m][n] = (f32x4){0.f, 0.f, 0.f, 0.f};
        cur = nxt; cA = nA; cB = nB; ++ui;
        if constexpr (ALIGN_EPI) { if (wr == 1) PG8_BAR; }
    }
    PG8_WAIT_V(0);
    if constexpr (!ALIGN_EPI) { if (wr == 0) PG8_BAR; }
    PG8_BAR;
    if constexpr (Epi::AFTER_DRAIN) { E.fused(acc, cur, wr, wc, fr, fq, lds, wid, lane); S.done(cur); }
#undef PG8_SA
#undef PG8_SB
#undef PG8_STAGE
#undef PG8_LDA
#undef PG8_LDB
#undef PG8_MMA
#undef PG8_WAIT_V
#undef PG8_WAIT_L
#undef PG8_BAR
#undef PG8_SCHED
}
}
#define GAS __attribute__((address_space(1)))
#define LAS __attribute__((address_space(3)))
#define XB_TMO      128
#define XB_XCNT(j)  (256  + 64 * (j))
#define XB_XSUB(j)  (1280 + 64 * (j))
#define XB_XGEN(j)  (2304 + 64 * (j))
#define XB_TOP      3328
#define XB_TOPGEN   3392
#define XCD_BAR_WORDS 3456
#define XB_SPIN_CAP (1u << 21)

__device__ __forceinline__ unsigned xb_ld(unsigned* p)              { return __hip_atomic_load(p, __ATOMIC_RELAXED, __HIP_MEMORY_SCOPE_AGENT); }
__device__ __forceinline__ unsigned xb_add(unsigned* p, unsigned v) { return __hip_atomic_fetch_add(p, v, __ATOMIC_RELAXED, __HIP_MEMORY_SCOPE_AGENT); }
__device__ __forceinline__ unsigned xb_xcc_id() { return (unsigned)__builtin_amdgcn_s_getreg((3 << 11) | 20) & 0xFu; }
#define XB_SPIN(cond, bar) do { unsigned _sp = 0; while (cond) { __builtin_amdgcn_s_sleep(1); \
    if ((++_sp & 255u) == 0u) { if (xb_ld(&(bar)[XB_TMO])) break; if (_sp > XB_SPIN_CAP) { atomicAdd(&(bar)[XB_TMO], 1u); break; } } } } while (0)

struct XcdBarrier {
    unsigned* bar; unsigned x;
    volatile LAS unsigned* st;
};

__device__ __forceinline__ XcdBarrier xcd_barrier_post(unsigned* bar, volatile LAS unsigned* st) {
    XcdBarrier b; b.bar = bar; b.x = xb_xcc_id(); b.st = st;
    if (threadIdx.x == 0) (void)xb_add(&bar[XB_XCNT(b.x)], 1u);
    return b;
}
__device__ __forceinline__ void xcd_barrier_complete(unsigned* bar, unsigned x, unsigned& nloc, unsigned& nx) {
    const unsigned G = gridDim.x * gridDim.y * gridDim.z;
    unsigned sum, cnt, mine, sp = 0u;
    for (;;) {
        sum = 0u; cnt = 0u; mine = 0u;
#pragma unroll
        for (unsigned j = 0; j < 16; ++j) { const unsigned c = xb_ld(&bar[XB_XCNT(j)]); sum += c; cnt += (c > 0u) ? 1u : 0u; mine = (j == x) ? c : mine; }
        if (sum == G) break;
        __builtin_amdgcn_s_sleep(1);
        if ((++sp & 255u) == 0u) { if (xb_ld(&bar[XB_TMO])) break; if (sp > XB_SPIN_CAP) { atomicAdd(&bar[XB_TMO], 1u); break; } }
    }
    nloc = mine > 0u ? mine : 1u; nx = cnt > 0u ? cnt : 1u;
}

__device__ __forceinline__ void xcd_barrier(const XcdBarrier& b) {
    asm volatile("s_waitcnt vmcnt(0)" ::: "memory");
    __syncthreads();
    if (threadIdx.x == 0) {
        unsigned* bar = b.bar;
        __builtin_amdgcn_s_waitcnt(0);
        unsigned nloc = b.st[0], nx = b.st[1];
        if (nloc == 0u) { xcd_barrier_complete(bar, b.x, nloc, nx); b.st[0] = nloc; b.st[1] = nx; }
        const unsigned old = xb_add(&bar[XB_XSUB(b.x)], 1u);
        const unsigned gen = old / nloc;
        if (old + 1u == (gen + 1u) * nloc) {
            __builtin_amdgcn_fence(__ATOMIC_RELEASE, "agent");
            asm volatile("s_waitcnt vmcnt(0)" ::: "memory");
            const unsigned og = xb_add(&bar[XB_TOP], 1u);
            const unsigned tg = og / nx;
            if (og + 1u == (tg + 1u) * nx) xb_add(&bar[XB_TOPGEN], 1u);
            else XB_SPIN(xb_ld(&bar[XB_TOPGEN]) == tg, bar);
            __builtin_amdgcn_fence(__ATOMIC_ACQUIRE, "agent");
            xb_add(&bar[XB_XGEN(b.x)], 1u);
            asm volatile("s_waitcnt vmcnt(0)" ::: "memory");
        } else {
            XB_SPIN(xb_ld(&bar[XB_XGEN(b.x)]) == gen, bar);
            __builtin_amdgcn_fence(__ATOMIC_ACQUIRE, "agent");
            asm volatile("s_waitcnt vmcnt(0)" ::: "memory");
        }
    }
    __syncthreads();
}

constexpr int D = 1024, NL = 4;
constexpr int PB = 4, PT = 8192, MP = PB * PT;
constexpr int SBN = 32, STN = 16, PAST = 2048, MS = SBN * STN;
constexpr int M = MP + MS;
constexpr int SKEYS = PAST + STN;
constexpr int SPITCH = 2112;
constexpr int KROWS = MP + SBN * SPITCH;
constexpr int M3 = M + SBN * PAST;
constexpr int NIN = 3236, NINP = 3328;
constexpr float EPS = 1e-6f;
constexpr float LOG2E = 1.4426950408889634f;
constexpr float QA_SC = 0.10206207261596575f * LOG2E, QB_SC = 0.125f * LOG2E, QC_SC = 0.125f * LOG2E;

constexpr size_t O_YP = 0, O_YS = O_YP + (size_t)MP * D, O_PCKV = O_YS + (size_t)MS * D, O_PKPE = O_PCKV + (size_t)NL * MP * 256, O_PFK = O_PKPE + (size_t)NL * MP * 32,
                 O_PFV = O_PFK + (size_t)NL * MP * 256, O_PLF = O_PFV + (size_t)NL * MP * 256, O_PSK = O_PLF + (size_t)NL * MP * 4, O_PSV = O_PSK + (size_t)NL * MP * 256,
                 O_SCKV = O_PSV + (size_t)NL * MP * 256, O_SKPE = O_SCKV + (size_t)NL * MS * 256, O_SFK = O_SKPE + (size_t)NL * MS * 32, O_SFV = O_SFK + (size_t)NL * MS * 256,
                 O_SLF = O_SFV + (size_t)NL * MS * 256, O_SSK = O_SLF + (size_t)NL * MS * 4, O_SSV = O_SSK + (size_t)NL * MS * 256, O_END = O_SSV + (size_t)NL * MS * 256;
static_assert(O_END == 209264640ull, "output size");

constexpr size_t MiB = 1u << 20;
constexpr size_t WS_CTL = 0, CTL_ZERO_BYTES = 1 * MiB;
constexpr size_t WS_ROPE = 1 * MiB, WS_WIN = 2 * MiB, WS_WUKV = 28 * MiB, WS_WOUT = 30 * MiB, WS_XN = 38 * MiB, WS_QA = 103 * MiB, WS_QB = 128 * MiB, WS_QC = 145 * MiB,
                 WS_GATE = 162 * MiB, WS_OP = 227 * MiB, WS_Y = 292 * MiB, WS_CKVB = 357 * MiB, WS_KA = 406 * MiB, WS_KR = 455 * MiB, WS_VA = 462 * MiB, WS_KB = 560 * MiB,
                 WS_VB = 609 * MiB, WS_KC = 658 * MiB, WS_VC = 707 * MiB, WS_LOGF = 756 * MiB, WS_FB = 758 * MiB, WS_SS = 760 * MiB, WS_KR2 = 762 * MiB, WS_END = 769 * MiB;
static_assert(WS_WIN + (size_t)NL * NINP * D * 2 <= WS_WUKV && WS_WUKV + (size_t)NL * 768 * 256 * 2 <= WS_WOUT && WS_WOUT + (size_t)NL * D * D * 2 <= WS_XN, "ws map 1");
static_assert(WS_XN + (size_t)M * D * 2 <= WS_QA && WS_QA + (size_t)(M + 64) * 384 * 2 <= WS_QB && WS_QB + (size_t)(M + 64) * 256 * 2 <= WS_QC && WS_QC + (size_t)(M + 64) * 256 * 2 <= WS_GATE, "ws map 2");
static_assert(WS_GATE + (size_t)M * D * 2 <= WS_OP && WS_OP + (size_t)M * D * 2 <= WS_Y && WS_Y + (size_t)M * D * 2 <= WS_CKVB && WS_CKVB + (size_t)M3 * 256 * 2 <= WS_KA, "ws map 3");
static_assert(WS_KA + (size_t)KROWS * 256 * 2 <= WS_KR && WS_KR + (size_t)KROWS * 32 * 2 <= WS_VA && WS_VA + (size_t)KROWS * 512 * 2 <= WS_KB && WS_KB + (size_t)KROWS * 256 * 2 <= WS_VB, "ws map 4");
static_assert(WS_VB + (size_t)KROWS * 256 * 2 <= WS_KC && WS_KC + (size_t)KROWS * 256 * 2 <= WS_VC && WS_VC + (size_t)KROWS * 256 * 2 <= WS_LOGF && WS_LOGF + (size_t)KROWS * 16 <= WS_FB && WS_FB + (size_t)KROWS * 16 <= WS_SS && WS_SS + (size_t)M * 48 <= WS_END, "ws map 5");
constexpr int CW_QUEUE = 64;
constexpr int CW_KMAX = 512;
constexpr int CW_BAR = 4096;
constexpr int RING_BYTES = 131072, MISC_OFF = RING_BYTES, PTR_OFF = RING_BYTES + 256, SCR_OFF = RING_BYTES + 512, LDS_BYTES = 147456;

typedef unsigned short bf16_t;
typedef short bf16x8 __attribute__((ext_vector_type(8)));
typedef short s16x4 __attribute__((ext_vector_type(4)));
typedef float f32x4 __attribute__((ext_vector_type(4)));
typedef float f32x16 __attribute__((ext_vector_type(16)));
typedef unsigned u32x4 __attribute__((ext_vector_type(4)));
typedef unsigned u32x2 __attribute__((ext_vector_type(2)));
typedef float f32x2_t __attribute__((ext_vector_type(2)));
typedef __bf16 bf16x2_t __attribute__((ext_vector_type(2)));
__device__ __forceinline__ unsigned cvtpk(float lo, float hi) { f32x2_t v = {lo, hi}; bf16x2_t b = __builtin_convertvector(v, bf16x2_t); return __builtin_bit_cast(unsigned, b); }
__device__ __forceinline__ float bf_lo(unsigned w) { return __uint_as_float(w << 16); }
__device__ __forceinline__ float bf_hi(unsigned w) { return __uint_as_float(w & 0xffff0000u); }
__device__ __forceinline__ float wave_sum(float v) {
#pragma unroll
    for (int o = 1; o < 64; o <<= 1) v += __shfl_xor(v, o);
    return v;
}
__device__ __forceinline__ float half_swap_sum(float v) { auto rr = __builtin_amdgcn_permlane32_swap(__float_as_uint(v), __float_as_uint(v), false, false); return __uint_as_float(rr[0]) + __uint_as_float(rr[1]); }
__device__ __forceinline__ float half_swap_max(float v) { auto rr = __builtin_amdgcn_permlane32_swap(__float_as_uint(v), __float_as_uint(v), false, false); return fmaxf(__uint_as_float(rr[0]), __uint_as_float(rr[1])); }
__device__ __forceinline__ int fresh_tid() { int t = threadIdx.x; asm volatile("" : "+v"(t)); return t; }
__device__ __forceinline__ size_t kr_off(int l) { return (l & 1) ? WS_KR2 : WS_KR; }
__device__ __forceinline__ int krow_of(int m) { return m < MP ? m : MP + ((m - MP) >> 4) * SPITCH + PAST + ((m - MP) & 15); }
__device__ __forceinline__ int pos_of(int m) { return m < MP ? (m & (PT - 1)) : PAST + ((m - MP) & 15); }
__device__ __forceinline__ float* rows_out(float* out, size_t off_p, size_t off_s, int l, int m, int W) {
    return m < MP ? out + off_p + ((size_t)l * MP + m) * W : out + off_s + ((size_t)l * MS + (m - MP)) * W;
}

struct Params { const float* in[18]; float* out; unsigned char* ws; int ph_lo, ph_hi; };
__device__ __forceinline__ const float* inp(LAS unsigned char* lds, int i) {
    const unsigned long long v = ((const LAS unsigned long long*)(lds + PTR_OFF))[i];
    const unsigned lo = __builtin_amdgcn_readfirstlane((unsigned)v), hi = __builtin_amdgcn_readfirstlane((unsigned)(v >> 32));
    return (const float*)(const GAS float*)(((unsigned long long)hi << 32) | lo);
}
#define WSP(T, off) ((T*)(ws + (off)))

__device__ __forceinline__ int win_logical_col(int n) {
    const int tile = n >> 8, c = n & 255;
    switch (tile) {
        case 0: return c;
        case 1: { const int blk = c >> 5, p = c & 31, e = 16 * ((p >> 2) & 1) + 4 * (p >> 3) + (p & 3);
                  if (blk < 4) return 256 + 32 * blk + e; if (blk == 4) return 640 + e; if (blk == 5 && p < 4) return 1440 + p; return -1; }
        case 2: return 384 + c;
        case 3: return 672 + c;
        case 4: return 928 + c;
        case 5: return 1184 + c;
        case 6: return 1444 + c;
        case 7: return 1700 + c;
        case 8: return 1956 + c;
        default: return 2212 + 256 * (tile - 9) + c;
    }
}
__device__ __forceinline__ void p0_item(unsigned char* ws, LAS unsigned char* lds, int kind, int l, int item, LAS float* scr, int lane) {
    const int K = kind == 1 ? 256 : 1024, N = kind == 0 ? NINP : kind == 1 ? 768 : 1024;
    const int nblk = N / 32, kb = item / nblk, nb = item % nblk, k0 = 64 * kb, n0 = 32 * nb;
    const int n = n0 + (lane & 31);
    const float* src; int ld; int col;
    if (kind == 0) { src = inp(lds, 11) + (size_t)l * D * NIN; ld = NIN; col = win_logical_col(n); }
    else if (kind == 1) { if (n < 256) { src = inp(lds, 13) + (size_t)l * 256 * 256; ld = 256; col = n; } else { src = inp(lds, 14) + (size_t)l * 256 * 512; ld = 512; col = n - 256; } }
    else { src = inp(lds, 17) + (size_t)l * D * D; ld = D; col = n; }
    const float* gain = kind == 0 ? inp(lds, 9) + l * D : kind == 2 ? inp(lds, 16) + l * D : nullptr;
#pragma unroll 8
    for (int i = 0; i < 32; ++i) { const int kk = 2 * i + (lane >> 5); float v = 0.f;
        if (col >= 0) { v = src[(size_t)(k0 + kk) * ld + col]; if (gain) v *= gain[k0 + kk]; }
        scr[kk * 33 + (lane & 31)] = v; }
    asm volatile("s_waitcnt lgkmcnt(0)" ::: "memory");
    bf16_t* WT = (bf16_t*)(ws + (kind == 0 ? WS_WIN + (size_t)l * NINP * D * 2 : kind == 1 ? WS_WUKV + (size_t)l * 768 * 256 * 2 : WS_WOUT + (size_t)l * D * D * 2));
    const int c = lane & 7;
#pragma unroll
    for (int j = 0; j < 4; ++j) { const int nn = (lane >> 3) + 8 * j; const LAS float* s = scr + (8 * c) * 33 + nn;
        u32x4 o; o.x = cvtpk(s[0 * 33], s[1 * 33]); o.y = cvtpk(s[2 * 33], s[3 * 33]); o.z = cvtpk(s[4 * 33], s[5 * 33]); o.w = cvtpk(s[6 * 33], s[7 * 33]);
        *(u32x4*)(WT + (size_t)(n0 + nn) * K + k0 + 8 * c) = o; }
    asm volatile("s_waitcnt lgkmcnt(0)" ::: "memory");
}
__device__ __forceinline__ void p0_prologue(unsigned char* ws, LAS unsigned char* lds) {
    const int tid = fresh_tid(), lane = tid & 63, wid = __builtin_amdgcn_readfirstlane(tid >> 6);
    LAS float* scr = (LAS float*)(lds + wid * 16384);
    const int gw = blockIdx.x * 8 + wid, NGW = gridDim.x * 8;
    constexpr int I0 = 16 * (NINP / 32), I1 = 4 * 24, I2 = 16 * 32, IL = I0 + I1 + I2;
    for (int it = gw; it < IL; it += NGW) {
        const int l = it / IL; int r = it % IL;
        if (r < I0) { p0_item(ws, lds, 0, l, r, scr, lane); continue; } r -= I0;
        if (r < I1) { p0_item(ws, lds, 1, l, r, scr, lane); continue; } r -= I1;
        p0_item(ws, lds, 2, l, r, scr, lane);
    }
    float* rope = (float*)(ws + WS_ROPE);
    for (int e = blockIdx.x * 512 + tid; e < PT * 16; e += gridDim.x * 512) {
        const int pos = e >> 4, i = e & 15;
        double inv = 1.0; for (int k = 0; k < i; ++k) inv *= 0.5623413251903491;
        const double rev = (double)pos * inv * 0.15915494309189535;
        const float fr = (float)(rev - __builtin_rint(rev));
        rope[pos * 32 + i] = __builtin_amdgcn_cosf(fr); rope[pos * 32 + 16 + i] = __builtin_amdgcn_sinf(fr);
    }
}

__device__ __forceinline__ void cvt_rows(const float* src, bf16_t* dst, int W, size_t dst_bstride, int gtid, int nthr) {
    const int per_b = PAST * W / 8, total = SBN * per_b;
    for (int q0 = gtid; q0 < total; q0 += 4 * nthr) {
        f32x4 a[4], b[4];
#pragma unroll
        for (int u = 0; u < 4; ++u) { const int q = q0 + u * nthr; if (q < total) { a[u] = *(const f32x4*)(src + (size_t)q * 8); b[u] = *(const f32x4*)(src + (size_t)q * 8 + 4); } }
#pragma unroll
        for (int u = 0; u < 4; ++u) { const int q = q0 + u * nthr; if (q < total) { const int sb = q / per_b, rem = q % per_b;
            u32x4 o; o.x = cvtpk(a[u][0], a[u][1]); o.y = cvtpk(a[u][2], a[u][3]); o.z = cvtpk(b[u][0], b[u][1]); o.w = cvtpk(b[u][2], b[u][3]);
            *(u32x4*)(dst + (size_t)sb * dst_bstride + (size_t)rem * 8) = o; } }
    }
}
__device__ __forceinline__ void p1_norm(unsigned char* ws, float* out, LAS unsigned char* lds, int l) {
    const int tid = fresh_tid(), lane = tid & 63, wid = __builtin_amdgcn_readfirstlane(tid >> 6);
    const int gw = blockIdx.x * 8 + wid, NGW = gridDim.x * 8;
    bf16_t* XN = (bf16_t*)(ws + WS_XN); const bf16_t* Y = (const bf16_t*)(ws + WS_Y);
    const float* xp = inp(lds, 0); const float* xs = inp(lds, 1); const float* gpost = inp(lds, 10);
    constexpr int RU = 4;
    f32x4 g[4];
    if (l > 0) {
#pragma unroll
        for (int j = 0; j < 4; ++j) g[j] = *(const f32x4*)(gpost + (l - 1) * D + 256 * j + 4 * lane);
    }
    for (int m0 = gw; m0 < M; m0 += RU * NGW) {
        f32x4 v[RU][4]; u32x2 yw[RU][4];
#pragma unroll
        for (int r = 0; r < RU; ++r) { const int m = m0 + r * NGW; if (m < M) {
            const float* base = (l <= 1) ? (m < MP ? xp + (size_t)m * D : xs + (size_t)(m - MP) * D) : out + (size_t)m * D;
#pragma unroll
            for (int j = 0; j < 4; ++j) v[r][j] = *(const f32x4*)(base + 256 * j + 4 * lane);
            if (l > 0) {
#pragma unroll
                for (int j = 0; j < 4; ++j) yw[r][j] = *(const u32x2*)(Y + (size_t)m * D + 256 * j + 4 * lane); } } }
#pragma unroll
        for (int r = 0; r < RU; ++r) { const int m = m0 + r * NGW; if (m < M) {
            float* xres = out + (size_t)m * D;
            if (l > 0) {
                f32x4 y[4]; float s = 0.f;
#pragma unroll
                for (int j = 0; j < 4; ++j) { const u32x2 w = yw[r][j]; y[j] = (f32x4){bf_lo(w.x), bf_hi(w.x), bf_lo(w.y), bf_hi(w.y)}; s += (y[j][0] * y[j][0] + y[j][1] * y[j][1]) + (y[j][2] * y[j][2] + y[j][3] * y[j][3]); }
                const float rr = 1.0f / sqrtf(wave_sum(s) * (1.0f / D) + EPS);
#pragma unroll
                for (int j = 0; j < 4; ++j) { v[r][j] = v[r][j] + y[j] * rr * g[j]; *(f32x4*)(xres + 256 * j + 4 * lane) = v[r][j]; }
            }
            if (l < NL) {
                float s = 0.f;
#pragma unroll
                for (int j = 0; j < 4; ++j) s += (v[r][j][0] * v[r][j][0] + v[r][j][1] * v[r][j][1]) + (v[r][j][2] * v[r][j][2] + v[r][j][3] * v[r][j][3]);
                const float rr = 1.0f / sqrtf(wave_sum(s) * (1.0f / D) + EPS);
#pragma unroll
                for (int j = 0; j < 4; ++j) { u32x2 w; w.x = cvtpk(v[r][j][0] * rr, v[r][j][1] * rr); w.y = cvtpk(v[r][j][2] * rr, v[r][j][3] * rr); *(u32x2*)(XN + (size_t)m * D + 256 * j + 4 * lane) = w; }
            } } }
    }
    if (l == 0) {
        const int gtid = blockIdx.x * 512 + tid, nthr = gridDim.x * 512;
        cvt_rows(inp(lds, 2) + (size_t)l * SBN * PAST * 256, (bf16_t*)(ws + WS_CKVB) + (size_t)M * 256, 256, (size_t)PAST * 256, gtid, nthr);
        cvt_rows(inp(lds, 3) + (size_t)l * SBN * PAST * 32, (bf16_t*)(ws + WS_KR) + (size_t)MP * 32, 32, (size_t)SPITCH * 32, gtid, nthr);
    }
}

__device__ __forceinline__ void st8(bf16_t* p, const f32x4 a, const f32x4 b, float sc) {
    u32x4 w; w.x = cvtpk(a[0] * sc, a[1] * sc); w.y = cvtpk(a[2] * sc, a[3] * sc); w.z = cvtpk(b[0] * sc, b[1] * sc); w.w = cvtpk(b[2] * sc, b[3] * sc); *(u32x4*)p = w;
}
__device__ __forceinline__ float silu_f(float x) { return x * __builtin_amdgcn_rcpf(1.0f + __builtin_amdgcn_exp2f(-x * LOG2E)); }
struct EpiP2 {
    static constexpr bool PERM = true, AFTER_DRAIN = false, MID = false;
    unsigned char* ws; float* out; const float* kvnorm; const float* fbias; int l; LAS float* scr;
    __device__ __forceinline__ void operator()(const pg8::f32x4 (&acc)[2][2][4][2], const pg8::Unit& u, int wr, int wc, int fr, int fq) const {
        int pn = u.pn, rbase = u.pm * 256 + wr * 64 + fr, cw = wc * 32 + 8 * fq;
        asm volatile("" : "+s"(pn), "+v"(rbase), "+v"(cw));
        bf16_t* const QA = WSP(bf16_t, WS_QA); bf16_t* const QB = WSP(bf16_t, WS_QB); bf16_t* const QC = WSP(bf16_t, WS_QC); bf16_t* const KR = (bf16_t*)(ws + kr_off(l)); bf16_t* const KB = WSP(bf16_t, WS_KB); bf16_t* const VB = WSP(bf16_t, WS_VB);
        bf16_t* const KC = WSP(bf16_t, WS_KC); bf16_t* const VC = WSP(bf16_t, WS_VC); bf16_t* const CKVB = WSP(bf16_t, WS_CKVB); bf16_t* const GATE = WSP(bf16_t, WS_GATE); float* const LOGF = WSP(float, WS_LOGF); const float* const rope = WSP(const float, WS_ROPE);
        if (pn == 0 || pn == 3 || pn == 6) {
            const float sc = pn == 0 ? QA_SC : pn == 3 ? QB_SC : QC_SC;
#pragma unroll
            for (int ai = 0; ai < 2; ++ai)
#pragma unroll
                for (int m = 0; m < 4; ++m) { const int row = rbase + ai * 128 + m * 16;
#pragma unroll
                    for (int bj = 0; bj < 2; ++bj) {
                        bf16_t* d = pn == 0 ? QA + (size_t)row * 384 + (2 * bj + (wc >> 1)) * 96 + 32 * (wc & 1) + 8 * fq : (pn == 3 ? QB : QC) + (size_t)row * 256 + 128 * bj + cw;
                        st8(d, acc[ai][bj][m][0], acc[ai][bj][m][1], sc); } }
        } else if (pn >= 9) {
#pragma unroll
            for (int ai = 0; ai < 2; ++ai)
#pragma unroll
                for (int m = 0; m < 4; ++m) { const int row = rbase + ai * 128 + m * 16;
#pragma unroll
                    for (int bj = 0; bj < 2; ++bj) { f32x4 a = acc[ai][bj][m][0], b = acc[ai][bj][m][1];
#pragma unroll
                        for (int j = 0; j < 4; ++j) { a[j] = silu_f(a[j]); b[j] = silu_f(b[j]); }
                        st8(GATE + (size_t)row * D + 256 * (pn - 9) + 128 * bj + cw, a, b, 1.0f); } }
        } else if (pn == 4 || pn == 5 || pn == 7 || pn == 8) {
            bf16_t* buf = pn == 4 ? KB : pn == 5 ? VB : pn == 7 ? KC : VC;
            const size_t offp = pn == 4 ? O_PFK : pn == 5 ? O_PFV : pn == 7 ? O_PSK : O_PSV, offs = pn == 4 ? O_SFK : pn == 5 ? O_SFV : pn == 7 ? O_SSK : O_SSV;
#pragma unroll
            for (int ai = 0; ai < 2; ++ai)
#pragma unroll
                for (int m = 0; m < 4; ++m) { const int row = rbase + ai * 128 + m * 16; const int kr = krow_of(row); float* o = rows_out(out, offp, offs, l, row, 256);
#pragma unroll
                    for (int bj = 0; bj < 2; ++bj) { const int c0 = 128 * bj + cw;
                        st8(buf + (size_t)kr * 256 + c0, acc[ai][bj][m][0], acc[ai][bj][m][1], 1.0f);
                        *(f32x4*)(o + c0) = acc[ai][bj][m][0]; *(f32x4*)(o + c0 + 4) = acc[ai][bj][m][1]; } }
            if (pn == 4 && u.pm < MP / 256) {
                float mx[2] = {0.f, 0.f};
#pragma unroll
                for (int ai = 0; ai < 2; ++ai)
#pragma unroll
                    for (int m = 0; m < 4; ++m)
#pragma unroll
                        for (int bj = 0; bj < 2; ++bj) { const f32x4 x = acc[ai][bj][m][0], y = acc[ai][bj][m][1];
                            float sq = ((x[0] * x[0] + x[1] * x[1]) + (x[2] * x[2] + x[3] * x[3])) + ((y[0] * y[0] + y[1] * y[1]) + (y[2] * y[2] + y[3] * y[3]));
                            sq += __shfl_xor(sq, 16); sq += __shfl_xor(sq, 32); mx[bj] = fmaxf(mx[bj], sq); }
#pragma unroll
                for (int bj = 0; bj < 2; ++bj) { float v = mx[bj];
                    v = fmaxf(v, __shfl_xor(v, 1)); v = fmaxf(v, __shfl_xor(v, 2)); v = fmaxf(v, __shfl_xor(v, 4)); v = fmaxf(v, __shfl_xor(v, 8));
                    if (fr == 0 && fq == 0) __hip_atomic_fetch_max(WSP(unsigned, WS_CTL) + CW_KMAX + ((l * 4 + (u.pm >> 5)) * 4 + 2 * bj + (wc >> 1)) * 2 + (wc & 1), __float_as_uint(v), __ATOMIC_RELAXED, __HIP_MEMORY_SCOPE_AGENT); }
            }
        } else if (pn == 1) {
#pragma unroll
            for (int ai = 0; ai < 2; ++ai)
#pragma unroll
                for (int m = 0; m < 4; ++m) { const int row = rbase + ai * 128 + m * 16; const int pos = pos_of(row);
                    const f32x4 cs = *(const f32x4*)(rope + pos * 32 + 4 * fq), sn = *(const f32x4*)(rope + pos * 32 + 16 + 4 * fq);
                    {
                        const f32x4 x1 = acc[ai][0][m][0], x2 = acc[ai][0][m][1]; const f32x4 y1 = (x1 * cs - x2 * sn) * QA_SC, y2 = (x1 * sn + x2 * cs) * QA_SC;
                        bf16_t* d = QA + (size_t)row * 384 + wc * 96 + 64 + 4 * fq;
                        u32x2 w1, w2; w1.x = cvtpk(y1[0], y1[1]); w1.y = cvtpk(y1[2], y1[3]); w2.x = cvtpk(y2[0], y2[1]); w2.y = cvtpk(y2[2], y2[3]);
                        *(u32x2*)d = w1; *(u32x2*)(d + 16) = w2; }
                    if (wc == 0) {
                        const f32x4 x1 = acc[ai][1][m][0], x2 = acc[ai][1][m][1]; const f32x4 y1 = x1 * cs - x2 * sn, y2 = x1 * sn + x2 * cs;
                        bf16_t* d = KR + (size_t)krow_of(row) * 32 + 4 * fq;
                        u32x2 w1, w2; w1.x = cvtpk(y1[0], y1[1]); w1.y = cvtpk(y1[2], y1[3]); w2.x = cvtpk(y2[0], y2[1]); w2.y = cvtpk(y2[2], y2[3]);
                        *(u32x2*)d = w1; *(u32x2*)(d + 16) = w2;
                        float* o = rows_out(out, O_PKPE, O_SKPE, l, row, 32) + 4 * fq; *(f32x4*)o = y1; *(f32x4*)(o + 16) = y2;
                    } else if (wc == 1 && fq == 0) {
                        f32x4 v = acc[ai][1][m][0] + *(const f32x4*)fbias; f32x4 lf;
#pragma unroll
                        for (int j = 0; j < 4; ++j) lf[j] = fminf(v[j], 0.f) - __logf(1.0f + __expf(-fabsf(v[j])));
                        *(f32x4*)rows_out(out, O_PLF, O_SLF, l, row, 4) = lf; *(f32x4*)(LOGF + (size_t)krow_of(row) * 4) = lf;
                    } }
        } else {
            float ssq[2][4];
#pragma unroll
            for (int ai = 0; ai < 2; ++ai)
#pragma unroll
                for (int m = 0; m < 4; ++m) { float s = 0.f;
#pragma unroll
                    for (int bj = 0; bj < 2; ++bj)
#pragma unroll
                        for (int n = 0; n < 2; ++n) { const f32x4 x = acc[ai][bj][m][n]; s += (x[0] * x[0] + x[1] * x[1]) + (x[2] * x[2] + x[3] * x[3]); }
                    s += __shfl_xor(s, 16); s += __shfl_xor(s, 32);
                    if (fq == 0) scr[(ai * 128 + wr * 64 + m * 16 + fr) * 4 + wc] = s; }
            asm volatile("s_waitcnt lgkmcnt(0)" ::: "memory"); __builtin_amdgcn_s_barrier(); asm volatile("" ::: "memory");
#pragma unroll
            for (int ai = 0; ai < 2; ++ai)
#pragma unroll
                for (int m = 0; m < 4; ++m) { const f32x4 p4 = *(const LAS f32x4*)(scr + (ai * 128 + wr * 64 + m * 16 + fr) * 4); ssq[ai][m] = (p4[0] + p4[1]) + (p4[2] + p4[3]); }
#pragma unroll
            for (int ai = 0; ai < 2; ++ai)
#pragma unroll
                for (int m = 0; m < 4; ++m) { const int row = rbase + ai * 128 + m * 16; const float r = 1.0f / sqrtf(ssq[ai][m] * (1.0f / 256.0f) + EPS); float* o = rows_out(out, O_PCKV, O_SCKV, l, row, 256);
#pragma unroll
                    for (int bj = 0; bj < 2; ++bj) { const int c0 = 128 * bj + cw;
                        const f32x4 a = acc[ai][bj][m][0] * r * *(const f32x4*)(kvnorm + c0), b = acc[ai][bj][m][1] * r * *(const f32x4*)(kvnorm + c0 + 4);
                        st8(CKVB + (size_t)row * 256 + c0, a, b, 1.0f); *(f32x4*)(o + c0) = a; *(f32x4*)(o + c0 + 4) = b; } }
        }
    }
};
struct EpiP3 {
    static constexpr bool PERM = true, AFTER_DRAIN = false, MID = false;
    unsigned char* ws;
    __device__ __forceinline__ void operator()(const pg8::f32x4 (&acc)[2][2][4][2], const pg8::Unit& u, int wr, int wc, int fr, int fq) const {
        int pn = u.pn, rbase = u.pm * 256 + wr * 64 + fr, cw = wc * 32 + 8 * fq;
        asm volatile("" : "+s"(pn), "+v"(rbase), "+v"(cw));
        bf16_t* const KA = WSP(bf16_t, WS_KA); bf16_t* const VA = WSP(bf16_t, WS_VA);
#pragma unroll
        for (int ai = 0; ai < 2; ++ai)
#pragma unroll
            for (int m = 0; m < 4; ++m) { const int row = rbase + ai * 128 + m * 16;
                const int dest = row < M ? krow_of(row) : MP + ((row - M) >> 11) * SPITCH + ((row - M) & 2047);
#pragma unroll
                for (int bj = 0; bj < 2; ++bj) { bf16_t* d = pn == 0 ? KA + (size_t)dest * 256 + 128 * bj + cw : VA + (size_t)dest * 512 + 256 * (pn - 1) + 128 * bj + cw;
                    st8(d, acc[ai][bj][m][0], acc[ai][bj][m][1], 1.0f); } }
    }
};
struct EpiP5 {
    static constexpr bool PERM = true, AFTER_DRAIN = false, MID = true; static constexpr int MID_T0 = 8, MID_T1 = 12;
    unsigned char* ws; LAS float* tab;
    __device__ __forceinline__ void prep(const pg8::Unit& u, int par, int tid) const {
        if (tid < 256) { const float* ss = WSP(const float, WS_SS) + (size_t)(u.pm * 256 + tid) * 12;
            const f32x4 a = *(const f32x4*)ss, b = *(const f32x4*)(ss + 4), c = *(const f32x4*)(ss + 8);
            const float ra = 1.0f / sqrtf(((a[0] + a[1]) + (a[2] + a[3])) * (1.0f / 512.0f) + EPS), rb = 1.0f / sqrtf(((b[0] + b[1]) + (b[2] + b[3])) * (1.0f / 256.0f) + EPS), rc = 1.0f / sqrtf(((c[0] + c[1]) + (c[2] + c[3])) * (1.0f / 256.0f) + EPS);
            *(LAS f32x4*)(tab + (par * 256 + tid) * 4) = (f32x4){ra / rb, rb / rc, rc, 0.f}; }
    }
    __device__ __forceinline__ void mid(pg8::f32x4 (&acc)[2][2][4][2], int par, int which, int wr, int fr) const {
#pragma unroll
        for (int ai = 0; ai < 2; ++ai)
#pragma unroll
            for (int m = 0; m < 4; ++m) { const f32x4 t4 = *(const LAS f32x4*)(tab + (par * 256 + ai * 128 + wr * 64 + m * 16 + fr) * 4); const float f = which == 0 ? t4[0] : which == 1 ? t4[1] : t4[2];
#pragma unroll
                for (int bj = 0; bj < 2; ++bj)
#pragma unroll
                    for (int n = 0; n < 2; ++n) acc[ai][bj][m][n] = acc[ai][bj][m][n] * f; }
    }
    __device__ __forceinline__ void operator()(const pg8::f32x4 (&acc)[2][2][4][2], const pg8::Unit& u, int wr, int wc, int fr, int fq) const {
        int rbase = u.pm * 256 + wr * 64 + fr, cw = u.pn * 256 + wc * 32 + 8 * fq; bf16_t* const Y = WSP(bf16_t, WS_Y);
        asm volatile("" : "+v"(rbase), "+v"(cw));
#pragma unroll
        for (int ai = 0; ai < 2; ++ai)
#pragma unroll
            for (int m = 0; m < 4; ++m) { const int row = rbase + ai * 128 + m * 16;
#pragma unroll
                for (int bj = 0; bj < 2; ++bj) st8(Y + (size_t)row * D + 128 * bj + cw, acc[ai][bj][m][0], acc[ai][bj][m][1], 1.0f); }
    }
};

__device__ __forceinline__ void cumsum_task(unsigned char* ws, int l, int task, LAS unsigned char* lds) {
    const int tid = fresh_tid(), lane = tid & 63, wid = tid >> 6;
    const float* LOGF = (const float*)(ws + WS_LOGF); float* FB = (float*)(ws + WS_FB);
    const bool prompt = task < 4; const int sb = task - 4;
    const int n = prompt ? PT : SKEYS, CH = prompt ? 16 : 5;
    const int krow0 = prompt ? task * PT : MP + sb * SPITCH;
    const float* cache = inp(lds, 6) + ((size_t)l * SBN + (prompt ? 0 : sb)) * PAST * 4;
    const int t0 = tid * CH;
    f32x4 s = {0.f, 0.f, 0.f, 0.f};
    for (int i = 0; i < CH; ++i) { const int t = t0 + i; if (t < n) { const f32x4 v = (!prompt && t < PAST) ? *(const f32x4*)(cache + (size_t)t * 4) : *(const f32x4*)(LOGF + (size_t)(krow0 + t) * 4); s = s + v; } }
    const f32x4 own = s;
#pragma unroll
    for (int off = 1; off < 64; off <<= 1) {
#pragma unroll
        for (int c = 0; c < 4; ++c) { const float t = __shfl_up(s[c], off); if (lane >= off) s[c] += t; } }
    LAS f32x4* wt = (LAS f32x4*)lds;
    if (lane == 63) wt[wid] = s;
    __syncthreads();
    f32x4 pre = s - own;
    for (int w = 0; w < wid; ++w) pre = pre + wt[w];
    for (int i = 0; i < CH; ++i) { const int t = t0 + i; if (t < n) { const f32x4 v = (!prompt && t < PAST) ? *(const f32x4*)(cache + (size_t)t * 4) : *(const f32x4*)(LOGF + (size_t)(krow0 + t) * 4); pre = pre + v;
        *(f32x4*)(FB + (size_t)(krow0 + t) * 4) = pre * LOG2E; } }
    __syncthreads();
}

#define MFMA32(a, b, c) __builtin_amdgcn_mfma_f32_32x32x16_bf16((a), (b), (c), 0, 0, 0)
__device__ __forceinline__ s16x4 tr_rd(const LAS unsigned char* p) { typedef short v4i16_t __attribute__((ext_vector_type(4))); return __builtin_bit_cast(s16x4, __builtin_amdgcn_ds_read_tr16_b64_v4i16((LAS v4i16_t*)p)); }
__device__ __forceinline__ bf16x8 pack8(const f32x16& p, int b) {
    u32x4 w; w.x = cvtpk(p[b], p[b + 1]); w.y = cvtpk(p[b + 2], p[b + 3]); w.z = cvtpk(p[b + 4], p[b + 5]); w.w = cvtpk(p[b + 6], p[b + 7]); return __builtin_bit_cast(bf16x8, w);
}
template <int TYPE, bool SAMP>
__device__ __forceinline__ void attn_unit(unsigned char* ws, LAS unsigned char* lds, int l, int qrow0, int nq, int krow0, int qpos0, int nkeys, int h) {
    constexpr int DQK = TYPE == 0 ? 96 : 64, DV = TYPE == 0 ? 128 : 64, NS = DQK / 16, NDB = DV / 32;
    constexpr int KP = TYPE == 0 ? 208 : 144, VP = TYPE == 0 ? 320 : 192;
    constexpr int KBYTES = 64 * KP, VBYTES = 64 * VP, BUFB = KBYTES + VBYTES, OFF_F = 2 * BUFB, OFF_FLAG = OFF_F + 512;
    const int tid = fresh_tid(), lane = tid & 63, wid = __builtin_amdgcn_readfirstlane(tid >> 6), r32 = lane & 31, hh = lane >> 5;
    const bool wave_on = 32 * wid < nq;
    const int qloc = min(32 * wid + r32, nq - 1);
    const int qrow = qrow0 + qloc;
    const int qpos = qpos0 + 32 * wid + r32;
    const int qp_lo = qpos0 + 32 * wid, qp_hi = qp_lo + 31;
    const int jmax = (qpos0 + nq - 1) >> 6;
    const int wjmax = TYPE == 0 ? (qp_lo >> 6) : TYPE == 1 ? (qp_hi >> 6) : ((qp_hi - 1) >> 6);
    const bf16_t* Kg = TYPE == 0 ? WSP(const bf16_t, WS_KA) : TYPE == 1 ? WSP(const bf16_t, WS_KB) : WSP(const bf16_t, WS_KC); const bf16_t* Vg = TYPE == 0 ? WSP(const bf16_t, WS_VA) : TYPE == 1 ? WSP(const bf16_t, WS_VB) : WSP(const bf16_t, WS_VC);
    constexpr int NKC = TYPE == 0 ? 2 : 1, NVC = TYPE == 0 ? 2 : 1;
    const bf16_t* ksrc[NKC]; int kdst[NKC]; bool kval[NKC]; const bf16_t* vsrc[NVC]; int vdst[NVC];
#pragma unroll
    for (int r = 0; r < NKC; ++r) {
        if (TYPE == 0) { const int n = tid + 512 * r; kval[r] = n < 768; const int nn = kval[r] ? n : 0; const int row = nn / 12, c = nn % 12;
            ksrc[r] = c < 8 ? WSP(const bf16_t, WS_KA) + (size_t)(krow0 + row) * 256 + h * 64 + c * 8 : (const bf16_t*)(ws + kr_off(l)) + (size_t)(krow0 + row) * 32 + (c - 8) * 8; kdst[r] = row * KP + c * 16; }
        else { const int row = tid >> 3, c = tid & 7; kval[r] = true; ksrc[r] = Kg + (size_t)(krow0 + row) * 256 + h * 64 + c * 8; kdst[r] = row * KP + c * 16; }
    }
#pragma unroll
    for (int r = 0; r < NVC; ++r) {
        if (TYPE == 0) { const int n = tid + 512 * r; const int row = n >> 4, c = n & 15; vsrc[r] = WSP(const bf16_t, WS_VA) + (size_t)(krow0 + row) * 512 + h * 128 + c * 8; vdst[r] = row * VP + c * 16; }
        else { const int row = tid >> 3, c = tid & 7; vsrc[r] = Vg + (size_t)(krow0 + row) * 256 + h * 64 + c * 8; vdst[r] = row * VP + c * 16; }
    }
    const size_t kstepA = (size_t)64 * 256, kstepR = (size_t)64 * 32, vstep = (size_t)64 * (TYPE == 0 ? 512 : 256);
    u32x4 kreg[NKC], vreg[NVC]; float freg = 0.f;
    constexpr bool F32C = SAMP && TYPE != 0;
    const float* kc32 = nullptr; const float* vc32 = nullptr; u32x4 kx[2], vx[2]; bool ld32 = false;
    if (F32C) { const int sb = (krow0 - MP) / SPITCH; const size_t o32 = (((size_t)l * SBN + sb) * PAST + (tid >> 3)) * 256 + h * 64 + (tid & 7) * 8;
        kc32 = inp(lds, TYPE == 1 ? 4 : 7) + o32; vc32 = inp(lds, TYPE == 1 ? 5 : 8) + o32; }
#define ATT_LOAD(j) do { if (F32C && (j) < PAST / 64) { ld32 = true; const size_t t_ = (size_t)(j) * 64 * 256; \
            kx[0] = *(const u32x4*)(kc32 + t_); kx[1] = *(const u32x4*)(kc32 + t_ + 4); vx[0] = *(const u32x4*)(vc32 + t_); vx[1] = *(const u32x4*)(vc32 + t_ + 4); } else { ld32 = false; \
        _Pragma("unroll") for (int r_ = 0; r_ < NKC; ++r_) { const bool rope_ = (TYPE == 0) && (((tid + 512 * r_) % 12) >= 8); \
            if (kval[r_]) kreg[r_] = *(const u32x4*)(ksrc[r_] + (size_t)(j) * (rope_ ? kstepR : kstepA)); } \
        _Pragma("unroll") for (int r_ = 0; r_ < NVC; ++r_) vreg[r_] = *(const u32x4*)(vsrc[r_] + (size_t)(j) * vstep); } \
        if (TYPE == 1 && tid < 64) freg = WSP(const float, WS_FB)[(size_t)(krow0 + 64 * (j) + tid) * 4 + h]; } while (0)
#define ATT_STORE(b) do { LAS unsigned char* kb_ = lds + (b) * BUFB; \
        if (F32C && ld32) { kreg[0] = (u32x4){cvtpk(__uint_as_float(kx[0].x), __uint_as_float(kx[0].y)), cvtpk(__uint_as_float(kx[0].z), __uint_as_float(kx[0].w)), cvtpk(__uint_as_float(kx[1].x), __uint_as_float(kx[1].y)), cvtpk(__uint_as_float(kx[1].z), __uint_as_float(kx[1].w))}; \
            vreg[0] = (u32x4){cvtpk(__uint_as_float(vx[0].x), __uint_as_float(vx[0].y)), cvtpk(__uint_as_float(vx[0].z), __uint_as_float(vx[0].w)), cvtpk(__uint_as_float(vx[1].x), __uint_as_float(vx[1].y)), cvtpk(__uint_as_float(vx[1].z), __uint_as_float(vx[1].w))}; } \
        _Pragma("unroll") for (int r_ = 0; r_ < NKC; ++r_) if (kval[r_]) *(LAS u32x4*)(kb_ + kdst[r_]) = kreg[r_]; \
        _Pragma("unroll") for (int r_ = 0; r_ < NVC; ++r_) *(LAS u32x4*)(kb_ + KBYTES + vdst[r_]) = vreg[r_]; \
        if (TYPE == 1 && tid < 64) ((LAS float*)(lds + OFF_F))[(b) * 64 + tid] = freg; } while (0)
    bf16x8 qf[NS];
    { const bf16_t* qp = TYPE == 0 ? WSP(const bf16_t, WS_QA) + (size_t)qrow * 384 + h * 96 : (TYPE == 1 ? WSP(const bf16_t, WS_QB) : WSP(const bf16_t, WS_QC)) + (size_t)qrow * 256 + h * 64;
#pragma unroll
      for (int s = 0; s < NS; ++s) qf[s] = *(const bf16x8*)(qp + 16 * s + 8 * hh); }
    float fq = 0.f; if (TYPE == 1) fq = WSP(const float, WS_FB)[(size_t)(krow0 + min(qpos, nkeys - 1)) * 4 + h];
    float bound = INFINITY;
    if (TYPE == 1 && nq == 256) {
        float qn = 0.f;
#pragma unroll
        for (int s = 0; s < NS; ++s)
#pragma unroll
            for (int e = 0; e < 8; ++e) { const float x = __uint_as_float((unsigned)(unsigned short)qf[s][e] << 16); qn += x * x; }
        qn = half_swap_sum(qn);
        const unsigned* km = WSP(const unsigned, WS_CTL) + CW_KMAX + ((l * 4 + krow0 / PT) * 4 + h) * 2;
        bound = sqrtf(qn * (__uint_as_float(km[0]) + __uint_as_float(km[1]))) * 1.02f + 1.0f;
    }
    f32x16 o[NDB];
#pragma unroll
    for (int d = 0; d < NDB; ++d)
#pragma unroll
        for (int i = 0; i < 16; ++i) o[d][i] = 0.f;
    float mrun = 0.f, lrun = 0.f, carry = 0.f; bool wdone = !wave_on;
    f32x16 negc;
#pragma unroll
    for (int i = 0; i < 16; ++i) negc[i] = (TYPE == 1) ? fq : 0.f;
    LAS unsigned* flags = (LAS unsigned*)(lds + OFF_FLAG);
    if (TYPE != 0 && lane == 0) { flags[wid] = wave_on ? 0u : 1u; flags[8 + wid] = wave_on ? 0u : 1u; }
    const int pir = (r32 & ~12) | ((r32 & 4) << 1) | ((r32 & 8) >> 1);
    const int krd = pir * KP + 16 * hh;
    const int vrd = (8 * hh + ((lane & 15) >> 2)) * VP + 32 * ((lane >> 4) & 1) + 8 * (lane & 3);
    ATT_LOAD(jmax); ATT_STORE(0);
    for (int j = jmax; j >= 0; --j) {
        const int buf = (jmax - j) & 1;
        if (j > 0) ATT_LOAD(j - 1);
        __syncthreads();
        if (TYPE != 0) { const u32x4 f0 = *(const LAS u32x4*)(flags + 8 * buf), f1 = *(const LAS u32x4*)(flags + 8 * buf + 4);
            const unsigned all = f0.x & f0.y & f0.z & f0.w & f1.x & f1.y & f1.z & f1.w; if (__builtin_amdgcn_readfirstlane(all)) break; }
        if (wave_on && !wdone && j <= wjmax) {
            const LAS unsigned char* Kb = lds + buf * BUFB; const LAS unsigned char* Vb = Kb + KBYTES;
            f32x16 s0, s1;
            {
                bf16x8 kf0[NS], kf1[NS];
#pragma unroll
                for (int s = 0; s < NS; ++s) { kf0[s] = *(const LAS bf16x8*)(Kb + krd + 32 * s); kf1[s] = *(const LAS bf16x8*)(Kb + krd + 32 * KP + 32 * s); }
                __builtin_amdgcn_sched_barrier(0);

#pragma unroll
                for (int s = 0; s < NS; ++s) { if (s == 0) { s0 = MFMA32(kf0[0], qf[0], negc); s1 = MFMA32(kf1[0], qf[0], negc); } else { s0 = MFMA32(kf0[s], qf[s], s0); s1 = MFMA32(kf1[s], qf[s], s1); } }

                __builtin_amdgcn_sched_barrier(0);
            }
            s16x4 vl[2][4], vh[2][4];
#pragma unroll
            for (int ks = 0; ks < 4; ++ks) { vl[0][ks] = tr_rd(Vb + vrd + (16 * ks) * VP); vh[0][ks] = tr_rd(Vb + vrd + (16 * ks + 4) * VP); }
            __builtin_amdgcn_sched_barrier(0);
            const int kb0 = 64 * j + 8 * hh;
            const bool need_mask = TYPE == 0 ? (64 * j + 63 >= nkeys) : TYPE == 1 ? (64 * j + 63 > qp_lo) : (64 * j + 63 >= qp_lo);
            if (TYPE != 2) {
                if (TYPE == 1) { const LAS float* F = (const LAS float*)(lds + OFF_F) + buf * 64 + 8 * hh;
#pragma unroll
                    for (int a = 0; a < 2; ++a) { const f32x4 f0 = *(const LAS f32x4*)(F + 16 * a), f1 = *(const LAS f32x4*)(F + 16 * a + 4), g0 = *(const LAS f32x4*)(F + 32 + 16 * a), g1 = *(const LAS f32x4*)(F + 32 + 16 * a + 4);
#pragma unroll
                        for (int e = 0; e < 4; ++e) { s0[8 * a + e] -= f0[e]; s0[8 * a + 4 + e] -= f1[e]; s1[8 * a + e] -= g0[e]; s1[8 * a + 4 + e] -= g1[e]; } } }
                if (need_mask) {
#pragma unroll
                    for (int i = 0; i < 16; ++i) { const int k0 = kb0 + 16 * (i >> 3) + (i & 7), k1 = k0 + 32;
                        const bool ok0 = TYPE == 0 ? (k0 < nkeys) : (k0 <= qpos), ok1 = TYPE == 0 ? (k1 < nkeys) : (k1 <= qpos);
                        s0[i] = ok0 ? s0[i] : -INFINITY; s1[i] = ok1 ? s1[i] : -INFINITY; } }
#define MX3(a, b, c) __builtin_fmaxf(__builtin_fmaxf((a), (b)), (c))
                float rm;
                { const float t0 = MX3(s0[0], s0[1], s0[2]), t1 = MX3(s0[3], s0[4], s0[5]), t2 = MX3(s0[6], s0[7], s0[8]), t3 = MX3(s0[9], s0[10], s0[11]), t4 = MX3(s0[12], s0[13], s0[14]),
                              t5 = MX3(s1[0], s1[1], s1[2]), t6 = MX3(s1[3], s1[4], s1[5]), t7 = MX3(s1[6], s1[7], s1[8]), t8 = MX3(s1[9], s1[10], s1[11]), t9 = MX3(s1[12], s1[13], s1[14]);
                  const float u0 = MX3(t0, t1, t2), u1 = MX3(t3, t4, t5), u2 = MX3(t6, t7, t8), u3 = MX3(t9, s0[15], s1[15]); rm = __builtin_fmaxf(MX3(u0, u1, u2), u3); }
#undef MX3
                rm = half_swap_max(rm);
                const bool first = (j == wjmax);
                if (first || __any(rm > 8.0f)) {
                    const float dl = first ? rm : fmaxf(rm, 0.f);
                    mrun += dl;
#pragma unroll
                    for (int i = 0; i < 16; ++i) { s0[i] -= dl; s1[i] -= dl; }
                    const float cin = (TYPE == 1 ? fq : 0.f) - mrun;
#pragma unroll
                    for (int i = 0; i < 16; ++i) negc[i] = cin;
                    if (!first) { const float f = __builtin_amdgcn_exp2f(-dl); lrun *= f;
#pragma unroll
                        for (int d = 0; d < NDB; ++d)
#pragma unroll
                            for (int i = 0; i < 16; ++i) o[d][i] *= f; }
                }
                f32x2_t ls2 = {0.f, 0.f};
#pragma unroll
                for (int i = 0; i < 16; ++i) { s0[i] = __builtin_amdgcn_exp2f(s0[i]); s1[i] = __builtin_amdgcn_exp2f(s1[i]); }
#pragma unroll
                for (int i = 0; i < 16; i += 2) { ls2 += (f32x2_t){s0[i], s0[i + 1]}; ls2 += (f32x2_t){s1[i], s1[i + 1]}; }
                lrun += ls2[0] + ls2[1];
                if (TYPE == 1 && j > 0) { const float fnext = WSP(const float, WS_FB)[(size_t)(krow0 + 64 * j - 1) * 4 + h]; wdone = __all(bound + (fq - fnext) - mrun < -150.0f); }
            } else {
                f32x16 lk0, lk1;
#pragma unroll
                for (int i = 0; i < 16; ++i) {
                    const float z0 = s0[i], z1 = s1[i];
                    const float sp0 = fmaxf(z0, 0.f) + __builtin_amdgcn_logf(1.0f + __builtin_amdgcn_exp2f(-fabsf(z0))), sp1 = fmaxf(z1, 0.f) + __builtin_amdgcn_logf(1.0f + __builtin_amdgcn_exp2f(-fabsf(z1)));
                    lk0[i] = -sp0; lk1[i] = -sp1; s0[i] = z0 - sp0; s1[i] = z1 - sp1; }
                if (need_mask) {
#pragma unroll
                    for (int i = 0; i < 16; ++i) { const int k0 = kb0 + 16 * (i >> 3) + (i & 7), k1 = k0 + 32; const bool ok0 = k0 < qpos, ok1 = k1 < qpos;
                        lk0[i] = ok0 ? lk0[i] : 0.f; lk1[i] = ok1 ? lk1[i] : 0.f; s0[i] = ok0 ? s0[i] : -INFINITY; s1[i] = ok1 ? s1[i] : -INFINITY; } }
                f32x16 sf0, sf1; float gt[4];
#pragma unroll
                for (int a = 0; a < 2; ++a) { float r0 = 0.f, r1 = 0.f;
#pragma unroll
                    for (int e = 7; e >= 0; --e) { sf0[8 * a + e] = r0; r0 += lk0[8 * a + e]; sf1[8 * a + e] = r1; r1 += lk1[8 * a + e]; }
                    gt[a] = r0; gt[2 + a] = r1; }
                float pt[4], gs[4];
#pragma unroll
                for (int c = 0; c < 4; ++c) pt[c] = __shfl_xor(gt[c], 32);
                float later = 0.f;
#pragma unroll
                for (int c = 3; c >= 0; --c) { gs[c] = later + (hh == 0 ? pt[c] : 0.f); later += gt[c] + pt[c]; }
#pragma unroll
                for (int i = 0; i < 16; ++i) { s0[i] = __builtin_amdgcn_exp2f(s0[i] + sf0[i] + gs[i >> 3] + carry); s1[i] = __builtin_amdgcn_exp2f(s1[i] + sf1[i] + gs[2 + (i >> 3)] + carry); }
                carry += later;
                wdone = __all(carry < -160.0f);
            }
            bf16x8 pk[4]; pk[0] = pack8(s0, 0); pk[1] = pack8(s0, 8); pk[2] = pack8(s1, 0); pk[3] = pack8(s1, 8);
            {
#pragma unroll
                for (int d = 0; d < NDB; ++d) {
                    if (d + 1 < NDB) {
#pragma unroll
                        for (int ks = 0; ks < 4; ++ks) { vl[(d + 1) & 1][ks] = tr_rd(Vb + vrd + (16 * ks) * VP + 64 * (d + 1)); vh[(d + 1) & 1][ks] = tr_rd(Vb + vrd + (16 * ks + 4) * VP + 64 * (d + 1)); } }
                    __builtin_amdgcn_sched_barrier(0);

#pragma unroll
                    for (int ks = 0; ks < 4; ++ks) { const bf16x8 vf = __builtin_shufflevector(vl[d & 1][ks], vh[d & 1][ks], 0, 1, 2, 3, 4, 5, 6, 7); o[d] = MFMA32(vf, pk[ks], o[d]); }

                    __builtin_amdgcn_sched_barrier(0);
                }
            }
        }
        if (TYPE != 0 && lane == 0) flags[8 * (buf ^ 1) + wid] = wdone ? 1u : 0u;
        if (j > 0) ATT_STORE(buf ^ 1);
    }
    __syncthreads();
    if (wave_on) {
        float inv = 1.0f;
        if (TYPE != 2) { const float lt = half_swap_sum(lrun); inv = 1.0f / lt; }
        float ssq = 0.f;
#pragma unroll
        for (int d = 0; d < NDB; ++d)
#pragma unroll
            for (int i = 0; i < 16; ++i) { o[d][i] *= inv; ssq += o[d][i] * o[d][i]; }
        ssq = half_swap_sum(ssq);
        const bool rowok = 32 * wid + r32 < nq;
        if (rowok) {
            if (hh == 0) WSP(float, WS_SS)[(size_t)qrow * 12 + TYPE * 4 + h] = ssq;
            const int col0 = (TYPE == 0 ? 0 : TYPE == 1 ? 512 : 768) + h * DV + 4 * hh;
#pragma unroll
            for (int d = 0; d < NDB; ++d) { u32x2 gw[4];
#pragma unroll
                for (int g = 0; g < 4; ++g) gw[g] = *(const u32x2*)(WSP(const bf16_t, WS_GATE) + (size_t)qrow * D + col0 + 32 * d + 8 * g);
#pragma unroll
                for (int g = 0; g < 4; ++g) { u32x2 w; w.x = cvtpk(o[d][4 * g] * bf_lo(gw[g].x), o[d][4 * g + 1] * bf_hi(gw[g].x)); w.y = cvtpk(o[d][4 * g + 2] * bf_lo(gw[g].y), o[d][4 * g + 3] * bf_hi(gw[g].y));
                    *(u32x2*)(WSP(bf16_t, WS_OP) + (size_t)qrow * D + col0 + 32 * d + 8 * g) = w; } }
        }
    }
#undef ATT_LOAD
#undef ATT_STORE
}

template <int TYPE>
__device__ __forceinline__ void sample_octet(unsigned char* ws, float* out, LAS unsigned char* lds, int l, int oct) {
    constexpr int DQK = TYPE == 0 ? 96 : 64, DV = TYPE == 0 ? 128 : 64, NS = DQK / 16, NDB = DV / 32, VP = TYPE == 0 ? 320 : 192;
    constexpr int NT = 65;
    const int tid = fresh_tid(), lane = tid & 63, wid = __builtin_amdgcn_readfirstlane(tid >> 6), r32 = lane & 31, hh = lane >> 5;
    const int unit = oct * 8 + wid, sb = unit >> 2, h = unit & 3;
    LAS unsigned char* Vl = lds + wid * 10240;
    const int krow0 = MP + sb * SPITCH, qrow = MP + sb * STN + min(r32, STN - 1), qpos = PAST + r32;
    bf16x8 qf[NS];
    { const bf16_t* qp = TYPE == 0 ? WSP(const bf16_t, WS_QA) + (size_t)qrow * 384 + h * 96 : (TYPE == 1 ? WSP(const bf16_t, WS_QB) : WSP(const bf16_t, WS_QC)) + (size_t)qrow * 256 + h * 64;
#pragma unroll
      for (int s = 0; s < NS; ++s) qf[s] = *(const bf16x8*)(qp + 16 * s + 8 * hh); }
    float fq = 0.f; if (TYPE == 1) fq = WSP(const float, WS_FB)[(size_t)(krow0 + min(qpos, SKEYS - 1)) * 4 + h];
    const int pir = (r32 & ~12) | ((r32 & 4) << 1) | ((r32 & 8) >> 1);
    const float* kc = nullptr; const float* vc = nullptr; const float* kn = nullptr; const float* vn = nullptr;
    if (TYPE != 0) { const size_t cb = ((size_t)l * SBN + sb) * PAST * 256 + h * 64, nb = ((size_t)l * MS + sb * STN) * 256 + h * 64;
        kc = inp(lds, TYPE == 1 ? 4 : 7) + cb; vc = inp(lds, TYPE == 1 ? 5 : 8) + cb; kn = out + (TYPE == 1 ? O_SFK : O_SSK) + nb; vn = out + (TYPE == 1 ? O_SFV : O_SSV) + nb; }
    const bf16_t* KAp = WSP(const bf16_t, WS_KA) + (size_t)krow0 * 256 + h * 64; const bf16_t* KRp = (const bf16_t*)(ws + kr_off(l)) + (size_t)krow0 * 32; const bf16_t* VAp = WSP(const bf16_t, WS_VA) + (size_t)krow0 * 512 + h * 128;
    constexpr int NKR = TYPE == 0 ? NS : 2 * NS, NVR = 8;
    constexpr int PD = 1;
    u32x4 kraw[PD][NKR], vraw[PD][NVR]; float fkr[2][2] = {{0.f, 0.f}, {0.f, 0.f}};
#define SO_LOAD(t, S) do { \
        if (TYPE == 0) { const size_t kr_ = (size_t)(32 * (t) + pir); \
            _Pragma("unroll") for (int s_ = 0; s_ < NS; ++s_) kraw[S][s_] = s_ < 4 ? *(const u32x4*)(KAp + kr_ * 256 + 16 * s_ + 8 * hh) : *(const u32x4*)(KRp + kr_ * 32 + 16 * (s_ - 4) + 8 * hh); \
            _Pragma("unroll") for (int i_ = 0; i_ < 8; ++i_) { const int m_ = lane + 64 * i_; vraw[S][i_] = *(const u32x4*)(VAp + (size_t)(32 * (t) + (m_ >> 4)) * 512 + (m_ & 15) * 8); } \
        } else { const float* kb_ = (t) < 64 ? kc + (size_t)(t) * 32 * 256 : kn; const float* vb_ = (t) < 64 ? vc + (size_t)(t) * 32 * 256 : vn; \
            const int rcap_ = (t) < 64 ? 31 : STN - 1;         \
            _Pragma("unroll") for (int s_ = 0; s_ < NS; ++s_) { const float* p_ = kb_ + (size_t)min(pir, rcap_) * 256 + 16 * s_ + 8 * hh; kraw[S][2 * s_] = *(const u32x4*)p_; kraw[S][2 * s_ + 1] = *(const u32x4*)(p_ + 4); } \
            _Pragma("unroll") for (int i_ = 0; i_ < 4; ++i_) { const int m_ = lane + 64 * i_; const float* p_ = vb_ + (size_t)min(m_ >> 3, rcap_) * 256 + (m_ & 7) * 8; vraw[S][2 * i_] = *(const u32x4*)p_; vraw[S][2 * i_ + 1] = *(const u32x4*)(p_ + 4); } \
            if (TYPE == 1) { fkr[S][0] = WSP(const float, WS_FB)[(size_t)(krow0 + 32 * (t) + 8 * hh + (lane & 7)) * 4 + h]; fkr[S][1] = WSP(const float, WS_FB)[(size_t)(krow0 + 32 * (t) + 16 + 8 * hh + (lane & 7)) * 4 + h]; } } } while (0)
#define F2B(a, b) (u32x4){cvtpk(__uint_as_float((a).x), __uint_as_float((a).y)), cvtpk(__uint_as_float((a).z), __uint_as_float((a).w)), cvtpk(__uint_as_float((b).x), __uint_as_float((b).y)), cvtpk(__uint_as_float((b).z), __uint_as_float((b).w))}
    f32x16 o[NDB];
#pragma unroll
    for (int d = 0; d < NDB; ++d)
#pragma unroll
        for (int i = 0; i < 16; ++i) o[d][i] = 0.f;
    float mrun = 0.f, lrun = 0.f, carry = 0.f; bool done = false;
    f32x16 negc;
#pragma unroll
    for (int i = 0; i < 16; ++i) negc[i] = (TYPE == 1) ? fq : 0.f;
    const int vrd = (8 * hh + ((lane & 15) >> 2)) * VP + 32 * ((lane >> 4) & 1) + 8 * (lane & 3);
#define SO_BODY(t, S) do { \
        bf16x8 kf[NS]; const float fk0 = fkr[S][0], fk1 = fkr[S][1]; \
        _Pragma("unroll") for (int s = 0; s < NS; ++s) kf[s] = TYPE == 0 ? __builtin_bit_cast(bf16x8, kraw[S][s]) : __builtin_bit_cast(bf16x8, F2B(kraw[S][2 * s], kraw[S][2 * s + 1])); \
        if (TYPE == 0) { _Pragma("unroll") for (int i = 0; i < 8; ++i) { const int m = lane + 64 * i; *(LAS u32x4*)(Vl + (m >> 4) * VP + (m & 15) * 16) = vraw[S][i]; } } \
        else { _Pragma("unroll") for (int i = 0; i < 4; ++i) { const int m = lane + 64 * i; *(LAS u32x4*)(Vl + (m >> 3) * VP + (m & 7) * 16) = F2B(vraw[S][2 * i], vraw[S][2 * i + 1]); } } \
        if ((t) >= PD) SO_LOAD((t) - PD, S); \
        f32x16 s0; \
         \
        _Pragma("unroll") for (int s = 0; s < NS; ++s) s0 = MFMA32(kf[s], qf[s], s == 0 ? negc : s0); \
         \
        const int kb0 = 32 * (t) + 8 * hh;                                          \
        const bool need_mask = ((t) == NT - 1); \
        if (TYPE != 2) { \
            if (TYPE == 1) {     \
                _Pragma("unroll") for (int i = 0; i < 16; ++i) { const float f = __shfl(i < 8 ? fk0 : fk1, (lane & 32) | (i & 7)); s0[i] -= f; } } \
            if (need_mask) { \
                _Pragma("unroll") for (int i = 0; i < 16; ++i) { const int k0 = kb0 + 16 * (i >> 3) + (i & 7); const bool ok = TYPE == 0 ? (k0 < SKEYS) : (k0 <= qpos); s0[i] = ok ? s0[i] : -INFINITY; } } \
            float rm = s0[0]; \
            _Pragma("unroll") for (int i = 1; i < 16; ++i) rm = fmaxf(rm, s0[i]); \
            rm = half_swap_max(rm); \
            const bool first = ((t) == NT - 1); \
            if (first || __any(rm > 8.0f)) { \
                const float dl = first ? rm : fmaxf(rm, 0.f); \
                mrun += dl; \
                _Pragma("unroll") for (int i = 0; i < 16; ++i) s0[i] -= dl; \
                const float cin = (TYPE == 1 ? fq : 0.f) - mrun; \
                _Pragma("unroll") for (int i = 0; i < 16; ++i) negc[i] = cin; \
                if (!first) { const float f = __builtin_amdgcn_exp2f(-dl); lrun *= f; \
                    _Pragma("unroll") for (int d = 0; d < NDB; ++d) _Pragma("unroll") for (int i = 0; i < 16; ++i) o[d][i] *= f; } \
            } \
            float ls = 0.f; \
            _Pragma("unroll") for (int i = 0; i < 16; ++i) { s0[i] = __builtin_amdgcn_exp2f(s0[i]); ls += s0[i]; } \
            lrun += ls; \
        } else { \
            f32x16 lk0; \
            _Pragma("unroll") for (int i = 0; i < 16; ++i) { const float z0 = s0[i]; const float sp0 = fmaxf(z0, 0.f) + __builtin_amdgcn_logf(1.0f + __builtin_amdgcn_exp2f(-fabsf(z0))); lk0[i] = -sp0; s0[i] = z0 - sp0; } \
            if (need_mask) { \
                _Pragma("unroll") for (int i = 0; i < 16; ++i) { const int k0 = kb0 + 16 * (i >> 3) + (i & 7); const bool ok = k0 < qpos; lk0[i] = ok ? lk0[i] : 0.f; s0[i] = ok ? s0[i] : -INFINITY; } } \
            f32x16 sf0; float gt[2]; \
            _Pragma("unroll") for (int a = 0; a < 2; ++a) { float r0 = 0.f; \
                _Pragma("unroll") for (int e = 7; e >= 0; --e) { sf0[8 * a + e] = r0; r0 += lk0[8 * a + e]; } \
                gt[a] = r0; } \
            float pt[2], gs[2]; \
            _Pragma("unroll") for (int c = 0; c < 2; ++c) pt[c] = __shfl_xor(gt[c], 32); \
            float later = 0.f; \
            _Pragma("unroll") for (int c = 1; c >= 0; --c) { gs[c] = later + (hh == 0 ? pt[c] : 0.f); later += gt[c] + pt[c]; } \
            _Pragma("unroll") for (int i = 0; i < 16; ++i) s0[i] = __builtin_amdgcn_exp2f(s0[i] + sf0[i] + gs[i >> 3] + carry); \
            carry += later; \
        } \
        bf16x8 pk[2]; pk[0] = pack8(s0, 0); pk[1] = pack8(s0, 8); \
        {     \
            s16x4 vl[NDB][2], vh[NDB][2]; \
            _Pragma("unroll") for (int d = 0; d < NDB; ++d) _Pragma("unroll") for (int ks = 0; ks < 2; ++ks) { vl[d][ks] = tr_rd(Vl + vrd + (16 * ks) * VP + 64 * d); vh[d][ks] = tr_rd(Vl + vrd + (16 * ks + 4) * VP + 64 * d); } \
             \
            _Pragma("unroll") for (int d = 0; d < NDB; ++d) _Pragma("unroll") for (int ks = 0; ks < 2; ++ks) { const bf16x8 vf = __builtin_shufflevector(vl[d][ks], vh[d][ks], 0, 1, 2, 3, 4, 5, 6, 7); o[d] = MFMA32(vf, pk[ks], o[d]); } \
             \
        } \
        if (TYPE == 2) done = __all(carry < -160.0f);        \
    } while (0)
    if (PD == 1) {
        SO_LOAD(NT - 1, 0);
        for (int t = NT - 1; t >= 0; --t) { SO_BODY(t, 0); }
    } else {
        SO_LOAD(NT - 1, 0); SO_LOAD(NT - 2, PD - 1);
        for (int t = NT - 1; t >= 0; t -= 2) {
            SO_BODY(t, 0); if (done) break;
            if (t >= 1) { SO_BODY(t - 1, PD - 1); if (done) break; }
        }
    }
#undef SO_BODY
#undef SO_LOAD
#undef F2B
    {
        float inv = 1.0f;
        if (TYPE != 2) { const float lt = half_swap_sum(lrun); inv = 1.0f / lt; }
        float ssq = 0.f;
#pragma unroll
        for (int d = 0; d < NDB; ++d)
#pragma unroll
            for (int i = 0; i < 16; ++i) { o[d][i] *= inv; ssq += o[d][i] * o[d][i]; }
        ssq = half_swap_sum(ssq);
        if (r32 < STN) {
            if (hh == 0) WSP(float, WS_SS)[(size_t)qrow * 12 + TYPE * 4 + h] = ssq;
            const int col0 = (TYPE == 0 ? 0 : TYPE == 1 ? 512 : 768) + h * DV + 4 * hh;
#pragma unroll
            for (int d = 0; d < NDB; ++d) { u32x2 gw[4];
#pragma unroll
                for (int g = 0; g < 4; ++g) gw[g] = *(const u32x2*)(WSP(const bf16_t, WS_GATE) + (size_t)qrow * D + col0 + 32 * d + 8 * g);
#pragma unroll
                for (int g = 0; g < 4; ++g) { u32x2 w; w.x = cvtpk(o[d][4 * g] * bf_lo(gw[g].x), o[d][4 * g + 1] * bf_hi(gw[g].x)); w.y = cvtpk(o[d][4 * g + 2] * bf_lo(gw[g].y), o[d][4 * g + 3] * bf_hi(gw[g].y));
                    *(u32x2*)(WSP(bf16_t, WS_OP) + (size_t)qrow * D + col0 + 32 * d + 8 * g) = w; } }
        }
    }
    __syncthreads();
}
constexpr int CV_CHUNKS = 4096, N_CV_CKV = SBN * PAST * 256 / 8 / CV_CHUNKS, N_CV_KPE = SBN * PAST * 32 / 8 / CV_CHUNKS, N_CV = N_CV_CKV + N_CV_KPE;
constexpr int P0_I0 = 16 * (NINP / 32), P0_I1 = 4 * 24, P0_I2 = 16 * 32, P0_IL = P0_I0 + P0_I1 + P0_I2, N_WT = P0_IL / 8;
static_assert(P0_IL % 8 == 0, "weight items per layer in units of 8");
__device__ __forceinline__ void conv_unit(unsigned char* ws, LAS unsigned char* lds, int ln, int u) {
    const int tid = fresh_tid();
    const bool ckv = u < N_CV_CKV; const int v = ckv ? u : u - N_CV_CKV;
    const float* src = ckv ? inp(lds, 2) + (size_t)ln * SBN * PAST * 256 : inp(lds, 3) + (size_t)ln * SBN * PAST * 32;
    f32x4 a[8], b[8];
#pragma unroll
    for (int k = 0; k < 8; ++k) { const size_t q = (size_t)v * CV_CHUNKS + tid + 512 * k; a[k] = *(const f32x4*)(src + q * 8); b[k] = *(const f32x4*)(src + q * 8 + 4); }
#pragma unroll
    for (int k = 0; k < 8; ++k) { const int q = v * CV_CHUNKS + tid + 512 * k;
        bf16_t* dst; if (ckv) dst = WSP(bf16_t, WS_CKVB) + (size_t)M * 256 + (size_t)q * 8; else { const int per_b = PAST * 32 / 8, sb = q / per_b, rem = q % per_b; dst = (bf16_t*)(ws + kr_off(ln)) + (size_t)MP * 32 + (size_t)sb * SPITCH * 32 + (size_t)rem * 8; }
        u32x4 o; o.x = cvtpk(a[k][0], a[k][1]); o.y = cvtpk(a[k][2], a[k][3]); o.z = cvtpk(b[k][0], b[k][1]); o.w = cvtpk(b[k][2], b[k][3]); *(u32x4*)dst = o; }
}
__device__ __forceinline__ void weight_unit(unsigned char* ws, LAS unsigned char* lds, int ln, int u) {
    const int tid = fresh_tid(), lane = tid & 63, wid = __builtin_amdgcn_readfirstlane(tid >> 6);
    LAS float* scr = (LAS float*)(lds + wid * 16384);
    int r = u * 8 + wid;
    if (r < P0_I0) p0_item(ws, lds, 0, ln, r, scr, lane);
    else if (r < P0_I0 + P0_I1) p0_item(ws, lds, 1, ln, r - P0_I0, scr, lane);
    else p0_item(ws, lds, 2, ln, r - P0_I0 - P0_I1, scr, lane);
}
constexpr int NU_P = 32 * 16, NU_S = SBN * 4 / 8, NU_T = NU_P + NU_S, NU_ALL = 3 * NU_T;
__device__ __forceinline__ int q_fetch(unsigned* head, LAS int* slot) {
    __syncthreads();
    if (threadIdx.x == 0) *slot = (int)__hip_atomic_fetch_add(head, 1u, __ATOMIC_RELAXED, __HIP_MEMORY_SCOPE_AGENT);
    __syncthreads();
    return __builtin_amdgcn_readfirstlane(*slot);
}
template <int TYPE>
__device__ __forceinline__ void attn_prompt(unsigned char* ws, LAS unsigned char* lds, int l, int u) {
    const int qb = 31 - (u >> 4), bh = u & 15, b = bh >> 2, h = bh & 3;
    attn_unit<TYPE, false>(ws, lds, l, b * PT + qb * 256, 256, b * PT, qb * 256, PT, h);
}
__device__ __forceinline__ void p4_attention(unsigned char* ws, float* out, int l, LAS unsigned char* lds, int rep) {
    unsigned* head = (unsigned*)(ws + WS_CTL) + CW_QUEUE + 64 * l + 16 * rep; LAS int* slot = (LAS int*)(lds + MISC_OFF + 64);
#define NEXT_BEGIN() int nx_ = 0; if (threadIdx.x == 0) nx_ = (int)__hip_atomic_fetch_add(head, 1u, __ATOMIC_RELAXED, __HIP_MEMORY_SCOPE_AGENT)
#define NEXT_END() do { if (threadIdx.x == 0) *slot = nx_; __syncthreads(); u = __builtin_amdgcn_readfirstlane(*slot); } while (0)
    const int ncv = (l + 1 < NL) ? N_CV : 0, nwt = (l + 1 < NL) ? N_WT : 0;
    const int b0 = ncv, b1 = b0 + nwt, b2 = b1 + NU_S, b3 = b2 + NU_S, b4 = b3 + NU_S, b5 = b4 + NU_P, b6 = b5 + NU_P, b7 = b6 + NU_P;
    int u = q_fetch(head, slot);
    while (u < b0) { NEXT_BEGIN(); conv_unit(ws, lds, l + 1, u); NEXT_END(); }
    while (u < b1) { NEXT_BEGIN(); weight_unit(ws, lds, l + 1, u - b0); NEXT_END(); }
    while (u < b2) { NEXT_BEGIN(); sample_octet<0>(ws, out, lds, l, u - b1); NEXT_END(); }
    while (u < b3) { NEXT_BEGIN(); sample_octet<1>(ws, out, lds, l, u - b2); NEXT_END(); }
    while (u < b4) { NEXT_BEGIN(); sample_octet<2>(ws, out, lds, l, u - b3); NEXT_END(); }
    while (u < b5) { NEXT_BEGIN(); attn_prompt<0>(ws, lds, l, u - b4); NEXT_END(); }
    while (u < b6) { NEXT_BEGIN(); attn_prompt<1>(ws, lds, l, u - b5); NEXT_END(); }
    while (u < b7) { NEXT_BEGIN(); attn_prompt<2>(ws, lds, l, u - b6); NEXT_END(); }
#undef NEXT_BEGIN
#undef NEXT_END
}
constexpr int N_PHASES = 2 + 5 * NL;
__global__ void __launch_bounds__(512, 2) fwd(Params P) {
    extern __shared__ __attribute__((aligned(16))) unsigned char lds_raw[];
    LAS unsigned char* lds = (LAS unsigned char*)lds_raw;
    const int tid = threadIdx.x;
    if (tid < 64) ((LAS unsigned*)(lds + MISC_OFF))[tid] = 0u;
    if (tid < 18) ((LAS unsigned long long*)(lds + PTR_OFF))[tid] = (unsigned long long)P.in[tid];
    __syncthreads();
    unsigned char* const ws0 = P.ws; float* const out0 = P.out;
    unsigned* ctl = (unsigned*)(ws0 + WS_CTL);
    XcdBarrier bar = xcd_barrier_post(ctl + CW_BAR, (volatile LAS unsigned*)(lds + MISC_OFF + 32));
    const int lo = P.ph_lo, hi = P.ph_hi;
#ifndef PHM
#define PHM 0x7f
#endif
#ifndef REP_P1
#define REP_P1 1
#endif
#ifndef REP_P2
#define REP_P2 1
#endif
#ifndef REP_P3
#define REP_P3 1
#endif
#ifndef REP_P4
#define REP_P4 1
#endif
#ifndef REP_P5
#define REP_P5 1
#endif
#define IN(k) (lo <= (k) && (k) < hi)
#define SEAM(k) do { if (IN(k) && IN((k) + 1)) { XcdBarrier b2_ = bar; unsigned* bb_ = b2_.bar; asm volatile("" : "+s"(bb_)); b2_.bar = bb_; xcd_barrier(b2_); } } while (0)
#define FRESH() unsigned long long ws_i_ = (unsigned long long)ws0, out_i_ = (unsigned long long)out0; asm volatile("" : "+s"(ws_i_), "+s"(out_i_)); unsigned char* ws = (unsigned char*)(GAS unsigned char*)ws_i_; float* out = (float*)(GAS float*)out_i_; (void)out
    if ((PHM & 1) && IN(0)) { FRESH(); p0_prologue(ws, lds); }
    SEAM(0);
    for (int l = 0; l <= NL; ++l) {
        const int pb = 1 + 5 * l;
        if ((PHM & 2) && IN(pb)) { FRESH(); p1_norm(ws, out, lds, l); }
        if (l == NL) break;
        SEAM(pb);
        if ((PHM & 4) && IN(pb + 1)) { FRESH();
            pg8::Gemm g{(const pg8::bf16_t*)(ws + WS_XN), (const pg8::bf16_t*)(ws + WS_WIN + (size_t)l * NINP * D * 2), M, NINP, D};
            pg8::StaticOrder S; S.init(M, NINP, (int)gridDim.x, (int)blockIdx.x);
            EpiP2 E; E.ws = ws; E.out = out; E.kvnorm = inp(lds, 12) + l * 256; E.fbias = inp(lds, 15) + l * 4; E.l = l; E.scr = (LAS float*)(lds + SCR_OFF);
            _Pragma("nounroll") for (int rep = 0; rep < REP_P2; ++rep) pg8::gemm_phase<EpiP2, pg8::StaticOrder, true, true>(lds, g, S, E);
        }
        SEAM(pb + 1);
        if ((PHM & 8) && IN(pb + 2)) { FRESH();
            if (blockIdx.x < 36) cumsum_task(ws, l, (int)blockIdx.x, lds);
            int k3 = 256; asm volatile("" : "+s"(k3));
            pg8::Gemm g{(const pg8::bf16_t*)(ws + WS_CKVB), (const pg8::bf16_t*)(ws + WS_WUKV + (size_t)l * 768 * 256 * 2), M3, 768, k3};
            pg8::StaticOrder S; S.init(M3, 768, (int)gridDim.x, (int)blockIdx.x);
            EpiP3 E; E.ws = ws;
            _Pragma("nounroll") for (int rep = 0; rep < REP_P3; ++rep) pg8::gemm_phase<EpiP3, pg8::StaticOrder, true, true>(lds, g, S, E);
        }
        SEAM(pb + 2);
        if ((PHM & 16) && IN(pb + 3)) { FRESH(); _Pragma("nounroll") for (int rep = 0; rep < REP_P4; ++rep) p4_attention(ws, out, l, lds, rep); }
        SEAM(pb + 3);
        if ((PHM & 64) && IN(pb + 4)) { FRESH();
            pg8::Gemm g{(const pg8::bf16_t*)(ws + WS_OP), (const pg8::bf16_t*)(ws + WS_WOUT + (size_t)l * D * D * 2), M, D, D};
            pg8::StaticOrder S; S.init(M, D, (int)gridDim.x, (int)blockIdx.x);
            EpiP5 E; E.ws = ws; E.tab = (LAS float*)(lds + SCR_OFF);
            _Pragma("nounroll") for (int rep = 0; rep < REP_P5; ++rep) pg8::gemm_phase<EpiP5, pg8::StaticOrder, true, true>(lds, g, S, E);
        }
        SEAM(pb + 4);
    }
#undef IN
#undef SEAM
}

#ifndef MK_SPLIT
#define MK_SPLIT 0
#endif
extern "C" void kernel_launch(void* const* d_in, const int* in_sizes, int n_in, void* d_out, int out_size, void* d_ws, size_t ws_size, hipStream_t stream) {
    static int grid = 0;
    if (grid == 0) {
        if (n_in != 18 || (size_t)out_size != O_END || ws_size < WS_END) { fprintf(stderr, "kernel_launch: unexpected shapes: n_in %d out %d ws %zu\n", n_in, out_size, ws_size); grid = -1; return; }
        int dev = 0, cus = 0, per_cu = 0;
        if (hipGetDevice(&dev) != hipSuccess || hipDeviceGetAttribute(&cus, hipDeviceAttributeMultiprocessorCount, dev) != hipSuccess) { grid = -1; return; }
        if (hipFuncSetAttribute((const void*)fwd, hipFuncAttributeMaxDynamicSharedMemorySize, LDS_BYTES) != hipSuccess) { fprintf(stderr, "kernel_launch: hipFuncSetAttribute failed\n"); grid = -1; return; }
        if (hipOccupancyMaxActiveBlocksPerMultiprocessor(&per_cu, (const void*)fwd, 512, LDS_BYTES) != hipSuccess || per_cu < 1) { fprintf(stderr, "kernel_launch: occupancy query reports %d blocks per CU\n", per_cu); (void)hipGetLastError(); grid = -1; return; }
        grid = cus;
    }
    if (grid < 0) return;
    (void)hipMemsetAsync((char*)d_ws + WS_CTL, 0, CTL_ZERO_BYTES, stream);
    Params p{};
    for (int i = 0; i < 18; ++i) p.in[i] = (const float*)d_in[i];
    p.out = (float*)d_out; p.ws = (unsigned char*)d_ws;
#if MK_SPLIT
    for (int ph = 0; ph < N_PHASES; ++ph) { p.ph_lo = ph; p.ph_hi = ph + 1; hipLaunchKernelGGL(fwd, dim3(grid), dim3(512), LDS_BYTES, stream, p); }
#else
    p.ph_lo = 0; p.ph_hi = N_PHASES;
    hipLaunchKernelGGL(fwd, dim3(grid), dim3(512), LDS_BYTES, stream, p);
#endif
    const hipError_t le = hipPeekAtLastError();
    if (le != hipSuccess) fprintf(stderr, "kernel_launch: launch failed: %s\n", hipGetErrorName(le));
}
```

```cpp
#include <hip/hip_runtime.h>
#include <cstdio>
#include <cstdint>
namespace pg8 {
#define PG8_LAS __attribute__((address_space(3)))
typedef unsigned short bf16_t;
typedef short bf16x8 __attribute__((ext_vector_type(8)));
typedef float f32x4 __attribute__((ext_vector_type(4)));
typedef unsigned u32x4 __attribute__((ext_vector_type(4)));
constexpr int BM = 256, BK = 64, HALF = 128, HTB = HALF * BK * 2  , STAGE_BYTES = 8 * HTB, NXCD = 8, WGM = 8;

__host__ __device__ __forceinline__ int lds_byte(int r, int c) { const int st = (r >> 4) * 2 + (c >> 5), rr = r & 15, cc = c & 31, ob = rr * 64 + cc * 2; return st * 1024 + (ob ^ (((ob >> 9) & 1) << 5)); }
__host__ __device__ __forceinline__ void stage_rc(int b, int& R, int& C) { const int st = b / 1024, sb = b % 1024, swz = sb ^ (((sb >> 9) & 1) << 5); R = (st >> 1) * 16 + swz / 64; C = (st & 1) * 32 + (swz % 64) / 2; }
__host__ __device__ __forceinline__ int perm32(int rho) { const int n = rho >> 4, i = rho & 15; return 8 * (i >> 2) + 4 * n + (i & 3); }

struct Unit { int pm, pn; };
struct Gemm { const bf16_t* A; const bf16_t* Bt; int M, N, K; };

struct StaticOrder {
    int nM, nN, nwg, G, c;
    __host__ __device__ void init(int M, int N, int G_, int c_) { nM = M / BM; nN = N / BM; nwg = nM * nN; G = G_; c = c_; }
    __host__ __device__ bool next(int i, Unit& u) const {
        const long L = (long)i * G + c; if (L >= nwg) return false;
        int wgid = (int)L; { const int q = nwg / NXCD, r = nwg % NXCD, xcd = wgid % NXCD, off = wgid / NXCD; wgid = (xcd < r ? xcd * (q + 1) : r * (q + 1) + (xcd - r) * q) + off; }
        const int nig = WGM * nN, gid = wgid / nig, fm = gid * WGM, gsz = (nM - fm) < WGM ? (nM - fm) : WGM;
        u.pm = fm + ((wgid % nig) % gsz); u.pn = (wgid % nig) / gsz; return true;
    }
    __device__ __forceinline__ void a_ready(const Unit&) const {}
    __device__ __forceinline__ void done(const Unit&) const {}
};

__device__ __forceinline__ unsigned cvt_pk_bf16(float lo, float hi) { unsigned r; asm volatile("v_cvt_pk_bf16_f32 %0, %1, %2" : "=v"(r) : "v"(lo), "v"(hi)); return r; }
typedef float f32x2 __attribute__((ext_vector_type(2)));
template <class Epi, class Sched, bool ALIGN_EPI = false, bool SP2 = false>
__device__ __forceinline__ void gemm_phase(PG8_LAS unsigned char* lds, const Gemm g, const Sched& S, const Epi& E) {
    int tid_ = threadIdx.x; asm volatile("" : "+v"(tid_));
    const int tid = tid_, wid = __builtin_amdgcn_readfirstlane(tid >> 6), lane = tid & 63, wr = wid >> 2, wc = wid & 3, fr = lane & 15, fq = lane >> 4;
    const int K = g.K, nt = K / BK;
    unsigned voffA[2], voffB[2];
#pragma unroll
    for (int i = 0; i < 2; ++i) { int R, C; stage_rc(tid * 16 + i * 8192, R, C); const int Rb = Epi::PERM ? ((R & ~31) + perm32(R & 31)) : R;
        voffA[i] = (unsigned)(R * K + C) * 2u; voffB[i] = (unsigned)(Rb * K + C) * 2u; }
    const size_t kstep = (size_t)(BK * 2);
    const size_t hstep = (size_t)HALF * K * 2;
    const size_t tstep = 2 * hstep;
    const unsigned ldsw = (unsigned)wid * 1024u;
    const int aoff = lds_byte(wr * 64 + fr, fq * 8), boff = lds_byte(wc * 32 + fr, fq * 8);
#define PG8_SA(b, h) (((b) * 2 + (h)) * HTB)
#define PG8_SB(b, h) ((4 + (b) * 2 + (h)) * HTB)
#define PG8_STAGE(bufoff, gbase, voff) do { _Pragma("unroll") for (int _i = 0; _i < 2; ++_i) \
        __builtin_amdgcn_global_load_lds((const unsigned*)((const char*)(gbase) + (voff)[_i]), (PG8_LAS unsigned*)(lds + (bufoff) + ldsw + _i * 8192), 16, 0, 0); } while (0)
#define PG8_LDA(dst, b, h) do { _Pragma("unroll") for (int m = 0; m < 4; ++m) _Pragma("unroll") for (int k = 0; k < 2; ++k) dst[m][k] = *(const PG8_LAS bf16x8*)(lds + PG8_SA(b, h) + aoff + m * 2048 + k * 1024); } while (0)
#define PG8_LDB(dst, b, h) do { _Pragma("unroll") for (int n = 0; n < 2; ++n) _Pragma("unroll") for (int k = 0; k < 2; ++k) dst[n][k] = *(const PG8_LAS bf16x8*)(lds + PG8_SB(b, h) + boff + n * 2048 + k * 1024); } while (0)
#define PG8_MMA(ai, bj, At, Bt) do { __builtin_amdgcn_s_setprio(1); _Pragma("unroll") for (int m = 0; m < 4; ++m) _Pragma("unroll") for (int n = 0; n < 2; ++n) _Pragma("unroll") for (int k = 0; k < 2; ++k) \
        acc[ai][bj][m][n] = __builtin_amdgcn_mfma_f32_16x16x32_bf16(Bt[n][k], At[m][k], acc[ai][bj][m][n], 0, 0, 0); __builtin_amdgcn_s_setprio(0); } while (0)
#define PG8_WAIT_V(n) asm volatile("s_waitcnt vmcnt(" #n ")" ::: "memory")
#define PG8_WAIT_L(n) asm volatile("s_waitcnt lgkmcnt(" #n ")" ::: "memory")
#define PG8_BAR __builtin_amdgcn_s_barrier()
#define PG8_SCHED __builtin_amdgcn_sched_barrier(0)
    Unit cur, nxt; int ui = 0;
    if (!S.next(0, cur)) return;
    f32x4 acc[2][2][4][2];
#pragma unroll
    for (int a = 0; a < 2; ++a)
#pragma unroll
        for (int b = 0; b < 2; ++b)
#pragma unroll
            for (int m = 0; m < 4; ++m)
#pragma unroll
                for (int n = 0; n < 2; ++n) acc[a][b][m][n] = (f32x4){0.f, 0.f, 0.f, 0.f};
    bf16x8 At[4][2], B0[2][2], B1[2][2];
    const char* cA = (const char*)g.A + (size_t)cur.pm * tstep; const char* cB = (const char*)g.Bt + (size_t)cur.pn * tstep;
    S.a_ready(cur);
    if constexpr (Epi::MID) E.prep(cur, 0, tid);
    if constexpr (SP2) {
        PG8_STAGE(PG8_SB(0, 0), cB, voffB); PG8_STAGE(PG8_SB(0, 1), cB + hstep, voffB); PG8_STAGE(PG8_SA(0, 0), cA, voffA); PG8_STAGE(PG8_SA(0, 1), cA + hstep, voffA);
        if (wr == 1) PG8_BAR;
        PG8_WAIT_V(2); PG8_BAR;
        PG8_STAGE(PG8_SB(1, 0), cB + kstep, voffB); PG8_STAGE(PG8_SA(1, 0), cA + kstep, voffA); PG8_STAGE(PG8_SB(1, 1), cB + hstep + kstep, voffB);
        PG8_WAIT_V(6); PG8_BAR;
    } else {
        PG8_STAGE(PG8_SB(0, 0), cB, voffB); PG8_STAGE(PG8_SA(0, 0), cA, voffA); PG8_STAGE(PG8_SB(0, 1), cB + hstep, voffB); PG8_STAGE(PG8_SA(0, 1), cA + hstep, voffA);
        if (wr == 1) PG8_BAR;
        PG8_WAIT_V(4); PG8_BAR;
        PG8_STAGE(PG8_SB(1, 0), cB + kstep, voffB); PG8_STAGE(PG8_SA(1, 0), cA + kstep, voffA); PG8_STAGE(PG8_SB(1, 1), cB + hstep + kstep, voffB);
        PG8_WAIT_V(6); PG8_BAR;
    }
    for (;;) {
        const bool has_next = S.next(ui + 1, nxt);
        const char* nA = has_next ? (const char*)g.A + (size_t)nxt.pm * tstep : cA; const char* nB = has_next ? (const char*)g.Bt + (size_t)nxt.pn * tstep : cB;
        for (int t = 0; t < nt; t += 2) {
            if constexpr (Epi::MID) { if (t == Epi::MID_T0 || t == Epi::MID_T1) E.mid(acc, ui & 1, t == Epi::MID_T0 ? 0 : 1, wr, fr); }
            const bool last = (t == nt - 2);
            const char* a1 = cA + (size_t)(t + 1) * kstep;
            const char* a2 = last ? nA : cA + (size_t)(t + 2) * kstep; const char* b2 = last ? nB : cB + (size_t)(t + 2) * kstep;
            const char* a3 = a2 + kstep; const char* b3 = b2 + kstep;
            if (last && has_next) S.a_ready(nxt);
            if constexpr (SP2) {
            PG8_LDB(B0, 0, 0); PG8_LDB(B1, 0, 1); PG8_SCHED; PG8_LDA(At, 0, 0); PG8_STAGE(PG8_SA(1, 1), a1 + hstep, voffA);
            PG8_WAIT_V(8); PG8_WAIT_L(0); PG8_BAR; PG8_MMA(0, 0, At, B0); PG8_MMA(0, 1, At, B1); PG8_BAR; PG8_SCHED;
            PG8_LDA(At, 0, 1); PG8_STAGE(PG8_SB(0, 0), b2, voffB); PG8_STAGE(PG8_SB(0, 1), b2 + hstep, voffB); PG8_STAGE(PG8_SA(0, 0), a2, voffA);
            PG8_WAIT_V(8); PG8_WAIT_L(0); PG8_BAR; PG8_MMA(1, 0, At, B0); PG8_MMA(1, 1, At, B1); PG8_BAR; PG8_SCHED;
            PG8_LDB(B0, 1, 0); PG8_LDB(B1, 1, 1); PG8_SCHED; PG8_LDA(At, 1, 0); PG8_STAGE(PG8_SA(0, 1), a2 + hstep, voffA);
            PG8_WAIT_V(8); PG8_WAIT_L(0); PG8_BAR; PG8_MMA(0, 0, At, B0); PG8_MMA(0, 1, At, B1); PG8_BAR; PG8_SCHED;
            PG8_LDA(At, 1, 1); PG8_STAGE(PG8_SB(1, 0), b3, voffB); PG8_STAGE(PG8_SB(1, 1), b3 + hstep, voffB); PG8_STAGE(PG8_SA(1, 0), a3, voffA);
            PG8_WAIT_V(8); PG8_WAIT_L(0); PG8_BAR; PG8_MMA(1, 0, At, B0); PG8_MMA(1, 1, At, B1); PG8_BAR; PG8_SCHED;
            } else {
            PG8_LDB(B0, 0, 0); PG8_SCHED; PG8_LDA(At, 0, 0); PG8_STAGE(PG8_SA(1, 1), a1 + hstep, voffA);
            PG8_WAIT_L(8); PG8_BAR; PG8_WAIT_L(0); PG8_MMA(0, 0, At, B0); PG8_BAR; PG8_SCHED;
            PG8_LDB(B1, 0, 1); PG8_STAGE(PG8_SB(0, 0), b2, voffB);
            PG8_BAR; PG8_WAIT_L(0); PG8_MMA(0, 1, At, B1); PG8_BAR;
            PG8_LDA(At, 0, 1); PG8_STAGE(PG8_SA(0, 0), a2, voffA);
            PG8_BAR; PG8_WAIT_L(0); PG8_MMA(1, 0, At, B0); PG8_BAR; PG8_SCHED;
            PG8_STAGE(PG8_SB(0, 1), b2 + hstep, voffB);
            PG8_WAIT_V(6); PG8_BAR; PG8_MMA(1, 1, At, B1); PG8_BAR;
            PG8_LDB(B0, 1, 0); PG8_SCHED; PG8_LDA(At, 1, 0); PG8_STAGE(PG8_SA(0, 1), a2 + hstep, voffA);
            PG8_WAIT_L(8); PG8_BAR; PG8_WAIT_L(0); PG8_MMA(0, 0, At, B0); PG8_BAR; PG8_SCHED;
            PG8_LDB(B1, 1, 1); PG8_STAGE(PG8_SB(1, 0), b3, voffB);
            PG8_BAR; PG8_WAIT_L(0); PG8_MMA(0, 1, At, B1); PG8_BAR;
            PG8_LDA(At, 1, 1); PG8_STAGE(PG8_SA(1, 0), a3, voffA);
            PG8_BAR; PG8_WAIT_L(0); PG8_MMA(1, 0, At, B0); PG8_BAR; PG8_SCHED;
            PG8_STAGE(PG8_SB(1, 1), b3 + hstep, voffB);
            PG8_WAIT_V(6); PG8_BAR; PG8_MMA(1, 1, At, B1); PG8_BAR;
            }
        }
        if constexpr (ALIGN_EPI) { if (wr == 0) PG8_BAR; }
        if constexpr (Epi::MID) E.mid(acc, ui & 1, 2, wr, fr);
        if constexpr (!Epi::AFTER_DRAIN) { E(acc, cur, wr, wc, fr, fq); S.done(cur); }
        if constexpr (Epi::MID) { if (has_next) E.prep(nxt, (ui + 1) & 1, tid); }
        if (!has_next) break;
#pragma unroll
        for (int a = 0; a < 2; ++a)
#pragma unroll
            for (int b = 0; b < 2; ++b)
#pragma unroll
                for (int m = 0; m < 4; ++m)
#pragma unroll
                    for (int n = 0; n < 2; ++n) acc[a][b][m][n] = (f32x4){0.f, 0.f, 0.f, 0.f};
        cur = nxt; cA = nA; cB = nB; ++ui;
        if constexpr (ALIGN_EPI) { if (wr == 1) PG8_BAR; }
    }
    PG8_WAIT_V(0);
    if constexpr (!ALIGN_EPI) { if (wr == 0) PG8_BAR; }
    PG8_BAR;
    if constexpr (Epi::AFTER_DRAIN) { E.fused(acc, cur, wr, wc, fr, fq, lds, wid, lane); S.done(cur); }
#undef PG8_SA
#undef PG8_SB
#undef PG8_STAGE
#undef PG8_LDA
#undef PG8_LDB
#undef PG8_MMA
#undef PG8_WAIT_V
#undef PG8_WAIT_L
#undef PG8_BAR
#undef PG8_SCHED
}
}
#define GAS __attribute__((address_space(1)))
#define LAS __attribute__((address_space(3)))
#define XB_TMO      128
#define XB_XCNT(j)  (256  + 64 * (j))
#define XB_XSUB(j)  (1280 + 64 * (j))
#define XB_XGEN(j)  (2304 + 64 * (j))
#define XB_TOP      3328
#define XB_TOPGEN   3392
#define XCD_BAR_WORDS 3456
#define XB_SPIN_CAP (1u << 21)

__device__ __forceinline__ unsigned xb_ld(unsigned* p)              { return __hip_atomic_load(p, __ATOMIC_RELAXED, __HIP_MEMORY_SCOPE_AGENT); }
__device__ __forceinline__ unsigned xb_add(unsigned* p, unsigned v) { return __hip_atomic_fetch_add(p, v, __ATOMIC_RELAXED, __HIP_MEMORY_SCOPE_AGENT); }
__device__ __forceinline__ unsigned xb_xcc_id() { return (unsigned)__builtin_amdgcn_s_getreg((3 << 11) | 20) & 0xFu; }
#define XB_SPIN(cond, bar) do { unsigned _sp = 0; while (cond) { __builtin_amdgcn_s_sleep(1); \
    if ((++_sp & 255u) == 0u) { if (xb_ld(&(bar)[XB_TMO])) break; if (_sp > XB_SPIN_CAP) { atomicAdd(&(bar)[XB_TMO], 1u); break; } } } } while (0)

struct XcdBarrier {
    unsigned* bar; unsigned x;
    volatile LAS unsigned* st;
};

__device__ __forceinline__ XcdBarrier xcd_barrier_post(unsigned* bar, volatile LAS unsigned* st) {
    XcdBarrier b; b.bar = bar; b.x = xb_xcc_id(); b.st = st;
    if (threadIdx.x == 0) (void)xb_add(&bar[XB_XCNT(b.x)], 1u);
    return b;
}
__device__ __forceinline__ void xcd_barrier_complete(unsigned* bar, unsigned x, unsigned& nloc, unsigned& nx) {
    const unsigned G = gridDim.x * gridDim.y * gridDim.z;
    unsigned sum, cnt, mine, sp = 0u;
    for (;;) {
        sum = 0u; cnt = 0u; mine = 0u;
#pragma unroll
        for (unsigned j = 0; j < 16; ++j) { const unsigned c = xb_ld(&bar[XB_XCNT(j)]); sum += c; cnt += (c > 0u) ? 1u : 0u; mine = (j == x) ? c : mine; }
        if (sum == G) break;
        __builtin_amdgcn_s_sleep(1);
        if ((++sp & 255u) == 0u) { if (xb_ld(&bar[XB_TMO])) break; if (sp > XB_SPIN_CAP) { atomicAdd(&bar[XB_TMO], 1u); break; } }
    }
    nloc = mine > 0u ? mine : 1u; nx = cnt > 0u ? cnt : 1u;
}

__device__ __forceinline__ void xcd_barrier(const XcdBarrier& b) {
    asm volatile("s_waitcnt vmcnt(0)" ::: "memory");
    __syncthreads();
    if (threadIdx.x == 0) {
        unsigned* bar = b.bar;
        __builtin_amdgcn_s_waitcnt(0);
        unsigned nloc = b.st[0], nx = b.st[1];
        if (nloc == 0u) { xcd_barrier_complete(bar, b.x, nloc, nx); b.st[0] = nloc; b.st[1] = nx; }
        const unsigned old = xb_add(&bar[XB_XSUB(b.x)], 1u);
        const unsigned gen = old / nloc;
        if (old + 1u == (gen + 1u) * nloc) {
            __builtin_amdgcn_fence(__ATOMIC_RELEASE, "agent");
            asm volatile("s_waitcnt vmcnt(0)" ::: "memory");
            const unsigned og = xb_add(&bar[XB_TOP], 1u);
            const unsigned tg = og / nx;
            if (og + 1u == (tg + 1u) * nx) xb_add(&bar[XB_TOPGEN], 1u);
            else XB_SPIN(xb_ld(&bar[XB_TOPGEN]) == tg, bar);
            __builtin_amdgcn_fence(__ATOMIC_ACQUIRE, "agent");
            xb_add(&bar[XB_XGEN(b.x)], 1u);
            asm volatile("s_waitcnt vmcnt(0)" ::: "memory");
        } else {
            XB_SPIN(xb_ld(&bar[XB_XGEN(b.x)]) == gen, bar);
            __builtin_amdgcn_fence(__ATOMIC_ACQUIRE, "agent");
            asm volatile("s_waitcnt vmcnt(0)" ::: "memory");
        }
    }
    __syncthreads();
}

constexpr int D = 1024, NL = 4;
constexpr int PB = 4, PT = 8192, MP = PB * PT;
constexpr int SBN = 32, STN = 16, PAST = 2048, MS = SBN * STN;
constexpr int M = MP + MS;
constexpr int SKEYS = PAST + STN;
constexpr int SPITCH = 2112;
constexpr int KROWS = MP + SBN * SPITCH;
constexpr int M3 = M + SBN * PAST;
constexpr int NIN = 3236, NINP = 3328;
constexpr float EPS = 1e-6f;
constexpr float LOG2E = 1.4426950408889634f;
constexpr float EXIT_LOG2 = -40.0f;
constexpr float QA_SC = 0.10206207261596575f * LOG2E, QB_SC = 0.125f * LOG2E, QC_SC = 0.125f * LOG2E;

constexpr size_t O_YP = 0, O_YS = O_YP + (size_t)MP * D, O_PCKV = O_YS + (size_t)MS * D, O_PKPE = O_PCKV + (size_t)NL * MP * 256, O_PFK = O_PKPE + (size_t)NL * MP * 32,
                 O_PFV = O_PFK + (size_t)NL * MP * 256, O_PLF = O_PFV + (size_t)NL * MP * 256, O_PSK = O_PLF + (size_t)NL * MP * 4, O_PSV = O_PSK + (size_t)NL * MP * 256,
                 O_SCKV = O_PSV + (size_t)NL * MP * 256, O_SKPE = O_SCKV + (size_t)NL * MS * 256, O_SFK = O_SKPE + (size_t)NL * MS * 32, O_SFV = O_SFK + (size_t)NL * MS * 256,
                 O_SLF = O_SFV + (size_t)NL * MS * 256, O_SSK = O_SLF + (size_t)NL * MS * 4, O_SSV = O_SSK + (size_t)NL * MS * 256, O_END = O_SSV + (size_t)NL * MS * 256;
static_assert(O_END == 209264640ull, "output size");

constexpr size_t MiB = 1u << 20;
constexpr size_t WS_CTL = 0, CTL_ZERO_BYTES = 1 * MiB;
constexpr size_t WS_ROPE = 1 * MiB, WS_WIN = 2 * MiB, WS_WUKV = 28 * MiB, WS_WOUT = 30 * MiB, WS_XN = 38 * MiB, WS_QA = 103 * MiB, WS_QB = 128 * MiB, WS_QC = 145 * MiB,
                 WS_GATE = 162 * MiB, WS_OP = 227 * MiB, WS_Y = 292 * MiB, WS_CKVB = 357 * MiB, WS_KA = 406 * MiB, WS_KR = 455 * MiB, WS_VA = 462 * MiB, WS_KB = 560 * MiB,
                 WS_VB = 609 * MiB, WS_KC = 658 * MiB, WS_VC = 707 * MiB, WS_LOGF = 756 * MiB, WS_FB = 758 * MiB, WS_SS = 760 * MiB, WS_KR2 = 762 * MiB, WS_END = 769 * MiB;
static_assert(WS_WIN + (size_t)NL * NINP * D * 2 <= WS_WUKV && WS_WUKV + (size_t)NL * 768 * 256 * 2 <= WS_WOUT && WS_WOUT + (size_t)NL * D * D * 2 <= WS_XN, "ws map 1");
static_assert(WS_XN + (size_t)M * D * 2 <= WS_QA && WS_QA + (size_t)(M + 64) * 384 * 2 <= WS_QB && WS_QB + (size_t)(M + 64) * 256 * 2 <= WS_QC && WS_QC + (size_t)(M + 64) * 256 * 2 <= WS_GATE, "ws map 2");
static_assert(WS_GATE + (size_t)M * D * 2 <= WS_OP && WS_OP + (size_t)M * D * 2 <= WS_Y && WS_Y + (size_t)M * D * 2 <= WS_CKVB && WS_CKVB + (size_t)M3 * 256 * 2 <= WS_KA, "ws map 3");
static_assert(WS_KA + (size_t)KROWS * 256 * 2 <= WS_KR && WS_KR + (size_t)KROWS * 32 * 2 <= WS_VA && WS_VA + (size_t)KROWS * 512 * 2 <= WS_KB && WS_KB + (size_t)KROWS * 256 * 2 <= WS_VB, "ws map 4");
static_assert(WS_VB + (size_t)KROWS * 256 * 2 <= WS_KC && WS_KC + (size_t)KROWS * 256 * 2 <= WS_VC && WS_VC + (size_t)KROWS * 256 * 2 <= WS_LOGF && WS_LOGF + (size_t)KROWS * 16 <= WS_FB && WS_FB + (size_t)KROWS * 16 <= WS_SS && WS_SS + (size_t)M * 48 <= WS_END, "ws map 5");
constexpr int CW_QUEUE = 64;
constexpr int CW_XQ = 1024;
constexpr int CW_KMAX = 512;
constexpr int CW_BAR = 4096;
constexpr int RING_BYTES = 131072, MISC_OFF = RING_BYTES, PTR_OFF = RING_BYTES + 256, SCR_OFF = RING_BYTES + 512, LDS_BYTES = 147456;

typedef unsigned short bf16_t;
typedef short bf16x8 __attribute__((ext_vector_type(8)));
typedef short s16x4 __attribute__((ext_vector_type(4)));
typedef float f32x4 __attribute__((ext_vector_type(4)));
typedef float f32x16 __attribute__((ext_vector_type(16)));
typedef unsigned u32x4 __attribute__((ext_vector_type(4)));
typedef unsigned u32x2 __attribute__((ext_vector_type(2)));
typedef float f32x2_t __attribute__((ext_vector_type(2)));
typedef __bf16 bf16x2_t __attribute__((ext_vector_type(2)));
__device__ __forceinline__ unsigned cvtpk(float lo, float hi) { f32x2_t v = {lo, hi}; bf16x2_t b = __builtin_convertvector(v, bf16x2_t); return __builtin_bit_cast(unsigned, b); }
__device__ __forceinline__ float bf_lo(unsigned w) { return __uint_as_float(w << 16); }
__device__ __forceinline__ float bf_hi(unsigned w) { return __uint_as_float(w & 0xffff0000u); }
__device__ __forceinline__ float wave_sum(float v) {
#pragma unroll
    for (int o = 1; o < 64; o <<= 1) v += __shfl_xor(v, o);
    return v;
}
__device__ __forceinline__ float half_swap_sum(float v) { auto rr = __builtin_amdgcn_permlane32_swap(__float_as_uint(v), __float_as_uint(v), false, false); return __uint_as_float(rr[0]) + __uint_as_float(rr[1]); }
__device__ __forceinline__ float half_swap_max(float v) { auto rr = __builtin_amdgcn_permlane32_swap(__float_as_uint(v), __float_as_uint(v), false, false); return fmaxf(__uint_as_float(rr[0]), __uint_as_float(rr[1])); }
__device__ __forceinline__ int fresh_tid() { int t = threadIdx.x; asm volatile("" : "+v"(t)); return t; }
__device__ __forceinline__ size_t kr_off(int l) { return (l & 1) ? WS_KR2 : WS_KR; }
__device__ __forceinline__ int krow_of(int m) { return m < MP ? m : MP + ((m - MP) >> 4) * SPITCH + PAST + ((m - MP) & 15); }
__device__ __forceinline__ int pos_of(int m) { return m < MP ? (m & (PT - 1)) : PAST + ((m - MP) & 15); }
__device__ __forceinline__ float* rows_out(float* out, size_t off_p, size_t off_s, int l, int m, int W) {
    return m < MP ? out + off_p + ((size_t)l * MP + m) * W : out + off_s + ((size_t)l * MS + (m - MP)) * W;
}

struct Params { const float* in[18]; float* out; unsigned char* ws; int ph_lo, ph_hi; };
__device__ __forceinline__ const float* inp(LAS unsigned char* lds, int i) {
    const unsigned long long v = ((const LAS unsigned long long*)(lds + PTR_OFF))[i];
    const unsigned lo = __builtin_amdgcn_readfirstlane((unsigned)v), hi = __builtin_amdgcn_readfirstlane((unsigned)(v >> 32));
    return (const float*)(const GAS float*)(((unsigned long long)hi << 32) | lo);
}
#define WSP(T, off) ((T*)(ws + (off)))

__device__ __forceinline__ int win_logical_col(int n) {
    const int tile = n >> 8, c = n & 255;
    switch (tile) {
        case 0: return c;
        case 1: { const int blk = c >> 5, p = c & 31, e = 16 * ((p >> 2) & 1) + 4 * (p >> 3) + (p & 3);
                  if (blk < 4) return 256 + 32 * blk + e; if (blk == 4) return 640 + e; if (blk == 5 && p < 4) return 1440 + p; return -1; }
        case 2: return 384 + c;
        case 3: return 672 + c;
        case 4: return 928 + c;
        case 5: return 1184 + c;
        case 6: return 1444 + c;
        case 7: return 1700 + c;
        case 8: return 1956 + c;
        default: return 2212 + 256 * (tile - 9) + c;
    }
}
__device__ __forceinline__ void p0_item(unsigned char* ws, LAS unsigned char* lds, int kind, int l, int item, LAS float* scr, int lane) {
    const int K = kind == 1 ? 256 : 1024, N = kind == 0 ? NINP : kind == 1 ? 768 : 1024;
    const int nblk = N / 32, kb = item / nblk, nb = item % nblk, k0 = 64 * kb, n0 = 32 * nb;
    const int n = n0 + (lane & 31);
    const float* src; int ld; int col;
    if (kind == 0) { src = inp(lds, 11) + (size_t)l * D * NIN; ld = NIN; col = win_logical_col(n); }
    else if (kind == 1) { if (n < 256) { src = inp(lds, 13) + (size_t)l * 256 * 256; ld = 256; col = n; } else { src = inp(lds, 14) + (size_t)l * 256 * 512; ld = 512; col = n - 256; } }
    else { src = inp(lds, 17) + (size_t)l * D * D; ld = D; col = n; }
    const float* gain = kind == 0 ? inp(lds, 9) + l * D : kind == 2 ? inp(lds, 16) + l * D : nullptr;
#pragma unroll 8
    for (int i = 0; i < 32; ++i) { const int kk = 2 * i + (lane >> 5); float v = 0.f;
        if (col >= 0) { v = src[(size_t)(k0 + kk) * ld + col]; if (gain) v *= gain[k0 + kk]; }
        scr[kk * 33 + (lane & 31)] = v; }
    asm volatile("s_waitcnt lgkmcnt(0)" ::: "memory");
    bf16_t* WT = (bf16_t*)(ws + (kind == 0 ? WS_WIN + (size_t)l * NINP * D * 2 : kind == 1 ? WS_WUKV + (size_t)l * 768 * 256 * 2 : WS_WOUT + (size_t)l * D * D * 2));
    const int c = lane & 7;
#pragma unroll
    for (int j = 0; j < 4; ++j) { const int nn = (lane >> 3) + 8 * j; const LAS float* s = scr + (8 * c) * 33 + nn;
        u32x4 o; o.x = cvtpk(s[0 * 33], s[1 * 33]); o.y = cvtpk(s[2 * 33], s[3 * 33]); o.z = cvtpk(s[4 * 33], s[5 * 33]); o.w = cvtpk(s[6 * 33], s[7 * 33]);
        *(u32x4*)(WT + (size_t)(n0 + nn) * K + k0 + 8 * c) = o; }
    asm volatile("s_waitcnt lgkmcnt(0)" ::: "memory");
}
__device__ __forceinline__ void p0_prologue(unsigned char* ws, LAS unsigned char* lds) {
    const int tid = fresh_tid(), lane = tid & 63, wid = __builtin_amdgcn_readfirstlane(tid >> 6);
    LAS float* scr = (LAS float*)(lds + wid * 16384);
    const int gw = blockIdx.x * 8 + wid, NGW = gridDim.x * 8;
    constexpr int I0 = 16 * (NINP / 32), I1 = 4 * 24, I2 = 16 * 32, IL = I0 + I1 + I2;
    for (int it = gw; it < IL; it += NGW) {
        const int l = it / IL; int r = it % IL;
        if (r < I0) { p0_item(ws, lds, 0, l, r, scr, lane); continue; } r -= I0;
        if (r < I1) { p0_item(ws, lds, 1, l, r, scr, lane); continue; } r -= I1;
        p0_item(ws, lds, 2, l, r, scr, lane);
    }
    float* rope = (float*)(ws + WS_ROPE);
    for (int e = blockIdx.x * 512 + tid; e < PT * 16; e += gridDim.x * 512) {
        const int pos = e >> 4, i = e & 15;
        double inv = 1.0; for (int k = 0; k < i; ++k) inv *= 0.5623413251903491;
        const double rev = (double)pos * inv * 0.15915494309189535;
        const float fr = (float)(rev - __builtin_rint(rev));
        rope[pos * 32 + i] = __builtin_amdgcn_cosf(fr); rope[pos * 32 + 16 + i] = __builtin_amdgcn_sinf(fr);
    }
}

__device__ __forceinline__ void cvt_rows(const float* src, bf16_t* dst, int W, size_t dst_bstride, int gtid, int nthr) {
    const int per_b = PAST * W / 8, total = SBN * per_b;
    for (int q0 = gtid; q0 < total; q0 += 4 * nthr) {
        f32x4 a[4], b[4];
#pragma unroll
        for (int u = 0; u < 4; ++u) { const int q = q0 + u * nthr; if (q < total) { a[u] = *(const f32x4*)(src + (size_t)q * 8); b[u] = *(const f32x4*)(src + (size_t)q * 8 + 4); } }
#pragma unroll
        for (int u = 0; u < 4; ++u) { const int q = q0 + u * nthr; if (q < total) { const int sb = q / per_b, rem = q % per_b;
            u32x4 o; o.x = cvtpk(a[u][0], a[u][1]); o.y = cvtpk(a[u][2], a[u][3]); o.z = cvtpk(b[u][0], b[u][1]); o.w = cvtpk(b[u][2], b[u][3]);
            *(u32x4*)(dst + (size_t)sb * dst_bstride + (size_t)rem * 8) = o; } }
    }
}
__device__ __forceinline__ void p1_norm(unsigned char* ws, float* out, LAS unsigned char* lds, int l) {
    const int tid = fresh_tid(), lane = tid & 63, wid = __builtin_amdgcn_readfirstlane(tid >> 6);
    const int gw = blockIdx.x * 8 + wid, NGW = gridDim.x * 8;
    bf16_t* XN = (bf16_t*)(ws + WS_XN); const bf16_t* Y = (const bf16_t*)(ws + WS_Y);
    const float* xp = inp(lds, 0); const float* xs = inp(lds, 1); const float* gpost = inp(lds, 10);
    constexpr int RU = 4;
    f32x4 g[4];
    if (l > 0) {
#pragma unroll
        for (int j = 0; j < 4; ++j) g[j] = *(const f32x4*)(gpost + (l - 1) * D + 256 * j + 4 * lane);
    }
    for (int m0 = gw; m0 < M; m0 += RU * NGW) {
        f32x4 v[RU][4]; u32x2 yw[RU][4];
#pragma unroll
        for (int r = 0; r < RU; ++r) { const int m = m0 + r * NGW; if (m < M) {
            const float* base = (l <= 1) ? (m < MP ? xp + (size_t)m * D : xs + (size_t)(m - MP) * D) : out + (size_t)m * D;
#pragma unroll
            for (int j = 0; j < 4; ++j) v[r][j] = *(const f32x4*)(base + 256 * j + 4 * lane);
            if (l > 0) {
#pragma unroll
                for (int j = 0; j < 4; ++j) yw[r][j] = *(const u32x2*)(Y + (size_t)m * D + 256 * j + 4 * lane); } } }
#pragma unroll
        for (int r = 0; r < RU; ++r) { const int m = m0 + r * NGW; if (m < M) {
            float* xres = out + (size_t)m * D;
            if (l > 0) {
                f32x4 y[4]; float s = 0.f;
#pragma unroll
                for (int j = 0; j < 4; ++j) { const u32x2 w = yw[r][j]; y[j] = (f32x4){bf_lo(w.x), bf_hi(w.x), bf_lo(w.y), bf_hi(w.y)}; s += (y[j][0] * y[j][0] + y[j][1] * y[j][1]) + (y[j][2] * y[j][2] + y[j][3] * y[j][3]); }
                const float rr = 1.0f / sqrtf(wave_sum(s) * (1.0f / D) + EPS);
#pragma unroll
                for (int j = 0; j < 4; ++j) { v[r][j] = v[r][j] + y[j] * rr * g[j]; *(f32x4*)(xres + 256 * j + 4 * lane) = v[r][j]; }
            }
            if (l < NL) {
                float s = 0.f;
#pragma unroll
                for (int j = 0; j < 4; ++j) s += (v[r][j][0] * v[r][j][0] + v[r][j][1] * v[r][j][1]) + (v[r][j][2] * v[r][j][2] + v[r][j][3] * v[r][j][3]);
                const float rr = 1.0f / sqrtf(wave_sum(s) * (1.0f / D) + EPS);
#pragma unroll
                for (int j = 0; j < 4; ++j) { u32x2 w; w.x = cvtpk(v[r][j][0] * rr, v[r][j][1] * rr); w.y = cvtpk(v[r][j][2] * rr, v[r][j][3] * rr); *(u32x2*)(XN + (size_t)m * D + 256 * j + 4 * lane) = w; }
            } } }
    }
    if (l == 0) {
        const int gtid = blockIdx.x * 512 + tid, nthr = gridDim.x * 512;
        cvt_rows(inp(lds, 2) + (size_t)l * SBN * PAST * 256, (bf16_t*)(ws + WS_CKVB) + (size_t)M * 256, 256, (size_t)PAST * 256, gtid, nthr);
        cvt_rows(inp(lds, 3) + (size_t)l * SBN * PAST * 32, (bf16_t*)(ws + WS_KR) + (size_t)MP * 32, 32, (size_t)SPITCH * 32, gtid, nthr);
    }
}

__device__ __forceinline__ void st8(bf16_t* p, const f32x4 a, const f32x4 b, float sc) {
    u32x4 w; w.x = cvtpk(a[0] * sc, a[1] * sc); w.y = cvtpk(a[2] * sc, a[3] * sc); w.z = cvtpk(b[0] * sc, b[1] * sc); w.w = cvtpk(b[2] * sc, b[3] * sc); *(u32x4*)p = w;
}
__device__ __forceinline__ float silu_f(float x) { return x * __builtin_amdgcn_rcpf(1.0f + __builtin_amdgcn_exp2f(-x * LOG2E)); }
struct EpiP2 {
    static constexpr bool PERM = true, AFTER_DRAIN = false, MID = false;
    unsigned char* ws; float* out; const float* kvnorm; const float* fbias; int l; LAS float* scr;
    __device__ __forceinline__ void operator()(const pg8::f32x4 (&acc)[2][2][4][2], const pg8::Unit& u, int wr, int wc, int fr, int fq) const {
        int pn = u.pn, rbase = u.pm * 256 + wr * 64 + fr, cw = wc * 32 + 8 * fq;
        asm volatile("" : "+s"(pn), "+v"(rbase), "+v"(cw));
        bf16_t* const QA = WSP(bf16_t, WS_QA); bf16_t* const QB = WSP(bf16_t, WS_QB); bf16_t* const QC = WSP(bf16_t, WS_QC); bf16_t* const KR = (bf16_t*)(ws + kr_off(l)); bf16_t* const KB = WSP(bf16_t, WS_KB); bf16_t* const VB = WSP(bf16_t, WS_VB);
        bf16_t* const KC = WSP(bf16_t, WS_KC); bf16_t* const VC = WSP(bf16_t, WS_VC); bf16_t* const CKVB = WSP(bf16_t, WS_CKVB); bf16_t* const GATE = WSP(bf16_t, WS_GATE); float* const LOGF = WSP(float, WS_LOGF); const float* const rope = WSP(const float, WS_ROPE);
        if (pn == 0 || pn == 3 || pn == 6) {
            const float sc = pn == 0 ? QA_SC : pn == 3 ? QB_SC : QC_SC;
#pragma unroll
            for (int ai = 0; ai < 2; ++ai)
#pragma unroll
                for (int m = 0; m < 4; ++m) { const int row = rbase + ai * 128 + m * 16;
#pragma unroll
                    for (int bj = 0; bj < 2; ++bj) {
                        bf16_t* d = pn == 0 ? QA + (size_t)row * 384 + (2 * bj + (wc >> 1)) * 96 + 32 * (wc & 1) + 8 * fq : (pn == 3 ? QB : QC) + (size_t)row * 256 + 128 * bj + cw;
                        st8(d, acc[ai][bj][m][0], acc[ai][bj][m][1], sc); } }
        } else if (pn >= 9) {
#pragma unroll
            for (int ai = 0; ai < 2; ++ai)
#pragma unroll
                for (int m = 0; m < 4; ++m) { const int row = rbase + ai * 128 + m * 16;
#pragma unroll
                    for (int bj = 0; bj < 2; ++bj) { f32x4 a = acc[ai][bj][m][0], b = acc[ai][bj][m][1];
#pragma unroll
                        for (int j = 0; j < 4; ++j) { a[j] = silu_f(a[j]); b[j] = silu_f(b[j]); }
                        st8(GATE + (size_t)row * D + 256 * (pn - 9) + 128 * bj + cw, a, b, 1.0f); } }
        } else if (pn == 4 || pn == 5 || pn == 7 || pn == 8) {
            bf16_t* buf = pn == 4 ? KB : pn == 5 ? VB : pn == 7 ? KC : VC;
            const size_t offp = pn == 4 ? O_PFK : pn == 5 ? O_PFV : pn == 7 ? O_PSK : O_PSV, offs = pn == 4 ? O_SFK : pn == 5 ? O_SFV : pn == 7 ? O_SSK : O_SSV;
#pragma unroll
            for (int ai = 0; ai < 2; ++ai)
#pragma unroll
                for (int m = 0; m < 4; ++m) { const int row = rbase + ai * 128 + m * 16; const int kr = krow_of(row); float* o = rows_out(out, offp, offs, l, row, 256);
#pragma unroll
                    for (int bj = 0; bj < 2; ++bj) { const int c0 = 128 * bj + cw;
                        st8(buf + (size_t)kr * 256 + c0, acc[ai][bj][m][0], acc[ai][bj][m][1], 1.0f);
                        *(f32x4*)(o + c0) = acc[ai][bj][m][0]; *(f32x4*)(o + c0 + 4) = acc[ai][bj][m][1]; } }
            if (pn == 4 && u.pm < MP / 256) {
                float mx[2] = {0.f, 0.f};
#pragma unroll
                for (int ai = 0; ai < 2; ++ai)
#pragma unroll
                    for (int m = 0; m < 4; ++m)
#pragma unroll
                        for (int bj = 0; bj < 2; ++bj) { const f32x4 x = acc[ai][bj][m][0], y = acc[ai][bj][m][1];
                            float sq = ((x[0] * x[0] + x[1] * x[1]) + (x[2] * x[2] + x[3] * x[3])) + ((y[0] * y[0] + y[1] * y[1]) + (y[2] * y[2] + y[3] * y[3]));
                            sq += __shfl_xor(sq, 16); sq += __shfl_xor(sq, 32); mx[bj] = fmaxf(mx[bj], sq); }
#pragma unroll
                for (int bj = 0; bj < 2; ++bj) { float v = mx[bj];
                    v = fmaxf(v, __shfl_xor(v, 1)); v = fmaxf(v, __shfl_xor(v, 2)); v = fmaxf(v, __shfl_xor(v, 4)); v = fmaxf(v, __shfl_xor(v, 8));
                    if (fr == 0 && fq == 0) __hip_atomic_fetch_max(WSP(unsigned, WS_CTL) + CW_KMAX + ((l * 4 + (u.pm >> 5)) * 4 + 2 * bj + (wc >> 1)) * 2 + (wc & 1), __float_as_uint(v), __ATOMIC_RELAXED, __HIP_MEMORY_SCOPE_AGENT); }
            }
        } else if (pn == 1) {
#pragma unroll
            for (int ai = 0; ai < 2; ++ai)
#pragma unroll
                for (int m = 0; m < 4; ++m) { const int row = rbase + ai * 128 + m * 16; const int pos = pos_of(row);
                    const f32x4 cs = *(const f32x4*)(rope + pos * 32 + 4 * fq), sn = *(const f32x4*)(rope + pos * 32 + 16 + 4 * fq);
                    {
                        const f32x4 x1 = acc[ai][0][m][0], x2 = acc[ai][0][m][1]; const f32x4 y1 = (x1 * cs - x2 * sn) * QA_SC, y2 = (x1 * sn + x2 * cs) * QA_SC;
                        bf16_t* d = QA + (size_t)row * 384 + wc * 96 + 64 + 4 * fq;
                        u32x2 w1, w2; w1.x = cvtpk(y1[0], y1[1]); w1.y = cvtpk(y1[2], y1[3]); w2.x = cvtpk(y2[0], y2[1]); w2.y = cvtpk(y2[2], y2[3]);
                        *(u32x2*)d = w1; *(u32x2*)(d + 16) = w2; }
                    if (wc == 0) {
                        const f32x4 x1 = acc[ai][1][m][0], x2 = acc[ai][1][m][1]; const f32x4 y1 = x1 * cs - x2 * sn, y2 = x1 * sn + x2 * cs;
                        bf16_t* d = KR + (size_t)krow_of(row) * 32 + 4 * fq;
                        u32x2 w1, w2; w1.x = cvtpk(y1[0], y1[1]); w1.y = cvtpk(y1[2], y1[3]); w2.x = cvtpk(y2[0], y2[1]); w2.y = cvtpk(y2[2], y2[3]);
                        *(u32x2*)d = w1; *(u32x2*)(d + 16) = w2;
                        float* o = rows_out(out, O_PKPE, O_SKPE, l, row, 32) + 4 * fq; *(f32x4*)o = y1; *(f32x4*)(o + 16) = y2;
                    } else if (wc == 1 && fq == 0) {
                        f32x4 v = acc[ai][1][m][0] + *(const f32x4*)fbias; f32x4 lf;
#pragma unroll
                        for (int j = 0; j < 4; ++j) lf[j] = fminf(v[j], 0.f) - __logf(1.0f + __expf(-fabsf(v[j])));
                        *(f32x4*)rows_out(out, O_PLF, O_SLF, l, row, 4) = lf; *(f32x4*)(LOGF + (size_t)krow_of(row) * 4) = lf;
                    } }
        } else {
            float ssq[2][4];
#pragma unroll
            for (int ai = 0; ai < 2; ++ai)
#pragma unroll
                for (int m = 0; m < 4; ++m) { float s = 0.f;
#pragma unroll
                    for (int bj = 0; bj < 2; ++bj)
#pragma unroll
                        for (int n = 0; n < 2; ++n) { const f32x4 x = acc[ai][bj][m][n]; s += (x[0] * x[0] + x[1] * x[1]) + (x[2] * x[2] + x[3] * x[3]); }
                    s += __shfl_xor(s, 16); s += __shfl_xor(s, 32);
                    if (fq == 0) scr[(ai * 128 + wr * 64 + m * 16 + fr) * 4 + wc] = s; }
            asm volatile("s_waitcnt lgkmcnt(0)" ::: "memory"); __builtin_amdgcn_s_barrier(); asm volatile("" ::: "memory");
#pragma unroll
            for (int ai = 0; ai < 2; ++ai)
#pragma unroll
                for (int m = 0; m < 4; ++m) { const f32x4 p4 = *(const LAS f32x4*)(scr + (ai * 128 + wr * 64 + m * 16 + fr) * 4); ssq[ai][m] = (p4[0] + p4[1]) + (p4[2] + p4[3]); }
#pragma unroll
            for (int ai = 0; ai < 2; ++ai)
#pragma unroll
                for (int m = 0; m < 4; ++m) { const int row = rbase + ai * 128 + m * 16; const float r = 1.0f / sqrtf(ssq[ai][m] * (1.0f / 256.0f) + EPS); float* o = rows_out(out, O_PCKV, O_SCKV, l, row, 256);
#pragma unroll
                    for (int bj = 0; bj < 2; ++bj) { const int c0 = 128 * bj + cw;
                        const f32x4 a = acc[ai][bj][m][0] * r * *(const f32x4*)(kvnorm + c0), b = acc[ai][bj][m][1] * r * *(const f32x4*)(kvnorm + c0 + 4);
                        st8(CKVB + (size_t)row * 256 + c0, a, b, 1.0f); *(f32x4*)(o + c0) = a; *(f32x4*)(o + c0 + 4) = b; } }
        }
    }
};
struct EpiP3 {
    static constexpr bool PERM = true, AFTER_DRAIN = false, MID = false;
    unsigned char* ws;
    __device__ __forceinline__ void operator()(const pg8::f32x4 (&acc)[2][2][4][2], const pg8::Unit& u, int wr, int wc, int fr, int fq) const {
        int pn = u.pn, rbase = u.pm * 256 + wr * 64 + fr, cw = wc * 32 + 8 * fq;
        asm volatile("" : "+s"(pn), "+v"(rbase), "+v"(cw));
        bf16_t* const KA = WSP(bf16_t, WS_KA); bf16_t* const VA = WSP(bf16_t, WS_VA);
#pragma unroll
        for (int ai = 0; ai < 2; ++ai)
#pragma unroll
            for (int m = 0; m < 4; ++m) { const int row = rbase + ai * 128 + m * 16;
                const int dest = row < M ? krow_of(row) : MP + ((row - M) >> 11) * SPITCH + ((row - M) & 2047);
#pragma unroll
                for (int bj = 0; bj < 2; ++bj) { bf16_t* d = pn == 0 ? KA + (size_t)dest * 256 + 128 * bj + cw : VA + (size_t)dest * 512 + 256 * (pn - 1) + 128 * bj + cw;
                    st8(d, acc[ai][bj][m][0], acc[ai][bj][m][1], 1.0f); } }
    }
};
struct EpiP5 {
    static constexpr bool PERM = true, AFTER_DRAIN = false, MID = true; static constexpr int MID_T0 = 8, MID_T1 = 12;
    unsigned char* ws; LAS float* tab;
    __device__ __forceinline__ void prep(const pg8::Unit& u, int par, int tid) const {
        if (tid < 256) { const float* ss = WSP(const float, WS_SS) + (size_t)(u.pm * 256 + tid) * 12;
            const f32x4 a = *(const f32x4*)ss, b = *(const f32x4*)(ss + 4), c = *(const f32x4*)(ss + 8);
            const float ra = 1.0f / sqrtf(((a[0] + a[1]) + (a[2] + a[3])) * (1.0f / 512.0f) + EPS), rb = 1.0f / sqrtf(((b[0] + b[1]) + (b[2] + b[3])) * (1.0f / 256.0f) + EPS), rc = 1.0f / sqrtf(((c[0] + c[1]) + (c[2] + c[3])) * (1.0f / 256.0f) + EPS);
            *(LAS f32x4*)(tab + (par * 256 + tid) * 4) = (f32x4){ra / rb, rb / rc, rc, 0.f}; }
    }
    __device__ __forceinline__ void mid(pg8::f32x4 (&acc)[2][2][4][2], int par, int which, int wr, int fr) const {
#pragma unroll
        for (int ai = 0; ai < 2; ++ai)
#pragma unroll
            for (int m = 0; m < 4; ++m) { const f32x4 t4 = *(const LAS f32x4*)(tab + (par * 256 + ai * 128 + wr * 64 + m * 16 + fr) * 4); const float f = which == 0 ? t4[0] : which == 1 ? t4[1] : t4[2];
#pragma unroll
                for (int bj = 0; bj < 2; ++bj)
#pragma unroll
                    for (int n = 0; n < 2; ++n) acc[ai][bj][m][n] = acc[ai][bj][m][n] * f; }
    }
    __device__ __forceinline__ void operator()(const pg8::f32x4 (&acc)[2][2][4][2], const pg8::Unit& u, int wr, int wc, int fr, int fq) const {
        int rbase = u.pm * 256 + wr * 64 + fr, cw = u.pn * 256 + wc * 32 + 8 * fq; bf16_t* const Y = WSP(bf16_t, WS_Y);
        asm volatile("" : "+v"(rbase), "+v"(cw));
#pragma unroll
        for (int ai = 0; ai < 2; ++ai)
#pragma unroll
            for (int m = 0; m < 4; ++m) { const int row = rbase + ai * 128 + m * 16;
#pragma unroll
                for (int bj = 0; bj < 2; ++bj) st8(Y + (size_t)row * D + 128 * bj + cw, acc[ai][bj][m][0], acc[ai][bj][m][1], 1.0f); }
    }
};

__device__ __forceinline__ void cumsum_task(unsigned char* ws, int l, int task, LAS unsigned char* lds) {
    const int tid = fresh_tid(), lane = tid & 63, wid = tid >> 6;
    const float* LOGF = (const float*)(ws + WS_LOGF); float* FB = (float*)(ws + WS_FB);
    const bool prompt = task < 4; const int sb = task - 4;
    const int n = prompt ? PT : SKEYS, CH = prompt ? 16 : 5;
    const int krow0 = prompt ? task * PT : MP + sb * SPITCH;
    const float* cache = inp(lds, 6) + ((size_t)l * SBN + (prompt ? 0 : sb)) * PAST * 4;
    const int t0 = tid * CH;
    f32x4 s = {0.f, 0.f, 0.f, 0.f};
    for (int i = 0; i < CH; ++i) { const int t = t0 + i; if (t < n) { const f32x4 v = (!prompt && t < PAST) ? *(const f32x4*)(cache + (size_t)t * 4) : *(const f32x4*)(LOGF + (size_t)(krow0 + t) * 4); s = s + v; } }
    const f32x4 own = s;
#pragma unroll
    for (int off = 1; off < 64; off <<= 1) {
#pragma unroll
        for (int c = 0; c < 4; ++c) { const float t = __shfl_up(s[c], off); if (lane >= off) s[c] += t; } }
    LAS f32x4* wt = (LAS f32x4*)lds;
    if (lane == 63) wt[wid] = s;
    __syncthreads();
    f32x4 pre = s - own;
    for (int w = 0; w < wid; ++w) pre = pre + wt[w];
    for (int i = 0; i < CH; ++i) { const int t = t0 + i; if (t < n) { const f32x4 v = (!prompt && t < PAST) ? *(const f32x4*)(cache + (size_t)t * 4) : *(const f32x4*)(LOGF + (size_t)(krow0 + t) * 4); pre = pre + v;
        *(f32x4*)(FB + (size_t)(krow0 + t) * 4) = pre * LOG2E; } }
    __syncthreads();
}

#define MFMA32(a, b, c) __builtin_amdgcn_mfma_f32_32x32x16_bf16((a), (b), (c), 0, 0, 0)
__device__ __forceinline__ s16x4 tr_rd(const LAS unsigned char* p) { typedef short v4i16_t __attribute__((ext_vector_type(4))); return __builtin_bit_cast(s16x4, __builtin_amdgcn_ds_read_tr16_b64_v4i16((LAS v4i16_t*)p)); }
__device__ __forceinline__ bf16x8 pack8(const f32x16& p, int b) {
    u32x4 w; w.x = cvtpk(p[b], p[b + 1]); w.y = cvtpk(p[b + 2], p[b + 3]); w.z = cvtpk(p[b + 4], p[b + 5]); w.w = cvtpk(p[b + 6], p[b + 7]); return __builtin_bit_cast(bf16x8, w);
}
template <int TYPE, bool SAMP>
__device__ __forceinline__ void attn_unit(unsigned char* ws, LAS unsigned char* lds, int l, int qrow0, int nq, int krow0, int qpos0, int nkeys, int h) {
    constexpr int DQK = TYPE == 0 ? 96 : 64, DV = TYPE == 0 ? 128 : 64, NS = DQK / 16, NDB = DV / 32;
    constexpr int KP = TYPE == 0 ? 208 : 144, VP = TYPE == 0 ? 320 : 192;
    constexpr int KBYTES = 64 * KP, VBYTES = 64 * VP, BUFB = KBYTES + VBYTES, OFF_F = 2 * BUFB, OFF_FLAG = OFF_F + 512;
    const int tid = fresh_tid(), lane = tid & 63, wid = __builtin_amdgcn_readfirstlane(tid >> 6), r32 = lane & 31, hh = lane >> 5;
    const bool wave_on = 32 * wid < nq;
    const int qloc = min(32 * wid + r32, nq - 1);
    const int qrow = qrow0 + qloc;
    const int qpos = qpos0 + 32 * wid + r32;
    const int qp_lo = qpos0 + 32 * wid, qp_hi = qp_lo + 31;
    const int jmax = (qpos0 + nq - 1) >> 6;
    const int wjmax = TYPE == 0 ? (qp_lo >> 6) : TYPE == 1 ? (qp_hi >> 6) : ((qp_hi - 1) >> 6);
    const bf16_t* Kg = TYPE == 0 ? WSP(const bf16_t, WS_KA) : TYPE == 1 ? WSP(const bf16_t, WS_KB) : WSP(const bf16_t, WS_KC); const bf16_t* Vg = TYPE == 0 ? WSP(const bf16_t, WS_VA) : TYPE == 1 ? WSP(const bf16_t, WS_VB) : WSP(const bf16_t, WS_VC);
    constexpr int NKC = TYPE == 0 ? 2 : 1, NVC = TYPE == 0 ? 2 : 1;
    const bf16_t* ksrc[NKC]; int kdst[NKC]; bool kval[NKC]; const bf16_t* vsrc[NVC]; int vdst[NVC];
#pragma unroll
    for (int r = 0; r < NKC; ++r) {
        if (TYPE == 0) { const int n = tid + 512 * r; kval[r] = n < 768; const int nn = kval[r] ? n : 0; const int row = nn / 12, c = nn % 12;
            ksrc[r] = c < 8 ? WSP(const bf16_t, WS_KA) + (size_t)(krow0 + row) * 256 + h * 64 + c * 8 : (const bf16_t*)(ws + kr_off(l)) + (size_t)(krow0 + row) * 32 + (c - 8) * 8; kdst[r] = row * KP + c * 16; }
        else { const int row = tid >> 3, c = tid & 7; kval[r] = true; ksrc[r] = Kg + (size_t)(krow0 + row) * 256 + h * 64 + c * 8; kdst[r] = row * KP + c * 16; }
    }
#pragma unroll
    for (int r = 0; r < NVC; ++r) {
        if (TYPE == 0) { const int n = tid + 512 * r; const int row = n >> 4, c = n & 15; vsrc[r] = WSP(const bf16_t, WS_VA) + (size_t)(krow0 + row) * 512 + h * 128 + c * 8; vdst[r] = row * VP + c * 16; }
        else { const int row = tid >> 3, c = tid & 7; vsrc[r] = Vg + (size_t)(krow0 + row) * 256 + h * 64 + c * 8; vdst[r] = row * VP + c * 16; }
    }
    const size_t kstepA = (size_t)64 * 256, kstepR = (size_t)64 * 32, vstep = (size_t)64 * (TYPE == 0 ? 512 : 256);
    u32x4 kreg[NKC], vreg[NVC]; float freg = 0.f;
    constexpr bool F32C = SAMP && TYPE != 0;
    const float* kc32 = nullptr; const float* vc32 = nullptr; u32x4 kx[2], vx[2]; bool ld32 = false;
    if (F32C) { const int sb = (krow0 - MP) / SPITCH; const size_t o32 = (((size_t)l * SBN + sb) * PAST + (tid >> 3)) * 256 + h * 64 + (tid & 7) * 8;
        kc32 = inp(lds, TYPE == 1 ? 4 : 7) + o32; vc32 = inp(lds, TYPE == 1 ? 5 : 8) + o32; }
#define ATT_LOAD(j) do { if (F32C && (j) < PAST / 64) { ld32 = true; const size_t t_ = (size_t)(j) * 64 * 256; \
            kx[0] = *(const u32x4*)(kc32 + t_); kx[1] = *(const u32x4*)(kc32 + t_ + 4); vx[0] = *(const u32x4*)(vc32 + t_); vx[1] = *(const u32x4*)(vc32 + t_ + 4); } else { ld32 = false; \
        _Pragma("unroll") for (int r_ = 0; r_ < NKC; ++r_) { const bool rope_ = (TYPE == 0) && (((tid + 512 * r_) % 12) >= 8); \
            if (kval[r_]) kreg[r_] = *(const u32x4*)(ksrc[r_] + (size_t)(j) * (rope_ ? kstepR : kstepA)); } \
        _Pragma("unroll") for (int r_ = 0; r_ < NVC; ++r_) vreg[r_] = *(const u32x4*)(vsrc[r_] + (size_t)(j) * vstep); } \
        if (TYPE == 1 && tid < 64) freg = WSP(const float, WS_FB)[(size_t)(krow0 + 64 * (j) + tid) * 4 + h]; } while (0)
#define ATT_STORE(b) do { LAS unsigned char* kb_ = lds + (b) * BUFB; \
        if (F32C && ld32) { kreg[0] = (u32x4){cvtpk(__uint_as_float(kx[0].x), __uint_as_float(kx[0].y)), cvtpk(__uint_as_float(kx[0].z), __uint_as_float(kx[0].w)), cvtpk(__uint_as_float(kx[1].x), __uint_as_float(kx[1].y)), cvtpk(__uint_as_float(kx[1].z), __uint_as_float(kx[1].w))}; \
            vreg[0] = (u32x4){cvtpk(__uint_as_float(vx[0].x), __uint_as_float(vx[0].y)), cvtpk(__uint_as_float(vx[0].z), __uint_as_float(vx[0].w)), cvtpk(__uint_as_float(vx[1].x), __uint_as_float(vx[1].y)), cvtpk(__uint_as_float(vx[1].z), __uint_as_float(vx[1].w))}; } \
        _Pragma("unroll") for (int r_ = 0; r_ < NKC; ++r_) if (kval[r_]) *(LAS u32x4*)(kb_ + kdst[r_]) = kreg[r_]; \
        _Pragma("unroll") for (int r_ = 0; r_ < NVC; ++r_) *(LAS u32x4*)(kb_ + KBYTES + vdst[r_]) = vreg[r_]; \
        if (TYPE == 1 && tid < 64) ((LAS float*)(lds + OFF_F))[(b) * 64 + tid] = freg; } while (0)
    bf16x8 qf[NS];
    { const bf16_t* qp = TYPE == 0 ? WSP(const bf16_t, WS_QA) + (size_t)qrow * 384 + h * 96 : (TYPE == 1 ? WSP(const bf16_t, WS_QB) : WSP(const bf16_t, WS_QC)) + (size_t)qrow * 256 + h * 64;
#pragma unroll
      for (int s = 0; s < NS; ++s) qf[s] = *(const bf16x8*)(qp + 16 * s + 8 * hh); }
    float fq = 0.f; if (TYPE == 1) fq = WSP(const float, WS_FB)[(size_t)(krow0 + min(qpos, nkeys - 1)) * 4 + h];
    float bound = INFINITY;
    if (TYPE == 1 && nq == 256) {
        float qn = 0.f;
#pragma unroll
        for (int s = 0; s < NS; ++s)
#pragma unroll
            for (int e = 0; e < 8; ++e) { const float x = __uint_as_float((unsigned)(unsigned short)qf[s][e] << 16); qn += x * x; }
        qn = half_swap_sum(qn);
        const unsigned* km = WSP(const unsigned, WS_CTL) + CW_KMAX + ((l * 4 + krow0 / PT) * 4 + h) * 2;
        bound = sqrtf(qn * (__uint_as_float(km[0]) + __uint_as_float(km[1]))) * 1.02f + 1.0f;
    }
    f32x16 o[NDB];
#pragma unroll
    for (int d = 0; d < NDB; ++d)
#pragma unroll
        for (int i = 0; i < 16; ++i) o[d][i] = 0.f;
    float mrun = 0.f, lrun = 0.f, carry = 0.f; bool wdone = !wave_on;
    f32x16 negc;
#pragma unroll
    for (int i = 0; i < 16; ++i) negc[i] = (TYPE == 1) ? fq : 0.f;
    LAS unsigned* flags = (LAS unsigned*)(lds + OFF_FLAG);
    if (TYPE != 0 && lane == 0) { flags[wid] = wave_on ? 0u : 1u; flags[8 + wid] = wave_on ? 0u : 1u; }
    const int pir = (r32 & ~12) | ((r32 & 4) << 1) | ((r32 & 8) >> 1);
    const int krd = pir * KP + 16 * hh;
    const int vrd = (8 * hh + ((lane & 15) >> 2)) * VP + 32 * ((lane >> 4) & 1) + 8 * (lane & 3);
    ATT_LOAD(jmax); ATT_STORE(0);
    for (int j = jmax; j >= 0; --j) {
        const int buf = (jmax - j) & 1;
        if (j > 0) ATT_LOAD(j - 1);
        __syncthreads();
        if (TYPE != 0) { const u32x4 f0 = *(const LAS u32x4*)(flags + 8 * buf), f1 = *(const LAS u32x4*)(flags + 8 * buf + 4);
            const unsigned all = f0.x & f0.y & f0.z & f0.w & f1.x & f1.y & f1.z & f1.w; if (__builtin_amdgcn_readfirstlane(all)) break; }
        if (wave_on && !wdone && j <= wjmax) {
            const LAS unsigned char* Kb = lds + buf * BUFB; const LAS unsigned char* Vb = Kb + KBYTES;
            f32x16 s0, s1;
            {
                bf16x8 kf0[NS], kf1[NS];
#pragma unroll
                for (int s = 0; s < NS; ++s) { kf0[s] = *(const LAS bf16x8*)(Kb + krd + 32 * s); kf1[s] = *(const LAS bf16x8*)(Kb + krd + 32 * KP + 32 * s); }
                __builtin_amdgcn_sched_barrier(0);

#pragma unroll
                for (int s = 0; s < NS; ++s) { if (s == 0) { s0 = MFMA32(kf0[0], qf[0], negc); s1 = MFMA32(kf1[0], qf[0], negc); } else { s0 = MFMA32(kf0[s], qf[s], s0); s1 = MFMA32(kf1[s], qf[s], s1); } }

                __builtin_amdgcn_sched_barrier(0);
            }
            s16x4 vl[2][4], vh[2][4];
#pragma unroll
            for (int ks = 0; ks < 4; ++ks) { vl[0][ks] = tr_rd(Vb + vrd + (16 * ks) * VP); vh[0][ks] = tr_rd(Vb + vrd + (16 * ks + 4) * VP); }
            __builtin_amdgcn_sched_barrier(0);
            const int kb0 = 64 * j + 8 * hh;
            const bool need_mask = TYPE == 0 ? (64 * j + 63 >= nkeys) : TYPE == 1 ? (64 * j + 63 > qp_lo) : (64 * j + 63 >= qp_lo);
            if (TYPE != 2) {
                if (TYPE == 1) { const LAS float* F = (const LAS float*)(lds + OFF_F) + buf * 64 + 8 * hh;
#pragma unroll
                    for (int a = 0; a < 2; ++a) { const f32x4 f0 = *(const LAS f32x4*)(F + 16 * a), f1 = *(const LAS f32x4*)(F + 16 * a + 4), g0 = *(const LAS f32x4*)(F + 32 + 16 * a), g1 = *(const LAS f32x4*)(F + 32 + 16 * a + 4);
#pragma unroll
                        for (int e = 0; e < 4; ++e) { s0[8 * a + e] -= f0[e]; s0[8 * a + 4 + e] -= f1[e]; s1[8 * a + e] -= g0[e]; s1[8 * a + 4 + e] -= g1[e]; } } }
                if (need_mask) {
#pragma unroll
                    for (int i = 0; i < 16; ++i) { const int k0 = kb0 + 16 * (i >> 3) + (i & 7), k1 = k0 + 32;
                        const bool ok0 = TYPE == 0 ? (k0 < nkeys) : (k0 <= qpos), ok1 = TYPE == 0 ? (k1 < nkeys) : (k1 <= qpos);
                        s0[i] = ok0 ? s0[i] : -INFINITY; s1[i] = ok1 ? s1[i] : -INFINITY; } }
#define MX3(a, b, c) __builtin_fmaxf(__builtin_fmaxf((a), (b)), (c))
                float rm;
                { const float t0 = MX3(s0[0], s0[1], s0[2]), t1 = MX3(s0[3], s0[4], s0[5]), t2 = MX3(s0[6], s0[7], s0[8]), t3 = MX3(s0[9], s0[10], s0[11]), t4 = MX3(s0[12], s0[13], s0[14]),
                              t5 = MX3(s1[0], s1[1], s1[2]), t6 = MX3(s1[3], s1[4], s1[5]), t7 = MX3(s1[6], s1[7], s1[8]), t8 = MX3(s1[9], s1[10], s1[11]), t9 = MX3(s1[12], s1[13], s1[14]);
                  const float u0 = MX3(t0, t1, t2), u1 = MX3(t3, t4, t5), u2 = MX3(t6, t7, t8), u3 = MX3(t9, s0[15], s1[15]); rm = __builtin_fmaxf(MX3(u0, u1, u2), u3); }
#undef MX3
                rm = half_swap_max(rm);
                const bool first = (j == wjmax);
                if (first || __any(rm > 8.0f)) {
                    const float dl = first ? rm : fmaxf(rm, 0.f);
                    mrun += dl;
#pragma unroll
                    for (int i = 0; i < 16; ++i) { s0[i] -= dl; s1[i] -= dl; }
                    const float cin = (TYPE == 1 ? fq : 0.f) - mrun;
#pragma unroll
                    for (int i = 0; i < 16; ++i) negc[i] = cin;
                    if (!first) { const float f = __builtin_amdgcn_exp2f(-dl); lrun *= f;
#pragma unroll
                        for (int d = 0; d < NDB; ++d)
#pragma unroll
                            for (int i = 0; i < 16; ++i) o[d][i] *= f; }
                }
                f32x2_t ls2 = {0.f, 0.f};
#pragma unroll
                for (int i = 0; i < 16; ++i) { s0[i] = __builtin_amdgcn_exp2f(s0[i]); s1[i] = __builtin_amdgcn_exp2f(s1[i]); }
#pragma unroll
                for (int i = 0; i < 16; i += 2) { ls2 += (f32x2_t){s0[i], s0[i + 1]}; ls2 += (f32x2_t){s1[i], s1[i + 1]}; }
                lrun += ls2[0] + ls2[1];
                if (TYPE == 1 && j > 0) { const float fnext = WSP(const float, WS_FB)[(size_t)(krow0 + 64 * j - 1) * 4 + h]; wdone = __all(bound + (fq - fnext) - mrun < EXIT_LOG2); }
            } else {
                f32x16 lk0, lk1;
#pragma unroll
                for (int i = 0; i < 16; ++i) {
                    const float z0 = s0[i], z1 = s1[i];
                    const float sp0 = fmaxf(z0, 0.f) + __builtin_amdgcn_logf(1.0f + __builtin_amdgcn_exp2f(-fabsf(z0))), sp1 = fmaxf(z1, 0.f) + __builtin_amdgcn_logf(1.0f + __builtin_amdgcn_exp2f(-fabsf(z1)));
                    lk0[i] = -sp0; lk1[i] = -sp1; s0[i] = z0 - sp0; s1[i] = z1 - sp1; }
                if (need_mask) {
#pragma unroll
                    for (int i = 0; i < 16; ++i) { const int k0 = kb0 + 16 * (i >> 3) + (i & 7), k1 = k0 + 32; const bool ok0 = k0 < qpos, ok1 = k1 < qpos;
                        lk0[i] = ok0 ? lk0[i] : 0.f; lk1[i] = ok1 ? lk1[i] : 0.f; s0[i] = ok0 ? s0[i] : -INFINITY; s1[i] = ok1 ? s1[i] : -INFINITY; } }
                f32x16 sf0, sf1; float gt[4];
#pragma unroll
                for (int a = 0; a < 2; ++a) { float r0 = 0.f, r1 = 0.f;
#pragma unroll
                    for (int e = 7; e >= 0; --e) { sf0[8 * a + e] = r0; r0 += lk0[8 * a + e]; sf1[8 * a + e] = r1; r1 += lk1[8 * a + e]; }
                    gt[a] = r0; gt[2 + a] = r1; }
                float pt[4], gs[4];
#pragma unroll
                for (int c = 0; c < 4; ++c) pt[c] = __shfl_xor(gt[c], 32);
                float later = 0.f;
#pragma unroll
                for (int c = 3; c >= 0; --c) { gs[c] = later + (hh == 0 ? pt[c] : 0.f); later += gt[c] + pt[c]; }
#pragma unroll
                for (int i = 0; i < 16; ++i) { s0[i] = __builtin_amdgcn_exp2f(s0[i] + sf0[i] + gs[i >> 3] + carry); s1[i] = __builtin_amdgcn_exp2f(s1[i] + sf1[i] + gs[2 + (i >> 3)] + carry); }
                carry += later;
                wdone = __all(carry < EXIT_LOG2);
            }
            bf16x8 pk[4]; pk[0] = pack8(s0, 0); pk[1] = pack8(s0, 8); pk[2] = pack8(s1, 0); pk[3] = pack8(s1, 8);
            {
#pragma unroll
                for (int d = 0; d < NDB; ++d) {
                    if (d + 1 < NDB) {
#pragma unroll
                        for (int ks = 0; ks < 4; ++ks) { vl[(d + 1) & 1][ks] = tr_rd(Vb + vrd + (16 * ks) * VP + 64 * (d + 1)); vh[(d + 1) & 1][ks] = tr_rd(Vb + vrd + (16 * ks + 4) * VP + 64 * (d + 1)); } }
                    __builtin_amdgcn_sched_barrier(0);

#pragma unroll
                    for (int ks = 0; ks < 4; ++ks) { const bf16x8 vf = __builtin_shufflevector(vl[d & 1][ks], vh[d & 1][ks], 0, 1, 2, 3, 4, 5, 6, 7); o[d] = MFMA32(vf, pk[ks], o[d]); }

                    __builtin_amdgcn_sched_barrier(0);
                }
            }
        }
        if (TYPE != 0 && lane == 0) flags[8 * (buf ^ 1) + wid] = wdone ? 1u : 0u;
        if (j > 0) ATT_STORE(buf ^ 1);
    }
    __syncthreads();
    if (wave_on) {
        float inv = 1.0f;
        if (TYPE != 2) { const float lt = half_swap_sum(lrun); inv = 1.0f / lt; }
        float ssq = 0.f;
#pragma unroll
        for (int d = 0; d < NDB; ++d)
#pragma unroll
            for (int i = 0; i < 16; ++i) { o[d][i] *= inv; ssq += o[d][i] * o[d][i]; }
        ssq = half_swap_sum(ssq);
        const bool rowok = 32 * wid + r32 < nq;
        if (rowok) {
            if (hh == 0) WSP(float, WS_SS)[(size_t)qrow * 12 + TYPE * 4 + h] = ssq;
            const int col0 = (TYPE == 0 ? 0 : TYPE == 1 ? 512 : 768) + h * DV + 4 * hh;
#pragma unroll
            for (int d = 0; d < NDB; ++d) { u32x2 gw[4];
#pragma unroll
                for (int g = 0; g < 4; ++g) gw[g] = *(const u32x2*)(WSP(const bf16_t, WS_GATE) + (size_t)qrow * D + col0 + 32 * d + 8 * g);
#pragma unroll
                for (int g = 0; g < 4; ++g) { u32x2 w; w.x = cvtpk(o[d][4 * g] * bf_lo(gw[g].x), o[d][4 * g + 1] * bf_hi(gw[g].x)); w.y = cvtpk(o[d][4 * g + 2] * bf_lo(gw[g].y), o[d][4 * g + 3] * bf_hi(gw[g].y));
                    *(u32x2*)(WSP(bf16_t, WS_OP) + (size_t)qrow * D + col0 + 32 * d + 8 * g) = w; } }
        }
    }
#undef ATT_LOAD
#undef ATT_STORE
}

template <int TYPE>
__device__ __forceinline__ void attn_pp(unsigned char* ws, LAS unsigned char* lds, int l, int qrow0, int krow0, int qpos0, int h) {
    constexpr int DQK = TYPE == 0 ? 96 : 64, DV = TYPE == 0 ? 128 : 64, NS = DQK / 16, NDB = DV / 32;
    constexpr int KP = TYPE == 0 ? 208 : 144, VP = TYPE == 0 ? 320 : 192;
    constexpr int KBYTES = 64 * KP, VBYTES = 64 * VP, OFF_V = 3 * KBYTES, OFF_F = OFF_V + 3 * VBYTES, OFF_FLAG = OFF_F + 3 * 256;
    const int tid = fresh_tid(), lane = tid & 63, wid = __builtin_amdgcn_readfirstlane(tid >> 6), r32 = lane & 31, hh = lane >> 5;
    const bool lag = wid >= 4;
    const int qrow = qrow0 + 32 * wid + r32, qpos = qpos0 + 32 * wid + r32, qp_lo = qpos0 + 32 * wid, qp_hi = qp_lo + 31;
    const int jmax = (qpos0 + 255) >> 6;
    const int wjmax = TYPE == 0 ? (qp_lo >> 6) : TYPE == 1 ? (qp_hi >> 6) : ((qp_hi - 1) >> 6);
    constexpr bool ASC = (TYPE == 0);
#define PP_T(i) (ASC ? (i) : jmax - (i))
    const size_t Kg = TYPE == 0 ? WS_KA : TYPE == 1 ? WS_KB : WS_KC, Vg = TYPE == 0 ? WS_VA : TYPE == 1 ? WS_VB : WS_VC;
    constexpr int NKC = TYPE == 0 ? 2 : 1, NVC = TYPE == 0 ? 2 : 1;
    unsigned ksrc[NKC]; int kdst[NKC]; unsigned vsrc[NVC]; int vdst[NVC];
#pragma unroll
    for (int r = 0; r < NKC; ++r) {
        if (TYPE == 0) {
            if (r == 0) { const int row = tid >> 3, c = tid & 7; ksrc[r] = (unsigned)(WS_KA + ((size_t)(krow0 + row) * 256 + h * 64 + c * 8) * 2); kdst[r] = row * KP + c * 16; }
            else { const int row = (tid & 255) >> 2, c = tid & 3; ksrc[r] = (unsigned)(kr_off(l) + ((size_t)(krow0 + row) * 32 + c * 8) * 2); kdst[r] = row * KP + 128 + c * 16; } }
        else { const int row = tid >> 3, c = tid & 7; ksrc[r] = (unsigned)(Kg + ((size_t)(krow0 + row) * 256 + h * 64 + c * 8) * 2); kdst[r] = row * KP + c * 16; }
    }
#pragma unroll
    for (int r = 0; r < NVC; ++r) {
        if (TYPE == 0) { const int row = tid >> 4, c = tid & 15; vsrc[r] = (unsigned)(WS_VA + ((size_t)(krow0 + row) * 512 + h * 128 + c * 8) * 2); vdst[r] = row * VP + c * 16; }
        else { const int row = tid >> 3, c = tid & 7; vsrc[r] = (unsigned)(Vg + ((size_t)(krow0 + row) * 256 + h * 64 + c * 8) * 2); vdst[r] = row * VP + c * 16; }
    }
    constexpr unsigned kstepA = 64u * 256u * 2u, kstepR = 64u * 32u * 2u, vstep = 64u * (TYPE == 0 ? 512u : 256u) * 2u;
    u32x4 kreg[NKC], vreg[NVC]; float freg = 0.f;
#define PP_KLOAD(j) do { _Pragma("unroll") for (int r_ = 0; r_ < NKC; ++r_) kreg[r_] = *(const u32x4*)(ws + (ksrc[r_] + (unsigned)(j) * (r_ == 1 ? kstepR : kstepA))); \
        if (TYPE == 1) freg = WSP(const float, WS_FB)[(size_t)(krow0 + 64 * (j) + lane) * 4 + h]; } while (0)
#define PP_VLOAD(j) do { _Pragma("unroll") for (int r_ = 0; r_ < NVC; ++r_) vreg[r_] = *(const u32x4*)((ws + (size_t)r_ * 32 * 1024) + (vsrc[0] + (unsigned)(j) * vstep)); } while (0)
#define PP_KSTORE(sl) do { LAS unsigned char* kb_ = lds + (sl) * KBYTES; \
        _Pragma("unroll") for (int r_ = 0; r_ < NKC; ++r_) *(LAS u32x4*)(kb_ + kdst[r_]) = kreg[r_]; \
        if (TYPE == 1) ((LAS float*)(lds + OFF_F))[(sl) * 64 + lane] = freg; } while (0)
#define PP_VSTORE(sl) do { LAS unsigned char* vb_ = lds + OFF_V + (sl) * VBYTES; \
        _Pragma("unroll") for (int r_ = 0; r_ < NVC; ++r_) *(LAS u32x4*)(vb_ + vdst[0] + r_ * 32 * VP) = vreg[r_]; } while (0)
    bf16x8 qf[NS];
    { const bf16_t* qp = TYPE == 0 ? WSP(const bf16_t, WS_QA) + (size_t)qrow * 384 + h * 96 : (TYPE == 1 ? WSP(const bf16_t, WS_QB) : WSP(const bf16_t, WS_QC)) + (size_t)qrow * 256 + h * 64;
#pragma unroll
      for (int s = 0; s < NS; ++s) qf[s] = *(const bf16x8*)(qp + 16 * s + 8 * hh); }
    float fq = 0.f; if (TYPE == 1) fq = WSP(const float, WS_FB)[(size_t)(krow0 + qpos) * 4 + h];
    float bound = INFINITY;
    if (TYPE == 1) {
        float qn = 0.f;
#pragma unroll
        for (int s = 0; s < NS; ++s)
#pragma unroll
            for (int e = 0; e < 8; ++e) { const float x = __uint_as_float((unsigned)(unsigned short)qf[s][e] << 16); qn += x * x; }
        qn = half_swap_sum(qn);
        const unsigned* km = WSP(const unsigned, WS_CTL) + CW_KMAX + ((l * 4 + krow0 / PT) * 4 + h) * 2;
        bound = sqrtf(qn * (__uint_as_float(km[0]) + __uint_as_float(km[1]))) * 1.02f + 1.0f;
    }
    f32x16 o[NDB];
#pragma unroll
    for (int d = 0; d < NDB; ++d)
#pragma unroll
        for (int i = 0; i < 16; ++i) o[d][i] = 0.f;
    float mrun = 0.f, lrun = 0.f, carry = 0.f; bool wdone = false, pend = false, brk = false;
    float cin = (TYPE == 1) ? fq : 0.f;
    LAS unsigned* flags = (LAS unsigned*)(lds + OFF_FLAG);
    const int pir = (r32 & ~12) | ((r32 & 4) << 1) | ((r32 & 8) >> 1);
    const int krd = pir * KP + 16 * hh;
    const int vrd = (8 * hh + ((lane & 15) >> 2)) * VP + 32 * ((lane >> 4) & 1) + 8 * (lane & 3);
    f32x16 s0, s1; bf16x8 pk[4];
#pragma unroll
    for (int i = 0; i < 16; ++i) { s0[i] = cin; s1[i] = cin; }
#pragma unroll
    for (int i = 0; i < 4; ++i) pk[i] = (bf16x8){0, 0, 0, 0, 0, 0, 0, 0};
#define PP_KRD(sl) do { const LAS unsigned char* Kb_ = lds + (sl) * KBYTES; \
        _Pragma("unroll") for (int s = 0; s < NS; ++s) { kf0[s] = *(const LAS bf16x8*)(Kb_ + krd + 32 * s); kf1[s] = *(const LAS bf16x8*)(Kb_ + krd + 32 * KP + 32 * s); } } while (0)
#define PP_QKM() do { __builtin_amdgcn_sched_barrier(0); \
        _Pragma("unroll") for (int s = 0; s < NS; ++s) { s0 = MFMA32(kf0[s], qf[s], s0); s1 = MFMA32(kf1[s], qf[s], s1); } \
        __builtin_amdgcn_sched_barrier(0); } while (0)
#define PP_VRD(sl, d) do { const LAS unsigned char* Vb_ = lds + OFF_V + (sl) * VBYTES; \
        _Pragma("unroll") for (int ks = 0; ks < 4; ++ks) { vl[d][ks] = tr_rd(Vb_ + vrd + (16 * ks) * VP + 64 * (d)); vh[d][ks] = tr_rd(Vb_ + vrd + (16 * ks + 4) * VP + 64 * (d)); } } while (0)
#define PP_PVM(d) do { _Pragma("unroll") for (int ks = 0; ks < 4; ++ks) { const bf16x8 vf = __builtin_shufflevector(vl[d][ks], vh[d][ks], 0, 1, 2, 3, 4, 5, 6, 7); o[d] = MFMA32(vf, pk[ks], o[d]); } } while (0)
    PP_KLOAD(PP_T(0)); PP_VLOAD(PP_T(0)); PP_KSTORE(0); PP_VSTORE(0);
    PP_KLOAD(PP_T(1)); PP_KSTORE(1);
    PP_KLOAD(PP_T(2)); PP_VLOAD(PP_T(1));
    __syncthreads();
    if (PP_T(0) <= wjmax) { bf16x8 kf0[NS], kf1[NS]; PP_KRD(0); PP_QKM(); }
    if (lag) __syncthreads();
    int c = 0;
    for (int it = 0; it <= jmax; ++it) {
        const int j = PP_T(it), jn = PP_T(it + 1);
        const int c1 = c == 2 ? 0 : c + 1, c2 = c1 == 2 ? 0 : c1 + 1;
        bf16x8 kf0[NS], kf1[NS];
        s16x4 vl[NDB][4], vh[NDB][4];
        __syncthreads();
        if (TYPE != 0 && !lag && it > 0) { const u32x4 f0 = *(const LAS u32x4*)(flags + 8 * ((j + 1) & 1)), f1 = *(const LAS u32x4*)(flags + 8 * ((j + 1) & 1) + 4);
            const unsigned all = f0.x & f0.y & f0.z & f0.w & f1.x & f1.y & f1.z & f1.w; if (__builtin_amdgcn_readfirstlane(all)) { brk = true; break; } }
        PP_KSTORE(c2); PP_VSTORE(c1);
        const bool doq = it < jmax && jn <= wjmax && !wdone;
        PP_KRD(c1);
        { const int ik = it + 3 <= jmax ? it + 3 : jmax, iv = it + 2 <= jmax ? it + 2 : jmax; PP_KLOAD(PP_T(ik)); PP_VLOAD(PP_T(iv)); }
        if (j <= wjmax && !wdone) {
            const int kb0 = 64 * j + 8 * hh;
            const bool need_mask = TYPE == 0 ? false : TYPE == 1 ? (64 * j + 63 > qp_lo) : (64 * j + 63 >= qp_lo);
            if (TYPE != 2) {
                if (TYPE == 1) { const LAS float* F = (const LAS float*)(lds + OFF_F) + c * 64 + 8 * hh;
#pragma unroll
                    for (int a = 0; a < 2; ++a) { const f32x4 f0 = *(const LAS f32x4*)(F + 16 * a), f1 = *(const LAS f32x4*)(F + 16 * a + 4), g0 = *(const LAS f32x4*)(F + 32 + 16 * a), g1 = *(const LAS f32x4*)(F + 32 + 16 * a + 4);
#pragma unroll
                        for (int e = 0; e < 4; ++e) { s0[8 * a + e] -= f0[e]; s0[8 * a + 4 + e] -= f1[e]; s1[8 * a + e] -= g0[e]; s1[8 * a + 4 + e] -= g1[e]; } } }
                if (need_mask) {
#pragma unroll
                    for (int i = 0; i < 16; ++i) { const int k0 = kb0 + 16 * (i >> 3) + (i & 7), k1 = k0 + 32;
                        s0[i] = (k0 <= qpos) ? s0[i] : -INFINITY; s1[i] = (k1 <= qpos) ? s1[i] : -INFINITY; } }
#define MX3(a, b, c) __builtin_fmaxf(__builtin_fmaxf((a), (b)), (c))
                float rm;
                { const float t0 = MX3(s0[0], s0[1], s0[2]), t1 = MX3(s0[3], s0[4], s0[5]), t2 = MX3(s0[6], s0[7], s0[8]), t3 = MX3(s0[9], s0[10], s0[11]), t4 = MX3(s0[12], s0[13], s0[14]),
                              t5 = MX3(s1[0], s1[1], s1[2]), t6 = MX3(s1[3], s1[4], s1[5]), t7 = MX3(s1[6], s1[7], s1[8]), t8 = MX3(s1[9], s1[10], s1[11]), t9 = MX3(s1[12], s1[13], s1[14]);
                  const float u0 = MX3(t0, t1, t2), u1 = MX3(t3, t4, t5), u2 = MX3(t6, t7, t8), u3 = MX3(t9, s0[15], s1[15]); rm = __builtin_fmaxf(MX3(u0, u1, u2), u3); }
#undef MX3
                rm = half_swap_max(rm);
                const bool first = ASC ? (it == 0) : (j == wjmax);
                if (first || __any(rm > 8.0f)) {
                    const float dl = first ? rm : fmaxf(rm, 0.f);
                    mrun += dl;
#pragma unroll
                    for (int i = 0; i < 16; ++i) { s0[i] -= dl; s1[i] -= dl; }
                    cin = (TYPE == 1 ? fq : 0.f) - mrun;
                    if (!first) { const float f = __builtin_amdgcn_exp2f(-dl); lrun *= f;
#pragma unroll
                        for (int d = 0; d < NDB; ++d)
#pragma unroll
                            for (int i = 0; i < 16; ++i) o[d][i] *= f; }
                }
                f32x2_t ls2 = {0.f, 0.f};
#pragma unroll
                for (int i = 0; i < 16; ++i) { s0[i] = __builtin_amdgcn_exp2f(s0[i]); s1[i] = __builtin_amdgcn_exp2f(s1[i]); }
#pragma unroll
                for (int i = 0; i < 16; i += 2) { ls2 += (f32x2_t){s0[i], s0[i + 1]}; ls2 += (f32x2_t){s1[i], s1[i + 1]}; }
                lrun += ls2[0] + ls2[1];
                if (TYPE == 1 && j > 0) { const float fnext = ((const LAS float*)(lds + OFF_F))[c1 * 64 + 63]; wdone = __all(bound + (fq - fnext) - mrun < EXIT_LOG2); }
            } else {
                f32x16 lk0, lk1;
#pragma unroll
                for (int i = 0; i < 16; ++i) {
                    const float z0 = s0[i], z1 = s1[i];
                    const float sp0 = fmaxf(z0, 0.f) + __builtin_amdgcn_logf(1.0f + __builtin_amdgcn_exp2f(-fabsf(z0))), sp1 = fmaxf(z1, 0.f) + __builtin_amdgcn_logf(1.0f + __builtin_amdgcn_exp2f(-fabsf(z1)));
                    lk0[i] = -sp0; lk1[i] = -sp1; s0[i] = z0 - sp0; s1[i] = z1 - sp1; }
                if (need_mask) {
#pragma unroll
                    for (int i = 0; i < 16; ++i) { const int k0 = kb0 + 16 * (i >> 3) + (i & 7), k1 = k0 + 32; const bool ok0 = k0 < qpos, ok1 = k1 < qpos;
                        lk0[i] = ok0 ? lk0[i] : 0.f; lk1[i] = ok1 ? lk1[i] : 0.f; s0[i] = ok0 ? s0[i] : -INFINITY; s1[i] = ok1 ? s1[i] : -INFINITY; } }
                f32x16 sf0, sf1; float gt[4];
#pragma unroll
                for (int a = 0; a < 2; ++a) { float r0 = 0.f, r1 = 0.f;
#pragma unroll
                    for (int e = 7; e >= 0; --e) { sf0[8 * a + e] = r0; r0 += lk0[8 * a + e]; sf1[8 * a + e] = r1; r1 += lk1[8 * a + e]; }
                    gt[a] = r0; gt[2 + a] = r1; }
                float pt[4], gs[4];
#pragma unroll
                for (int cc = 0; cc < 4; ++cc) pt[cc] = __shfl_xor(gt[cc], 32);
                float later = 0.f;
#pragma unroll
                for (int cc = 3; cc >= 0; --cc) { gs[cc] = later + (hh == 0 ? pt[cc] : 0.f); later += gt[cc] + pt[cc]; }
#pragma unroll
                for (int i = 0; i < 16; ++i) { s0[i] = __builtin_amdgcn_exp2f(s0[i] + sf0[i] + gs[i >> 3] + carry); s1[i] = __builtin_amdgcn_exp2f(s1[i] + sf1[i] + gs[2 + (i >> 3)] + carry); }
                carry += later;
                wdone = __all(carry < EXIT_LOG2);
            }
            pk[0] = pack8(s0, 0); pk[1] = pack8(s0, 8); pk[2] = pack8(s1, 0); pk[3] = pack8(s1, 8); pend = true;
#pragma unroll
            for (int i = 0; i < 16; ++i) { s0[i] = cin; s1[i] = cin; }
        }
        if (TYPE != 0 && lane == 0) flags[8 * (j & 1) + wid] = wdone ? 1u : 0u;
        __syncthreads();
        bool allq = false;
        if (TYPE != 0 && lag) { const u32x4 f0 = *(const LAS u32x4*)(flags + 8 * (j & 1)), f1 = *(const LAS u32x4*)(flags + 8 * (j & 1) + 4);
            const unsigned all = f0.x & f0.y & f0.z & f0.w & f1.x & f1.y & f1.z & f1.w; allq = __builtin_amdgcn_readfirstlane(all) != 0u; }
        if (pend) PP_VRD(c, 0);
        if (doq && !wdone && !allq) PP_QKM();
        if (pend) {
            PP_VRD(c, 1); if (NDB > 2) { PP_VRD(c, 2); PP_VRD(c, 3); }
            __builtin_amdgcn_sched_barrier(0);
            PP_PVM(0); PP_PVM(1);
            if (NDB > 2) { PP_PVM(2); PP_PVM(3); }
            __builtin_amdgcn_sched_barrier(0);
            pend = false; }
        if (allq) { brk = true; break; }
        c = c1;
    }
    if (!lag && !brk) __syncthreads();
    __syncthreads();
#undef PP_T
#undef PP_KLOAD
#undef PP_VLOAD
#undef PP_KSTORE
#undef PP_VSTORE
#undef PP_KRD
#undef PP_QKM
#undef PP_VRD
#undef PP_PVM
    {
        float inv = 1.0f;
        if (TYPE != 2) { const float lt = half_swap_sum(lrun); inv = 1.0f / lt; }
        float ssq = 0.f;
#pragma unroll
        for (int d = 0; d < NDB; ++d)
#pragma unroll
            for (int i = 0; i < 16; ++i) { o[d][i] *= inv; ssq += o[d][i] * o[d][i]; }
        ssq = half_swap_sum(ssq);
        if (hh == 0) WSP(float, WS_SS)[(size_t)qrow * 12 + TYPE * 4 + h] = ssq;
        const int col0 = (TYPE == 0 ? 0 : TYPE == 1 ? 512 : 768) + h * DV + 4 * hh;
#pragma unroll
        for (int d = 0; d < NDB; ++d) { u32x2 gw[4];
#pragma unroll
            for (int g = 0; g < 4; ++g) gw[g] = *(const u32x2*)(WSP(const bf16_t, WS_GATE) + (size_t)qrow * D + col0 + 32 * d + 8 * g);
#pragma unroll
            for (int g = 0; g < 4; ++g) { u32x2 w; w.x = cvtpk(o[d][4 * g] * bf_lo(gw[g].x), o[d][4 * g + 1] * bf_hi(gw[g].x)); w.y = cvtpk(o[d][4 * g + 2] * bf_lo(gw[g].y), o[d][4 * g + 3] * bf_hi(gw[g].y));
                *(u32x2*)(WSP(bf16_t, WS_OP) + (size_t)qrow * D + col0 + 32 * d + 8 * g) = w; } }
    }
}

template <int TYPE>
__device__ __forceinline__ void sample_octet(unsigned char* ws, float* out, LAS unsigned char* lds, int l, int oct) {
    constexpr int DQK = TYPE == 0 ? 96 : 64, DV = TYPE == 0 ? 128 : 64, NS = DQK / 16, NDB = DV / 32, VP = TYPE == 0 ? 320 : 192;
    constexpr int NT = 65;
    const int tid = fresh_tid(), lane = tid & 63, wid = __builtin_amdgcn_readfirstlane(tid >> 6), r32 = lane & 31, hh = lane >> 5;
    const int unit = oct * 8 + wid, sb = unit >> 2, h = unit & 3;
    LAS unsigned char* Vl = lds + wid * 10240;
    const int krow0 = MP + sb * SPITCH, qrow = MP + sb * STN + min(r32, STN - 1), qpos = PAST + r32;
    bf16x8 qf[NS];
    { const bf16_t* qp = TYPE == 0 ? WSP(const bf16_t, WS_QA) + (size_t)qrow * 384 + h * 96 : (TYPE == 1 ? WSP(const bf16_t, WS_QB) : WSP(const bf16_t, WS_QC)) + (size_t)qrow * 256 + h * 64;
#pragma unroll
      for (int s = 0; s < NS; ++s) qf[s] = *(const bf16x8*)(qp + 16 * s + 8 * hh); }
    float fq = 0.f; if (TYPE == 1) fq = WSP(const float, WS_FB)[(size_t)(krow0 + min(qpos, SKEYS - 1)) * 4 + h];
    const int pir = (r32 & ~12) | ((r32 & 4) << 1) | ((r32 & 8) >> 1);
    const float* kc = nullptr; const float* vc = nullptr; const float* kn = nullptr; const float* vn = nullptr;
    if (TYPE != 0) { const size_t cb = ((size_t)l * SBN + sb) * PAST * 256 + h * 64, nb = ((size_t)l * MS + sb * STN) * 256 + h * 64;
        kc = inp(lds, TYPE == 1 ? 4 : 7) + cb; vc = inp(lds, TYPE == 1 ? 5 : 8) + cb; kn = out + (TYPE == 1 ? O_SFK : O_SSK) + nb; vn = out + (TYPE == 1 ? O_SFV : O_SSV) + nb; }
    const bf16_t* KAp = WSP(const bf16_t, WS_KA) + (size_t)krow0 * 256 + h * 64; const bf16_t* KRp = (const bf16_t*)(ws + kr_off(l)) + (size_t)krow0 * 32; const bf16_t* VAp = WSP(const bf16_t, WS_VA) + (size_t)krow0 * 512 + h * 128;
    constexpr int NKR = TYPE == 0 ? NS : 2 * NS, NVR = 8;
    constexpr int PD = 1;
    u32x4 kraw[PD][NKR], vraw[PD][NVR]; float fkr[2][2] = {{0.f, 0.f}, {0.f, 0.f}};
#define SO_LOAD(t, S) do { \
        if (TYPE == 0) { const size_t kr_ = (size_t)(32 * (t) + pir); \
            _Pragma("unroll") for (int s_ = 0; s_ < NS; ++s_) kraw[S][s_] = s_ < 4 ? *(const u32x4*)(KAp + kr_ * 256 + 16 * s_ + 8 * hh) : *(const u32x4*)(KRp + kr_ * 32 + 16 * (s_ - 4) + 8 * hh); \
            _Pragma("unroll") for (int i_ = 0; i_ < 8; ++i_) { const int m_ = lane + 64 * i_; vraw[S][i_] = *(const u32x4*)(VAp + (size_t)(32 * (t) + (m_ >> 4)) * 512 + (m_ & 15) * 8); } \
        } else { const float* kb_ = (t) < 64 ? kc + (size_t)(t) * 32 * 256 : kn; const float* vb_ = (t) < 64 ? vc + (size_t)(t) * 32 * 256 : vn; \
            const int rcap_ = (t) < 64 ? 31 : STN - 1;         \
            _Pragma("unroll") for (int s_ = 0; s_ < NS; ++s_) { const float* p_ = kb_ + (size_t)min(pir, rcap_) * 256 + 16 * s_ + 8 * hh; kraw[S][2 * s_] = *(const u32x4*)p_; kraw[S][2 * s_ + 1] = *(const u32x4*)(p_ + 4); } \
            _Pragma("unroll") for (int i_ = 0; i_ < 4; ++i_) { const int m_ = lane + 64 * i_; const float* p_ = vb_ + (size_t)min(m_ >> 3, rcap_) * 256 + (m_ & 7) * 8; vraw[S][2 * i_] = *(const u32x4*)p_; vraw[S][2 * i_ + 1] = *(const u32x4*)(p_ + 4); } \
            if (TYPE == 1) { fkr[S][0] = WSP(const float, WS_FB)[(size_t)(krow0 + 32 * (t) + 8 * hh + (lane & 7)) * 4 + h]; fkr[S][1] = WSP(const float, WS_FB)[(size_t)(krow0 + 32 * (t) + 16 + 8 * hh + (lane & 7)) * 4 + h]; } } } while (0)
#define F2B(a, b) (u32x4){cvtpk(__uint_as_float((a).x), __uint_as_float((a).y)), cvtpk(__uint_as_float((a).z), __uint_as_float((a).w)), cvtpk(__uint_as_float((b).x), __uint_as_float((b).y)), cvtpk(__uint_as_float((b).z), __uint_as_float((b).w))}
    f32x16 o[NDB];
#pragma unroll
    for (int d = 0; d < NDB; ++d)
#pragma unroll
        for (int i = 0; i < 16; ++i) o[d][i] = 0.f;
    float mrun = 0.f, lrun = 0.f, carry = 0.f; bool done = false;
    f32x16 negc;
#pragma unroll
    for (int i = 0; i < 16; ++i) negc[i] = (TYPE == 1) ? fq : 0.f;
    const int vrd = (8 * hh + ((lane & 15) >> 2)) * VP + 32 * ((lane >> 4) & 1) + 8 * (lane & 3);
#define SO_BODY(t, S) do { \
        bf16x8 kf[NS]; const float fk0 = fkr[S][0], fk1 = fkr[S][1]; \
        _Pragma("unroll") for (int s = 0; s < NS; ++s) kf[s] = TYPE == 0 ? __builtin_bit_cast(bf16x8, kraw[S][s]) : __builtin_bit_cast(bf16x8, F2B(kraw[S][2 * s], kraw[S][2 * s + 1])); \
        if (TYPE == 0) { _Pragma("unroll") for (int i = 0; i < 8; ++i) { const int m = lane + 64 * i; *(LAS u32x4*)(Vl + (m >> 4) * VP + (m & 15) * 16) = vraw[S][i]; } } \
        else { _Pragma("unroll") for (int i = 0; i < 4; ++i) { const int m = lane + 64 * i; *(LAS u32x4*)(Vl + (m >> 3) * VP + (m & 7) * 16) = F2B(vraw[S][2 * i], vraw[S][2 * i + 1]); } } \
        if ((t) >= PD) SO_LOAD((t) - PD, S); \
        f32x16 s0; \
         \
        _Pragma("unroll") for (int s = 0; s < NS; ++s) s0 = MFMA32(kf[s], qf[s], s == 0 ? negc : s0); \
         \
        const int kb0 = 32 * (t) + 8 * hh;                                          \
        const bool need_mask = ((t) == NT - 1); \
        if (TYPE != 2) { \
            if (TYPE == 1) {     \
                _Pragma("unroll") for (int i = 0; i < 16; ++i) { const float f = __shfl(i < 8 ? fk0 : fk1, (lane & 32) | (i & 7)); s0[i] -= f; } } \
            if (need_mask) { \
                _Pragma("unroll") for (int i = 0; i < 16; ++i) { const int k0 = kb0 + 16 * (i >> 3) + (i & 7); const bool ok = TYPE == 0 ? (k0 < SKEYS) : (k0 <= qpos); s0[i] = ok ? s0[i] : -INFINITY; } } \
            float rm = s0[0]; \
            _Pragma("unroll") for (int i = 1; i < 16; ++i) rm = fmaxf(rm, s0[i]); \
            rm = half_swap_max(rm); \
            const bool first = ((t) == NT - 1); \
            if (first || __any(rm > 8.0f)) { \
                const float dl = first ? rm : fmaxf(rm, 0.f); \
                mrun += dl; \
                _Pragma("unroll") for (int i = 0; i < 16; ++i) s0[i] -= dl; \
                const float cin = (TYPE == 1 ? fq : 0.f) - mrun; \
                _Pragma("unroll") for (int i = 0; i < 16; ++i) negc[i] = cin; \
                if (!first) { const float f = __builtin_amdgcn_exp2f(-dl); lrun *= f; \
                    _Pragma("unroll") for (int d = 0; d < NDB; ++d) _Pragma("unroll") for (int i = 0; i < 16; ++i) o[d][i] *= f; } \
            } \
            float ls = 0.f; \
            _Pragma("unroll") for (int i = 0; i < 16; ++i) { s0[i] = __builtin_amdgcn_exp2f(s0[i]); ls += s0[i]; } \
            lrun += ls; \
        } else { \
            f32x16 lk0; \
            _Pragma("unroll") for (int i = 0; i < 16; ++i) { const float z0 = s0[i]; const float sp0 = fmaxf(z0, 0.f) + __builtin_amdgcn_logf(1.0f + __builtin_amdgcn_exp2f(-fabsf(z0))); lk0[i] = -sp0; s0[i] = z0 - sp0; } \
            if (need_mask) { \
                _Pragma("unroll") for (int i = 0; i < 16; ++i) { const int k0 = kb0 + 16 * (i >> 3) + (i & 7); const bool ok = k0 < qpos; lk0[i] = ok ? lk0[i] : 0.f; s0[i] = ok ? s0[i] : -INFINITY; } } \
            f32x16 sf0; float gt[2]; \
            _Pragma("unroll") for (int a = 0; a < 2; ++a) { float r0 = 0.f; \
                _Pragma("unroll") for (int e = 7; e >= 0; --e) { sf0[8 * a + e] = r0; r0 += lk0[8 * a + e]; } \
                gt[a] = r0; } \
            float pt[2], gs[2]; \
            _Pragma("unroll") for (int c = 0; c < 2; ++c) pt[c] = __shfl_xor(gt[c], 32); \
            float later = 0.f; \
            _Pragma("unroll") for (int c = 1; c >= 0; --c) { gs[c] = later + (hh == 0 ? pt[c] : 0.f); later += gt[c] + pt[c]; } \
            _Pragma("unroll") for (int i = 0; i < 16; ++i) s0[i] = __builtin_amdgcn_exp2f(s0[i] + sf0[i] + gs[i >> 3] + carry); \
            carry += later; \
        } \
        bf16x8 pk[2]; pk[0] = pack8(s0, 0); pk[1] = pack8(s0, 8); \
        {     \
            s16x4 vl[NDB][2], vh[NDB][2]; \
            _Pragma("unroll") for (int d = 0; d < NDB; ++d) _Pragma("unroll") for (int ks = 0; ks < 2; ++ks) { vl[d][ks] = tr_rd(Vl + vrd + (16 * ks) * VP + 64 * d); vh[d][ks] = tr_rd(Vl + vrd + (16 * ks + 4) * VP + 64 * d); } \
             \
            _Pragma("unroll") for (int d = 0; d < NDB; ++d) _Pragma("unroll") for (int ks = 0; ks < 2; ++ks) { const bf16x8 vf = __builtin_shufflevector(vl[d][ks], vh[d][ks], 0, 1, 2, 3, 4, 5, 6, 7); o[d] = MFMA32(vf, pk[ks], o[d]); } \
             \
        } \
        if (TYPE == 2) done = __all(carry < EXIT_LOG2);        \
    } while (0)
    if (PD == 1) {
        SO_LOAD(NT - 1, 0);
        for (int t = NT - 1; t >= 0; --t) { SO_BODY(t, 0); if (TYPE == 2 && done) break; }
    } else {
        SO_LOAD(NT - 1, 0); SO_LOAD(NT - 2, PD - 1);
        for (int t = NT - 1; t >= 0; t -= 2) {
            SO_BODY(t, 0); if (done) break;
            if (t >= 1) { SO_BODY(t - 1, PD - 1); if (done) break; }
        }
    }
#undef SO_BODY
#undef SO_LOAD
#undef F2B
    {
        float inv = 1.0f;
        if (TYPE != 2) { const float lt = half_swap_sum(lrun); inv = 1.0f / lt; }
        float ssq = 0.f;
#pragma unroll
        for (int d = 0; d < NDB; ++d)
#pragma unroll
            for (int i = 0; i < 16; ++i) { o[d][i] *= inv; ssq += o[d][i] * o[d][i]; }
        ssq = half_swap_sum(ssq);
        if (r32 < STN) {
            if (hh == 0) WSP(float, WS_SS)[(size_t)qrow * 12 + TYPE * 4 + h] = ssq;
            const int col0 = (TYPE == 0 ? 0 : TYPE == 1 ? 512 : 768) + h * DV + 4 * hh;
#pragma unroll
            for (int d = 0; d < NDB; ++d) { u32x2 gw[4];
#pragma unroll
                for (int g = 0; g < 4; ++g) gw[g] = *(const u32x2*)(WSP(const bf16_t, WS_GATE) + (size_t)qrow * D + col0 + 32 * d + 8 * g);
#pragma unroll
                for (int g = 0; g < 4; ++g) { u32x2 w; w.x = cvtpk(o[d][4 * g] * bf_lo(gw[g].x), o[d][4 * g + 1] * bf_hi(gw[g].x)); w.y = cvtpk(o[d][4 * g + 2] * bf_lo(gw[g].y), o[d][4 * g + 3] * bf_hi(gw[g].y));
                    *(u32x2*)(WSP(bf16_t, WS_OP) + (size_t)qrow * D + col0 + 32 * d + 8 * g) = w; } }
        }
    }
    __syncthreads();
}
constexpr int CV_CHUNKS = 4096, N_CV_CKV = SBN * PAST * 256 / 8 / CV_CHUNKS, N_CV_KPE = SBN * PAST * 32 / 8 / CV_CHUNKS, N_CV = N_CV_CKV + N_CV_KPE;
constexpr int P0_I0 = 16 * (NINP / 32), P0_I1 = 4 * 24, P0_I2 = 16 * 32, P0_IL = P0_I0 + P0_I1 + P0_I2, N_WT = P0_IL / 8;
static_assert(P0_IL % 8 == 0, "weight items per layer in units of 8");
__device__ __forceinline__ void conv_unit(unsigned char* ws, LAS unsigned char* lds, int ln, int u) {
    const int tid = fresh_tid();
    const bool ckv = u < N_CV_CKV; const int v = ckv ? u : u - N_CV_CKV;
    const float* src = ckv ? inp(lds, 2) + (size_t)ln * SBN * PAST * 256 : inp(lds, 3) + (size_t)ln * SBN * PAST * 32;
    f32x4 a[8], b[8];
#pragma unroll
    for (int k = 0; k < 8; ++k) { const size_t q = (size_t)v * CV_CHUNKS + tid + 512 * k; a[k] = *(const f32x4*)(src + q * 8); b[k] = *(const f32x4*)(src + q * 8 + 4); }
#pragma unroll
    for (int k = 0; k < 8; ++k) { const int q = v * CV_CHUNKS + tid + 512 * k;
        bf16_t* dst; if (ckv) dst = WSP(bf16_t, WS_CKVB) + (size_t)M * 256 + (size_t)q * 8; else { const int per_b = PAST * 32 / 8, sb = q / per_b, rem = q % per_b; dst = (bf16_t*)(ws + kr_off(ln)) + (size_t)MP * 32 + (size_t)sb * SPITCH * 32 + (size_t)rem * 8; }
        u32x4 o; o.x = cvtpk(a[k][0], a[k][1]); o.y = cvtpk(a[k][2], a[k][3]); o.z = cvtpk(b[k][0], b[k][1]); o.w = cvtpk(b[k][2], b[k][3]); *(u32x4*)dst = o; }
}
__device__ __forceinline__ void weight_unit(unsigned char* ws, LAS unsigned char* lds, int ln, int u) {
    const int tid = fresh_tid(), lane = tid & 63, wid = __builtin_amdgcn_readfirstlane(tid >> 6);
    LAS float* scr = (LAS float*)(lds + wid * 16384);
    int r = u * 8 + wid;
    if (r < P0_I0) p0_item(ws, lds, 0, ln, r, scr, lane);
    else if (r < P0_I0 + P0_I1) p0_item(ws, lds, 1, ln, r - P0_I0, scr, lane);
    else p0_item(ws, lds, 2, ln, r - P0_I0 - P0_I1, scr, lane);
}
constexpr int NU_P = 32 * 16, NU_S = SBN * 4 / 8, NU_T = NU_P + NU_S, NU_ALL = 3 * NU_T;
__device__ __forceinline__ int q_fetch(unsigned* head, LAS int* slot) {
    __syncthreads();
    if (threadIdx.x == 0) *slot = (int)__hip_atomic_fetch_add(head, 1u, __ATOMIC_RELAXED, __HIP_MEMORY_SCOPE_AGENT);
    __syncthreads();
    return __builtin_amdgcn_readfirstlane(*slot);
}
template <int TYPE>
__device__ __forceinline__ void attn_prompt(unsigned char* ws, LAS unsigned char* lds, int l, int xq, int v) {
    const int qb = 31 - (v >> 1), bh = 2 * xq + (v & 1), b = bh >> 2, h = bh & 3;
#ifndef PP_MASK
#define PP_MASK 7
#endif
    if ((PP_MASK >> TYPE) & 1) attn_pp<TYPE>(ws, lds, l, b * PT + qb * 256, b * PT, qb * 256, h);
    else attn_unit<TYPE, false>(ws, lds, l, b * PT + qb * 256, 256, b * PT, qb * 256, PT, h);
}
template <int TYPE>
__device__ __forceinline__ void prompt_queues(unsigned char* ws, LAS unsigned char* lds, int l, LAS int* slot) {
    const int x = (int)(xb_xcc_id() & 7u);
#pragma nounroll
    for (int i = 0; i < 8; ++i) { const int xq = (x + i) & 7;
        unsigned* hq = (unsigned*)(ws + WS_CTL) + CW_XQ + ((l * 3 + TYPE) * 8 + xq) * 16;
        int v = q_fetch(hq, slot);
        while (v < 64) { attn_prompt<TYPE>(ws, lds, l, xq, v); v = q_fetch(hq, slot); }
    }
}
__device__ __forceinline__ void p4_attention(unsigned char* ws, float* out, int l, LAS unsigned char* lds, int rep) {
    unsigned* head = (unsigned*)(ws + WS_CTL) + CW_QUEUE + 64 * l + 16 * rep; LAS int* slot = (LAS int*)(lds + MISC_OFF + 64);
#define NEXT_BEGIN() int nx_ = 0; if (threadIdx.x == 0) nx_ = (int)__hip_atomic_fetch_add(head, 1u, __ATOMIC_RELAXED, __HIP_MEMORY_SCOPE_AGENT)
#define NEXT_END() do { if (threadIdx.x == 0) *slot = nx_; __syncthreads(); u = __builtin_amdgcn_readfirstlane(*slot); } while (0)
    const int ncv = (l + 1 < NL) ? N_CV : 0, nwt = (l + 1 < NL) ? N_WT : 0;
    const int b0 = ncv, b1 = b0 + nwt, b2 = b1 + NU_S, b3 = b2 + NU_S, b4 = b3 + NU_S;
    int u = q_fetch(head, slot);
    while (u < b0) { NEXT_BEGIN(); conv_unit(ws, lds, l + 1, u); NEXT_END(); }
    while (u < b1) { NEXT_BEGIN(); weight_unit(ws, lds, l + 1, u - b0); NEXT_END(); }
    while (u < b2) { NEXT_BEGIN(); sample_octet<0>(ws, out, lds, l, u - b1); NEXT_END(); }
    while (u < b3) { NEXT_BEGIN(); sample_octet<1>(ws, out, lds, l, u - b2); NEXT_END(); }
    while (u < b4) { NEXT_BEGIN(); sample_octet<2>(ws, out, lds, l, u - b3); NEXT_END(); }
    prompt_queues<0>(ws, lds, l, slot);
    prompt_queues<1>(ws, lds, l, slot);
    prompt_queues<2>(ws, lds, l, slot);
#undef NEXT_BEGIN
#undef NEXT_END
}
constexpr int N_PHASES = 2 + 5 * NL;
__global__ void __launch_bounds__(512, 2) fwd(Params P) {
    extern __shared__ __attribute__((aligned(16))) unsigned char lds_raw[];
    LAS unsigned char* lds = (LAS unsigned char*)lds_raw;
    const int tid = threadIdx.x;
    if (tid < 64) ((LAS unsigned*)(lds + MISC_OFF))[tid] = 0u;
    if (tid < 18) ((LAS unsigned long long*)(lds + PTR_OFF))[tid] = (unsigned long long)P.in[tid];
    __syncthreads();
    unsigned char* const ws0 = P.ws; float* const out0 = P.out;
    unsigned* ctl = (unsigned*)(ws0 + WS_CTL);
    XcdBarrier bar = xcd_barrier_post(ctl + CW_BAR, (volatile LAS unsigned*)(lds + MISC_OFF + 32));
    const int lo = P.ph_lo, hi = P.ph_hi;
#ifndef PHM
#define PHM 0x7f
#endif
#ifndef REP_P1
#define REP_P1 1
#endif
#ifndef REP_P2
#define REP_P2 1
#endif
#ifndef REP_P3
#define REP_P3 1
#endif
#ifndef REP_P4
#define REP_P4 1
#endif
#ifndef REP_P5
#define REP_P5 1
#endif
#define IN(k) (lo <= (k) && (k) < hi)
#define SEAM(k) do { if (IN(k) && IN((k) + 1)) { XcdBarrier b2_ = bar; unsigned* bb_ = b2_.bar; asm volatile("" : "+s"(bb_)); b2_.bar = bb_; xcd_barrier(b2_); } } while (0)
#define FRESH() unsigned long long ws_i_ = (unsigned long long)ws0, out_i_ = (unsigned long long)out0; asm volatile("" : "+s"(ws_i_), "+s"(out_i_)); unsigned char* ws = (unsigned char*)(GAS unsigned char*)ws_i_; float* out = (float*)(GAS float*)out_i_; (void)out
    if ((PHM & 1) && IN(0)) { FRESH(); p0_prologue(ws, lds); }
    SEAM(0);
    for (int l = 0; l <= NL; ++l) {
        const int pb = 1 + 5 * l;
        if ((PHM & 2) && IN(pb)) { FRESH(); p1_norm(ws, out, lds, l); }
        if (l == NL) break;
        SEAM(pb);
        if ((PHM & 4) && IN(pb + 1)) { FRESH();
            pg8::Gemm g{(const pg8::bf16_t*)(ws + WS_XN), (const pg8::bf16_t*)(ws + WS_WIN + (size_t)l * NINP * D * 2), M, NINP, D};
            pg8::StaticOrder S; S.init(M, NINP, (int)gridDim.x, (int)blockIdx.x);
            EpiP2 E; E.ws = ws; E.out = out; E.kvnorm = inp(lds, 12) + l * 256; E.fbias = inp(lds, 15) + l * 4; E.l = l; E.scr = (LAS float*)(lds + SCR_OFF);
            _Pragma("nounroll") for (int rep = 0; rep < REP_P2; ++rep) pg8::gemm_phase<EpiP2, pg8::StaticOrder, true, true>(lds, g, S, E);
        }
        SEAM(pb + 1);
        if ((PHM & 8) && IN(pb + 2)) { FRESH();
            if (blockIdx.x < 36) cumsum_task(ws, l, (int)blockIdx.x, lds);
            int k3 = 256; asm volatile("" : "+s"(k3));
            pg8::Gemm g{(const pg8::bf16_t*)(ws + WS_CKVB), (const pg8::bf16_t*)(ws + WS_WUKV + (size_t)l * 768 * 256 * 2), M3, 768, k3};
            pg8::StaticOrder S; S.init(M3, 768, (int)gridDim.x, (int)blockIdx.x);
            EpiP3 E; E.ws = ws;
            _Pragma("nounroll") for (int rep = 0; rep < REP_P3; ++rep) pg8::gemm_phase<EpiP3, pg8::StaticOrder, true, true>(lds, g, S, E);
        }
        SEAM(pb + 2);
        if ((PHM & 16) && IN(pb + 3)) { FRESH(); _Pragma("nounroll") for (int rep = 0; rep < REP_P4; ++rep) p4_attention(ws, out, l, lds, rep); }
        SEAM(pb + 3);
        if ((PHM & 64) && IN(pb + 4)) { FRESH();
            pg8::Gemm g{(const pg8::bf16_t*)(ws + WS_OP), (const pg8::bf16_t*)(ws + WS_WOUT + (size_t)l * D * D * 2), M, D, D};
            pg8::StaticOrder S; S.init(M, D, (int)gridDim.x, (int)blockIdx.x);
            EpiP5 E; E.ws = ws; E.tab = (LAS float*)(lds + SCR_OFF);
            _Pragma("nounroll") for (int rep = 0; rep < REP_P5; ++rep) pg8::gemm_phase<EpiP5, pg8::StaticOrder, true, true>(lds, g, S, E);
        }
        SEAM(pb + 4);
    }
#undef IN
#undef SEAM
}

#ifndef MK_SPLIT
#define MK_SPLIT 0
#endif
extern "C" void kernel_launch(void* const* d_in, const int* in_sizes, int n_in, void* d_out, int out_size, void* d_ws, size_t ws_size, hipStream_t stream) {
    static int grid = 0;
    if (grid == 0) {
        if (n_in != 18 || (size_t)out_size != O_END || ws_size < WS_END) { fprintf(stderr, "kernel_launch: unexpected shapes: n_in %d out %d ws %zu\n", n_in, out_size, ws_size); grid = -1; return; }
        int dev = 0, cus = 0, per_cu = 0;
        if (hipGetDevice(&dev) != hipSuccess || hipDeviceGetAttribute(&cus, hipDeviceAttributeMultiprocessorCount, dev) != hipSuccess) { grid = -1; return; }
        if (hipFuncSetAttribute((const void*)fwd, hipFuncAttributeMaxDynamicSharedMemorySize, LDS_BYTES) != hipSuccess) { fprintf(stderr, "kernel_launch: hipFuncSetAttribute failed\n"); grid = -1; return; }
        if (hipOccupancyMaxActiveBlocksPerMultiprocessor(&per_cu, (const void*)fwd, 512, LDS_BYTES) != hipSuccess || per_cu < 1) { fprintf(stderr, "kernel_launch: occupancy query reports %d blocks per CU\n", per_cu); (void)hipGetLastError(); grid = -1; return; }
        grid = cus;
    }
    if (grid < 0) return;
    (void)hipMemsetAsync((char*)d_ws + WS_CTL, 0, CTL_ZERO_BYTES, stream);
    Params p{};
    for (int i = 0; i < 18; ++i) p.in[i] = (const float*)d_in[i];
    p.out = (float*)d_out; p.ws = (unsigned char*)d_ws;
#if MK_SPLIT
    for (int ph = 0; ph < N_PHASES; ++ph) { p.ph_lo = ph; p.ph_hi = ph + 1; hipLaunchKernelGGL(fwd, dim3(grid), dim3(512), LDS_BYTES, stream, p); }
#else
    p.ph_lo = 0; p.ph_hi = N_PHASES;
    hipLaunchKernelGGL(fwd, dim3(grid), dim3(512), LDS_BYTES, stream, p);
#endif
    const hipError_t le = hipPeekAtLastError();
    if (le != hipSuccess) fprintf(stderr, "kernel_launch: launch failed: %s\n", hipGetErrorName(le));
}
```

```cpp
#include <hip/hip_runtime.h>
#include <cstdio>
#include <cstdint>
namespace pg8 {
#define PG8_LAS __attribute__((address_space(3)))
typedef unsigned short bf16_t;
typedef short bf16x8 __attribute__((ext_vector_type(8)));
typedef float f32x4 __attribute__((ext_vector_type(4)));
typedef unsigned u32x4 __attribute__((ext_vector_type(4)));
constexpr int BM = 256, BK = 64, HALF = 128, HTB = HALF * BK * 2  , STAGE_BYTES = 8 * HTB, NXCD = 8, WGM = 8;

__host__ __device__ __forceinline__ int lds_byte(int r, int c) { const int st = (r >> 4) * 2 + (c >> 5), rr = r & 15, cc = c & 31, ob = rr * 64 + cc * 2; return st * 1024 + (ob ^ (((ob >> 9) & 1) << 5)); }
__host__ __device__ __forceinline__ void stage_rc(int b, int& R, int& C) { const int st = b / 1024, sb = b % 1024, swz = sb ^ (((sb >> 9) & 1) << 5); R = (st >> 1) * 16 + swz / 64; C = (st & 1) * 32 + (swz % 64) / 2; }
__host__ __device__ __forceinline__ int perm32(int rho) { const int n = rho >> 4, i = rho & 15; return 8 * (i >> 2) + 4 * n + (i & 3); }

struct Unit { int pm, pn; };
struct Gemm { const bf16_t* A; const bf16_t* Bt; int M, N, K; };

struct StaticOrder {
    int nM, nN, nwg, G, c;
    __host__ __device__ void init(int M, int N, int G_, int c_) { nM = M / BM; nN = N / BM; nwg = nM * nN; G = G_; c = c_; }
    __host__ __device__ bool next(int i, Unit& u) const {
        const long L = (long)i * G + c; if (L >= nwg) return false;
        int wgid = (int)L; { const int q = nwg / NXCD, r = nwg % NXCD, xcd = wgid % NXCD, off = wgid / NXCD; wgid = (xcd < r ? xcd * (q + 1) : r * (q + 1) + (xcd - r) * q) + off; }
        const int nig = WGM * nN, gid = wgid / nig, fm = gid * WGM, gsz = (nM - fm) < WGM ? (nM - fm) : WGM;
        u.pm = fm + ((wgid % nig) % gsz); u.pn = (wgid % nig) / gsz; return true;
    }
    __device__ __forceinline__ void a_ready(const Unit&) const {}
    __device__ __forceinline__ void done(const Unit&) const {}
};

__device__ __forceinline__ unsigned cvt_pk_bf16(float lo, float hi) { unsigned r; asm volatile("v_cvt_pk_bf16_f32 %0, %1, %2" : "=v"(r) : "v"(lo), "v"(hi)); return r; }
typedef float f32x2 __attribute__((ext_vector_type(2)));
template <class Epi, class Sched, bool ALIGN_EPI = false, bool SP2 = false>
__device__ __forceinline__ void gemm_phase(PG8_LAS unsigned char* lds, const Gemm g, const Sched& S, const Epi& E) {
    int tid_ = threadIdx.x; asm volatile("" : "+v"(tid_));
    const int tid = tid_, wid = __builtin_amdgcn_readfirstlane(tid >> 6), lane = tid & 63, wr = wid >> 2, wc = wid & 3, fr = lane & 15, fq = lane >> 4;
    const int K = g.K, nt = K / BK;
    unsigned voffA[2], voffB[2];
#pragma unroll
    for (int i = 0; i < 2; ++i) { int R, C; stage_rc(tid * 16 + i * 8192, R, C); const int Rb = Epi::PERM ? ((R & ~31) + perm32(R & 31)) : R;
        voffA[i] = (unsigned)(R * K + C) * 2u; voffB[i] = (unsigned)(Rb * K + C) * 2u; }
    const size_t kstep = (size_t)(BK * 2);
    const size_t hstep = (size_t)HALF * K * 2;
    const size_t tstep = 2 * hstep;
    const unsigned ldsw = (unsigned)wid * 1024u;
    const int aoff = lds_byte(wr * 64 + fr, fq * 8), boff = lds_byte(wc * 32 + fr, fq * 8);
#define PG8_SA(b, h) (((b) * 2 + (h)) * HTB)
#define PG8_SB(b, h) ((4 + (b) * 2 + (h)) * HTB)
#define PG8_STAGE(bufoff, gbase, voff) do { _Pragma("unroll") for (int _i = 0; _i < 2; ++_i) \
        __builtin_amdgcn_global_load_lds((const unsigned*)((const char*)(gbase) + (voff)[_i]), (PG8_LAS unsigned*)(lds + (bufoff) + ldsw + _i * 8192), 16, 0, 0); } while (0)
#define PG8_LDA(dst, b, h) do { _Pragma("unroll") for (int m = 0; m < 4; ++m) _Pragma("unroll") for (int k = 0; k < 2; ++k) dst[m][k] = *(const PG8_LAS bf16x8*)(lds + PG8_SA(b, h) + aoff + m * 2048 + k * 1024); } while (0)
#define PG8_LDB(dst, b, h) do { _Pragma("unroll") for (int n = 0; n < 2; ++n) _Pragma("unroll") for (int k = 0; k < 2; ++k) dst[n][k] = *(const PG8_LAS bf16x8*)(lds + PG8_SB(b, h) + boff + n * 2048 + k * 1024); } while (0)
#define PG8_MMA(ai, bj, At, Bt) do { __builtin_amdgcn_s_setprio(1); _Pragma("unroll") for (int m = 0; m < 4; ++m) _Pragma("unroll") for (int n = 0; n < 2; ++n) _Pragma("unroll") for (int k = 0; k < 2; ++k) \
        acc[ai][bj][m][n] = __builtin_amdgcn_mfma_f32_16x16x32_bf16(Bt[n][k], At[m][k], acc[ai][bj][m][n], 0, 0, 0); __builtin_amdgcn_s_setprio(0); } while (0)
#define PG8_WAIT_V(n) asm volatile("s_waitcnt vmcnt(" #n ")" ::: "memory")
#define PG8_WAIT_L(n) asm volatile("s_waitcnt lgkmcnt(" #n ")" ::: "memory")
#define PG8_BAR __builtin_amdgcn_s_barrier()
#define PG8_SCHED __builtin_amdgcn_sched_barrier(0)
    Unit cur, nxt; int ui = 0;
    if (!S.next(0, cur)) return;
    f32x4 acc[2][2][4][2];
#pragma unroll
    for (int a = 0; a < 2; ++a)
#pragma unroll
        for (int b = 0; b < 2; ++b)
#pragma unroll
            for (int m = 0; m < 4; ++m)
#pragma unroll
                for (int n = 0; n < 2; ++n) acc[a][b][m][n] = (f32x4){0.f, 0.f, 0.f, 0.f};
    bf16x8 At[4][2], B0[2][2], B1[2][2];
    const char* cA = (const char*)g.A + (size_t)cur.pm * tstep; const char* cB = (const char*)g.Bt + (size_t)cur.pn * tstep;
    S.a_ready(cur);
    if constexpr (Epi::MID) E.prep(cur, 0, tid);
    if constexpr (SP2) {
        PG8_STAGE(PG8_SB(0, 0), cB, voffB); PG8_STAGE(PG8_SB(0, 1), cB + hstep, voffB); PG8_STAGE(PG8_SA(0, 0), cA, voffA); PG8_STAGE(PG8_SA(0, 1), cA + hstep, voffA);
        if (wr == 1) PG8_BAR;
        PG8_WAIT_V(2); PG8_BAR;
        PG8_STAGE(PG8_SB(1, 0), cB + kstep, voffB); PG8_STAGE(PG8_SA(1, 0), cA + kstep, voffA); PG8_STAGE(PG8_SB(1, 1), cB + hstep + kstep, voffB);
        PG8_WAIT_V(6); PG8_BAR;
    } else {
        PG8_STAGE(PG8_SB(0, 0), cB, voffB); PG8_STAGE(PG8_SA(0, 0), cA, voffA); PG8_STAGE(PG8_SB(0, 1), cB + hstep, voffB); PG8_STAGE(PG8_SA(0, 1), cA + hstep, voffA);
        if (wr == 1) PG8_BAR;
        PG8_WAIT_V(4); PG8_BAR;
        PG8_STAGE(PG8_SB(1, 0), cB + kstep, voffB); PG8_STAGE(PG8_SA(1, 0), cA + kstep, voffA); PG8_STAGE(PG8_SB(1, 1), cB + hstep + kstep, voffB);
        PG8_WAIT_V(6); PG8_BAR;
    }
    for (;;) {
        const bool has_next = S.next(ui + 1, nxt);
        const char* nA = has_next ? (const char*)g.A + (size_t)nxt.pm * tstep : cA; const char* nB = has_next ? (const char*)g.Bt + (size_t)nxt.pn * tstep : cB;
        for (int t = 0; t < nt; t += 2) {
            if constexpr (Epi::MID) { if (t == Epi::MID_T0 || t == Epi::MID_T1) E.mid(acc, ui & 1, t == Epi::MID_T0 ? 0 : 1, wr, fr); }
            const bool last = (t == nt - 2);
            const char* a1 = cA + (size_t)(t + 1) * kstep;
            const char* a2 = last ? nA : cA + (size_t)(t + 2) * kstep; const char* b2 = last ? nB : cB + (size_t)(t + 2) * kstep;
            const char* a3 = a2 + kstep; const char* b3 = b2 + kstep;
            if (last && has_next) S.a_ready(nxt);
            if constexpr (SP2) {
            PG8_LDB(B0, 0, 0); PG8_LDB(B1, 0, 1); PG8_SCHED; PG8_LDA(At, 0, 0); PG8_STAGE(PG8_SA(1, 1), a1 + hstep, voffA);
            PG8_WAIT_V(8); PG8_WAIT_L(0); PG8_BAR; PG8_MMA(0, 0, At, B0); PG8_MMA(0, 1, At, B1); PG8_BAR; PG8_SCHED;
            PG8_LDA(At, 0, 1); PG8_STAGE(PG8_SB(0, 0), b2, voffB); PG8_STAGE(PG8_SB(0, 1), b2 + hstep, voffB); PG8_STAGE(PG8_SA(0, 0), a2, voffA);
            PG8_WAIT_V(8); PG8_WAIT_L(0); PG8_BAR; PG8_MMA(1, 0, At, B0); PG8_MMA(1, 1, At, B1); PG8_BAR; PG8_SCHED;
            PG8_LDB(B0, 1, 0); PG8_LDB(B1, 1, 1); PG8_SCHED; PG8_LDA(At, 1, 0); PG8_STAGE(PG8_SA(0, 1), a2 + hstep, voffA);
            PG8_WAIT_V(8); PG8_WAIT_L(0); PG8_BAR; PG8_MMA(0, 0, At, B0); PG8_MMA(0, 1, At, B1); PG8_BAR; PG8_SCHED;
            PG8_LDA(At, 1, 1); PG8_STAGE(PG8_SB(1, 0), b3, voffB); PG8_STAGE(PG8_SB(1, 1), b3 + hstep, voffB); PG8_STAGE(PG8_SA(1, 0), a3, voffA);
            PG8_WAIT_V(8); PG8_WAIT_L(0); PG8_BAR; PG8_MMA(1, 0, At, B0); PG8_MMA(1, 1, At, B1); PG8_BAR; PG8_SCHED;
            } else {
            PG8_LDB(B0, 0, 0); PG8_SCHED; PG8_LDA(At, 0, 0); PG8_STAGE(PG8_SA(1, 1), a1 + hstep, voffA);
            PG8_WAIT_L(8); PG8_BAR; PG8_WAIT_L(0); PG8_MMA(0, 0, At, B0); PG8_BAR; PG8_SCHED;
            PG8_LDB(B1, 0, 1); PG8_STAGE(PG8_SB(0, 0), b2, voffB);
            PG8_BAR; PG8_WAIT_L(0); PG8_MMA(0, 1, At, B1); PG8_BAR;
            PG8_LDA(At, 0, 1); PG8_STAGE(PG8_SA(0, 0), a2, voffA);
            PG8_BAR; PG8_WAIT_L(0); PG8_MMA(1, 0, At, B0); PG8_BAR; PG8_SCHED;
            PG8_STAGE(PG8_SB(0, 1), b2 + hstep, voffB);
            PG8_WAIT_V(6); PG8_BAR; PG8_MMA(1, 1, At, B1); PG8_BAR;
            PG8_LDB(B0, 1, 0); PG8_SCHED; PG8_LDA(At, 1, 0); PG8_STAGE(PG8_SA(0, 1), a2 + hstep, voffA);
            PG8_WAIT_L(8); PG8_BAR; PG8_WAIT_L(0); PG8_MMA(0, 0, At, B0); PG8_BAR; PG8_SCHED;
            PG8_LDB(B1, 1, 1); PG8_STAGE(PG8_SB(1, 0), b3, voffB);
            PG8_BAR; PG8_WAIT_L(0); PG8_MMA(0, 1, At, B1); PG8_BAR;
            PG8_LDA(At, 1, 1); PG8_STAGE(PG8_SA(1, 0), a3, voffA);
            PG8_BAR; PG8_WAIT_L(0); PG8_MMA(1, 0, At, B0); PG8_BAR; PG8_SCHED;
            PG8_STAGE(PG8_SB(1, 1), b3 + hstep, voffB);
            PG8_WAIT_V(6); PG8_BAR; PG8_MMA(1, 1, At, B1); PG8_BAR;
            }
        }
        if constexpr (ALIGN_EPI) { if (wr == 0) PG8_BAR; }
        if constexpr (Epi::MID) E.mid(acc, ui & 1, 2, wr, fr);
        if constexpr (!Epi::AFTER_DRAIN) { E(acc, cur, wr, wc, fr, fq); S.done(cur); }
        if constexpr (Epi::MID) { if (has_next) E.prep(nxt, (ui + 1) & 1, tid); }
        if (!has_next) break;
#pragma unroll
        for (int a = 0; a < 2; ++a)
#pragma unroll
            for (int b = 0; b < 2; ++b)
#pragma unroll
                for (int m = 0; m < 4; ++m)
#pragma unroll
                    for (int n = 0; n < 2; ++n) acc[a][b][m][n] = (f32x4){0.f, 0.f, 0.f, 0.f};
        cur = nxt; cA = nA; cB = nB; ++ui;
        if constexpr (ALIGN_EPI) { if (wr == 1) PG8_BAR; }
    }
    PG8_WAIT_V(0);
    if constexpr (!ALIGN_EPI) { if (wr == 0) PG8_BAR; }
    PG8_BAR;
    if constexpr (Epi::AFTER_DRAIN) { E.fused(acc, cur, wr, wc, fr, fq, lds, wid, lane); S.done(cur); }
#undef PG8_SA
#undef PG8_SB
#undef PG8_STAGE
#undef PG8_LDA
#undef PG8_LDB
#undef PG8_MMA
#undef PG8_WAIT_V
#undef PG8_WAIT_L
#undef PG8_BAR
#undef PG8_SCHED
}
}
#define GAS __attribute__((address_space(1)))
#define LAS __attribute__((address_space(3)))
#define XB_TMO      128
#define XB_XCNT(j)  (256  + 64 * (j))
#define XB_XSUB(j)  (1280 + 64 * (j))
#define XB_XGEN(j)  (2304 + 64 * (j))
#define XB_TOP      3328
#define XB_TOPGEN   3392
#define XCD_BAR_WORDS 3456
#define XB_SPIN_CAP (1u << 21)

__device__ __forceinline__ unsigned xb_ld(unsigned* p)              { return __hip_atomic_load(p, __ATOMIC_RELAXED, __HIP_MEMORY_SCOPE_AGENT); }
__device__ __forceinline__ unsigned xb_add(unsigned* p, unsigned v) { return __hip_atomic_fetch_add(p, v, __ATOMIC_RELAXED, __HIP_MEMORY_SCOPE_AGENT); }
__device__ __forceinline__ unsigned xb_xcc_id() { return (unsigned)__builtin_amdgcn_s_getreg((3 << 11) | 20) & 0xFu; }
#define XB_SPIN(cond, bar) do { unsigned _sp = 0; while (cond) { __builtin_amdgcn_s_sleep(1); \
    if ((++_sp & 255u) == 0u) { if (xb_ld(&(bar)[XB_TMO])) break; if (_sp > XB_SPIN_CAP) { atomicAdd(&(bar)[XB_TMO], 1u); break; } } } } while (0)

struct XcdBarrier {
    unsigned* bar; unsigned x;
    volatile LAS unsigned* st;
};

__device__ __forceinline__ XcdBarrier xcd_barrier_post(unsigned* bar, volatile LAS unsigned* st) {
    XcdBarrier b; b.bar = bar; b.x = xb_xcc_id(); b.st = st;
    if (threadIdx.x == 0) (void)xb_add(&bar[XB_XCNT(b.x)], 1u);
    return b;
}
__device__ __forceinline__ void xcd_barrier_complete(unsigned* bar, unsigned x, unsigned& nloc, unsigned& nx) {
    const unsigned G = gridDim.x * gridDim.y * gridDim.z;
    unsigned sum, cnt, mine, sp = 0u;
    for (;;) {
        sum = 0u; cnt = 0u; mine = 0u;
#pragma unroll
        for (unsigned j = 0; j < 16; ++j) { const unsigned c = xb_ld(&bar[XB_XCNT(j)]); sum += c; cnt += (c > 0u) ? 1u : 0u; mine = (j == x) ? c : mine; }
        if (sum == G) break;
        __builtin_amdgcn_s_sleep(1);
        if ((++sp & 255u) == 0u) { if (xb_ld(&bar[XB_TMO])) break; if (sp > XB_SPIN_CAP) { atomicAdd(&bar[XB_TMO], 1u); break; } }
    }
    nloc = mine > 0u ? mine : 1u; nx = cnt > 0u ? cnt : 1u;
}

__device__ __forceinline__ void xcd_barrier(const XcdBarrier& b) {
    asm volatile("s_waitcnt vmcnt(0)" ::: "memory");
    __syncthreads();
    if (threadIdx.x == 0) {
        unsigned* bar = b.bar;
        __builtin_amdgcn_s_waitcnt(0);
        unsigned nloc = b.st[0], nx = b.st[1];
        if (nloc == 0u) { xcd_barrier_complete(bar, b.x, nloc, nx); b.st[0] = nloc; b.st[1] = nx; }
        const unsigned old = xb_add(&bar[XB_XSUB(b.x)], 1u);
        const unsigned gen = old / nloc;
        if (old + 1u == (gen + 1u) * nloc) {
            __builtin_amdgcn_fence(__ATOMIC_RELEASE, "agent");
            asm volatile("s_waitcnt vmcnt(0)" ::: "memory");
            const unsigned og = xb_add(&bar[XB_TOP], 1u);
            const unsigned tg = og / nx;
            if (og + 1u == (tg + 1u) * nx) xb_add(&bar[XB_TOPGEN], 1u);
            else XB_SPIN(xb_ld(&bar[XB_TOPGEN]) == tg, bar);
            __builtin_amdgcn_fence(__ATOMIC_ACQUIRE, "agent");
            xb_add(&bar[XB_XGEN(b.x)], 1u);
            asm volatile("s_waitcnt vmcnt(0)" ::: "memory");
        } else {
            XB_SPIN(xb_ld(&bar[XB_XGEN(b.x)]) == gen, bar);
            __builtin_amdgcn_fence(__ATOMIC_ACQUIRE, "agent");
            asm volatile("s_waitcnt vmcnt(0)" ::: "memory");
        }
    }
    __syncthreads();
}

constexpr int D = 1024, NL = 4;
constexpr int PB = 4, PT = 8192, MP = PB * PT;
constexpr int SBN = 32, STN = 16, PAST = 2048, MS = SBN * STN;
constexpr int M = MP + MS;
constexpr int SKEYS = PAST + STN;
constexpr int SPITCH = 2112;
constexpr int KROWS = MP + SBN * SPITCH;
constexpr int M3 = M + SBN * PAST;
constexpr int NIN = 3236, NINP = 3328;
constexpr float EPS = 1e-6f;
constexpr float LOG2E = 1.4426950408889634f;
constexpr float EXIT_LOG2 = -40.0f;
constexpr float QA_SC = 0.10206207261596575f * LOG2E, QB_SC = 0.125f * LOG2E, QC_SC = 0.125f * LOG2E;

constexpr size_t O_YP = 0, O_YS = O_YP + (size_t)MP * D, O_PCKV = O_YS + (size_t)MS * D, O_PKPE = O_PCKV + (size_t)NL * MP * 256, O_PFK = O_PKPE + (size_t)NL * MP * 32,
                 O_PFV = O_PFK + (size_t)NL * MP * 256, O_PLF = O_PFV + (size_t)NL * MP * 256, O_PSK = O_PLF + (size_t)NL * MP * 4, O_PSV = O_PSK + (size_t)NL * MP * 256,
                 O_SCKV = O_PSV + (size_t)NL * MP * 256, O_SKPE = O_SCKV + (size_t)NL * MS * 256, O_SFK = O_SKPE + (size_t)NL * MS * 32, O_SFV = O_SFK + (size_t)NL * MS * 256,
                 O_SLF = O_SFV + (size_t)NL * MS * 256, O_SSK = O_SLF + (size_t)NL * MS * 4, O_SSV = O_SSK + (size_t)NL * MS * 256, O_END = O_SSV + (size_t)NL * MS * 256;
static_assert(O_END == 209264640ull, "output size");

constexpr size_t MiB = 1u << 20;
constexpr size_t WS_CTL = 0, CTL_ZERO_BYTES = 1 * MiB;
constexpr size_t WS_ROPE = 1 * MiB, WS_WIN = 2 * MiB, WS_WUKV = 28 * MiB, WS_WOUT = 30 * MiB, WS_XN = 38 * MiB, WS_QA = 103 * MiB, WS_QB = 128 * MiB, WS_QC = 145 * MiB,
                 WS_GATE = 162 * MiB, WS_OP = 227 * MiB, WS_Y = 292 * MiB, WS_CKVB = 357 * MiB, WS_KA = 406 * MiB, WS_KR = 455 * MiB, WS_VA = 462 * MiB, WS_KB = 560 * MiB,
                 WS_VB = 609 * MiB, WS_KC = 658 * MiB, WS_VC = 707 * MiB, WS_LOGF = 756 * MiB, WS_FB = 758 * MiB, WS_SS = 760 * MiB, WS_KR2 = 762 * MiB, WS_RSTD = 769 * MiB, WS_END = 770 * MiB;
static_assert(WS_WIN + (size_t)NL * NINP * D * 2 <= WS_WUKV && WS_WUKV + (size_t)NL * 768 * 256 * 2 <= WS_WOUT && WS_WOUT + (size_t)NL * D * D * 2 <= WS_XN, "ws map 1");
static_assert(WS_XN + (size_t)M * D * 2 <= WS_QA && WS_QA + (size_t)(M + 64) * 384 * 2 <= WS_QB && WS_QB + (size_t)(M + 64) * 256 * 2 <= WS_QC && WS_QC + (size_t)(M + 64) * 256 * 2 <= WS_GATE, "ws map 2");
static_assert(WS_GATE + (size_t)M * D * 2 <= WS_OP && WS_OP + (size_t)M * D * 2 <= WS_Y && WS_Y + (size_t)M * D * 2 <= WS_CKVB && WS_CKVB + (size_t)M3 * 256 * 2 <= WS_KA, "ws map 3");
static_assert(WS_KA + (size_t)KROWS * 256 * 2 <= WS_KR && WS_KR + (size_t)KROWS * 32 * 2 <= WS_VA && WS_VA + (size_t)KROWS * 512 * 2 <= WS_KB && WS_KB + (size_t)KROWS * 256 * 2 <= WS_VB, "ws map 4");
static_assert(WS_VB + (size_t)KROWS * 256 * 2 <= WS_KC && WS_KC + (size_t)KROWS * 256 * 2 <= WS_VC && WS_VC + (size_t)KROWS * 256 * 2 <= WS_LOGF && WS_LOGF + (size_t)KROWS * 16 <= WS_FB && WS_FB + (size_t)KROWS * 16 <= WS_SS && WS_SS + (size_t)M * 48 <= WS_END, "ws map 5");
constexpr int CW_QUEUE = 64;
constexpr int CW_XQ = 1024;
constexpr int CW_KMAX = 512;
constexpr int CW_BAR = 4096;
constexpr int RING_BYTES = 131072, MISC_OFF = RING_BYTES, PTR_OFF = RING_BYTES + 256, SCR_OFF = RING_BYTES + 512, LDS_BYTES = 147456;

typedef unsigned short bf16_t;
typedef short bf16x8 __attribute__((ext_vector_type(8)));
typedef short s16x4 __attribute__((ext_vector_type(4)));
typedef float f32x4 __attribute__((ext_vector_type(4)));
typedef float f32x16 __attribute__((ext_vector_type(16)));
typedef unsigned u32x4 __attribute__((ext_vector_type(4)));
typedef unsigned u32x2 __attribute__((ext_vector_type(2)));
typedef float f32x2_t __attribute__((ext_vector_type(2)));
typedef __bf16 bf16x2_t __attribute__((ext_vector_type(2)));
__device__ __forceinline__ unsigned cvtpk(float lo, float hi) { f32x2_t v = {lo, hi}; bf16x2_t b = __builtin_convertvector(v, bf16x2_t); return __builtin_bit_cast(unsigned, b); }
__device__ __forceinline__ float bf_lo(unsigned w) { return __uint_as_float(w << 16); }
__device__ __forceinline__ float bf_hi(unsigned w) { return __uint_as_float(w & 0xffff0000u); }
__device__ __forceinline__ float wave_sum(float v) {
#pragma unroll
    for (int o = 1; o < 64; o <<= 1) v += __shfl_xor(v, o);
    return v;
}
__device__ __forceinline__ float half_swap_sum(float v) { auto rr = __builtin_amdgcn_permlane32_swap(__float_as_uint(v), __float_as_uint(v), false, false); return __uint_as_float(rr[0]) + __uint_as_float(rr[1]); }
__device__ __forceinline__ float half_swap_max(float v) { auto rr = __builtin_amdgcn_permlane32_swap(__float_as_uint(v), __float_as_uint(v), false, false); return fmaxf(__uint_as_float(rr[0]), __uint_as_float(rr[1])); }
__device__ __forceinline__ int fresh_tid() { int t = threadIdx.x; asm volatile("" : "+v"(t)); return t; }
__device__ __forceinline__ size_t kr_off(int l) { return (l & 1) ? WS_KR2 : WS_KR; }
__device__ __forceinline__ int krow_of(int m) { return m < MP ? m : MP + ((m - MP) >> 4) * SPITCH + PAST + ((m - MP) & 15); }
__device__ __forceinline__ int pos_of(int m) { return m < MP ? (m & (PT - 1)) : PAST + ((m - MP) & 15); }
__device__ __forceinline__ float* rows_out(float* out, size_t off_p, size_t off_s, int l, int m, int W) {
    return m < MP ? out + off_p + ((size_t)l * MP + m) * W : out + off_s + ((size_t)l * MS + (m - MP)) * W;
}

struct Params { const float* in[18]; float* out; unsigned char* ws; int ph_lo, ph_hi; };
__device__ __forceinline__ const float* inp(LAS unsigned char* lds, int i) {
    const unsigned long long v = ((const LAS unsigned long long*)(lds + PTR_OFF))[i];
    const unsigned lo = __builtin_amdgcn_readfirstlane((unsigned)v), hi = __builtin_amdgcn_readfirstlane((unsigned)(v >> 32));
    return (const float*)(const GAS float*)(((unsigned long long)hi << 32) | lo);
}
#define WSP(T, off) ((T*)(ws + (off)))

__device__ __forceinline__ int win_logical_col(int n) {
    const int tile = n >> 8, c = n & 255;
    switch (tile) {
        case 0: return c;
        case 1: { const int blk = c >> 5, p = c & 31, e = 16 * ((p >> 2) & 1) + 4 * (p >> 3) + (p & 3);
                  if (blk < 4) return 256 + 32 * blk + e; if (blk == 4) return 640 + e; if (blk == 5 && p < 4) return 1440 + p; return -1; }
        case 2: return 384 + c;
        case 3: return 672 + c;
        case 4: return 928 + c;
        case 5: return 1184 + c;
        case 6: return 1444 + c;
        case 7: return 1700 + c;
        case 8: return 1956 + c;
        default: return 2212 + 256 * (tile - 9) + c;
    }
}
__device__ __forceinline__ void p0_item(unsigned char* ws, LAS unsigned char* lds, int kind, int l, int item, LAS float* scr, int lane) {
    const int K = kind == 1 ? 256 : 1024, N = kind == 0 ? NINP : kind == 1 ? 768 : 1024;
    const int nblk = N / 32, kb = item / nblk, nb = item % nblk, k0 = 64 * kb, n0 = 32 * nb;
    const int n = n0 + (lane & 31);
    const float* src; int ld; int col;
    if (kind == 0) { src = inp(lds, 11) + (size_t)l * D * NIN; ld = NIN; col = win_logical_col(n); }
    else if (kind == 1) { if (n < 256) { src = inp(lds, 13) + (size_t)l * 256 * 256; ld = 256; col = n; } else { src = inp(lds, 14) + (size_t)l * 256 * 512; ld = 512; col = n - 256; } }
    else { src = inp(lds, 17) + (size_t)l * D * D; ld = D; col = n; }
    const float* gain = kind == 0 ? inp(lds, 9) + l * D : kind == 2 ? inp(lds, 16) + l * D : nullptr;
#pragma unroll 8
    for (int i = 0; i < 32; ++i) { const int kk = 2 * i + (lane >> 5); float v = 0.f;
        if (col >= 0) { v = src[(size_t)(k0 + kk) * ld + col]; if (gain) v *= gain[k0 + kk]; }
        scr[kk * 33 + (lane & 31)] = v; }
    asm volatile("s_waitcnt lgkmcnt(0)" ::: "memory");
    bf16_t* WT = (bf16_t*)(ws + (kind == 0 ? WS_WIN + (size_t)l * NINP * D * 2 : kind == 1 ? WS_WUKV + (size_t)l * 768 * 256 * 2 : WS_WOUT + (size_t)l * D * D * 2));
    const int c = lane & 7;
#pragma unroll
    for (int j = 0; j < 4; ++j) { const int nn = (lane >> 3) + 8 * j; const LAS float* s = scr + (8 * c) * 33 + nn;
        u32x4 o; o.x = cvtpk(s[0 * 33], s[1 * 33]); o.y = cvtpk(s[2 * 33], s[3 * 33]); o.z = cvtpk(s[4 * 33], s[5 * 33]); o.w = cvtpk(s[6 * 33], s[7 * 33]);
        *(u32x4*)(WT + (size_t)(n0 + nn) * K + k0 + 8 * c) = o; }
    asm volatile("s_waitcnt lgkmcnt(0)" ::: "memory");
}
__device__ __forceinline__ void p0_prologue(unsigned char* ws, LAS unsigned char* lds) {
    const int tid = fresh_tid(), lane = tid & 63, wid = __builtin_amdgcn_readfirstlane(tid >> 6);
    LAS float* scr = (LAS float*)(lds + wid * 16384);
    const int gw = blockIdx.x * 8 + wid, NGW = gridDim.x * 8;
    constexpr int I0 = 16 * (NINP / 32), I1 = 4 * 24, I2 = 16 * 32, IL = I0 + I1 + I2;
    for (int it = gw; it < IL; it += NGW) {
        const int l = it / IL; int r = it % IL;
        if (r < I0) { p0_item(ws, lds, 0, l, r, scr, lane); continue; } r -= I0;
        if (r < I1) { p0_item(ws, lds, 1, l, r, scr, lane); continue; } r -= I1;
        p0_item(ws, lds, 2, l, r, scr, lane);
    }
    float* rope = (float*)(ws + WS_ROPE);
    for (int e = blockIdx.x * 512 + tid; e < PT * 16; e += gridDim.x * 512) {
        const int pos = e >> 4, i = e & 15;
        double inv = 1.0; for (int k = 0; k < i; ++k) inv *= 0.5623413251903491;
        const double rev = (double)pos * inv * 0.15915494309189535;
        const float fr = (float)(rev - __builtin_rint(rev));
        rope[pos * 32 + i] = __builtin_amdgcn_cosf(fr); rope[pos * 32 + 16 + i] = __builtin_amdgcn_sinf(fr);
    }
}

__device__ __forceinline__ void cvt_rows(const float* src, bf16_t* dst, int W, size_t dst_bstride, int gtid, int nthr) {
    const int per_b = PAST * W / 8, total = SBN * per_b;
    for (int q0 = gtid; q0 < total; q0 += 4 * nthr) {
        f32x4 a[4], b[4];
#pragma unroll
        for (int u = 0; u < 4; ++u) { const int q = q0 + u * nthr; if (q < total) { a[u] = *(const f32x4*)(src + (size_t)q * 8); b[u] = *(const f32x4*)(src + (size_t)q * 8 + 4); } }
#pragma unroll
        for (int u = 0; u < 4; ++u) { const int q = q0 + u * nthr; if (q < total) { const int sb = q / per_b, rem = q % per_b;
            u32x4 o; o.x = cvtpk(a[u][0], a[u][1]); o.y = cvtpk(a[u][2], a[u][3]); o.z = cvtpk(b[u][0], b[u][1]); o.w = cvtpk(b[u][2], b[u][3]);
            *(u32x4*)(dst + (size_t)sb * dst_bstride + (size_t)rem * 8) = o; } }
    }
}
__device__ __forceinline__ void p1_norm(unsigned char* ws, float* out, LAS unsigned char* lds, int l) {
    const int tid = fresh_tid(), lane = tid & 63, wid = __builtin_amdgcn_readfirstlane(tid >> 6);
    const int gw = blockIdx.x * 8 + wid, NGW = gridDim.x * 8;
    bf16_t* XB = (bf16_t*)(ws + WS_XN); const bf16_t* Y = (const bf16_t*)(ws + WS_Y); float* RSTD = (float*)(ws + WS_RSTD);
    const float* xp = inp(lds, 0); const float* xs = inp(lds, 1); const float* gpost = inp(lds, 10);
    constexpr int RU = 4;
    f32x4 g[4];
    if (l > 0) {
#pragma unroll
        for (int j = 0; j < 4; ++j) g[j] = *(const f32x4*)(gpost + (l - 1) * D + 256 * j + 4 * lane);
    }
    for (int m0 = gw; m0 < M; m0 += RU * NGW) {
        f32x4 v[RU][4]; u32x2 yw[RU][4];
#pragma unroll
        for (int r = 0; r < RU; ++r) { const int m = m0 + r * NGW; if (m < M) {
            if (l == 0) { const float* base = m < MP ? xp + (size_t)m * D : xs + (size_t)(m - MP) * D;
#pragma unroll
                for (int j = 0; j < 4; ++j) v[r][j] = *(const f32x4*)(base + 256 * j + 4 * lane); }
            else {
#pragma unroll
                for (int j = 0; j < 4; ++j) { const u32x2 w = *(const u32x2*)(XB + (size_t)m * D + 256 * j + 4 * lane); v[r][j] = (f32x4){bf_lo(w.x), bf_hi(w.x), bf_lo(w.y), bf_hi(w.y)}; }
#pragma unroll
                for (int j = 0; j < 4; ++j) yw[r][j] = *(const u32x2*)(Y + (size_t)m * D + 256 * j + 4 * lane); } } }
#pragma unroll
        for (int r = 0; r < RU; ++r) { const int m = m0 + r * NGW; if (m < M) {
            if (l > 0) {
                f32x4 y[4]; float s = 0.f;
#pragma unroll
                for (int j = 0; j < 4; ++j) { const u32x2 w = yw[r][j]; y[j] = (f32x4){bf_lo(w.x), bf_hi(w.x), bf_lo(w.y), bf_hi(w.y)}; s += (y[j][0] * y[j][0] + y[j][1] * y[j][1]) + (y[j][2] * y[j][2] + y[j][3] * y[j][3]); }
                const float rr = 1.0f / sqrtf(wave_sum(s) * (1.0f / D) + EPS);
#pragma unroll
                for (int j = 0; j < 4; ++j) v[r][j] = v[r][j] + y[j] * rr * g[j];
            }
            if (l < NL) {
                float s = 0.f;
#pragma unroll
                for (int j = 0; j < 4; ++j) s += (v[r][j][0] * v[r][j][0] + v[r][j][1] * v[r][j][1]) + (v[r][j][2] * v[r][j][2] + v[r][j][3] * v[r][j][3]);
                const float rr = 1.0f / sqrtf(wave_sum(s) * (1.0f / D) + EPS);
                if (lane == 0) RSTD[m] = rr;
#pragma unroll
                for (int j = 0; j < 4; ++j) { u32x2 w; w.x = cvtpk(v[r][j][0], v[r][j][1]); w.y = cvtpk(v[r][j][2], v[r][j][3]); *(u32x2*)(XB + (size_t)m * D + 256 * j + 4 * lane) = w; }
            } else {
                float* xres = out + (size_t)m * D;
#pragma unroll
                for (int j = 0; j < 4; ++j) *(f32x4*)(xres + 256 * j + 4 * lane) = v[r][j];
            } } }
    }
    if (l == 0) {
        const int gtid = blockIdx.x * 512 + tid, nthr = gridDim.x * 512;
        cvt_rows(inp(lds, 2) + (size_t)l * SBN * PAST * 256, (bf16_t*)(ws + WS_CKVB) + (size_t)M * 256, 256, (size_t)PAST * 256, gtid, nthr);
        cvt_rows(inp(lds, 3) + (size_t)l * SBN * PAST * 32, (bf16_t*)(ws + WS_KR) + (size_t)MP * 32, 32, (size_t)SPITCH * 32, gtid, nthr);
    }
}

__device__ __forceinline__ void st8(bf16_t* p, const f32x4 a, const f32x4 b, float sc) {
    u32x4 w; w.x = cvtpk(a[0] * sc, a[1] * sc); w.y = cvtpk(a[2] * sc, a[3] * sc); w.z = cvtpk(b[0] * sc, b[1] * sc); w.w = cvtpk(b[2] * sc, b[3] * sc); *(u32x4*)p = w;
}
__device__ __forceinline__ float silu_f(float x) { return x * __builtin_amdgcn_rcpf(1.0f + __builtin_amdgcn_exp2f(-x * LOG2E)); }
struct EpiP2 {
    static constexpr bool PERM = true, AFTER_DRAIN = false, MID = false;
    unsigned char* ws; float* out; const float* kvnorm; const float* fbias; int l; LAS float* scr;
    __device__ __forceinline__ void operator()(pg8::f32x4 (&acc)[2][2][4][2], const pg8::Unit& u, int wr, int wc, int fr, int fq) const {
        int pn = u.pn, rbase = u.pm * 256 + wr * 64 + fr, cw = wc * 32 + 8 * fq;
        asm volatile("" : "+s"(pn), "+v"(rbase), "+v"(cw));
        {
            const float* const RSTD = WSP(const float, WS_RSTD); float rs[2][4];
#pragma unroll
            for (int ai = 0; ai < 2; ++ai)
#pragma unroll
                for (int m = 0; m < 4; ++m) rs[ai][m] = RSTD[rbase + ai * 128 + m * 16];
#pragma unroll
            for (int ai = 0; ai < 2; ++ai)
#pragma unroll
                for (int m = 0; m < 4; ++m)
#pragma unroll
                    for (int bj = 0; bj < 2; ++bj)
#pragma unroll
                        for (int n = 0; n < 2; ++n) acc[ai][bj][m][n] = acc[ai][bj][m][n] * rs[ai][m];
        }
        bf16_t* const QA = WSP(bf16_t, WS_QA); bf16_t* const QB = WSP(bf16_t, WS_QB); bf16_t* const QC = WSP(bf16_t, WS_QC); bf16_t* const KR = (bf16_t*)(ws + kr_off(l)); bf16_t* const KB = WSP(bf16_t, WS_KB); bf16_t* const VB = WSP(bf16_t, WS_VB);
        bf16_t* const KC = WSP(bf16_t, WS_KC); bf16_t* const VC = WSP(bf16_t, WS_VC); bf16_t* const CKVB = WSP(bf16_t, WS_CKVB); bf16_t* const GATE = WSP(bf16_t, WS_GATE); float* const LOGF = WSP(float, WS_LOGF); const float* const rope = WSP(const float, WS_ROPE);
        if (pn == 0 || pn == 3 || pn == 6) {
            const float sc = pn == 0 ? QA_SC : pn == 3 ? QB_SC : QC_SC;
#pragma unroll
            for (int ai = 0; ai < 2; ++ai)
#pragma unroll
                for (int m = 0; m < 4; ++m) { const int row = rbase + ai * 128 + m * 16;
#pragma unroll
                    for (int bj = 0; bj < 2; ++bj) {
                        bf16_t* d = pn == 0 ? QA + (size_t)row * 384 + (2 * bj + (wc >> 1)) * 96 + 32 * (wc & 1) + 8 * fq : (pn == 3 ? QB : QC) + (size_t)row * 256 + 128 * bj + cw;
                        st8(d, acc[ai][bj][m][0], acc[ai][bj][m][1], sc); } }
        } else if (pn >= 9) {
#pragma unroll
            for (int ai = 0; ai < 2; ++ai)
#pragma unroll
                for (int m = 0; m < 4; ++m) { const int row = rbase + ai * 128 + m * 16;
#pragma unroll
                    for (int bj = 0; bj < 2; ++bj) { f32x4 a = acc[ai][bj][m][0], b = acc[ai][bj][m][1];
#pragma unroll
                        for (int j = 0; j < 4; ++j) { a[j] = silu_f(a[j]); b[j] = silu_f(b[j]); }
                        st8(GATE + (size_t)row * D + 256 * (pn - 9) + 128 * bj + cw, a, b, 1.0f); } }
        } else if (pn == 4 || pn == 5 || pn == 7 || pn == 8) {
            bf16_t* buf = pn == 4 ? KB : pn == 5 ? VB : pn == 7 ? KC : VC;
            const size_t offp = pn == 4 ? O_PFK : pn == 5 ? O_PFV : pn == 7 ? O_PSK : O_PSV, offs = pn == 4 ? O_SFK : pn == 5 ? O_SFV : pn == 7 ? O_SSK : O_SSV;
#pragma unroll
            for (int ai = 0; ai < 2; ++ai)
#pragma unroll
                for (int m = 0; m < 4; ++m) { const int row = rbase + ai * 128 + m * 16; const int kr = krow_of(row); float* o = rows_out(out, offp, offs, l, row, 256);
#pragma unroll
                    for (int bj = 0; bj < 2; ++bj) { const int c0 = 128 * bj + cw;
                        st8(buf + (size_t)kr * 256 + c0, acc[ai][bj][m][0], acc[ai][bj][m][1], 1.0f);
                        *(f32x4*)(o + c0) = acc[ai][bj][m][0]; *(f32x4*)(o + c0 + 4) = acc[ai][bj][m][1]; } }
            if (pn == 4 && u.pm < MP / 256) {
                float mx[2] = {0.f, 0.f};
#pragma unroll
                for (int ai = 0; ai < 2; ++ai)
#pragma unroll
                    for (int m = 0; m < 4; ++m)
#pragma unroll
                        for (int bj = 0; bj < 2; ++bj) { const f32x4 x = acc[ai][bj][m][0], y = acc[ai][bj][m][1];
                            float sq = ((x[0] * x[0] + x[1] * x[1]) + (x[2] * x[2] + x[3] * x[3])) + ((y[0] * y[0] + y[1] * y[1]) + (y[2] * y[2] + y[3] * y[3]));
                            sq += __shfl_xor(sq, 16); sq += __shfl_xor(sq, 32); mx[bj] = fmaxf(mx[bj], sq); }
#pragma unroll
                for (int bj = 0; bj < 2; ++bj) { float v = mx[bj];
                    v = fmaxf(v, __shfl_xor(v, 1)); v = fmaxf(v, __shfl_xor(v, 2)); v = fmaxf(v, __shfl_xor(v, 4)); v = fmaxf(v, __shfl_xor(v, 8));
                    if (fr == 0 && fq == 0) __hip_atomic_fetch_max(WSP(unsigned, WS_CTL) + CW_KMAX + ((l * 4 + (u.pm >> 5)) * 4 + 2 * bj + (wc >> 1)) * 2 + (wc & 1), __float_as_uint(v), __ATOMIC_RELAXED, __HIP_MEMORY_SCOPE_AGENT); }
            }
        } else if (pn == 1) {
#pragma unroll
            for (int ai = 0; ai < 2; ++ai)
#pragma unroll
                for (int m = 0; m < 4; ++m) { const int row = rbase + ai * 128 + m * 16; const int pos = pos_of(row);
                    const f32x4 cs = *(const f32x4*)(rope + pos * 32 + 4 * fq), sn = *(const f32x4*)(rope + pos * 32 + 16 + 4 * fq);
                    {
                        const f32x4 x1 = acc[ai][0][m][0], x2 = acc[ai][0][m][1]; const f32x4 y1 = (x1 * cs - x2 * sn) * QA_SC, y2 = (x1 * sn + x2 * cs) * QA_SC;
                        bf16_t* d = QA + (size_t)row * 384 + wc * 96 + 64 + 4 * fq;
                        u32x2 w1, w2; w1.x = cvtpk(y1[0], y1[1]); w1.y = cvtpk(y1[2], y1[3]); w2.x = cvtpk(y2[0], y2[1]); w2.y = cvtpk(y2[2], y2[3]);
                        *(u32x2*)d = w1; *(u32x2*)(d + 16) = w2; }
                    if (wc == 0) {
                        const f32x4 x1 = acc[ai][1][m][0], x2 = acc[ai][1][m][1]; const f32x4 y1 = x1 * cs - x2 * sn, y2 = x1 * sn + x2 * cs;
                        bf16_t* d = KR + (size_t)krow_of(row) * 32 + 4 * fq;
                        u32x2 w1, w2; w1.x = cvtpk(y1[0], y1[1]); w1.y = cvtpk(y1[2], y1[3]); w2.x = cvtpk(y2[0], y2[1]); w2.y = cvtpk(y2[2], y2[3]);
                        *(u32x2*)d = w1; *(u32x2*)(d + 16) = w2;
                        float* o = rows_out(out, O_PKPE, O_SKPE, l, row, 32) + 4 * fq; *(f32x4*)o = y1; *(f32x4*)(o + 16) = y2;
                    } else if (wc == 1 && fq == 0) {
                        f32x4 v = acc[ai][1][m][0] + *(const f32x4*)fbias; f32x4 lf;
#pragma unroll
                        for (int j = 0; j < 4; ++j) lf[j] = fminf(v[j], 0.f) - __logf(1.0f + __expf(-fabsf(v[j])));
                        *(f32x4*)rows_out(out, O_PLF, O_SLF, l, row, 4) = lf; *(f32x4*)(LOGF + (size_t)krow_of(row) * 4) = lf;
                    } }
        } else {
            float ssq[2][4];
#pragma unroll
            for (int ai = 0; ai < 2; ++ai)
#pragma unroll
                for (int m = 0; m < 4; ++m) { float s = 0.f;
#pragma unroll
                    for (int bj = 0; bj < 2; ++bj)
#pragma unroll
                        for (int n = 0; n < 2; ++n) { const f32x4 x = acc[ai][bj][m][n]; s += (x[0] * x[0] + x[1] * x[1]) + (x[2] * x[2] + x[3] * x[3]); }
                    s += __shfl_xor(s, 16); s += __shfl_xor(s, 32);
                    if (fq == 0) scr[(ai * 128 + wr * 64 + m * 16 + fr) * 4 + wc] = s; }
            asm volatile("s_waitcnt lgkmcnt(0)" ::: "memory"); __builtin_amdgcn_s_barrier(); asm volatile("" ::: "memory");
#pragma unroll
            for (int ai = 0; ai < 2; ++ai)
#pragma unroll
                for (int m = 0; m < 4; ++m) { const f32x4 p4 = *(const LAS f32x4*)(scr + (ai * 128 + wr * 64 + m * 16 + fr) * 4); ssq[ai][m] = (p4[0] + p4[1]) + (p4[2] + p4[3]); }
#pragma unroll
            for (int ai = 0; ai < 2; ++ai)
#pragma unroll
                for (int m = 0; m < 4; ++m) { const int row = rbase + ai * 128 + m * 16; const float r = 1.0f / sqrtf(ssq[ai][m] * (1.0f / 256.0f) + EPS); float* o = rows_out(out, O_PCKV, O_SCKV, l, row, 256);
#pragma unroll
                    for (int bj = 0; bj < 2; ++bj) { const int c0 = 128 * bj + cw;
                        const f32x4 a = acc[ai][bj][m][0] * r * *(const f32x4*)(kvnorm + c0), b = acc[ai][bj][m][1] * r * *(const f32x4*)(kvnorm + c0 + 4);
                        st8(CKVB + (size_t)row * 256 + c0, a, b, 1.0f); *(f32x4*)(o + c0) = a; *(f32x4*)(o + c0 + 4) = b; } }
        }
    }
};
struct EpiP3 {
    static constexpr bool PERM = true, AFTER_DRAIN = false, MID = false;
    unsigned char* ws;
    __device__ __forceinline__ void operator()(const pg8::f32x4 (&acc)[2][2][4][2], const pg8::Unit& u, int wr, int wc, int fr, int fq) const {
        int pn = u.pn, rbase = u.pm * 256 + wr * 64 + fr, cw = wc * 32 + 8 * fq;
        asm volatile("" : "+s"(pn), "+v"(rbase), "+v"(cw));
        bf16_t* const KA = WSP(bf16_t, WS_KA); bf16_t* const VA = WSP(bf16_t, WS_VA);
#pragma unroll
        for (int ai = 0; ai < 2; ++ai)
#pragma unroll
            for (int m = 0; m < 4; ++m) { const int row = rbase + ai * 128 + m * 16;
                const int dest = row < M ? krow_of(row) : MP + ((row - M) >> 11) * SPITCH + ((row - M) & 2047);
#pragma unroll
                for (int bj = 0; bj < 2; ++bj) { bf16_t* d = pn == 0 ? KA + (size_t)dest * 256 + 128 * bj + cw : VA + (size_t)dest * 512 + 256 * (pn - 1) + 128 * bj + cw;
                    st8(d, acc[ai][bj][m][0], acc[ai][bj][m][1], 1.0f); } }
    }
};
struct EpiP5 {
    static constexpr bool PERM = true, AFTER_DRAIN = false, MID = true; static constexpr int MID_T0 = 8, MID_T1 = 12;
    unsigned char* ws; LAS float* tab;
    __device__ __forceinline__ void prep(const pg8::Unit& u, int par, int tid) const {
        if (tid < 256) { const float* ss = WSP(const float, WS_SS) + (size_t)(u.pm * 256 + tid) * 12;
            const f32x4 a = *(const f32x4*)ss, b = *(const f32x4*)(ss + 4), c = *(const f32x4*)(ss + 8);
            const float ra = 1.0f / sqrtf(((a[0] + a[1]) + (a[2] + a[3])) * (1.0f / 512.0f) + EPS), rb = 1.0f / sqrtf(((b[0] + b[1]) + (b[2] + b[3])) * (1.0f / 256.0f) + EPS), rc = 1.0f / sqrtf(((c[0] + c[1]) + (c[2] + c[3])) * (1.0f / 256.0f) + EPS);
            *(LAS f32x4*)(tab + (par * 256 + tid) * 4) = (f32x4){ra / rb, rb / rc, rc, 0.f}; }
    }
    __device__ __forceinline__ void mid(pg8::f32x4 (&acc)[2][2][4][2], int par, int which, int wr, int fr) const {
#pragma unroll
        for (int ai = 0; ai < 2; ++ai)
#pragma unroll
            for (int m = 0; m < 4; ++m) { const f32x4 t4 = *(const LAS f32x4*)(tab + (par * 256 + ai * 128 + wr * 64 + m * 16 + fr) * 4); const float f = which == 0 ? t4[0] : which == 1 ? t4[1] : t4[2];
#pragma unroll
                for (int bj = 0; bj < 2; ++bj)
#pragma unroll
                    for (int n = 0; n < 2; ++n) acc[ai][bj][m][n] = acc[ai][bj][m][n] * f; }
    }
    __device__ __forceinline__ void operator()(const pg8::f32x4 (&acc)[2][2][4][2], const pg8::Unit& u, int wr, int wc, int fr, int fq) const {
        int rbase = u.pm * 256 + wr * 64 + fr, cw = u.pn * 256 + wc * 32 + 8 * fq; bf16_t* const Y = WSP(bf16_t, WS_Y);
        asm volatile("" : "+v"(rbase), "+v"(cw));
#pragma unroll
        for (int ai = 0; ai < 2; ++ai)
#pragma unroll
            for (int m = 0; m < 4; ++m) { const int row = rbase + ai * 128 + m * 16;
#pragma unroll
                for (int bj = 0; bj < 2; ++bj) st8(Y + (size_t)row * D + 128 * bj + cw, acc[ai][bj][m][0], acc[ai][bj][m][1], 1.0f); }
    }
};

__device__ __forceinline__ void cumsum_task(unsigned char* ws, int l, int task, LAS unsigned char* lds) {
    const int tid = fresh_tid(), lane = tid & 63, wid = tid >> 6;
    const float* LOGF = (const float*)(ws + WS_LOGF); float* FB = (float*)(ws + WS_FB);
    const bool prompt = task < 4; const int sb = task - 4;
    const int n = prompt ? PT : SKEYS, CH = prompt ? 16 : 5;
    const int krow0 = prompt ? task * PT : MP + sb * SPITCH;
    const float* cache = inp(lds, 6) + ((size_t)l * SBN + (prompt ? 0 : sb)) * PAST * 4;
    const int t0 = tid * CH;
    f32x4 s = {0.f, 0.f, 0.f, 0.f};
    for (int i = 0; i < CH; ++i) { const int t = t0 + i; if (t < n) { const f32x4 v = (!prompt && t < PAST) ? *(const f32x4*)(cache + (size_t)t * 4) : *(const f32x4*)(LOGF + (size_t)(krow0 + t) * 4); s = s + v; } }
    const f32x4 own = s;
#pragma unroll
    for (int off = 1; off < 64; off <<= 1) {
#pragma unroll
        for (int c = 0; c < 4; ++c) { const float t = __shfl_up(s[c], off); if (lane >= off) s[c] += t; } }
    LAS f32x4* wt = (LAS f32x4*)lds;
    if (lane == 63) wt[wid] = s;
    __syncthreads();
    f32x4 pre = s - own;
    for (int w = 0; w < wid; ++w) pre = pre + wt[w];
    for (int i = 0; i < CH; ++i) { const int t = t0 + i; if (t < n) { const f32x4 v = (!prompt && t < PAST) ? *(const f32x4*)(cache + (size_t)t * 4) : *(const f32x4*)(LOGF + (size_t)(krow0 + t) * 4); pre = pre + v;
        *(f32x4*)(FB + (size_t)(krow0 + t) * 4) = pre * LOG2E; } }
    __syncthreads();
}

#define MFMA32(a, b, c) __builtin_amdgcn_mfma_f32_32x32x16_bf16((a), (b), (c), 0, 0, 0)
__device__ __forceinline__ s16x4 tr_rd(const LAS unsigned char* p) { typedef short v4i16_t __attribute__((ext_vector_type(4))); return __builtin_bit_cast(s16x4, __builtin_amdgcn_ds_read_tr16_b64_v4i16((LAS v4i16_t*)p)); }
__device__ __forceinline__ bf16x8 pack8(const f32x16& p, int b) {
    u32x4 w; w.x = cvtpk(p[b], p[b + 1]); w.y = cvtpk(p[b + 2], p[b + 3]); w.z = cvtpk(p[b + 4], p[b + 5]); w.w = cvtpk(p[b + 6], p[b + 7]); return __builtin_bit_cast(bf16x8, w);
}
template <int TYPE, bool SAMP>
__device__ __forceinline__ void attn_unit(unsigned char* ws, LAS unsigned char* lds, int l, int qrow0, int nq, int krow0, int qpos0, int nkeys, int h) {
    constexpr int DQK = TYPE == 0 ? 96 : 64, DV = TYPE == 0 ? 128 : 64, NS = DQK / 16, NDB = DV / 32;
    constexpr int KP = TYPE == 0 ? 208 : 144, VP = TYPE == 0 ? 320 : 192;
    constexpr int KBYTES = 64 * KP, VBYTES = 64 * VP, BUFB = KBYTES + VBYTES, OFF_F = 2 * BUFB, OFF_FLAG = OFF_F + 512;
    const int tid = fresh_tid(), lane = tid & 63, wid = __builtin_amdgcn_readfirstlane(tid >> 6), r32 = lane & 31, hh = lane >> 5;
    const bool wave_on = 32 * wid < nq;
    const int qloc = min(32 * wid + r32, nq - 1);
    const int qrow = qrow0 + qloc;
    const int qpos = qpos0 + 32 * wid + r32;
    const int qp_lo = qpos0 + 32 * wid, qp_hi = qp_lo + 31;
    const int jmax = (qpos0 + nq - 1) >> 6;
    const int wjmax = TYPE == 0 ? (qp_lo >> 6) : TYPE == 1 ? (qp_hi >> 6) : ((qp_hi - 1) >> 6);
    const bf16_t* Kg = TYPE == 0 ? WSP(const bf16_t, WS_KA) : TYPE == 1 ? WSP(const bf16_t, WS_KB) : WSP(const bf16_t, WS_KC); const bf16_t* Vg = TYPE == 0 ? WSP(const bf16_t, WS_VA) : TYPE == 1 ? WSP(const bf16_t, WS_VB) : WSP(const bf16_t, WS_VC);
    constexpr int NKC = TYPE == 0 ? 2 : 1, NVC = TYPE == 0 ? 2 : 1;
    const bf16_t* ksrc[NKC]; int kdst[NKC]; bool kval[NKC]; const bf16_t* vsrc[NVC]; int vdst[NVC];
#pragma unroll
    for (int r = 0; r < NKC; ++r) {
        if (TYPE == 0) { const int n = tid + 512 * r; kval[r] = n < 768; const int nn = kval[r] ? n : 0; const int row = nn / 12, c = nn % 12;
            ksrc[r] = c < 8 ? WSP(const bf16_t, WS_KA) + (size_t)(krow0 + row) * 256 + h * 64 + c * 8 : (const bf16_t*)(ws + kr_off(l)) + (size_t)(krow0 + row) * 32 + (c - 8) * 8; kdst[r] = row * KP + c * 16; }
        else { const int row = tid >> 3, c = tid & 7; kval[r] = true; ksrc[r] = Kg + (size_t)(krow0 + row) * 256 + h * 64 + c * 8; kdst[r] = row * KP + c * 16; }
    }
#pragma unroll
    for (int r = 0; r < NVC; ++r) {
        if (TYPE == 0) { const int n = tid + 512 * r; const int row = n >> 4, c = n & 15; vsrc[r] = WSP(const bf16_t, WS_VA) + (size_t)(krow0 + row) * 512 + h * 128 + c * 8; vdst[r] = row * VP + c * 16; }
        else { const int row = tid >> 3, c = tid & 7; vsrc[r] = Vg + (size_t)(krow0 + row) * 256 + h * 64 + c * 8; vdst[r] = row * VP + c * 16; }
    }
    const size_t kstepA = (size_t)64 * 256, kstepR = (size_t)64 * 32, vstep = (size_t)64 * (TYPE == 0 ? 512 : 256);
    u32x4 kreg[NKC], vreg[NVC]; float freg = 0.f;
    constexpr bool F32C = SAMP && TYPE != 0;
    const float* kc32 = nullptr; const float* vc32 = nullptr; u32x4 kx[2], vx[2]; bool ld32 = false;
    if (F32C) { const int sb = (krow0 - MP) / SPITCH; const size_t o32 = (((size_t)l * SBN + sb) * PAST + (tid >> 3)) * 256 + h * 64 + (tid & 7) * 8;
        kc32 = inp(lds, TYPE == 1 ? 4 : 7) + o32; vc32 = inp(lds, TYPE == 1 ? 5 : 8) + o32; }
#define ATT_LOAD(j) do { if (F32C && (j) < PAST / 64) { ld32 = true; const size_t t_ = (size_t)(j) * 64 * 256; \
            kx[0] = *(const u32x4*)(kc32 + t_); kx[1] = *(const u32x4*)(kc32 + t_ + 4); vx[0] = *(const u32x4*)(vc32 + t_); vx[1] = *(const u32x4*)(vc32 + t_ + 4); } else { ld32 = false; \
        _Pragma("unroll") for (int r_ = 0; r_ < NKC; ++r_) { const bool rope_ = (TYPE == 0) && (((tid + 512 * r_) % 12) >= 8); \
            if (kval[r_]) kreg[r_] = *(const u32x4*)(ksrc[r_] + (size_t)(j) * (rope_ ? kstepR : kstepA)); } \
        _Pragma("unroll") for (int r_ = 0; r_ < NVC; ++r_) vreg[r_] = *(const u32x4*)(vsrc[r_] + (size_t)(j) * vstep); } \
        if (TYPE == 1 && tid < 64) freg = WSP(const float, WS_FB)[(size_t)(krow0 + 64 * (j) + tid) * 4 + h]; } while (0)
#define ATT_STORE(b) do { LAS unsigned char* kb_ = lds + (b) * BUFB; \
        if (F32C && ld32) { kreg[0] = (u32x4){cvtpk(__uint_as_float(kx[0].x), __uint_as_float(kx[0].y)), cvtpk(__uint_as_float(kx[0].z), __uint_as_float(kx[0].w)), cvtpk(__uint_as_float(kx[1].x), __uint_as_float(kx[1].y)), cvtpk(__uint_as_float(kx[1].z), __uint_as_float(kx[1].w))}; \
            vreg[0] = (u32x4){cvtpk(__uint_as_float(vx[0].x), __uint_as_float(vx[0].y)), cvtpk(__uint_as_float(vx[0].z), __uint_as_float(vx[0].w)), cvtpk(__uint_as_float(vx[1].x), __uint_as_float(vx[1].y)), cvtpk(__uint_as_float(vx[1].z), __uint_as_float(vx[1].w))}; } \
        _Pragma("unroll") for (int r_ = 0; r_ < NKC; ++r_) if (kval[r_]) *(LAS u32x4*)(kb_ + kdst[r_]) = kreg[r_]; \
        _Pragma("unroll") for (int r_ = 0; r_ < NVC; ++r_) *(LAS u32x4*)(kb_ + KBYTES + vdst[r_]) = vreg[r_]; \
        if (TYPE == 1 && tid < 64) ((LAS float*)(lds + OFF_F))[(b) * 64 + tid] = freg; } while (0)
    bf16x8 qf[NS];
    { const bf16_t* qp = TYPE == 0 ? WSP(const bf16_t, WS_QA) + (size_t)qrow * 384 + h * 96 : (TYPE == 1 ? WSP(const bf16_t, WS_QB) : WSP(const bf16_t, WS_QC)) + (size_t)qrow * 256 + h * 64;
#pragma unroll
      for (int s = 0; s < NS; ++s) qf[s] = *(const bf16x8*)(qp + 16 * s + 8 * hh); }
    float fq = 0.f; if (TYPE == 1) fq = WSP(const float, WS_FB)[(size_t)(krow0 + min(qpos, nkeys - 1)) * 4 + h];
    float bound = INFINITY;
    if (TYPE == 1 && nq == 256) {
        float qn = 0.f;
#pragma unroll
        for (int s = 0; s < NS; ++s)
#pragma unroll
            for (int e = 0; e < 8; ++e) { const float x = __uint_as_float((unsigned)(unsigned short)qf[s][e] << 16); qn += x * x; }
        qn = half_swap_sum(qn);
        const unsigned* km = WSP(const unsigned, WS_CTL) + CW_KMAX + ((l * 4 + krow0 / PT) * 4 + h) * 2;
        bound = sqrtf(qn * (__uint_as_float(km[0]) + __uint_as_float(km[1]))) * 1.02f + 1.0f;
    }
    f32x16 o[NDB];
#pragma unroll
    for (int d = 0; d < NDB; ++d)
#pragma unroll
        for (int i = 0; i < 16; ++i) o[d][i] = 0.f;
    float mrun = 0.f, lrun = 0.f, carry = 0.f; bool wdone = !wave_on;
    f32x16 negc;
#pragma unroll
    for (int i = 0; i < 16; ++i) negc[i] = (TYPE == 1) ? fq : 0.f;
    LAS unsigned* flags = (LAS unsigned*)(lds + OFF_FLAG);
    if (TYPE != 0 && lane == 0) { flags[wid] = wave_on ? 0u : 1u; flags[8 + wid] = wave_on ? 0u : 1u; }
    const int pir = (r32 & ~12) | ((r32 & 4) << 1) | ((r32 & 8) >> 1);
    const int krd = pir * KP + 16 * hh;
    const int vrd = (8 * hh + ((lane & 15) >> 2)) * VP + 32 * ((lane >> 4) & 1) + 8 * (lane & 3);
    ATT_LOAD(jmax); ATT_STORE(0);
    for (int j = jmax; j >= 0; --j) {
        const int buf = (jmax - j) & 1;
        if (j > 0) ATT_LOAD(j - 1);
        __syncthreads();
        if (TYPE != 0) { const u32x4 f0 = *(const LAS u32x4*)(flags + 8 * buf), f1 = *(const LAS u32x4*)(flags + 8 * buf + 4);
            const unsigned all = f0.x & f0.y & f0.z & f0.w & f1.x & f1.y & f1.z & f1.w; if (__builtin_amdgcn_readfirstlane(all)) break; }
        if (wave_on && !wdone && j <= wjmax) {
            const LAS unsigned char* Kb = lds + buf * BUFB; const LAS unsigned char* Vb = Kb + KBYTES;
            f32x16 s0, s1;
            {
                bf16x8 kf0[NS], kf1[NS];
#pragma unroll
                for (int s = 0; s < NS; ++s) { kf0[s] = *(const LAS bf16x8*)(Kb + krd + 32 * s); kf1[s] = *(const LAS bf16x8*)(Kb + krd + 32 * KP + 32 * s); }
                __builtin_amdgcn_sched_barrier(0);

#pragma unroll
                for (int s = 0; s < NS; ++s) { if (s == 0) { s0 = MFMA32(kf0[0], qf[0], negc); s1 = MFMA32(kf1[0], qf[0], negc); } else { s0 = MFMA32(kf0[s], qf[s], s0); s1 = MFMA32(kf1[s], qf[s], s1); } }

                __builtin_amdgcn_sched_barrier(0);
            }
            s16x4 vl[2][4], vh[2][4];
#pragma unroll
            for (int ks = 0; ks < 4; ++ks) { vl[0][ks] = tr_rd(Vb + vrd + (16 * ks) * VP); vh[0][ks] = tr_rd(Vb + vrd + (16 * ks + 4) * VP); }
            __builtin_amdgcn_sched_barrier(0);
            const int kb0 = 64 * j + 8 * hh;
            const bool need_mask = TYPE == 0 ? (64 * j + 63 >= nkeys) : TYPE == 1 ? (64 * j + 63 > qp_lo) : (64 * j + 63 >= qp_lo);
            if (TYPE != 2) {
                if (TYPE == 1) { const LAS float* F = (const LAS float*)(lds + OFF_F) + buf * 64 + 8 * hh;
#pragma unroll
                    for (int a = 0; a < 2; ++a) { const f32x4 f0 = *(const LAS f32x4*)(F + 16 * a), f1 = *(const LAS f32x4*)(F + 16 * a + 4), g0 = *(const LAS f32x4*)(F + 32 + 16 * a), g1 = *(const LAS f32x4*)(F + 32 + 16 * a + 4);
#pragma unroll
                        for (int e = 0; e < 4; ++e) { s0[8 * a + e] -= f0[e]; s0[8 * a + 4 + e] -= f1[e]; s1[8 * a + e] -= g0[e]; s1[8 * a + 4 + e] -= g1[e]; } } }
                if (need_mask) {
#pragma unroll
                    for (int i = 0; i < 16; ++i) { const int k0 = kb0 + 16 * (i >> 3) + (i & 7), k1 = k0 + 32;
                        const bool ok0 = TYPE == 0 ? (k0 < nkeys) : (k0 <= qpos), ok1 = TYPE == 0 ? (k1 < nkeys) : (k1 <= qpos);
                        s0[i] = ok0 ? s0[i] : -INFINITY; s1[i] = ok1 ? s1[i] : -INFINITY; } }
#define MX3(a, b, c) __builtin_fmaxf(__builtin_fmaxf((a), (b)), (c))
                float rm;
                { const float t0 = MX3(s0[0], s0[1], s0[2]), t1 = MX3(s0[3], s0[4], s0[5]), t2 = MX3(s0[6], s0[7], s0[8]), t3 = MX3(s0[9], s0[10], s0[11]), t4 = MX3(s0[12], s0[13], s0[14]),
                              t5 = MX3(s1[0], s1[1], s1[2]), t6 = MX3(s1[3], s1[4], s1[5]), t7 = MX3(s1[6], s1[7], s1[8]), t8 = MX3(s1[9], s1[10], s1[11]), t9 = MX3(s1[12], s1[13], s1[14]);
                  const float u0 = MX3(t0, t1, t2), u1 = MX3(t3, t4, t5), u2 = MX3(t6, t7, t8), u3 = MX3(t9, s0[15], s1[15]); rm = __builtin_fmaxf(MX3(u0, u1, u2), u3); }
#undef MX3
                rm = half_swap_max(rm);
                const bool first = (j == wjmax);
                if (first || __any(rm > 8.0f)) {
                    const float dl = first ? rm : fmaxf(rm, 0.f);
                    mrun += dl;
#pragma unroll
                    for (int i = 0; i < 16; ++i) { s0[i] -= dl; s1[i] -= dl; }
                    const float cin = (TYPE == 1 ? fq : 0.f) - mrun;
#pragma unroll
                    for (int i = 0; i < 16; ++i) negc[i] = cin;
                    if (!first) { const float f = __builtin_amdgcn_exp2f(-dl); lrun *= f;
#pragma unroll
                        for (int d = 0; d < NDB; ++d)
#pragma unroll
                            for (int i = 0; i < 16; ++i) o[d][i] *= f; }
                }
                f32x2_t ls2 = {0.f, 0.f};
#pragma unroll
                for (int i = 0; i < 16; ++i) { s0[i] = __builtin_amdgcn_exp2f(s0[i]); s1[i] = __builtin_amdgcn_exp2f(s1[i]); }
#pragma unroll
                for (int i = 0; i < 16; i += 2) { ls2 += (f32x2_t){s0[i], s0[i + 1]}; ls2 += (f32x2_t){s1[i], s1[i + 1]}; }
                lrun += ls2[0] + ls2[1];
                if (TYPE == 1 && j > 0) { const float fnext = WSP(const float, WS_FB)[(size_t)(krow0 + 64 * j - 1) * 4 + h]; wdone = __all(bound + (fq - fnext) - mrun < EXIT_LOG2); }
            } else {
                f32x16 lk0, lk1;
#pragma unroll
                for (int i = 0; i < 16; ++i) {
                    const float z0 = s0[i], z1 = s1[i];
                    const float sp0 = fmaxf(z0, 0.f) + __builtin_amdgcn_logf(1.0f + __builtin_amdgcn_exp2f(-fabsf(z0))), sp1 = fmaxf(z1, 0.f) + __builtin_amdgcn_logf(1.0f + __builtin_amdgcn_exp2f(-fabsf(z1)));
                    lk0[i] = -sp0; lk1[i] = -sp1; s0[i] = z0 - sp0; s1[i] = z1 - sp1; }
                if (need_mask) {
#pragma unroll
                    for (int i = 0; i < 16; ++i) { const int k0 = kb0 + 16 * (i >> 3) + (i & 7), k1 = k0 + 32; const bool ok0 = k0 < qpos, ok1 = k1 < qpos;
                        lk0[i] = ok0 ? lk0[i] : 0.f; lk1[i] = ok1 ? lk1[i] : 0.f; s0[i] = ok0 ? s0[i] : -INFINITY; s1[i] = ok1 ? s1[i] : -INFINITY; } }
                f32x16 sf0, sf1; float gt[4];
#pragma unroll
                for (int a = 0; a < 2; ++a) { float r0 = 0.f, r1 = 0.f;
#pragma unroll
                    for (int e = 7; e >= 0; --e) { sf0[8 * a + e] = r0; r0 += lk0[8 * a + e]; sf1[8 * a + e] = r1; r1 += lk1[8 * a + e]; }
                    gt[a] = r0; gt[2 + a] = r1; }
                float pt[4], gs[4];
#pragma unroll
                for (int c = 0; c < 4; ++c) pt[c] = __shfl_xor(gt[c], 32);
                float later = 0.f;
#pragma unroll
                for (int c = 3; c >= 0; --c) { gs[c] = later + (hh == 0 ? pt[c] : 0.f); later += gt[c] + pt[c]; }
#pragma unroll
                for (int i = 0; i < 16; ++i) { s0[i] = __builtin_amdgcn_exp2f(s0[i] + sf0[i] + gs[i >> 3] + carry); s1[i] = __builtin_amdgcn_exp2f(s1[i] + sf1[i] + gs[2 + (i >> 3)] + carry); }
                carry += later;
                wdone = __all(carry < EXIT_LOG2);
            }
            bf16x8 pk[4]; pk[0] = pack8(s0, 0); pk[1] = pack8(s0, 8); pk[2] = pack8(s1, 0); pk[3] = pack8(s1, 8);
            {
#pragma unroll
                for (int d = 0; d < NDB; ++d) {
                    if (d + 1 < NDB) {
#pragma unroll
                        for (int ks = 0; ks < 4; ++ks) { vl[(d + 1) & 1][ks] = tr_rd(Vb + vrd + (16 * ks) * VP + 64 * (d + 1)); vh[(d + 1) & 1][ks] = tr_rd(Vb + vrd + (16 * ks + 4) * VP + 64 * (d + 1)); } }
                    __builtin_amdgcn_sched_barrier(0);

#pragma unroll
                    for (int ks = 0; ks < 4; ++ks) { const bf16x8 vf = __builtin_shufflevector(vl[d & 1][ks], vh[d & 1][ks], 0, 1, 2, 3, 4, 5, 6, 7); o[d] = MFMA32(vf, pk[ks], o[d]); }

                    __builtin_amdgcn_sched_barrier(0);
                }
            }
        }
        if (TYPE != 0 && lane == 0) flags[8 * (buf ^ 1) + wid] = wdone ? 1u : 0u;
        if (j > 0) ATT_STORE(buf ^ 1);
    }
    __syncthreads();
    if (wave_on) {
        float inv = 1.0f;
        if (TYPE != 2) { const float lt = half_swap_sum(lrun); inv = 1.0f / lt; }
        float ssq = 0.f;
#pragma unroll
        for (int d = 0; d < NDB; ++d)
#pragma unroll
            for (int i = 0; i < 16; ++i) { o[d][i] *= inv; ssq += o[d][i] * o[d][i]; }
        ssq = half_swap_sum(ssq);
        const bool rowok = 32 * wid + r32 < nq;
        if (rowok) {
            if (hh == 0) WSP(float, WS_SS)[(size_t)qrow * 12 + TYPE * 4 + h] = ssq;
            const int col0 = (TYPE == 0 ? 0 : TYPE == 1 ? 512 : 768) + h * DV + 4 * hh;
#pragma unroll
            for (int d = 0; d < NDB; ++d) { u32x2 gw[4];
#pragma unroll
                for (int g = 0; g < 4; ++g) gw[g] = *(const u32x2*)(WSP(const bf16_t, WS_GATE) + (size_t)qrow * D + col0 + 32 * d + 8 * g);
#pragma unroll
                for (int g = 0; g < 4; ++g) { u32x2 w; w.x = cvtpk(o[d][4 * g] * bf_lo(gw[g].x), o[d][4 * g + 1] * bf_hi(gw[g].x)); w.y = cvtpk(o[d][4 * g + 2] * bf_lo(gw[g].y), o[d][4 * g + 3] * bf_hi(gw[g].y));
                    *(u32x2*)(WSP(bf16_t, WS_OP) + (size_t)qrow * D + col0 + 32 * d + 8 * g) = w; } }
        }
    }
#undef ATT_LOAD
#undef ATT_STORE
}

template <int TYPE>
__device__ __forceinline__ void attn_pp(unsigned char* ws, LAS unsigned char* lds, int l, int qrow0, int krow0, int qpos0, int h) {
    constexpr int DQK = TYPE == 0 ? 96 : 64, DV = TYPE == 0 ? 128 : 64, NS = DQK / 16, NDB = DV / 32;
    constexpr int KP = TYPE == 0 ? 208 : 144, VP = TYPE == 0 ? 320 : 192;
    constexpr int KBYTES = 64 * KP, VBYTES = 64 * VP, OFF_V = 3 * KBYTES, OFF_F = OFF_V + 3 * VBYTES, OFF_FLAG = OFF_F + 3 * 256;
    const int tid = fresh_tid(), lane = tid & 63, wid = __builtin_amdgcn_readfirstlane(tid >> 6), r32 = lane & 31, hh = lane >> 5;
    const bool lag = wid >= 4;
    const int qrow = qrow0 + 32 * wid + r32, qpos = qpos0 + 32 * wid + r32, qp_lo = qpos0 + 32 * wid, qp_hi = qp_lo + 31;
    const int jmax = (qpos0 + 255) >> 6;
    const int wjmax = TYPE == 0 ? (qp_lo >> 6) : TYPE == 1 ? (qp_hi >> 6) : ((qp_hi - 1) >> 6);
    constexpr bool ASC = (TYPE == 0);
#define PP_T(i) (ASC ? (i) : jmax - (i))
    const size_t Kg = TYPE == 0 ? WS_KA : TYPE == 1 ? WS_KB : WS_KC, Vg = TYPE == 0 ? WS_VA : TYPE == 1 ? WS_VB : WS_VC;
    constexpr int NKC = TYPE == 0 ? 2 : 1, NVC = TYPE == 0 ? 2 : 1;
    unsigned ksrc[NKC]; int kdst[NKC]; unsigned vsrc[NVC]; int vdst[NVC];
#pragma unroll
    for (int r = 0; r < NKC; ++r) {
        if (TYPE == 0) {
            if (r == 0) { const int row = tid >> 3, c = tid & 7; ksrc[r] = (unsigned)(WS_KA + ((size_t)(krow0 + row) * 256 + h * 64 + c * 8) * 2); kdst[r] = row * KP + c * 16; }
            else { const int row = (tid & 255) >> 2, c = tid & 3; ksrc[r] = (unsigned)(kr_off(l) + ((size_t)(krow0 + row) * 32 + c * 8) * 2); kdst[r] = row * KP + 128 + c * 16; } }
        else { const int row = tid >> 3, c = tid & 7; ksrc[r] = (unsigned)(Kg + ((size_t)(krow0 + row) * 256 + h * 64 + c * 8) * 2); kdst[r] = row * KP + c * 16; }
    }
#pragma unroll
    for (int r = 0; r < NVC; ++r) {
        if (TYPE == 0) { const int row = tid >> 4, c = tid & 15; vsrc[r] = (unsigned)(WS_VA + ((size_t)(krow0 + row) * 512 + h * 128 + c * 8) * 2); vdst[r] = row * VP + c * 16; }
        else { const int row = tid >> 3, c = tid & 7; vsrc[r] = (unsigned)(Vg + ((size_t)(krow0 + row) * 256 + h * 64 + c * 8) * 2); vdst[r] = row * VP + c * 16; }
    }
    constexpr unsigned kstepA = 64u * 256u * 2u, kstepR = 64u * 32u * 2u, vstep = 64u * (TYPE == 0 ? 512u : 256u) * 2u;
    u32x4 kreg[NKC], vreg[NVC]; float freg = 0.f;
#define PP_KLOAD(j) do { _Pragma("unroll") for (int r_ = 0; r_ < NKC; ++r_) kreg[r_] = *(const u32x4*)(ws + (ksrc[r_] + (unsigned)(j) * (r_ == 1 ? kstepR : kstepA))); \
        if (TYPE == 1) freg = WSP(const float, WS_FB)[(size_t)(krow0 + 64 * (j) + lane) * 4 + h]; } while (0)
#define PP_VLOAD(j) do { _Pragma("unroll") for (int r_ = 0; r_ < NVC; ++r_) vreg[r_] = *(const u32x4*)((ws + (size_t)r_ * 32 * 1024) + (vsrc[0] + (unsigned)(j) * vstep)); } while (0)
#define PP_KSTORE(sl) do { LAS unsigned char* kb_ = lds + (sl) * KBYTES; \
        _Pragma("unroll") for (int r_ = 0; r_ < NKC; ++r_) *(LAS u32x4*)(kb_ + kdst[r_]) = kreg[r_]; \
        if (TYPE == 1) ((LAS float*)(lds + OFF_F))[(sl) * 64 + lane] = freg; } while (0)
#define PP_VSTORE(sl) do { LAS unsigned char* vb_ = lds + OFF_V + (sl) * VBYTES; \
        _Pragma("unroll") for (int r_ = 0; r_ < NVC; ++r_) *(LAS u32x4*)(vb_ + vdst[0] + r_ * 32 * VP) = vreg[r_]; } while (0)
    bf16x8 qf[NS];
    { const bf16_t* qp = TYPE == 0 ? WSP(const bf16_t, WS_QA) + (size_t)qrow * 384 + h * 96 : (TYPE == 1 ? WSP(const bf16_t, WS_QB) : WSP(const bf16_t, WS_QC)) + (size_t)qrow * 256 + h * 64;
#pragma unroll
      for (int s = 0; s < NS; ++s) qf[s] = *(const bf16x8*)(qp + 16 * s + 8 * hh); }
    float fq = 0.f; if (TYPE == 1) fq = WSP(const float, WS_FB)[(size_t)(krow0 + qpos) * 4 + h];
    float bound = INFINITY;
    if (TYPE == 1) {
        float qn = 0.f;
#pragma unroll
        for (int s = 0; s < NS; ++s)
#pragma unroll
            for (int e = 0; e < 8; ++e) { const float x = __uint_as_float((unsigned)(unsigned short)qf[s][e] << 16); qn += x * x; }
        qn = half_swap_sum(qn);
        const unsigned* km = WSP(const unsigned, WS_CTL) + CW_KMAX + ((l * 4 + krow0 / PT) * 4 + h) * 2;
        bound = sqrtf(qn * (__uint_as_float(km[0]) + __uint_as_float(km[1]))) * 1.02f + 1.0f;
    }
    f32x16 o[NDB];
#pragma unroll
    for (int d = 0; d < NDB; ++d)
#pragma unroll
        for (int i = 0; i < 16; ++i) o[d][i] = 0.f;
    float mrun = 0.f, lrun = 0.f, carry = 0.f; bool wdone = false, pend = false, brk = false;
    float cin = (TYPE == 1) ? fq : 0.f;
    LAS unsigned* flags = (LAS unsigned*)(lds + OFF_FLAG);
    const int pir = (r32 & ~12) | ((r32 & 4) << 1) | ((r32 & 8) >> 1);
    const int krd = pir * KP + 16 * hh;
    const int vrd = (8 * hh + ((lane & 15) >> 2)) * VP + 32 * ((lane >> 4) & 1) + 8 * (lane & 3);
    f32x16 s0, s1; bf16x8 pk[4];
#pragma unroll
    for (int i = 0; i < 16; ++i) { s0[i] = cin; s1[i] = cin; }
#pragma unroll
    for (int i = 0; i < 4; ++i) pk[i] = (bf16x8){0, 0, 0, 0, 0, 0, 0, 0};
#define PP_KRD(sl) do { const LAS unsigned char* Kb_ = lds + (sl) * KBYTES; \
        _Pragma("unroll") for (int s = 0; s < NS; ++s) { kf0[s] = *(const LAS bf16x8*)(Kb_ + krd + 32 * s); kf1[s] = *(const LAS bf16x8*)(Kb_ + krd + 32 * KP + 32 * s); } } while (0)
#define PP_QKM() do { __builtin_amdgcn_sched_barrier(0); \
        _Pragma("unroll") for (int s = 0; s < NS; ++s) { s0 = MFMA32(kf0[s], qf[s], s0); s1 = MFMA32(kf1[s], qf[s], s1); } \
        __builtin_amdgcn_sched_barrier(0); } while (0)
#define PP_VRD(sl, d) do { const LAS unsigned char* Vb_ = lds + OFF_V + (sl) * VBYTES; \
        _Pragma("unroll") for (int ks = 0; ks < 4; ++ks) { vl[d][ks] = tr_rd(Vb_ + vrd + (16 * ks) * VP + 64 * (d)); vh[d][ks] = tr_rd(Vb_ + vrd + (16 * ks + 4) * VP + 64 * (d)); } } while (0)
#define PP_PVM(d) do { _Pragma("unroll") for (int ks = 0; ks < 4; ++ks) { const bf16x8 vf = __builtin_shufflevector(vl[d][ks], vh[d][ks], 0, 1, 2, 3, 4, 5, 6, 7); o[d] = MFMA32(vf, pk[ks], o[d]); } } while (0)
    PP_KLOAD(PP_T(0)); PP_VLOAD(PP_T(0)); PP_KSTORE(0); PP_VSTORE(0);
    PP_KLOAD(PP_T(1)); PP_KSTORE(1);
    PP_KLOAD(PP_T(2)); PP_VLOAD(PP_T(1));
    __syncthreads();
    if (PP_T(0) <= wjmax) { bf16x8 kf0[NS], kf1[NS]; PP_KRD(0); PP_QKM(); }
    if (lag) __syncthreads();
    int c = 0;
    for (int it = 0; it <= jmax; ++it) {
        const int j = PP_T(it), jn = PP_T(it + 1);
        const int c1 = c == 2 ? 0 : c + 1, c2 = c1 == 2 ? 0 : c1 + 1;
        bf16x8 kf0[NS], kf1[NS];
        s16x4 vl[NDB][4], vh[NDB][4];
        __syncthreads();
        if (TYPE != 0 && !lag && it > 0) { const u32x4 f0 = *(const LAS u32x4*)(flags + 8 * ((j + 1) & 1)), f1 = *(const LAS u32x4*)(flags + 8 * ((j + 1) & 1) + 4);
            const unsigned all = f0.x & f0.y & f0.z & f0.w & f1.x & f1.y & f1.z & f1.w; if (__builtin_amdgcn_readfirstlane(all)) { brk = true; break; } }
        PP_KSTORE(c2); PP_VSTORE(c1);
        const bool doq = it < jmax && jn <= wjmax && !wdone;
        PP_KRD(c1);
        { const int ik = it + 3 <= jmax ? it + 3 : jmax, iv = it + 2 <= jmax ? it + 2 : jmax; PP_KLOAD(PP_T(ik)); PP_VLOAD(PP_T(iv)); }
        if (j <= wjmax && !wdone) {
            const int kb0 = 64 * j + 8 * hh;
            const bool need_mask = TYPE == 0 ? false : TYPE == 1 ? (64 * j + 63 > qp_lo) : (64 * j + 63 >= qp_lo);
            if (TYPE != 2) {
                if (TYPE == 1) { const LAS float* F = (const LAS float*)(lds + OFF_F) + c * 64 + 8 * hh;
#pragma unroll
                    for (int a = 0; a < 2; ++a) { const f32x4 f0 = *(const LAS f32x4*)(F + 16 * a), f1 = *(const LAS f32x4*)(F + 16 * a + 4), g0 = *(const LAS f32x4*)(F + 32 + 16 * a), g1 = *(const LAS f32x4*)(F + 32 + 16 * a + 4);
#pragma unroll
                        for (int e = 0; e < 4; ++e) { s0[8 * a + e] -= f0[e]; s0[8 * a + 4 + e] -= f1[e]; s1[8 * a + e] -= g0[e]; s1[8 * a + 4 + e] -= g1[e]; } } }
                if (need_mask) {
#pragma unroll
                    for (int i = 0; i < 16; ++i) { const int k0 = kb0 + 16 * (i >> 3) + (i & 7), k1 = k0 + 32;
                        s0[i] = (k0 <= qpos) ? s0[i] : -INFINITY; s1[i] = (k1 <= qpos) ? s1[i] : -INFINITY; } }
#define MX3(a, b, c) __builtin_fmaxf(__builtin_fmaxf((a), (b)), (c))
                float rm;
                { const float t0 = MX3(s0[0], s0[1], s0[2]), t1 = MX3(s0[3], s0[4], s0[5]), t2 = MX3(s0[6], s0[7], s0[8]), t3 = MX3(s0[9], s0[10], s0[11]), t4 = MX3(s0[12], s0[13], s0[14]),
                              t5 = MX3(s1[0], s1[1], s1[2]), t6 = MX3(s1[3], s1[4], s1[5]), t7 = MX3(s1[6], s1[7], s1[8]), t8 = MX3(s1[9], s1[10], s1[11]), t9 = MX3(s1[12], s1[13], s1[14]);
                  const float u0 = MX3(t0, t1, t2), u1 = MX3(t3, t4, t5), u2 = MX3(t6, t7, t8), u3 = MX3(t9, s0[15], s1[15]); rm = __builtin_fmaxf(MX3(u0, u1, u2), u3); }
#undef MX3
                rm = half_swap_max(rm);
                const bool first = ASC ? (it == 0) : (j == wjmax);
                if (first || __any(rm > 8.0f)) {
                    const float dl = first ? rm : fmaxf(rm, 0.f);
                    mrun += dl;
#pragma unroll
                    for (int i = 0; i < 16; ++i) { s0[i] -= dl; s1[i] -= dl; }
                    cin = (TYPE == 1 ? fq : 0.f) - mrun;
                    if (!first) { const float f = __builtin_amdgcn_exp2f(-dl); lrun *= f;
#pragma unroll
                        for (int d = 0; d < NDB; ++d)
#pragma unroll
                            for (int i = 0; i < 16; ++i) o[d][i] *= f; }
                }
                f32x2_t ls2 = {0.f, 0.f};
#pragma unroll
                for (int i = 0; i < 16; ++i) { s0[i] = __builtin_amdgcn_exp2f(s0[i]); s1[i] = __builtin_amdgcn_exp2f(s1[i]); }
#pragma unroll
                for (int i = 0; i < 16; i += 2) { ls2 += (f32x2_t){s0[i], s0[i + 1]}; ls2 += (f32x2_t){s1[i], s1[i + 1]}; }
                lrun += ls2[0] + ls2[1];
                if (TYPE == 1 && j > 0) { const float fnext = ((const LAS float*)(lds + OFF_F))[c1 * 64 + 63]; wdone = __all(bound + (fq - fnext) - mrun < EXIT_LOG2); }
            } else {
                f32x16 lk0, lk1;
#pragma unroll
                for (int i = 0; i < 16; ++i) {
                    const float z0 = s0[i], z1 = s1[i];
                    const float sp0 = fmaxf(z0, 0.f) + __builtin_amdgcn_logf(1.0f + __builtin_amdgcn_exp2f(-fabsf(z0))), sp1 = fmaxf(z1, 0.f) + __builtin_amdgcn_logf(1.0f + __builtin_amdgcn_exp2f(-fabsf(z1)));
                    lk0[i] = -sp0; lk1[i] = -sp1; s0[i] = z0 - sp0; s1[i] = z1 - sp1; }
                if (need_mask) {
#pragma unroll
                    for (int i = 0; i < 16; ++i) { const int k0 = kb0 + 16 * (i >> 3) + (i & 7), k1 = k0 + 32; const bool ok0 = k0 < qpos, ok1 = k1 < qpos;
                        lk0[i] = ok0 ? lk0[i] : 0.f; lk1[i] = ok1 ? lk1[i] : 0.f; s0[i] = ok0 ? s0[i] : -INFINITY; s1[i] = ok1 ? s1[i] : -INFINITY; } }
                f32x16 sf0, sf1; float gt[4];
#pragma unroll
                for (int a = 0; a < 2; ++a) { float r0 = 0.f, r1 = 0.f;
#pragma unroll
                    for (int e = 7; e >= 0; --e) { sf0[8 * a + e] = r0; r0 += lk0[8 * a + e]; sf1[8 * a + e] = r1; r1 += lk1[8 * a + e]; }
                    gt[a] = r0; gt[2 + a] = r1; }
                float pt[4], gs[4];
#pragma unroll
                for (int cc = 0; cc < 4; ++cc) pt[cc] = __shfl_xor(gt[cc], 32);
                float later = 0.f;
#pragma unroll
                for (int cc = 3; cc >= 0; --cc) { gs[cc] = later + (hh == 0 ? pt[cc] : 0.f); later += gt[cc] + pt[cc]; }
#pragma unroll
                for (int i = 0; i < 16; ++i) { s0[i] = __builtin_amdgcn_exp2f(s0[i] + sf0[i] + gs[i >> 3] + carry); s1[i] = __builtin_amdgcn_exp2f(s1[i] + sf1[i] + gs[2 + (i >> 3)] + carry); }
                carry += later;
                wdone = __all(carry < EXIT_LOG2);
            }
            pk[0] = pack8(s0, 0); pk[1] = pack8(s0, 8); pk[2] = pack8(s1, 0); pk[3] = pack8(s1, 8); pend = true;
#pragma unroll
            for (int i = 0; i < 16; ++i) { s0[i] = cin; s1[i] = cin; }
        }
        if (TYPE != 0 && lane == 0) flags[8 * (j & 1) + wid] = wdone ? 1u : 0u;
        __syncthreads();
        bool allq = false;
        if (TYPE != 0 && lag) { const u32x4 f0 = *(const LAS u32x4*)(flags + 8 * (j & 1)), f1 = *(const LAS u32x4*)(flags + 8 * (j & 1) + 4);
            const unsigned all = f0.x & f0.y & f0.z & f0.w & f1.x & f1.y & f1.z & f1.w; allq = __builtin_amdgcn_readfirstlane(all) != 0u; }
        if (pend) PP_VRD(c, 0);
        if (doq && !wdone && !allq) PP_QKM();
        if (pend) {
            PP_VRD(c, 1); if (NDB > 2) { PP_VRD(c, 2); PP_VRD(c, 3); }
            __builtin_amdgcn_sched_barrier(0);
            PP_PVM(0); PP_PVM(1);
            if (NDB > 2) { PP_PVM(2); PP_PVM(3); }
            __builtin_amdgcn_sched_barrier(0);
            pend = false; }
        if (allq) { brk = true; break; }
        c = c1;
    }
    if (!lag && !brk) __syncthreads();
    __syncthreads();
#undef PP_T
#undef PP_KLOAD
#undef PP_VLOAD
#undef PP_KSTORE
#undef PP_VSTORE
#undef PP_KRD
#undef PP_QKM
#undef PP_VRD
#undef PP_PVM
    {
        float inv = 1.0f;
        if (TYPE != 2) { const float lt = half_swap_sum(lrun); inv = 1.0f / lt; }
        float ssq = 0.f;
#pragma unroll
        for (int d = 0; d < NDB; ++d)
#pragma unroll
            for (int i = 0; i < 16; ++i) { o[d][i] *= inv; ssq += o[d][i] * o[d][i]; }
        ssq = half_swap_sum(ssq);
        if (hh == 0) WSP(float, WS_SS)[(size_t)qrow * 12 + TYPE * 4 + h] = ssq;
        const int col0 = (TYPE == 0 ? 0 : TYPE == 1 ? 512 : 768) + h * DV + 4 * hh;
#pragma unroll
        for (int d = 0; d < NDB; ++d) { u32x2 gw[4];
#pragma unroll
            for (int g = 0; g < 4; ++g) gw[g] = *(const u32x2*)(WSP(const bf16_t, WS_GATE) + (size_t)qrow * D + col0 + 32 * d + 8 * g);
#pragma unroll
            for (int g = 0; g < 4; ++g) { u32x2 w; w.x = cvtpk(o[d][4 * g] * bf_lo(gw[g].x), o[d][4 * g + 1] * bf_hi(gw[g].x)); w.y = cvtpk(o[d][4 * g + 2] * bf_lo(gw[g].y), o[d][4 * g + 3] * bf_hi(gw[g].y));
                *(u32x2*)(WSP(bf16_t, WS_OP) + (size_t)qrow * D + col0 + 32 * d + 8 * g) = w; } }
    }
}

template <int TYPE>
__device__ __forceinline__ void sample_octet(unsigned char* ws, float* out, LAS unsigned char* lds, int l, int oct) {
    constexpr int DQK = TYPE == 0 ? 96 : 64, DV = TYPE == 0 ? 128 : 64, NS = DQK / 16, NDB = DV / 32, VP = TYPE == 0 ? 320 : 192;
    constexpr int NT = 65;
    const int tid = fresh_tid(), lane = tid & 63, wid = __builtin_amdgcn_readfirstlane(tid >> 6), r32 = lane & 31, hh = lane >> 5;
    const int unit = oct * 8 + wid, sb = unit >> 2, h = unit & 3;
    LAS unsigned char* Vl = lds + wid * 10240;
    const int krow0 = MP + sb * SPITCH, qrow = MP + sb * STN + min(r32, STN - 1), qpos = PAST + r32;
    bf16x8 qf[NS];
    { const bf16_t* qp = TYPE == 0 ? WSP(const bf16_t, WS_QA) + (size_t)qrow * 384 + h * 96 : (TYPE == 1 ? WSP(const bf16_t, WS_QB) : WSP(const bf16_t, WS_QC)) + (size_t)qrow * 256 + h * 64;
#pragma unroll
      for (int s = 0; s < NS; ++s) qf[s] = *(const bf16x8*)(qp + 16 * s + 8 * hh); }
    float fq = 0.f; if (TYPE == 1) fq = WSP(const float, WS_FB)[(size_t)(krow0 + min(qpos, SKEYS - 1)) * 4 + h];
    const int pir = (r32 & ~12) | ((r32 & 4) << 1) | ((r32 & 8) >> 1);
    const float* kc = nullptr; const float* vc = nullptr; const float* kn = nullptr; const float* vn = nullptr;
    if (TYPE != 0) { const size_t cb = ((size_t)l * SBN + sb) * PAST * 256 + h * 64, nb = ((size_t)l * MS + sb * STN) * 256 + h * 64;
        kc = inp(lds, TYPE == 1 ? 4 : 7) + cb; vc = inp(lds, TYPE == 1 ? 5 : 8) + cb; kn = out + (TYPE == 1 ? O_SFK : O_SSK) + nb; vn = out + (TYPE == 1 ? O_SFV : O_SSV) + nb; }
    const bf16_t* KAp = WSP(const bf16_t, WS_KA) + (size_t)krow0 * 256 + h * 64; const bf16_t* KRp = (const bf16_t*)(ws + kr_off(l)) + (size_t)krow0 * 32; const bf16_t* VAp = WSP(const bf16_t, WS_VA) + (size_t)krow0 * 512 + h * 128;
    constexpr int NKR = TYPE == 0 ? NS : 2 * NS, NVR = 8;
    constexpr int PD = 1;
    u32x4 kraw[PD][NKR], vraw[PD][NVR]; float fkr[2][2] = {{0.f, 0.f}, {0.f, 0.f}};
#define SO_LOAD(t, S) do { \
        if (TYPE == 0) { const size_t kr_ = (size_t)(32 * (t) + pir); \
            _Pragma("unroll") for (int s_ = 0; s_ < NS; ++s_) kraw[S][s_] = s_ < 4 ? *(const u32x4*)(KAp + kr_ * 256 + 16 * s_ + 8 * hh) : *(const u32x4*)(KRp + kr_ * 32 + 16 * (s_ - 4) + 8 * hh); \
            _Pragma("unroll") for (int i_ = 0; i_ < 8; ++i_) { const int m_ = lane + 64 * i_; vraw[S][i_] = *(const u32x4*)(VAp + (size_t)(32 * (t) + (m_ >> 4)) * 512 + (m_ & 15) * 8); } \
        } else { const float* kb_ = (t) < 64 ? kc + (size_t)(t) * 32 * 256 : kn; const float* vb_ = (t) < 64 ? vc + (size_t)(t) * 32 * 256 : vn; \
            const int rcap_ = (t) < 64 ? 31 : STN - 1;         \
            _Pragma("unroll") for (int s_ = 0; s_ < NS; ++s_) { const float* p_ = kb_ + (size_t)min(pir, rcap_) * 256 + 16 * s_ + 8 * hh; kraw[S][2 * s_] = *(const u32x4*)p_; kraw[S][2 * s_ + 1] = *(const u32x4*)(p_ + 4); } \
            _Pragma("unroll") for (int i_ = 0; i_ < 4; ++i_) { const int m_ = lane + 64 * i_; const float* p_ = vb_ + (size_t)min(m_ >> 3, rcap_) * 256 + (m_ & 7) * 8; vraw[S][2 * i_] = *(const u32x4*)p_; vraw[S][2 * i_ + 1] = *(const u32x4*)(p_ + 4); } \
            if (TYPE == 1) { fkr[S][0] = WSP(const float, WS_FB)[(size_t)(krow0 + 32 * (t) + 8 * hh + (lane & 7)) * 4 + h]; fkr[S][1] = WSP(const float, WS_FB)[(size_t)(krow0 + 32 * (t) + 16 + 8 * hh + (lane & 7)) * 4 + h]; } } } while (0)
#define F2B(a, b) (u32x4){cvtpk(__uint_as_float((a).x), __uint_as_float((a).y)), cvtpk(__uint_as_float((a).z), __uint_as_float((a).w)), cvtpk(__uint_as_float((b).x), __uint_as_float((b).y)), cvtpk(__uint_as_float((b).z), __uint_as_float((b).w))}
    f32x16 o[NDB];
#pragma unroll
    for (int d = 0; d < NDB; ++d)
#pragma unroll
        for (int i = 0; i < 16; ++i) o[d][i] = 0.f;
    float mrun = 0.f, lrun = 0.f, carry = 0.f; bool done = false;
    f32x16 negc;
#pragma unroll
    for (int i = 0; i < 16; ++i) negc[i] = (TYPE == 1) ? fq : 0.f;
    const int vrd = (8 * hh + ((lane & 15) >> 2)) * VP + 32 * ((lane >> 4) & 1) + 8 * (lane & 3);
#define SO_BODY(t, S) do { \
        bf16x8 kf[NS]; const float fk0 = fkr[S][0], fk1 = fkr[S][1]; \
        _Pragma("unroll") for (int s = 0; s < NS; ++s) kf[s] = TYPE == 0 ? __builtin_bit_cast(bf16x8, kraw[S][s]) : __builtin_bit_cast(bf16x8, F2B(kraw[S][2 * s], kraw[S][2 * s + 1])); \
        if (TYPE == 0) { _Pragma("unroll") for (int i = 0; i < 8; ++i) { const int m = lane + 64 * i; *(LAS u32x4*)(Vl + (m >> 4) * VP + (m & 15) * 16) = vraw[S][i]; } } \
        else { _Pragma("unroll") for (int i = 0; i < 4; ++i) { const int m = lane + 64 * i; *(LAS u32x4*)(Vl + (m >> 3) * VP + (m & 7) * 16) = F2B(vraw[S][2 * i], vraw[S][2 * i + 1]); } } \
        if ((t) >= PD) SO_LOAD((t) - PD, S); \
        f32x16 s0; \
         \
        _Pragma("unroll") for (int s = 0; s < NS; ++s) s0 = MFMA32(kf[s], qf[s], s == 0 ? negc : s0); \
         \
        const int kb0 = 32 * (t) + 8 * hh;                                          \
        const bool need_mask = ((t) == NT - 1); \
        if (TYPE != 2) { \
            if (TYPE == 1) {     \
                _Pragma("unroll") for (int i = 0; i < 16; ++i) { const float f = __shfl(i < 8 ? fk0 : fk1, (lane & 32) | (i & 7)); s0[i] -= f; } } \
            if (need_mask) { \
                _Pragma("unroll") for (int i = 0; i < 16; ++i) { const int k0 = kb0 + 16 * (i >> 3) + (i & 7); const bool ok = TYPE == 0 ? (k0 < SKEYS) : (k0 <= qpos); s0[i] = ok ? s0[i] : -INFINITY; } } \
            float rm = s0[0]; \
            _Pragma("unroll") for (int i = 1; i < 16; ++i) rm = fmaxf(rm, s0[i]); \
            rm = half_swap_max(rm); \
            const bool first = ((t) == NT - 1); \
            if (first || __any(rm > 8.0f)) { \
                const float dl = first ? rm : fmaxf(rm, 0.f); \
                mrun += dl; \
                _Pragma("unroll") for (int i = 0; i < 16; ++i) s0[i] -= dl; \
                const float cin = (TYPE == 1 ? fq : 0.f) - mrun; \
                _Pragma("unroll") for (int i = 0; i < 16; ++i) negc[i] = cin; \
                if (!first) { const float f = __builtin_amdgcn_exp2f(-dl); lrun *= f; \
                    _Pragma("unroll") for (int d = 0; d < NDB; ++d) _Pragma("unroll") for (int i = 0; i < 16; ++i) o[d][i] *= f; } \
            } \
            float ls = 0.f; \
            _Pragma("unroll") for (int i = 0; i < 16; ++i) { s0[i] = __builtin_amdgcn_exp2f(s0[i]); ls += s0[i]; } \
            lrun += ls; \
        } else { \
            f32x16 lk0; \
            _Pragma("unroll") for (int i = 0; i < 16; ++i) { const float z0 = s0[i]; const float sp0 = fmaxf(z0, 0.f) + __builtin_amdgcn_logf(1.0f + __builtin_amdgcn_exp2f(-fabsf(z0))); lk0[i] = -sp0; s0[i] = z0 - sp0; } \
            if (need_mask) { \
                _Pragma("unroll") for (int i = 0; i < 16; ++i) { const int k0 = kb0 + 16 * (i >> 3) + (i & 7); const bool ok = k0 < qpos; lk0[i] = ok ? lk0[i] : 0.f; s0[i] = ok ? s0[i] : -INFINITY; } } \
            f32x16 sf0; float gt[2]; \
            _Pragma("unroll") for (int a = 0; a < 2; ++a) { float r0 = 0.f; \
                _Pragma("unroll") for (int e = 7; e >= 0; --e) { sf0[8 * a + e] = r0; r0 += lk0[8 * a + e]; } \
                gt[a] = r0; } \
            float pt[2], gs[2]; \
            _Pragma("unroll") for (int c = 0; c < 2; ++c) pt[c] = __shfl_xor(gt[c], 32); \
            float later = 0.f; \
            _Pragma("unroll") for (int c = 1; c >= 0; --c) { gs[c] = later + (hh == 0 ? pt[c] : 0.f); later += gt[c] + pt[c]; } \
            _Pragma("unroll") for (int i = 0; i < 16; ++i) s0[i] = __builtin_amdgcn_exp2f(s0[i] + sf0[i] + gs[i >> 3] + carry); \
            carry += later; \
        } \
        bf16x8 pk[2]; pk[0] = pack8(s0, 0); pk[1] = pack8(s0, 8); \
        {     \
            s16x4 vl[NDB][2], vh[NDB][2]; \
            _Pragma("unroll") for (int d = 0; d < NDB; ++d) _Pragma("unroll") for (int ks = 0; ks < 2; ++ks) { vl[d][ks] = tr_rd(Vl + vrd + (16 * ks) * VP + 64 * d); vh[d][ks] = tr_rd(Vl + vrd + (16 * ks + 4) * VP + 64 * d); } \
             \
            _Pragma("unroll") for (int d = 0; d < NDB; ++d) _Pragma("unroll") for (int ks = 0; ks < 2; ++ks) { const bf16x8 vf = __builtin_shufflevector(vl[d][ks], vh[d][ks], 0, 1, 2, 3, 4, 5, 6, 7); o[d] = MFMA32(vf, pk[ks], o[d]); } \
             \
        } \
        if (TYPE == 2) done = __all(carry < EXIT_LOG2);        \
    } while (0)
    if (PD == 1) {
        SO_LOAD(NT - 1, 0);
        for (int t = NT - 1; t >= 0; --t) { SO_BODY(t, 0); if (TYPE == 2 && done) break; }
    } else {
        SO_LOAD(NT - 1, 0); SO_LOAD(NT - 2, PD - 1);
        for (int t = NT - 1; t >= 0; t -= 2) {
            SO_BODY(t, 0); if (done) break;
            if (t >= 1) { SO_BODY(t - 1, PD - 1); if (done) break; }
        }
    }
#undef SO_BODY
#undef SO_LOAD
#undef F2B
    {
        float inv = 1.0f;
        if (TYPE != 2) { const float lt = half_swap_sum(lrun); inv = 1.0f / lt; }
        float ssq = 0.f;
#pragma unroll
        for (int d = 0; d < NDB; ++d)
#pragma unroll
            for (int i = 0; i < 16; ++i) { o[d][i] *= inv; ssq += o[d][i] * o[d][i]; }
        ssq = half_swap_sum(ssq);
        if (r32 < STN) {
            if (hh == 0) WSP(float, WS_SS)[(size_t)qrow * 12 + TYPE * 4 + h] = ssq;
            const int col0 = (TYPE == 0 ? 0 : TYPE == 1 ? 512 : 768) + h * DV + 4 * hh;
#pragma unroll
            for (int d = 0; d < NDB; ++d) { u32x2 gw[4];
#pragma unroll
                for (int g = 0; g < 4; ++g) gw[g] = *(const u32x2*)(WSP(const bf16_t, WS_GATE) + (size_t)qrow * D + col0 + 32 * d + 8 * g);
#pragma unroll
                for (int g = 0; g < 4; ++g) { u32x2 w; w.x = cvtpk(o[d][4 * g] * bf_lo(gw[g].x), o[d][4 * g + 1] * bf_hi(gw[g].x)); w.y = cvtpk(o[d][4 * g + 2] * bf_lo(gw[g].y), o[d][4 * g + 3] * bf_hi(gw[g].y));
                    *(u32x2*)(WSP(bf16_t, WS_OP) + (size_t)qrow * D + col0 + 32 * d + 8 * g) = w; } }
        }
    }
    __syncthreads();
}
constexpr int CV_CHUNKS = 4096, N_CV_CKV = SBN * PAST * 256 / 8 / CV_CHUNKS, N_CV_KPE = SBN * PAST * 32 / 8 / CV_CHUNKS, N_CV = N_CV_CKV + N_CV_KPE;
constexpr int P0_I0 = 16 * (NINP / 32), P0_I1 = 4 * 24, P0_I2 = 16 * 32, P0_IL = P0_I0 + P0_I1 + P0_I2, N_WT = P0_IL / 8;
static_assert(P0_IL % 8 == 0, "weight items per layer in units of 8");
__device__ __forceinline__ void conv_unit(unsigned char* ws, LAS unsigned char* lds, int ln, int u) {
    const int tid = fresh_tid();
    const bool ckv = u < N_CV_CKV; const int v = ckv ? u : u - N_CV_CKV;
    const float* src = ckv ? inp(lds, 2) + (size_t)ln * SBN * PAST * 256 : inp(lds, 3) + (size_t)ln * SBN * PAST * 32;
    f32x4 a[8], b[8];
#pragma unroll
    for (int k = 0; k < 8; ++k) { const size_t q = (size_t)v * CV_CHUNKS + tid + 512 * k; a[k] = *(const f32x4*)(src + q * 8); b[k] = *(const f32x4*)(src + q * 8 + 4); }
#pragma unroll
    for (int k = 0; k < 8; ++k) { const int q = v * CV_CHUNKS + tid + 512 * k;
        bf16_t* dst; if (ckv) dst = WSP(bf16_t, WS_CKVB) + (size_t)M * 256 + (size_t)q * 8; else { const int per_b = PAST * 32 / 8, sb = q / per_b, rem = q % per_b; dst = (bf16_t*)(ws + kr_off(ln)) + (size_t)MP * 32 + (size_t)sb * SPITCH * 32 + (size_t)rem * 8; }
        u32x4 o; o.x = cvtpk(a[k][0], a[k][1]); o.y = cvtpk(a[k][2], a[k][3]); o.z = cvtpk(b[k][0], b[k][1]); o.w = cvtpk(b[k][2], b[k][3]); *(u32x4*)dst = o; }
}
__device__ __forceinline__ void weight_unit(unsigned char* ws, LAS unsigned char* lds, int ln, int u) {
    const int tid = fresh_tid(), lane = tid & 63, wid = __builtin_amdgcn_readfirstlane(tid >> 6);
    LAS float* scr = (LAS float*)(lds + wid * 16384);
    int r = u * 8 + wid;
    if (r < P0_I0) p0_item(ws, lds, 0, ln, r, scr, lane);
    else if (r < P0_I0 + P0_I1) p0_item(ws, lds, 1, ln, r - P0_I0, scr, lane);
    else p0_item(ws, lds, 2, ln, r - P0_I0 - P0_I1, scr, lane);
}
constexpr int NU_P = 32 * 16, NU_S = SBN * 4 / 8, NU_T = NU_P + NU_S, NU_ALL = 3 * NU_T;
__device__ __forceinline__ int q_fetch(unsigned* head, LAS int* slot) {
    __syncthreads();
    if (threadIdx.x == 0) *slot = (int)__hip_atomic_fetch_add(head, 1u, __ATOMIC_RELAXED, __HIP_MEMORY_SCOPE_AGENT);
    __syncthreads();
    return __builtin_amdgcn_readfirstlane(*slot);
}
template <int TYPE>
__device__ __forceinline__ void attn_prompt(unsigned char* ws, LAS unsigned char* lds, int l, int xq, int v) {
    const int qb = 31 - (v >> 1), bh = 2 * xq + (v & 1), b = bh >> 2, h = bh & 3;
#ifndef PP_MASK
#define PP_MASK 7
#endif
    if ((PP_MASK >> TYPE) & 1) attn_pp<TYPE>(ws, lds, l, b * PT + qb * 256, b * PT, qb * 256, h);
    else attn_unit<TYPE, false>(ws, lds, l, b * PT + qb * 256, 256, b * PT, qb * 256, PT, h);
}
template <int TYPE>
__device__ __forceinline__ void prompt_queues(unsigned char* ws, LAS unsigned char* lds, int l, LAS int* slot) {
    const int x = (int)(xb_xcc_id() & 7u);
#pragma nounroll
    for (int i = 0; i < 8; ++i) { const int xq = (x + i) & 7;
        unsigned* hq = (unsigned*)(ws + WS_CTL) + CW_XQ + ((l * 3 + TYPE) * 8 + xq) * 16;
        int v = q_fetch(hq, slot);
        while (v < 64) { attn_prompt<TYPE>(ws, lds, l, xq, v); v = q_fetch(hq, slot); }
    }
}
__device__ __forceinline__ void p4_attention(unsigned char* ws, float* out, int l, LAS unsigned char* lds, int rep) {
    unsigned* head = (unsigned*)(ws + WS_CTL) + CW_QUEUE + 64 * l + 16 * rep; LAS int* slot = (LAS int*)(lds + MISC_OFF + 64);
#define NEXT_BEGIN() int nx_ = 0; if (threadIdx.x == 0) nx_ = (int)__hip_atomic_fetch_add(head, 1u, __ATOMIC_RELAXED, __HIP_MEMORY_SCOPE_AGENT)
#define NEXT_END() do { if (threadIdx.x == 0) *slot = nx_; __syncthreads(); u = __builtin_amdgcn_readfirstlane(*slot); } while (0)
    const int ncv = (l + 1 < NL) ? N_CV : 0, nwt = (l + 1 < NL) ? N_WT : 0;
    const int b0 = ncv, b1 = b0 + nwt, b2 = b1 + NU_S, b3 = b2 + NU_S, b4 = b3 + NU_S;
    int u = q_fetch(head, slot);
    while (u < b0) { NEXT_BEGIN(); conv_unit(ws, lds, l + 1, u); NEXT_END(); }
    while (u < b1) { NEXT_BEGIN(); weight_unit(ws, lds, l + 1, u - b0); NEXT_END(); }
    while (u < b2) { NEXT_BEGIN(); sample_octet<0>(ws, out, lds, l, u - b1); NEXT_END(); }
    while (u < b3) { NEXT_BEGIN(); sample_octet<1>(ws, out, lds, l, u - b2); NEXT_END(); }
    while (u < b4) { NEXT_BEGIN(); sample_octet<2>(ws, out, lds, l, u - b3); NEXT_END(); }
    prompt_queues<0>(ws, lds, l, slot);
    prompt_queues<1>(ws, lds, l, slot);
    prompt_queues<2>(ws, lds, l, slot);
#undef NEXT_BEGIN
#undef NEXT_END
}
constexpr int N_PHASES = 2 + 5 * NL;
__global__ void __launch_bounds__(512, 2) fwd(Params P) {
    extern __shared__ __attribute__((aligned(16))) unsigned char lds_raw[];
    LAS unsigned char* lds = (LAS unsigned char*)lds_raw;
    const int tid = threadIdx.x;
    if (tid < 64) ((LAS unsigned*)(lds + MISC_OFF))[tid] = 0u;
    if (tid < 18) ((LAS unsigned long long*)(lds + PTR_OFF))[tid] = (unsigned long long)P.in[tid];
    __syncthreads();
    unsigned char* const ws0 = P.ws; float* const out0 = P.out;
    unsigned* ctl = (unsigned*)(ws0 + WS_CTL);
    XcdBarrier bar = xcd_barrier_post(ctl + CW_BAR, (volatile LAS unsigned*)(lds + MISC_OFF + 32));
    const int lo = P.ph_lo, hi = P.ph_hi;
#ifndef PHM
#define PHM 0x7f
#endif
#ifndef REP_P1
#define REP_P1 1
#endif
#ifndef REP_P2
#define REP_P2 1
#endif
#ifndef REP_P3
#define REP_P3 1
#endif
#ifndef REP_P4
#define REP_P4 1
#endif
#ifndef REP_P5
#define REP_P5 1
#endif
#define IN(k) (lo <= (k) && (k) < hi)
#define SEAM(k) do { if (IN(k) && IN((k) + 1)) { XcdBarrier b2_ = bar; unsigned* bb_ = b2_.bar; asm volatile("" : "+s"(bb_)); b2_.bar = bb_; xcd_barrier(b2_); } } while (0)
#define FRESH() unsigned long long ws_i_ = (unsigned long long)ws0, out_i_ = (unsigned long long)out0; asm volatile("" : "+s"(ws_i_), "+s"(out_i_)); unsigned char* ws = (unsigned char*)(GAS unsigned char*)ws_i_; float* out = (float*)(GAS float*)out_i_; (void)out
    if ((PHM & 1) && IN(0)) { FRESH(); p0_prologue(ws, lds); }
    SEAM(0);
    for (int l = 0; l <= NL; ++l) {
        const int pb = 1 + 5 * l;
        if ((PHM & 2) && IN(pb)) { FRESH(); p1_norm(ws, out, lds, l); }
        if (l == NL) break;
        SEAM(pb);
        if ((PHM & 4) && IN(pb + 1)) { FRESH();
            pg8::Gemm g{(const pg8::bf16_t*)(ws + WS_XN), (const pg8::bf16_t*)(ws + WS_WIN + (size_t)l * NINP * D * 2), M, NINP, D};
            pg8::StaticOrder S; S.init(M, NINP, (int)gridDim.x, (int)blockIdx.x);
            EpiP2 E; E.ws = ws; E.out = out; E.kvnorm = inp(lds, 12) + l * 256; E.fbias = inp(lds, 15) + l * 4; E.l = l; E.scr = (LAS float*)(lds + SCR_OFF);
            _Pragma("nounroll") for (int rep = 0; rep < REP_P2; ++rep) pg8::gemm_phase<EpiP2, pg8::StaticOrder, true, true>(lds, g, S, E);
        }
        SEAM(pb + 1);
        if ((PHM & 8) && IN(pb + 2)) { FRESH();
            if (blockIdx.x < 36) cumsum_task(ws, l, (int)blockIdx.x, lds);
            int k3 = 256; asm volatile("" : "+s"(k3));
            pg8::Gemm g{(const pg8::bf16_t*)(ws + WS_CKVB), (const pg8::bf16_t*)(ws + WS_WUKV + (size_t)l * 768 * 256 * 2), M3, 768, k3};
            pg8::StaticOrder S; S.init(M3, 768, (int)gridDim.x, (int)blockIdx.x);
            EpiP3 E; E.ws = ws;
            _Pragma("nounroll") for (int rep = 0; rep < REP_P3; ++rep) pg8::gemm_phase<EpiP3, pg8::StaticOrder, true, true>(lds, g, S, E);
        }
        SEAM(pb + 2);
        if ((PHM & 16) && IN(pb + 3)) { FRESH(); _Pragma("nounroll") for (int rep = 0; rep < REP_P4; ++rep) p4_attention(ws, out, l, lds, rep); }
        SEAM(pb + 3);
        if ((PHM & 64) && IN(pb + 4)) { FRESH();
            pg8::Gemm g{(const pg8::bf16_t*)(ws + WS_OP), (const pg8::bf16_t*)(ws + WS_WOUT + (size_t)l * D * D * 2), M, D, D};
            pg8::StaticOrder S; S.init(M, D, (int)gridDim.x, (int)blockIdx.x);
            EpiP5 E; E.ws = ws; E.tab = (LAS float*)(lds + SCR_OFF);
            _Pragma("nounroll") for (int rep = 0; rep < REP_P5; ++rep) pg8::gemm_phase<EpiP5, pg8::StaticOrder, true, true>(lds, g, S, E);
        }
        SEAM(pb + 4);
    }
#undef IN
#undef SEAM
}

#ifndef MK_SPLIT
#define MK_SPLIT 0
#endif
extern "C" void kernel_launch(void* const* d_in, const int* in_sizes, int n_in, void* d_out, int out_size, void* d_ws, size_t ws_size, hipStream_t stream) {
    static int grid = 0;
    if (grid == 0) {
        if (n_in != 18 || (size_t)out_size != O_END || ws_size < WS_END) { fprintf(stderr, "kernel_launch: unexpected shapes: n_in %d out %d ws %zu\n", n_in, out_size, ws_size); grid = -1; return; }
        int dev = 0, cus = 0, per_cu = 0;
        if (hipGetDevice(&dev) != hipSuccess || hipDeviceGetAttribute(&cus, hipDeviceAttributeMultiprocessorCount, dev) != hipSuccess) { grid = -1; return; }
        if (hipFuncSetAttribute((const void*)fwd, hipFuncAttributeMaxDynamicSharedMemorySize, LDS_BYTES) != hipSuccess) { fprintf(stderr, "kernel_launch: hipFuncSetAttribute failed\n"); grid = -1; return; }
        if (hipOccupancyMaxActiveBlocksPerMultiprocessor(&per_cu, (const void*)fwd, 512, LDS_BYTES) != hipSuccess || per_cu < 1) { fprintf(stderr, "kernel_launch: occupancy query reports %d blocks per CU\n", per_cu); (void)hipGetLastError(); grid = -1; return; }
        grid = cus;
    }
    if (grid < 0) return;
    (void)hipMemsetAsync((char*)d_ws + WS_CTL, 0, CTL_ZERO_BYTES, stream);
    Params p{};
    for (int i = 0; i < 18; ++i) p.in[i] = (const float*)d_in[i];
    p.out = (float*)d_out; p.ws = (unsigned char*)d_ws;
#if MK_SPLIT
    for (int ph = 0; ph < N_PHASES; ++ph) { p.ph_lo = ph; p.ph_hi = ph + 1; hipLaunchKernelGGL(fwd, dim3(grid), dim3(512), LDS_BYTES, stream, p); }
#else
    p.ph_lo = 0; p.ph_hi = N_PHASES;
    hipLaunchKernelGGL(fwd, dim3(grid), dim3(512), LDS_BYTES, stream, p);
#endif
    const hipError_t le = hipPeekAtLastError();
    if (le != hipSuccess) fprintf(stderr, "kernel_launch: launch failed: %s\n", hipGetErrorName(le));
}
```

```cpp
#include <hip/hip_runtime.h>
#include <cstdio>
#include <cstdint>
namespace pg8 {
#define PG8_LAS __attribute__((address_space(3)))
typedef unsigned short bf16_t;
typedef short bf16x8 __attribute__((ext_vector_type(8)));
typedef float f32x4 __attribute__((ext_vector_type(4)));
typedef unsigned u32x4 __attribute__((ext_vector_type(4)));
constexpr int BM = 256, BK = 64, HALF = 128, HTB = HALF * BK * 2  , STAGE_BYTES = 8 * HTB, NXCD = 8, WGM = 8;

__host__ __device__ __forceinline__ int lds_byte(int r, int c) { const int st = (r >> 4) * 2 + (c >> 5), rr = r & 15, cc = c & 31, ob = rr * 64 + cc * 2; return st * 1024 + (ob ^ (((ob >> 9) & 1) << 5)); }
__host__ __device__ __forceinline__ void stage_rc(int b, int& R, int& C) { const int st = b / 1024, sb = b % 1024, swz = sb ^ (((sb >> 9) & 1) << 5); R = (st >> 1) * 16 + swz / 64; C = (st & 1) * 32 + (swz % 64) / 2; }
__host__ __device__ __forceinline__ int perm32(int rho) { const int n = rho >> 4, i = rho & 15; return 8 * (i >> 2) + 4 * n + (i & 3); }

struct Unit { int pm, pn; };
struct Gemm { const bf16_t* A; const bf16_t* Bt; int M, N, K; };

struct StaticOrder {
    int nM, nN, nwg, G, c;
    __host__ __device__ void init(int M, int N, int G_, int c_) { nM = M / BM; nN = N / BM; nwg = nM * nN; G = G_; c = c_; }
    __host__ __device__ bool next(int i, Unit& u) const {
        const long L = (long)i * G + c; if (L >= nwg) return false;
        int wgid = (int)L; { const int q = nwg / NXCD, r = nwg % NXCD, xcd = wgid % NXCD, off = wgid / NXCD; wgid = (xcd < r ? xcd * (q + 1) : r * (q + 1) + (xcd - r) * q) + off; }
        const int nig = WGM * nN, gid = wgid / nig, fm = gid * WGM, gsz = (nM - fm) < WGM ? (nM - fm) : WGM;
        u.pm = fm + ((wgid % nig) % gsz); u.pn = (wgid % nig) / gsz; return true;
    }
    __device__ __forceinline__ void a_ready(const Unit&) const {}
    __device__ __forceinline__ void done(const Unit&) const {}
};

__device__ __forceinline__ unsigned cvt_pk_bf16(float lo, float hi) { unsigned r; asm volatile("v_cvt_pk_bf16_f32 %0, %1, %2" : "=v"(r) : "v"(lo), "v"(hi)); return r; }
typedef float f32x2 __attribute__((ext_vector_type(2)));
template <class Epi, class Sched, bool ALIGN_EPI = false, bool SP2 = false>
__device__ __forceinline__ void gemm_phase(PG8_LAS unsigned char* lds, const Gemm g, const Sched& S, const Epi& E) {
    int tid_ = threadIdx.x; asm volatile("" : "+v"(tid_));
    const int tid = tid_, wid = __builtin_amdgcn_readfirstlane(tid >> 6), lane = tid & 63, wr = wid >> 2, wc = wid & 3, fr = lane & 15, fq = lane >> 4;
    const int K = g.K, nt = K / BK;
    unsigned voffA[2], voffB[2];
#pragma unroll
    for (int i = 0; i < 2; ++i) { int R, C; stage_rc(tid * 16 + i * 8192, R, C); const int Rb = Epi::PERM ? ((R & ~31) + perm32(R & 31)) : R;
        voffA[i] = (unsigned)(R * K + C) * 2u; voffB[i] = (unsigned)(Rb * K + C) * 2u; }
    const size_t kstep = (size_t)(BK * 2);
    const size_t hstep = (size_t)HALF * K * 2;
    const size_t tstep = 2 * hstep;
    const unsigned ldsw = (unsigned)wid * 1024u;
    const int aoff = lds_byte(wr * 64 + fr, fq * 8), boff = lds_byte(wc * 32 + fr, fq * 8);
#define PG8_SA(b, h) (((b) * 2 + (h)) * HTB)
#define PG8_SB(b, h) ((4 + (b) * 2 + (h)) * HTB)
#define PG8_STAGE(bufoff, gbase, voff) do { _Pragma("unroll") for (int _i = 0; _i < 2; ++_i) \
        __builtin_amdgcn_global_load_lds((const unsigned*)((const char*)(gbase) + (voff)[_i]), (PG8_LAS unsigned*)(lds + (bufoff) + ldsw + _i * 8192), 16, 0, 0); } while (0)
#define PG8_LDA(dst, b, h) do { _Pragma("unroll") for (int m = 0; m < 4; ++m) _Pragma("unroll") for (int k = 0; k < 2; ++k) dst[m][k] = *(const PG8_LAS bf16x8*)(lds + PG8_SA(b, h) + aoff + m * 2048 + k * 1024); } while (0)
#define PG8_LDB(dst, b, h) do { _Pragma("unroll") for (int n = 0; n < 2; ++n) _Pragma("unroll") for (int k = 0; k < 2; ++k) dst[n][k] = *(const PG8_LAS bf16x8*)(lds + PG8_SB(b, h) + boff + n * 2048 + k * 1024); } while (0)
#define PG8_MMA(ai, bj, At, Bt) do { __builtin_amdgcn_s_setprio(1); _Pragma("unroll") for (int m = 0; m < 4; ++m) _Pragma("unroll") for (int n = 0; n < 2; ++n) _Pragma("unroll") for (int k = 0; k < 2; ++k) \
        acc[ai][bj][m][n] = __builtin_amdgcn_mfma_f32_16x16x32_bf16(Bt[n][k], At[m][k], acc[ai][bj][m][n], 0, 0, 0); __builtin_amdgcn_s_setprio(0); } while (0)
#define PG8_WAIT_V(n) asm volatile("s_waitcnt vmcnt(" #n ")" ::: "memory")
#define PG8_WAIT_L(n) asm volatile("s_waitcnt lgkmcnt(" #n ")" ::: "memory")
#define PG8_BAR __builtin_amdgcn_s_barrier()
#define PG8_SCHED __builtin_amdgcn_sched_barrier(0)
    Unit cur, nxt; int ui = 0;
    if (!S.next(0, cur)) return;
    f32x4 acc[2][2][4][2];
#pragma unroll
    for (int a = 0; a < 2; ++a)
#pragma unroll
        for (int b = 0; b < 2; ++b)
#pragma unroll
            for (int m = 0; m < 4; ++m)
#pragma unroll
                for (int n = 0; n < 2; ++n) acc[a][b][m][n] = (f32x4){0.f, 0.f, 0.f, 0.f};
    bf16x8 At[4][2], B0[2][2], B1[2][2];
    const char* cA = (const char*)g.A + (size_t)cur.pm * tstep; const char* cB = (const char*)g.Bt + (size_t)cur.pn * tstep;
    S.a_ready(cur);
    if constexpr (Epi::MID) E.prep(cur, 0, tid);
    if constexpr (SP2) {
        PG8_STAGE(PG8_SB(0, 0), cB, voffB); PG8_STAGE(PG8_SB(0, 1), cB + hstep, voffB); PG8_STAGE(PG8_SA(0, 0), cA, voffA); PG8_STAGE(PG8_SA(0, 1), cA + hstep, voffA);
        if (wr == 1) PG8_BAR;
        PG8_WAIT_V(2); PG8_BAR;
        PG8_STAGE(PG8_SB(1, 0), cB + kstep, voffB); PG8_STAGE(PG8_SA(1, 0), cA + kstep, voffA); PG8_STAGE(PG8_SB(1, 1), cB + hstep + kstep, voffB);
        PG8_WAIT_V(6); PG8_BAR;
    } else {
        PG8_STAGE(PG8_SB(0, 0), cB, voffB); PG8_STAGE(PG8_SA(0, 0), cA, voffA); PG8_STAGE(PG8_SB(0, 1), cB + hstep, voffB); PG8_STAGE(PG8_SA(0, 1), cA + hstep, voffA);
        if (wr == 1) PG8_BAR;
        PG8_WAIT_V(4); PG8_BAR;
        PG8_STAGE(PG8_SB(1, 0), cB + kstep, voffB); PG8_STAGE(PG8_SA(1, 0), cA + kstep, voffA); PG8_STAGE(PG8_SB(1, 1), cB + hstep + kstep, voffB);
        PG8_WAIT_V(6); PG8_BAR;
    }
    for (;;) {
        const bool has_next = S.next(ui + 1, nxt);
        const char* nA = has_next ? (const char*)g.A + (size_t)nxt.pm * tstep : cA; const char* nB = has_next ? (const char*)g.Bt + (size_t)nxt.pn * tstep : cB;
        for (int t = 0; t < nt; t += 2) {
            if constexpr (Epi::MID) { if (t == Epi::MID_T0 || t == Epi::MID_T1) E.mid(acc, ui & 1, t == Epi::MID_T0 ? 0 : 1, wr, fr); }
            const bool last = (t == nt - 2);
            const char* a1 = cA + (size_t)(t + 1) * kstep;
            const char* a2 = last ? nA : cA + (size_t)(t + 2) * kstep; const char* b2 = last ? nB : cB + (size_t)(t + 2) * kstep;
            const char* a3 = a2 + kstep; const char* b3 = b2 + kstep;
            if (last && has_next) S.a_ready(nxt);
            if constexpr (SP2) {
            PG8_LDB(B0, 0, 0); PG8_LDB(B1, 0, 1); PG8_SCHED; PG8_LDA(At, 0, 0); PG8_STAGE(PG8_SA(1, 1), a1 + hstep, voffA);
            PG8_WAIT_V(8); PG8_WAIT_L(0); PG8_BAR; PG8_MMA(0, 0, At, B0); PG8_MMA(0, 1, At, B1); PG8_BAR; PG8_SCHED;
            PG8_LDA(At, 0, 1); PG8_STAGE(PG8_SB(0, 0), b2, voffB); PG8_STAGE(PG8_SB(0, 1), b2 + hstep, voffB); PG8_STAGE(PG8_SA(0, 0), a2, voffA);
            PG8_WAIT_V(8); PG8_WAIT_L(0); PG8_BAR; PG8_MMA(1, 0, At, B0); PG8_MMA(1, 1, At, B1); PG8_BAR; PG8_SCHED;
            PG8_LDB(B0, 1, 0); PG8_LDB(B1, 1, 1); PG8_SCHED; PG8_LDA(At, 1, 0); PG8_STAGE(PG8_SA(0, 1), a2 + hstep, voffA);
            PG8_WAIT_V(8); PG8_WAIT_L(0); PG8_BAR; PG8_MMA(0, 0, At, B0); PG8_MMA(0, 1, At, B1); PG8_BAR; PG8_SCHED;
            PG8_LDA(At, 1, 1); PG8_STAGE(PG8_SB(1, 0), b3, voffB); PG8_STAGE(PG8_SB(1, 1), b3 + hstep, voffB); PG8_STAGE(PG8_SA(1, 0), a3, voffA);
            PG8_WAIT_V(8); PG8_WAIT_L(0); PG8_BAR; PG8_MMA(1, 0, At, B0); PG8_MMA(1, 1, At, B1); PG8_BAR; PG8_SCHED;
            } else {
            PG8_LDB(B0, 0, 0); PG8_SCHED; PG8_LDA(At, 0, 0); PG8_STAGE(PG8_SA(1, 1), a1 + hstep, voffA);
            PG8_WAIT_L(8); PG8_BAR; PG8_WAIT_L(0); PG8_MMA(0, 0, At, B0); PG8_BAR; PG8_SCHED;
            PG8_LDB(B1, 0, 1); PG8_STAGE(PG8_SB(0, 0), b2, voffB);
            PG8_BAR; PG8_WAIT_L(0); PG8_MMA(0, 1, At, B1); PG8_BAR;
            PG8_LDA(At, 0, 1); PG8_STAGE(PG8_SA(0, 0), a2, voffA);
            PG8_BAR; PG8_WAIT_L(0); PG8_MMA(1, 0, At, B0); PG8_BAR; PG8_SCHED;
            PG8_STAGE(PG8_SB(0, 1), b2 + hstep, voffB);
            PG8_WAIT_V(6); PG8_BAR; PG8_MMA(1, 1, At, B1); PG8_BAR;
            PG8_LDB(B0, 1, 0); PG8_SCHED; PG8_LDA(At, 1, 0); PG8_STAGE(PG8_SA(0, 1), a2 + hstep, voffA);
            PG8_WAIT_L(8); PG8_BAR; PG8_WAIT_L(0); PG8_MMA(0, 0, At, B0); PG8_BAR; PG8_SCHED;
            PG8_LDB(B1, 1, 1); PG8_STAGE(PG8_SB(1, 0), b3, voffB);
            PG8_BAR; PG8_WAIT_L(0); PG8_MMA(0, 1, At, B1); PG8_BAR;
            PG8_LDA(At, 1, 1); PG8_STAGE(PG8_SA(1, 0), a3, voffA);
            PG8_BAR; PG8_WAIT_L(0); PG8_MMA(1, 0, At, B0); PG8_BAR; PG8_SCHED;
            PG8_STAGE(PG8_SB(1, 1), b3 + hstep, voffB);
            PG8_WAIT_V(6); PG8_BAR; PG8_MMA(1, 1, At, B1); PG8_BAR;
            }
        }
        if constexpr (ALIGN_EPI) { if (wr == 0) PG8_BAR; }
        if constexpr (Epi::MID) E.mid(acc, ui & 1, 2, wr, fr);
        if constexpr (!Epi::AFTER_DRAIN) { E(acc, cur, wr, wc, fr, fq); S.done(cur); }
        if constexpr (Epi::MID) { if (has_next) E.prep(nxt, (ui + 1) & 1, tid); }
        if (!has_next) break;
#pragma unroll
        for (int a = 0; a < 2; ++a)
#pragma unroll
            for (int b = 0; b < 2; ++b)
#pragma unroll
                for (int m = 0; m < 4; ++m)
#pragma unroll
                    for (int n = 0; n < 2; ++n) acc[a][b][m][n] = (f32x4){0.f, 0.f, 0.f, 0.f};
        cur = nxt; cA = nA; cB = nB; ++ui;
        if constexpr (ALIGN_EPI) { if (wr == 1) PG8_BAR; }
    }
    PG8_WAIT_V(0);
    if constexpr (!ALIGN_EPI) { if (wr == 0) PG8_BAR; }
    PG8_BAR;
    if constexpr (Epi::AFTER_DRAIN) { E.fused(acc, cur, wr, wc, fr, fq, lds, wid, lane); S.done(cur); }
#undef PG8_SA
#undef PG8_SB
#undef PG8_STAGE
#undef PG8_LDA
#undef PG8_LDB
#undef PG8_MMA
#undef PG8_WAIT_V
#undef PG8_WAIT_L
#undef PG8_BAR
#undef PG8_SCHED
}
}
#define GAS __attribute__((address_space(1)))
#define LAS __attribute__((address_space(3)))
#define XB_TMO      128
#define XB_XCNT(j)  (256  + 64 * (j))
#define XB_XSUB(j)  (1280 + 64 * (j))
#define XB_XGEN(j)  (2304 + 64 * (j))
#define XB_TOP      3328
#define XB_TOPGEN   3392
#define XCD_BAR_WORDS 3456
#define XB_SPIN_CAP (1u << 21)

__device__ __forceinline__ unsigned xb_ld(unsigned* p)              { return __hip_atomic_load(p, __ATOMIC_RELAXED, __HIP_MEMORY_SCOPE_AGENT); }
__device__ __forceinline__ unsigned xb_add(unsigned* p, unsigned v) { return __hip_atomic_fetch_add(p, v, __ATOMIC_RELAXED, __HIP_MEMORY_SCOPE_AGENT); }
__device__ __forceinline__ unsigned xb_xcc_id() { return (unsigned)__builtin_amdgcn_s_getreg((3 << 11) | 20) & 0xFu; }
#define XB_SPIN(cond, bar) do { unsigned _sp = 0; while (cond) { __builtin_amdgcn_s_sleep(1); \
    if ((++_sp & 255u) == 0u) { if (xb_ld(&(bar)[XB_TMO])) break; if (_sp > XB_SPIN_CAP) { atomicAdd(&(bar)[XB_TMO], 1u); break; } } } } while (0)

struct XcdBarrier {
    unsigned* bar; unsigned x;
    volatile LAS unsigned* st;
};

__device__ __forceinline__ XcdBarrier xcd_barrier_post(unsigned* bar, volatile LAS unsigned* st) {
    XcdBarrier b; b.bar = bar; b.x = xb_xcc_id(); b.st = st;
    if (threadIdx.x == 0) (void)xb_add(&bar[XB_XCNT(b.x)], 1u);
    return b;
}
__device__ __forceinline__ void xcd_barrier_complete(unsigned* bar, unsigned x, unsigned& nloc, unsigned& nx) {
    const unsigned G = gridDim.x * gridDim.y * gridDim.z;
    unsigned sum, cnt, mine, sp = 0u;
    for (;;) {
        sum = 0u; cnt = 0u; mine = 0u;
#pragma unroll
        for (unsigned j = 0; j < 16; ++j) { const unsigned c = xb_ld(&bar[XB_XCNT(j)]); sum += c; cnt += (c > 0u) ? 1u : 0u; mine = (j == x) ? c : mine; }
        if (sum == G) break;
        __builtin_amdgcn_s_sleep(1);
        if ((++sp & 255u) == 0u) { if (xb_ld(&bar[XB_TMO])) break; if (sp > XB_SPIN_CAP) { atomicAdd(&bar[XB_TMO], 1u); break; } }
    }
    nloc = mine > 0u ? mine : 1u; nx = cnt > 0u ? cnt : 1u;
}

__device__ __forceinline__ void xcd_barrier(const XcdBarrier& b) {
    asm volatile("s_waitcnt vmcnt(0)" ::: "memory");
    __syncthreads();
    if (threadIdx.x == 0) {
        unsigned* bar = b.bar;
        __builtin_amdgcn_s_waitcnt(0);
        unsigned nloc = b.st[0], nx = b.st[1];
        if (nloc == 0u) { xcd_barrier_complete(bar, b.x, nloc, nx); b.st[0] = nloc; b.st[1] = nx; }
        const unsigned old = xb_add(&bar[XB_XSUB(b.x)], 1u);
        const unsigned gen = old / nloc;
        if (old + 1u == (gen + 1u) * nloc) {
            __builtin_amdgcn_fence(__ATOMIC_RELEASE, "agent");
            asm volatile("s_waitcnt vmcnt(0)" ::: "memory");
            const unsigned og = xb_add(&bar[XB_TOP], 1u);
            const unsigned tg = og / nx;
            if (og + 1u == (tg + 1u) * nx) xb_add(&bar[XB_TOPGEN], 1u);
            else XB_SPIN(xb_ld(&bar[XB_TOPGEN]) == tg, bar);
            __builtin_amdgcn_fence(__ATOMIC_ACQUIRE, "agent");
            xb_add(&bar[XB_XGEN(b.x)], 1u);
            asm volatile("s_waitcnt vmcnt(0)" ::: "memory");
        } else {
            XB_SPIN(xb_ld(&bar[XB_XGEN(b.x)]) == gen, bar);
            __builtin_amdgcn_fence(__ATOMIC_ACQUIRE, "agent");
            asm volatile("s_waitcnt vmcnt(0)" ::: "memory");
        }
    }
    __syncthreads();
}

constexpr int D = 1024, NL = 4;
constexpr int PB = 4, PT = 8192, MP = PB * PT;
constexpr int SBN = 32, STN = 16, PAST = 2048, MS = SBN * STN;
constexpr int M = MP + MS;
constexpr int SKEYS = PAST + STN;
constexpr int SPITCH = 2112;
constexpr int KROWS = MP + SBN * SPITCH;
constexpr int M3 = M + SBN * PAST;
constexpr int NIN = 3236, NINP = 3328;
constexpr float EPS = 1e-6f;
constexpr float LOG2E = 1.4426950408889634f;
constexpr float EXIT_LOG2 = -40.0f;
constexpr float QA_SC = 0.10206207261596575f * LOG2E, QB_SC = 0.125f * LOG2E, QC_SC = 0.125f * LOG2E;

constexpr size_t O_YP = 0, O_YS = O_YP + (size_t)MP * D, O_PCKV = O_YS + (size_t)MS * D, O_PKPE = O_PCKV + (size_t)NL * MP * 256, O_PFK = O_PKPE + (size_t)NL * MP * 32,
                 O_PFV = O_PFK + (size_t)NL * MP * 256, O_PLF = O_PFV + (size_t)NL * MP * 256, O_PSK = O_PLF + (size_t)NL * MP * 4, O_PSV = O_PSK + (size_t)NL * MP * 256,
                 O_SCKV = O_PSV + (size_t)NL * MP * 256, O_SKPE = O_SCKV + (size_t)NL * MS * 256, O_SFK = O_SKPE + (size_t)NL * MS * 32, O_SFV = O_SFK + (size_t)NL * MS * 256,
                 O_SLF = O_SFV + (size_t)NL * MS * 256, O_SSK = O_SLF + (size_t)NL * MS * 4, O_SSV = O_SSK + (size_t)NL * MS * 256, O_END = O_SSV + (size_t)NL * MS * 256;
static_assert(O_END == 209264640ull, "output size");

constexpr size_t MiB = 1u << 20;
constexpr size_t WS_CTL = 0, CTL_ZERO_BYTES = 1 * MiB;
constexpr size_t WS_ROPE = 1 * MiB, WS_WIN = 2 * MiB, WS_WUKV = 28 * MiB, WS_WOUT = 30 * MiB, WS_XN = 38 * MiB, WS_QA = 103 * MiB, WS_QB = 128 * MiB, WS_QC = 145 * MiB,
                 WS_GATE = 162 * MiB, WS_OP = 227 * MiB, WS_Y = 292 * MiB, WS_CKVB = 357 * MiB, WS_KA = 406 * MiB, WS_KR = 455 * MiB, WS_VA = 462 * MiB, WS_KB = 560 * MiB,
                 WS_VB = 609 * MiB, WS_KC = 658 * MiB, WS_VC = 707 * MiB, WS_LOGF = 756 * MiB, WS_FB = 758 * MiB, WS_SS = 760 * MiB, WS_KR2 = 762 * MiB, WS_RSTD = 769 * MiB, WS_END = 770 * MiB;
static_assert(WS_WIN + (size_t)NL * NINP * D * 2 <= WS_WUKV && WS_WUKV + (size_t)NL * 768 * 256 * 2 <= WS_WOUT && WS_WOUT + (size_t)NL * D * D * 2 <= WS_XN, "ws map 1");
static_assert(WS_XN + (size_t)M * D * 2 <= WS_QA && WS_QA + (size_t)(M + 64) * 384 * 2 <= WS_QB && WS_QB + (size_t)(M + 64) * 256 * 2 <= WS_QC && WS_QC + (size_t)(M + 64) * 256 * 2 <= WS_GATE, "ws map 2");
static_assert(WS_GATE + (size_t)M * D * 2 <= WS_OP && WS_OP + (size_t)M * D * 2 <= WS_Y && WS_Y + (size_t)M * D * 2 <= WS_CKVB && WS_CKVB + (size_t)M3 * 256 * 2 <= WS_KA, "ws map 3");
static_assert(WS_KA + (size_t)KROWS * 256 * 2 <= WS_KR && WS_KR + (size_t)KROWS * 32 * 2 <= WS_VA && WS_VA + (size_t)KROWS * 512 * 2 <= WS_KB && WS_KB + (size_t)KROWS * 256 * 2 <= WS_VB, "ws map 4");
static_assert(WS_VB + (size_t)KROWS * 256 * 2 <= WS_KC && WS_KC + (size_t)KROWS * 256 * 2 <= WS_VC && WS_VC + (size_t)KROWS * 256 * 2 <= WS_LOGF && WS_LOGF + (size_t)KROWS * 16 <= WS_FB && WS_FB + (size_t)KROWS * 16 <= WS_SS && WS_SS + (size_t)M * 48 <= WS_END, "ws map 5");
constexpr int CW_QUEUE = 64;
constexpr int CW_XQ = 1024;
constexpr int CW_KMAX = 512;
constexpr int CW_BAR = 4096;
constexpr int RING_BYTES = 131072, MISC_OFF = RING_BYTES, PTR_OFF = RING_BYTES + 256, SCR_OFF = RING_BYTES + 512, LDS_BYTES = 147456;

typedef unsigned short bf16_t;
typedef short bf16x8 __attribute__((ext_vector_type(8)));
typedef short s16x4 __attribute__((ext_vector_type(4)));
typedef float f32x4 __attribute__((ext_vector_type(4)));
typedef float f32x16 __attribute__((ext_vector_type(16)));
typedef unsigned u32x4 __attribute__((ext_vector_type(4)));
typedef unsigned u32x2 __attribute__((ext_vector_type(2)));
typedef float f32x2_t __attribute__((ext_vector_type(2)));
typedef __bf16 bf16x2_t __attribute__((ext_vector_type(2)));
__device__ __forceinline__ unsigned cvtpk(float lo, float hi) { f32x2_t v = {lo, hi}; bf16x2_t b = __builtin_convertvector(v, bf16x2_t); return __builtin_bit_cast(unsigned, b); }
__device__ __forceinline__ float bf_lo(unsigned w) { return __uint_as_float(w << 16); }
__device__ __forceinline__ float bf_hi(unsigned w) { return __uint_as_float(w & 0xffff0000u); }
__device__ __forceinline__ float wave_sum(float v) {
#pragma unroll
    for (int o = 1; o < 64; o <<= 1) v += __shfl_xor(v, o);
    return v;
}
__device__ __forceinline__ float half_swap_sum(float v) { auto rr = __builtin_amdgcn_permlane32_swap(__float_as_uint(v), __float_as_uint(v), false, false); return __uint_as_float(rr[0]) + __uint_as_float(rr[1]); }
__device__ __forceinline__ float half_swap_max(float v) { auto rr = __builtin_amdgcn_permlane32_swap(__float_as_uint(v), __float_as_uint(v), false, false); return fmaxf(__uint_as_float(rr[0]), __uint_as_float(rr[1])); }
__device__ __forceinline__ int fresh_tid() { int t = threadIdx.x; asm volatile("" : "+v"(t)); return t; }
__device__ __forceinline__ size_t kr_off(int l) { return (l & 1) ? WS_KR2 : WS_KR; }
__device__ __forceinline__ int krow_of(int m) { return m < MP ? m : MP + ((m - MP) >> 4) * SPITCH + PAST + ((m - MP) & 15); }
__device__ __forceinline__ int pos_of(int m) { return m < MP ? (m & (PT - 1)) : PAST + ((m - MP) & 15); }
__device__ __forceinline__ float* rows_out(float* out, size_t off_p, size_t off_s, int l, int m, int W) {
    return m < MP ? out + off_p + ((size_t)l * MP + m) * W : out + off_s + ((size_t)l * MS + (m - MP)) * W;
}

struct Params { const float* in[18]; float* out; unsigned char* ws; int ph_lo, ph_hi; };
__device__ __forceinline__ const float* inp(LAS unsigned char* lds, int i) {
    const unsigned long long v = ((const LAS unsigned long long*)(lds + PTR_OFF))[i];
    const unsigned lo = __builtin_amdgcn_readfirstlane((unsigned)v), hi = __builtin_amdgcn_readfirstlane((unsigned)(v >> 32));
    return (const float*)(const GAS float*)(((unsigned long long)hi << 32) | lo);
}
#define WSP(T, off) ((T*)(ws + (off)))

__device__ __forceinline__ int win_logical_col(int n) {
    const int tile = n >> 8, c = n & 255;
    switch (tile) {
        case 0: return c;
        case 1: { const int blk = c >> 5, p = c & 31, e = 16 * ((p >> 2) & 1) + 4 * (p >> 3) + (p & 3);
                  if (blk < 4) return 256 + 32 * blk + e; if (blk == 4) return 640 + e; if (blk == 5 && p < 4) return 1440 + p; return -1; }
        case 2: return 384 + c;
        case 3: return 672 + c;
        case 4: return 928 + c;
        case 5: return 1184 + c;
        case 6: return 1444 + c;
        case 7: return 1700 + c;
        case 8: return 1956 + c;
        default: return 2212 + 256 * (tile - 9) + c;
    }
}
__device__ __forceinline__ void p0_item(unsigned char* ws, LAS unsigned char* lds, int kind, int l, int item, LAS float* scr, int lane) {
    const int K = kind == 1 ? 256 : 1024, N = kind == 0 ? NINP : kind == 1 ? 768 : 1024;
    const int nblk = N / 32, kb = item / nblk, nb = item % nblk, k0 = 64 * kb, n0 = 32 * nb;
    const int n = n0 + (lane & 31);
    const float* src; int ld; int col;
    if (kind == 0) { src = inp(lds, 11) + (size_t)l * D * NIN; ld = NIN; col = win_logical_col(n); }
    else if (kind == 1) { if (n < 256) { src = inp(lds, 13) + (size_t)l * 256 * 256; ld = 256; col = n; } else { src = inp(lds, 14) + (size_t)l * 256 * 512; ld = 512; col = n - 256; } }
    else { src = inp(lds, 17) + (size_t)l * D * D; ld = D; col = n; }
    const float* gain = kind == 0 ? inp(lds, 9) + l * D : kind == 2 ? inp(lds, 16) + l * D : nullptr;
#pragma unroll 8
    for (int i = 0; i < 32; ++i) { const int kk = 2 * i + (lane >> 5); float v = 0.f;
        if (col >= 0) { v = src[(size_t)(k0 + kk) * ld + col]; if (gain) v *= gain[k0 + kk]; }
        scr[kk * 33 + (lane & 31)] = v; }
    asm volatile("s_waitcnt lgkmcnt(0)" ::: "memory");
    bf16_t* WT = (bf16_t*)(ws + (kind == 0 ? WS_WIN + (size_t)l * NINP * D * 2 : kind == 1 ? WS_WUKV + (size_t)l * 768 * 256 * 2 : WS_WOUT + (size_t)l * D * D * 2));
    const int c = lane & 7;
#pragma unroll
    for (int j = 0; j < 4; ++j) { const int nn = (lane >> 3) + 8 * j; const LAS float* s = scr + (8 * c) * 33 + nn;
        u32x4 o; o.x = cvtpk(s[0 * 33], s[1 * 33]); o.y = cvtpk(s[2 * 33], s[3 * 33]); o.z = cvtpk(s[4 * 33], s[5 * 33]); o.w = cvtpk(s[6 * 33], s[7 * 33]);
        *(u32x4*)(WT + (size_t)(n0 + nn) * K + k0 + 8 * c) = o; }
    asm volatile("s_waitcnt lgkmcnt(0)" ::: "memory");
}
__device__ __forceinline__ void p0_prologue(unsigned char* ws, LAS unsigned char* lds) {
    const int tid = fresh_tid(), lane = tid & 63, wid = __builtin_amdgcn_readfirstlane(tid >> 6);
    LAS float* scr = (LAS float*)(lds + wid * 16384);
    const int gw = blockIdx.x * 8 + wid, NGW = gridDim.x * 8;
    constexpr int I0 = 16 * (NINP / 32), I1 = 4 * 24, I2 = 16 * 32, IL = I0 + I1 + I2;
    for (int it = gw; it < IL; it += NGW) {
        const int l = it / IL; int r = it % IL;
        if (r < I0) { p0_item(ws, lds, 0, l, r, scr, lane); continue; } r -= I0;
        if (r < I1) { p0_item(ws, lds, 1, l, r, scr, lane); continue; } r -= I1;
        p0_item(ws, lds, 2, l, r, scr, lane);
    }
    float* rope = (float*)(ws + WS_ROPE);
    for (int e = blockIdx.x * 512 + tid; e < PT * 16; e += gridDim.x * 512) {
        const int pos = e >> 4, i = e & 15;
        double inv = 1.0; for (int k = 0; k < i; ++k) inv *= 0.5623413251903491;
        const double rev = (double)pos * inv * 0.15915494309189535;
        const float fr = (float)(rev - __builtin_rint(rev));
        rope[pos * 32 + i] = __builtin_amdgcn_cosf(fr); rope[pos * 32 + 16 + i] = __builtin_amdgcn_sinf(fr);
    }
}

__device__ __forceinline__ void cvt_rows(const float* src, bf16_t* dst, int W, size_t dst_bstride, int gtid, int nthr) {
    const int per_b = PAST * W / 8, total = SBN * per_b;
    for (int q0 = gtid; q0 < total; q0 += 4 * nthr) {
        f32x4 a[4], b[4];
#pragma unroll
        for (int u = 0; u < 4; ++u) { const int q = q0 + u * nthr; if (q < total) { a[u] = *(const f32x4*)(src + (size_t)q * 8); b[u] = *(const f32x4*)(src + (size_t)q * 8 + 4); } }
#pragma unroll
        for (int u = 0; u < 4; ++u) { const int q = q0 + u * nthr; if (q < total) { const int sb = q / per_b, rem = q % per_b;
            u32x4 o; o.x = cvtpk(a[u][0], a[u][1]); o.y = cvtpk(a[u][2], a[u][3]); o.z = cvtpk(b[u][0], b[u][1]); o.w = cvtpk(b[u][2], b[u][3]);
            *(u32x4*)(dst + (size_t)sb * dst_bstride + (size_t)rem * 8) = o; } }
    }
}
__device__ __forceinline__ void p1_norm(unsigned char* ws, float* out, LAS unsigned char* lds, int l) {
    const int tid = fresh_tid(), lane = tid & 63, wid = __builtin_amdgcn_readfirstlane(tid >> 6);
    const int gw = blockIdx.x * 8 + wid, NGW = gridDim.x * 8;
    bf16_t* XB = (bf16_t*)(ws + WS_XN); const bf16_t* Y = (const bf16_t*)(ws + WS_Y); float* RSTD = (float*)(ws + WS_RSTD);
    const float* xp = inp(lds, 0); const float* xs = inp(lds, 1); const float* gpost = inp(lds, 10);
    constexpr int RU = 4;
    f32x4 g[4];
    if (l > 0) {
#pragma unroll
        for (int j = 0; j < 4; ++j) g[j] = *(const f32x4*)(gpost + (l - 1) * D + 256 * j + 4 * lane);
    }
    for (int m0 = gw; m0 < M; m0 += RU * NGW) {
        f32x4 v[RU][4]; u32x2 yw[RU][4];
#pragma unroll
        for (int r = 0; r < RU; ++r) { const int m = m0 + r * NGW; if (m < M) {
            if (l == 0) { const float* base = m < MP ? xp + (size_t)m * D : xs + (size_t)(m - MP) * D;
#pragma unroll
                for (int j = 0; j < 4; ++j) v[r][j] = *(const f32x4*)(base + 256 * j + 4 * lane); }
            else {
#pragma unroll
                for (int j = 0; j < 4; ++j) { const u32x2 w = *(const u32x2*)(XB + (size_t)m * D + 256 * j + 4 * lane); v[r][j] = (f32x4){bf_lo(w.x), bf_hi(w.x), bf_lo(w.y), bf_hi(w.y)}; }
#pragma unroll
                for (int j = 0; j < 4; ++j) yw[r][j] = *(const u32x2*)(Y + (size_t)m * D + 256 * j + 4 * lane); } } }
#pragma unroll
        for (int r = 0; r < RU; ++r) { const int m = m0 + r * NGW; if (m < M) {
            if (l > 0) {
                f32x4 y[4]; float s = 0.f;
#pragma unroll
                for (int j = 0; j < 4; ++j) { const u32x2 w = yw[r][j]; y[j] = (f32x4){bf_lo(w.x), bf_hi(w.x), bf_lo(w.y), bf_hi(w.y)}; s += (y[j][0] * y[j][0] + y[j][1] * y[j][1]) + (y[j][2] * y[j][2] + y[j][3] * y[j][3]); }
                const float rr = 1.0f / sqrtf(wave_sum(s) * (1.0f / D) + EPS);
#pragma unroll
                for (int j = 0; j < 4; ++j) v[r][j] = v[r][j] + y[j] * rr * g[j];
            }
            if (l < NL) {
                float s = 0.f;
#pragma unroll
                for (int j = 0; j < 4; ++j) s += (v[r][j][0] * v[r][j][0] + v[r][j][1] * v[r][j][1]) + (v[r][j][2] * v[r][j][2] + v[r][j][3] * v[r][j][3]);
                const float rr = 1.0f / sqrtf(wave_sum(s) * (1.0f / D) + EPS);
                if (lane == 0) RSTD[m] = rr;
#pragma unroll
                for (int j = 0; j < 4; ++j) { u32x2 w; w.x = cvtpk(v[r][j][0], v[r][j][1]); w.y = cvtpk(v[r][j][2], v[r][j][3]); *(u32x2*)(XB + (size_t)m * D + 256 * j + 4 * lane) = w; }
            } else {
                float* xres = out + (size_t)m * D;
#pragma unroll
                for (int j = 0; j < 4; ++j) *(f32x4*)(xres + 256 * j + 4 * lane) = v[r][j];
            } } }
    }
    if (l == 0) {
        const int gtid = blockIdx.x * 512 + tid, nthr = gridDim.x * 512;
        cvt_rows(inp(lds, 2) + (size_t)l * SBN * PAST * 256, (bf16_t*)(ws + WS_CKVB) + (size_t)M * 256, 256, (size_t)PAST * 256, gtid, nthr);
        cvt_rows(inp(lds, 3) + (size_t)l * SBN * PAST * 32, (bf16_t*)(ws + WS_KR) + (size_t)MP * 32, 32, (size_t)SPITCH * 32, gtid, nthr);
    }
}

__device__ __forceinline__ void st8(bf16_t* p, const f32x4 a, const f32x4 b, float sc) {
    u32x4 w; w.x = cvtpk(a[0] * sc, a[1] * sc); w.y = cvtpk(a[2] * sc, a[3] * sc); w.z = cvtpk(b[0] * sc, b[1] * sc); w.w = cvtpk(b[2] * sc, b[3] * sc); *(u32x4*)p = w;
}
__device__ __forceinline__ float silu_f(float x) { return x * __builtin_amdgcn_rcpf(1.0f + __builtin_amdgcn_exp2f(-x * LOG2E)); }
struct EpiP2 {
    static constexpr bool PERM = true, AFTER_DRAIN = false, MID = false;
    unsigned char* ws; float* out; const float* kvnorm; const float* fbias; int l; LAS float* scr;
    __device__ __forceinline__ void operator()(pg8::f32x4 (&acc)[2][2][4][2], const pg8::Unit& u, int wr, int wc, int fr, int fq) const {
        int pn = u.pn, rbase = u.pm * 256 + wr * 64 + fr, cw = wc * 32 + 8 * fq;
        asm volatile("" : "+s"(pn), "+v"(rbase), "+v"(cw));
        {
            const float* const RSTD = WSP(const float, WS_RSTD); float rs[2][4];
#pragma unroll
            for (int ai = 0; ai < 2; ++ai)
#pragma unroll
                for (int m = 0; m < 4; ++m) rs[ai][m] = RSTD[rbase + ai * 128 + m * 16];
#pragma unroll
            for (int ai = 0; ai < 2; ++ai)
#pragma unroll
                for (int m = 0; m < 4; ++m)
#pragma unroll
                    for (int bj = 0; bj < 2; ++bj)
#pragma unroll
                        for (int n = 0; n < 2; ++n) acc[ai][bj][m][n] = acc[ai][bj][m][n] * rs[ai][m];
        }
        bf16_t* const QA = WSP(bf16_t, WS_QA); bf16_t* const QB = WSP(bf16_t, WS_QB); bf16_t* const QC = WSP(bf16_t, WS_QC); bf16_t* const KR = (bf16_t*)(ws + kr_off(l)); bf16_t* const KB = WSP(bf16_t, WS_KB); bf16_t* const VB = WSP(bf16_t, WS_VB);
        bf16_t* const KC = WSP(bf16_t, WS_KC); bf16_t* const VC = WSP(bf16_t, WS_VC); bf16_t* const CKVB = WSP(bf16_t, WS_CKVB); bf16_t* const GATE = WSP(bf16_t, WS_GATE); float* const LOGF = WSP(float, WS_LOGF); const float* const rope = WSP(const float, WS_ROPE);
        if (pn == 0 || pn == 3 || pn == 6) {
            const float sc = pn == 0 ? QA_SC : pn == 3 ? QB_SC : QC_SC;
#pragma unroll
            for (int ai = 0; ai < 2; ++ai)
#pragma unroll
                for (int m = 0; m < 4; ++m) { const int row = rbase + ai * 128 + m * 16;
#pragma unroll
                    for (int bj = 0; bj < 2; ++bj) {
                        bf16_t* d = pn == 0 ? QA + (size_t)row * 384 + (2 * bj + (wc >> 1)) * 96 + 32 * (wc & 1) + 8 * fq : (pn == 3 ? QB : QC) + (size_t)row * 256 + 128 * bj + cw;
                        st8(d, acc[ai][bj][m][0], acc[ai][bj][m][1], sc); } }
        } else if (pn >= 9) {
#pragma unroll
            for (int ai = 0; ai < 2; ++ai)
#pragma unroll
                for (int m = 0; m < 4; ++m) { const int row = rbase + ai * 128 + m * 16;
#pragma unroll
                    for (int bj = 0; bj < 2; ++bj) { f32x4 a = acc[ai][bj][m][0], b = acc[ai][bj][m][1];
#pragma unroll
                        for (int j = 0; j < 4; ++j) { a[j] = silu_f(a[j]); b[j] = silu_f(b[j]); }
                        st8(GATE + (size_t)row * D + 256 * (pn - 9) + 128 * bj + cw, a, b, 1.0f); } }
        } else if (pn == 4 || pn == 5 || pn == 7 || pn == 8) {
            bf16_t* buf = pn == 4 ? KB : pn == 5 ? VB : pn == 7 ? KC : VC;
            const size_t offp = pn == 4 ? O_PFK : pn == 5 ? O_PFV : pn == 7 ? O_PSK : O_PSV, offs = pn == 4 ? O_SFK : pn == 5 ? O_SFV : pn == 7 ? O_SSK : O_SSV;
#pragma unroll
            for (int ai = 0; ai < 2; ++ai)
#pragma unroll
                for (int m = 0; m < 4; ++m) { const int row = rbase + ai * 128 + m * 16; const int kr = krow_of(row); float* o = rows_out(out, offp, offs, l, row, 256);
#pragma unroll
                    for (int bj = 0; bj < 2; ++bj) { const int c0 = 128 * bj + cw;
                        st8(buf + (size_t)kr * 256 + c0, acc[ai][bj][m][0], acc[ai][bj][m][1], 1.0f);
                        *(f32x4*)(o + c0) = acc[ai][bj][m][0]; *(f32x4*)(o + c0 + 4) = acc[ai][bj][m][1]; } }
            if (pn == 4 && u.pm < MP / 256) {
                float mx[2] = {0.f, 0.f};
#pragma unroll
                for (int ai = 0; ai < 2; ++ai)
#pragma unroll
                    for (int m = 0; m < 4; ++m)
#pragma unroll
                        for (int bj = 0; bj < 2; ++bj) { const f32x4 x = acc[ai][bj][m][0], y = acc[ai][bj][m][1];
                            float sq = ((x[0] * x[0] + x[1] * x[1]) + (x[2] * x[2] + x[3] * x[3])) + ((y[0] * y[0] + y[1] * y[1]) + (y[2] * y[2] + y[3] * y[3]));
                            sq += __shfl_xor(sq, 16); sq += __shfl_xor(sq, 32); mx[bj] = fmaxf(mx[bj], sq); }
#pragma unroll
                for (int bj = 0; bj < 2; ++bj) { float v = mx[bj];
                    v = fmaxf(v, __shfl_xor(v, 1)); v = fmaxf(v, __shfl_xor(v, 2)); v = fmaxf(v, __shfl_xor(v, 4)); v = fmaxf(v, __shfl_xor(v, 8));
                    if (fr == 0 && fq == 0) __hip_atomic_fetch_max(WSP(unsigned, WS_CTL) + CW_KMAX + ((l * 4 + (u.pm >> 5)) * 4 + 2 * bj + (wc >> 1)) * 2 + (wc & 1), __float_as_uint(v), __ATOMIC_RELAXED, __HIP_MEMORY_SCOPE_AGENT); }
            }
        } else if (pn == 1) {
#pragma unroll
            for (int ai = 0; ai < 2; ++ai)
#pragma unroll
                for (int m = 0; m < 4; ++m) { const int row = rbase + ai * 128 + m * 16; const int pos = pos_of(row);
                    const f32x4 cs = *(const f32x4*)(rope + pos * 32 + 4 * fq), sn = *(const f32x4*)(rope + pos * 32 + 16 + 4 * fq);
                    {
                        const f32x4 x1 = acc[ai][0][m][0], x2 = acc[ai][0][m][1]; const f32x4 y1 = (x1 * cs - x2 * sn) * QA_SC, y2 = (x1 * sn + x2 * cs) * QA_SC;
                        bf16_t* d = QA + (size_t)row * 384 + wc * 96 + 64 + 4 * fq;
                        u32x2 w1, w2; w1.x = cvtpk(y1[0], y1[1]); w1.y = cvtpk(y1[2], y1[3]); w2.x = cvtpk(y2[0], y2[1]); w2.y = cvtpk(y2[2], y2[3]);
                        *(u32x2*)d = w1; *(u32x2*)(d + 16) = w2; }
                    if (wc == 0) {
                        const f32x4 x1 = acc[ai][1][m][0], x2 = acc[ai][1][m][1]; const f32x4 y1 = x1 * cs - x2 * sn, y2 = x1 * sn + x2 * cs;
                        bf16_t* d = KR + (size_t)krow_of(row) * 32 + 4 * fq;
                        u32x2 w1, w2; w1.x = cvtpk(y1[0], y1[1]); w1.y = cvtpk(y1[2], y1[3]); w2.x = cvtpk(y2[0], y2[1]); w2.y = cvtpk(y2[2], y2[3]);
                        *(u32x2*)d = w1; *(u32x2*)(d + 16) = w2;
                        float* o = rows_out(out, O_PKPE, O_SKPE, l, row, 32) + 4 * fq; *(f32x4*)o = y1; *(f32x4*)(o + 16) = y2;
                    } else if (wc == 1 && fq == 0) {
                        f32x4 v = acc[ai][1][m][0] + *(const f32x4*)fbias; f32x4 lf;
#pragma unroll
                        for (int j = 0; j < 4; ++j) lf[j] = fminf(v[j], 0.f) - __logf(1.0f + __expf(-fabsf(v[j])));
                        *(f32x4*)rows_out(out, O_PLF, O_SLF, l, row, 4) = lf; *(f32x4*)(LOGF + (size_t)krow_of(row) * 4) = lf;
                    } }
        } else {
            float ssq[2][4];
#pragma unroll
            for (int ai = 0; ai < 2; ++ai)
#pragma unroll
                for (int m = 0; m < 4; ++m) { float s = 0.f;
#pragma unroll
                    for (int bj = 0; bj < 2; ++bj)
#pragma unroll
                        for (int n = 0; n < 2; ++n) { const f32x4 x = acc[ai][bj][m][n]; s += (x[0] * x[0] + x[1] * x[1]) + (x[2] * x[2] + x[3] * x[3]); }
                    s += __shfl_xor(s, 16); s += __shfl_xor(s, 32);
                    if (fq == 0) scr[(ai * 128 + wr * 64 + m * 16 + fr) * 4 + wc] = s; }
            asm volatile("s_waitcnt lgkmcnt(0)" ::: "memory"); __builtin_amdgcn_s_barrier(); asm volatile("" ::: "memory");
#pragma unroll
            for (int ai = 0; ai < 2; ++ai)
#pragma unroll
                for (int m = 0; m < 4; ++m) { const f32x4 p4 = *(const LAS f32x4*)(scr + (ai * 128 + wr * 64 + m * 16 + fr) * 4); ssq[ai][m] = (p4[0] + p4[1]) + (p4[2] + p4[3]); }
#pragma unroll
            for (int ai = 0; ai < 2; ++ai)
#pragma unroll
                for (int m = 0; m < 4; ++m) { const int row = rbase + ai * 128 + m * 16; const float r = 1.0f / sqrtf(ssq[ai][m] * (1.0f / 256.0f) + EPS); float* o = rows_out(out, O_PCKV, O_SCKV, l, row, 256);
#pragma unroll
                    for (int bj = 0; bj < 2; ++bj) { const int c0 = 128 * bj + cw;
                        const f32x4 a = acc[ai][bj][m][0] * r * *(const f32x4*)(kvnorm + c0), b = acc[ai][bj][m][1] * r * *(const f32x4*)(kvnorm + c0 + 4);
                        st8(CKVB + (size_t)row * 256 + c0, a, b, 1.0f); *(f32x4*)(o + c0) = a; *(f32x4*)(o + c0 + 4) = b; } }
        }
    }
};
struct EpiP3 {
    static constexpr bool PERM = true, AFTER_DRAIN = false, MID = false;
    unsigned char* ws;
    __device__ __forceinline__ void operator()(const pg8::f32x4 (&acc)[2][2][4][2], const pg8::Unit& u, int wr, int wc, int fr, int fq) const {
        int pn = u.pn, rbase = u.pm * 256 + wr * 64 + fr, cw = wc * 32 + 8 * fq;
        asm volatile("" : "+s"(pn), "+v"(rbase), "+v"(cw));
        bf16_t* const KA = WSP(bf16_t, WS_KA); bf16_t* const VA = WSP(bf16_t, WS_VA);
#pragma unroll
        for (int ai = 0; ai < 2; ++ai)
#pragma unroll
            for (int m = 0; m < 4; ++m) { const int row = rbase + ai * 128 + m * 16;
                const int dest = row < M ? krow_of(row) : MP + ((row - M) >> 11) * SPITCH + ((row - M) & 2047);
#pragma unroll
                for (int bj = 0; bj < 2; ++bj) { bf16_t* d = pn == 0 ? KA + (size_t)dest * 256 + 128 * bj + cw : VA + (size_t)dest * 512 + 256 * (pn - 1) + 128 * bj + cw;
                    st8(d, acc[ai][bj][m][0], acc[ai][bj][m][1], 1.0f); } }
    }
};
struct EpiP5 {
    static constexpr bool PERM = true, AFTER_DRAIN = false, MID = true; static constexpr int MID_T0 = 8, MID_T1 = 12;
    unsigned char* ws; LAS float* tab;
    __device__ __forceinline__ void prep(const pg8::Unit& u, int par, int tid) const {
        if (tid < 256) { const float* ss = WSP(const float, WS_SS) + (size_t)(u.pm * 256 + tid) * 12;
            const f32x4 a = *(const f32x4*)ss, b = *(const f32x4*)(ss + 4), c = *(const f32x4*)(ss + 8);
            const float ra = 1.0f / sqrtf(((a[0] + a[1]) + (a[2] + a[3])) * (1.0f / 512.0f) + EPS), rb = 1.0f / sqrtf(((b[0] + b[1]) + (b[2] + b[3])) * (1.0f / 256.0f) + EPS), rc = 1.0f / sqrtf(((c[0] + c[1]) + (c[2] + c[3])) * (1.0f / 256.0f) + EPS);
            *(LAS f32x4*)(tab + (par * 256 + tid) * 4) = (f32x4){ra / rb, rb / rc, rc, 0.f}; }
    }
    __device__ __forceinline__ void mid(pg8::f32x4 (&acc)[2][2][4][2], int par, int which, int wr, int fr) const {
#pragma unroll
        for (int ai = 0; ai < 2; ++ai)
#pragma unroll
            for (int m = 0; m < 4; ++m) { const f32x4 t4 = *(const LAS f32x4*)(tab + (par * 256 + ai * 128 + wr * 64 + m * 16 + fr) * 4); const float f = which == 0 ? t4[0] : which == 1 ? t4[1] : t4[2];
#pragma unroll
                for (int bj = 0; bj < 2; ++bj)
#pragma unroll
                    for (int n = 0; n < 2; ++n) acc[ai][bj][m][n] = acc[ai][bj][m][n] * f; }
    }
    __device__ __forceinline__ void operator()(const pg8::f32x4 (&acc)[2][2][4][2], const pg8::Unit& u, int wr, int wc, int fr, int fq) const {
        int rbase = u.pm * 256 + wr * 64 + fr, cw = u.pn * 256 + wc * 32 + 8 * fq; bf16_t* const Y = WSP(bf16_t, WS_Y);
        asm volatile("" : "+v"(rbase), "+v"(cw));
#pragma unroll
        for (int ai = 0; ai < 2; ++ai)
#pragma unroll
            for (int m = 0; m < 4; ++m) { const int row = rbase + ai * 128 + m * 16;
#pragma unroll
                for (int bj = 0; bj < 2; ++bj) st8(Y + (size_t)row * D + 128 * bj + cw, acc[ai][bj][m][0], acc[ai][bj][m][1], 1.0f); }
    }
};

__device__ __forceinline__ void cumsum_task(unsigned char* ws, int l, int task, LAS unsigned char* lds) {
    const int tid = fresh_tid(), lane = tid & 63, wid = tid >> 6;
    const float* LOGF = (const float*)(ws + WS_LOGF); float* FB = (float*)(ws + WS_FB);
    const bool prompt = task < 4; const int sb = task - 4;
    const int n = prompt ? PT : SKEYS, CH = prompt ? 16 : 5;
    const int krow0 = prompt ? task * PT : MP + sb * SPITCH;
    const float* cache = inp(lds, 6) + ((size_t)l * SBN + (prompt ? 0 : sb)) * PAST * 4;
    const int t0 = tid * CH;
    f32x4 s = {0.f, 0.f, 0.f, 0.f};
    for (int i = 0; i < CH; ++i) { const int t = t0 + i; if (t < n) { const f32x4 v = (!prompt && t < PAST) ? *(const f32x4*)(cache + (size_t)t * 4) : *(const f32x4*)(LOGF + (size_t)(krow0 + t) * 4); s = s + v; } }
    const f32x4 own = s;
#pragma unroll
    for (int off = 1; off < 64; off <<= 1) {
#pragma unroll
        for (int c = 0; c < 4; ++c) { const float t = __shfl_up(s[c], off); if (lane >= off) s[c] += t; } }
    LAS f32x4* wt = (LAS f32x4*)lds;
    if (lane == 63) wt[wid] = s;
    __syncthreads();
    f32x4 pre = s - own;
    for (int w = 0; w < wid; ++w) pre = pre + wt[w];
    for (int i = 0; i < CH; ++i) { const int t = t0 + i; if (t < n) { const f32x4 v = (!prompt && t < PAST) ? *(const f32x4*)(cache + (size_t)t * 4) : *(const f32x4*)(LOGF + (size_t)(krow0 + t) * 4); pre = pre + v;
        *(f32x4*)(FB + (size_t)(krow0 + t) * 4) = pre * LOG2E; } }
    __syncthreads();
}

#define MFMA32(a, b, c) __builtin_amdgcn_mfma_f32_32x32x16_bf16((a), (b), (c), 0, 0, 0)
__device__ __forceinline__ s16x4 tr_rd(const LAS unsigned char* p) { typedef short v4i16_t __attribute__((ext_vector_type(4))); return __builtin_bit_cast(s16x4, __builtin_amdgcn_ds_read_tr16_b64_v4i16((LAS v4i16_t*)p)); }
__device__ __forceinline__ bf16x8 pack8(const f32x16& p, int b) {
    u32x4 w; w.x = cvtpk(p[b], p[b + 1]); w.y = cvtpk(p[b + 2], p[b + 3]); w.z = cvtpk(p[b + 4], p[b + 5]); w.w = cvtpk(p[b + 6], p[b + 7]); return __builtin_bit_cast(bf16x8, w);
}
template <int TYPE, bool SAMP>
__device__ __forceinline__ void attn_unit(unsigned char* ws, LAS unsigned char* lds, int l, int qrow0, int nq, int krow0, int qpos0, int nkeys, int h) {
    constexpr int DQK = TYPE == 0 ? 96 : 64, DV = TYPE == 0 ? 128 : 64, NS = DQK / 16, NDB = DV / 32;
    constexpr int KP = TYPE == 0 ? 208 : 144, VP = TYPE == 0 ? 320 : 192;
    constexpr int KBYTES = 64 * KP, VBYTES = 64 * VP, BUFB = KBYTES + VBYTES, OFF_F = 2 * BUFB, OFF_FLAG = OFF_F + 512;
    const int tid = fresh_tid(), lane = tid & 63, wid = __builtin_amdgcn_readfirstlane(tid >> 6), r32 = lane & 31, hh = lane >> 5;
    const bool wave_on = 32 * wid < nq;
    const int qloc = min(32 * wid + r32, nq - 1);
    const int qrow = qrow0 + qloc;
    const int qpos = qpos0 + 32 * wid + r32;
    const int qp_lo = qpos0 + 32 * wid, qp_hi = qp_lo + 31;
    const int jmax = (qpos0 + nq - 1) >> 6;
    const int wjmax = TYPE == 0 ? (qp_lo >> 6) : TYPE == 1 ? (qp_hi >> 6) : ((qp_hi - 1) >> 6);
    const bf16_t* Kg = TYPE == 0 ? WSP(const bf16_t, WS_KA) : TYPE == 1 ? WSP(const bf16_t, WS_KB) : WSP(const bf16_t, WS_KC); const bf16_t* Vg = TYPE == 0 ? WSP(const bf16_t, WS_VA) : TYPE == 1 ? WSP(const bf16_t, WS_VB) : WSP(const bf16_t, WS_VC);
    constexpr int NKC = TYPE == 0 ? 2 : 1, NVC = TYPE == 0 ? 2 : 1;
    const bf16_t* ksrc[NKC]; int kdst[NKC]; bool kval[NKC]; const bf16_t* vsrc[NVC]; int vdst[NVC];
#pragma unroll
    for (int r = 0; r < NKC; ++r) {
        if (TYPE == 0) { const int n = tid + 512 * r; kval[r] = n < 768; const int nn = kval[r] ? n : 0; const int row = nn / 12, c = nn % 12;
            ksrc[r] = c < 8 ? WSP(const bf16_t, WS_KA) + (size_t)(krow0 + row) * 256 + h * 64 + c * 8 : (const bf16_t*)(ws + kr_off(l)) + (size_t)(krow0 + row) * 32 + (c - 8) * 8; kdst[r] = row * KP + c * 16; }
        else { const int row = tid >> 3, c = tid & 7; kval[r] = true; ksrc[r] = Kg + (size_t)(krow0 + row) * 256 + h * 64 + c * 8; kdst[r] = row * KP + c * 16; }
    }
#pragma unroll
    for (int r = 0; r < NVC; ++r) {
        if (TYPE == 0) { const int n = tid + 512 * r; const int row = n >> 4, c = n & 15; vsrc[r] = WSP(const bf16_t, WS_VA) + (size_t)(krow0 + row) * 512 + h * 128 + c * 8; vdst[r] = row * VP + c * 16; }
        else { const int row = tid >> 3, c = tid & 7; vsrc[r] = Vg + (size_t)(krow0 + row) * 256 + h * 64 + c * 8; vdst[r] = row * VP + c * 16; }
    }
    const size_t kstepA = (size_t)64 * 256, kstepR = (size_t)64 * 32, vstep = (size_t)64 * (TYPE == 0 ? 512 : 256);
    u32x4 kreg[NKC], vreg[NVC]; float freg = 0.f;
    constexpr bool F32C = SAMP && TYPE != 0;
    const float* kc32 = nullptr; const float* vc32 = nullptr; u32x4 kx[2], vx[2]; bool ld32 = false;
    if (F32C) { const int sb = (krow0 - MP) / SPITCH; const size_t o32 = (((size_t)l * SBN + sb) * PAST + (tid >> 3)) * 256 + h * 64 + (tid & 7) * 8;
        kc32 = inp(lds, TYPE == 1 ? 4 : 7) + o32; vc32 = inp(lds, TYPE == 1 ? 5 : 8) + o32; }
#define ATT_LOAD(j) do { if (F32C && (j) < PAST / 64) { ld32 = true; const size_t t_ = (size_t)(j) * 64 * 256; \
            kx[0] = *(const u32x4*)(kc32 + t_); kx[1] = *(const u32x4*)(kc32 + t_ + 4); vx[0] = *(const u32x4*)(vc32 + t_); vx[1] = *(const u32x4*)(vc32 + t_ + 4); } else { ld32 = false; \
        _Pragma("unroll") for (int r_ = 0; r_ < NKC; ++r_) { const bool rope_ = (TYPE == 0) && (((tid + 512 * r_) % 12) >= 8); \
            if (kval[r_]) kreg[r_] = *(const u32x4*)(ksrc[r_] + (size_t)(j) * (rope_ ? kstepR : kstepA)); } \
        _Pragma("unroll") for (int r_ = 0; r_ < NVC; ++r_) vreg[r_] = *(const u32x4*)(vsrc[r_] + (size_t)(j) * vstep); } \
        if (TYPE == 1 && tid < 64) freg = WSP(const float, WS_FB)[(size_t)(krow0 + 64 * (j) + tid) * 4 + h]; } while (0)
#define ATT_STORE(b) do { LAS unsigned char* kb_ = lds + (b) * BUFB; \
        if (F32C && ld32) { kreg[0] = (u32x4){cvtpk(__uint_as_float(kx[0].x), __uint_as_float(kx[0].y)), cvtpk(__uint_as_float(kx[0].z), __uint_as_float(kx[0].w)), cvtpk(__uint_as_float(kx[1].x), __uint_as_float(kx[1].y)), cvtpk(__uint_as_float(kx[1].z), __uint_as_float(kx[1].w))}; \
            vreg[0] = (u32x4){cvtpk(__uint_as_float(vx[0].x), __uint_as_float(vx[0].y)), cvtpk(__uint_as_float(vx[0].z), __uint_as_float(vx[0].w)), cvtpk(__uint_as_float(vx[1].x), __uint_as_float(vx[1].y)), cvtpk(__uint_as_float(vx[1].z), __uint_as_float(vx[1].w))}; } \
        _Pragma("unroll") for (int r_ = 0; r_ < NKC; ++r_) if (kval[r_]) *(LAS u32x4*)(kb_ + kdst[r_]) = kreg[r_]; \
        _Pragma("unroll") for (int r_ = 0; r_ < NVC; ++r_) *(LAS u32x4*)(kb_ + KBYTES + vdst[r_]) = vreg[r_]; \
        if (TYPE == 1 && tid < 64) ((LAS float*)(lds + OFF_F))[(b) * 64 + tid] = freg; } while (0)
    bf16x8 qf[NS];
    { const bf16_t* qp = TYPE == 0 ? WSP(const bf16_t, WS_QA) + (size_t)qrow * 384 + h * 96 : (TYPE == 1 ? WSP(const bf16_t, WS_QB) : WSP(const bf16_t, WS_QC)) + (size_t)qrow * 256 + h * 64;
#pragma unroll
      for (int s = 0; s < NS; ++s) qf[s] = *(const bf16x8*)(qp + 16 * s + 8 * hh); }
    float fq = 0.f; if (TYPE == 1) fq = WSP(const float, WS_FB)[(size_t)(krow0 + min(qpos, nkeys - 1)) * 4 + h];
    float bound = INFINITY;
    if (TYPE == 1 && nq == 256) {
        float qn = 0.f;
#pragma unroll
        for (int s = 0; s < NS; ++s)
#pragma unroll
            for (int e = 0; e < 8; ++e) { const float x = __uint_as_float((unsigned)(unsigned short)qf[s][e] << 16); qn += x * x; }
        qn = half_swap_sum(qn);
        const unsigned* km = WSP(const unsigned, WS_CTL) + CW_KMAX + ((l * 4 + krow0 / PT) * 4 + h) * 2;
        bound = sqrtf(qn * (__uint_as_float(km[0]) + __uint_as_float(km[1]))) * 1.02f + 1.0f;
    }
    f32x16 o[NDB];
#pragma unroll
    for (int d = 0; d < NDB; ++d)
#pragma unroll
        for (int i = 0; i < 16; ++i) o[d][i] = 0.f;
    float mrun = 0.f, lrun = 0.f, carry = 0.f; bool wdone = !wave_on;
    f32x16 negc;
#pragma unroll
    for (int i = 0; i < 16; ++i) negc[i] = (TYPE == 1) ? fq : 0.f;
    LAS unsigned* flags = (LAS unsigned*)(lds + OFF_FLAG);
    if (TYPE != 0 && lane == 0) { flags[wid] = wave_on ? 0u : 1u; flags[8 + wid] = wave_on ? 0u : 1u; }
    const int pir = (r32 & ~12) | ((r32 & 4) << 1) | ((r32 & 8) >> 1);
    const int krd = pir * KP + 16 * hh;
    const int vrd = (8 * hh + ((lane & 15) >> 2)) * VP + 32 * ((lane >> 4) & 1) + 8 * (lane & 3);
    ATT_LOAD(jmax); ATT_STORE(0);
    for (int j = jmax; j >= 0; --j) {
        const int buf = (jmax - j) & 1;
        if (j > 0) ATT_LOAD(j - 1);
        __syncthreads();
        if (TYPE != 0) { const u32x4 f0 = *(const LAS u32x4*)(flags + 8 * buf), f1 = *(const LAS u32x4*)(flags + 8 * buf + 4);
            const unsigned all = f0.x & f0.y & f0.z & f0.w & f1.x & f1.y & f1.z & f1.w; if (__builtin_amdgcn_readfirstlane(all)) break; }
        if (wave_on && !wdone && j <= wjmax) {
            const LAS unsigned char* Kb = lds + buf * BUFB; const LAS unsigned char* Vb = Kb + KBYTES;
            f32x16 s0, s1;
            {
                bf16x8 kf0[NS], kf1[NS];
#pragma unroll
                for (int s = 0; s < NS; ++s) { kf0[s] = *(const LAS bf16x8*)(Kb + krd + 32 * s); kf1[s] = *(const LAS bf16x8*)(Kb + krd + 32 * KP + 32 * s); }
                __builtin_amdgcn_sched_barrier(0);

#pragma unroll
                for (int s = 0; s < NS; ++s) { if (s == 0) { s0 = MFMA32(kf0[0], qf[0], negc); s1 = MFMA32(kf1[0], qf[0], negc); } else { s0 = MFMA32(kf0[s], qf[s], s0); s1 = MFMA32(kf1[s], qf[s], s1); } }

                __builtin_amdgcn_sched_barrier(0);
            }
            s16x4 vl[2][4], vh[2][4];
#pragma unroll
            for (int ks = 0; ks < 4; ++ks) { vl[0][ks] = tr_rd(Vb + vrd + (16 * ks) * VP); vh[0][ks] = tr_rd(Vb + vrd + (16 * ks + 4) * VP); }
            __builtin_amdgcn_sched_barrier(0);
            const int kb0 = 64 * j + 8 * hh;
            const bool need_mask = TYPE == 0 ? (64 * j + 63 >= nkeys) : TYPE == 1 ? (64 * j + 63 > qp_lo) : (64 * j + 63 >= qp_lo);
            if (TYPE != 2) {
                if (TYPE == 1) { const LAS float* F = (const LAS float*)(lds + OFF_F) + buf * 64 + 8 * hh;
#pragma unroll
                    for (int a = 0; a < 2; ++a) { const f32x4 f0 = *(const LAS f32x4*)(F + 16 * a), f1 = *(const LAS f32x4*)(F + 16 * a + 4), g0 = *(const LAS f32x4*)(F + 32 + 16 * a), g1 = *(const LAS f32x4*)(F + 32 + 16 * a + 4);
#pragma unroll
                        for (int e = 0; e < 4; ++e) { s0[8 * a + e] -= f0[e]; s0[8 * a + 4 + e] -= f1[e]; s1[8 * a + e] -= g0[e]; s1[8 * a + 4 + e] -= g1[e]; } } }
                if (need_mask) {
#pragma unroll
                    for (int i = 0; i < 16; ++i) { const int k0 = kb0 + 16 * (i >> 3) + (i & 7), k1 = k0 + 32;
                        const bool ok0 = TYPE == 0 ? (k0 < nkeys) : (k0 <= qpos), ok1 = TYPE == 0 ? (k1 < nkeys) : (k1 <= qpos);
                        s0[i] = ok0 ? s0[i] : -INFINITY; s1[i] = ok1 ? s1[i] : -INFINITY; } }
#define MX3(a, b, c) __builtin_fmaxf(__builtin_fmaxf((a), (b)), (c))
                float rm;
                { const float t0 = MX3(s0[0], s0[1], s0[2]), t1 = MX3(s0[3], s0[4], s0[5]), t2 = MX3(s0[6], s0[7], s0[8]), t3 = MX3(s0[9], s0[10], s0[11]), t4 = MX3(s0[12], s0[13], s0[14]),
                              t5 = MX3(s1[0], s1[1], s1[2]), t6 = MX3(s1[3], s1[4], s1[5]), t7 = MX3(s1[6], s1[7], s1[8]), t8 = MX3(s1[9], s1[10], s1[11]), t9 = MX3(s1[12], s1[13], s1[14]);
                  const float u0 = MX3(t0, t1, t2), u1 = MX3(t3, t4, t5), u2 = MX3(t6, t7, t8), u3 = MX3(t9, s0[15], s1[15]); rm = __builtin_fmaxf(MX3(u0, u1, u2), u3); }
#undef MX3
                rm = half_swap_max(rm);
                const bool first = (j == wjmax);
                if (first || __any(rm > 8.0f)) {
                    const float dl = first ? rm : fmaxf(rm, 0.f);
                    mrun += dl;
#pragma unroll
                    for (int i = 0; i < 16; ++i) { s0[i] -= dl; s1[i] -= dl; }
                    const float cin = (TYPE == 1 ? fq : 0.f) - mrun;
#pragma unroll
                    for (int i = 0; i < 16; ++i) negc[i] = cin;
                    if (!first) { const float f = __builtin_amdgcn_exp2f(-dl); lrun *= f;
#pragma unroll
                        for (int d = 0; d < NDB; ++d)
#pragma unroll
                            for (int i = 0; i < 16; ++i) o[d][i] *= f; }
                }
                f32x2_t ls2 = {0.f, 0.f};
#pragma unroll
                for (int i = 0; i < 16; ++i) { s0[i] = __builtin_amdgcn_exp2f(s0[i]); s1[i] = __builtin_amdgcn_exp2f(s1[i]); }
#pragma unroll
                for (int i = 0; i < 16; i += 2) { ls2 += (f32x2_t){s0[i], s0[i + 1]}; ls2 += (f32x2_t){s1[i], s1[i + 1]}; }
                lrun += ls2[0] + ls2[1];
                if (TYPE == 1 && j > 0) { const float fnext = WSP(const float, WS_FB)[(size_t)(krow0 + 64 * j - 1) * 4 + h]; wdone = __all(bound + (fq - fnext) - mrun < EXIT_LOG2); }
            } else {
                f32x16 lk0, lk1;
#pragma unroll
                for (int i = 0; i < 16; ++i) {
                    const float z0 = s0[i], z1 = s1[i];
                    const float sp0 = fmaxf(z0, 0.f) + __builtin_amdgcn_logf(1.0f + __builtin_amdgcn_exp2f(-fabsf(z0))), sp1 = fmaxf(z1, 0.f) + __builtin_amdgcn_logf(1.0f + __builtin_amdgcn_exp2f(-fabsf(z1)));
                    lk0[i] = -sp0; lk1[i] = -sp1; s0[i] = z0 - sp0; s1[i] = z1 - sp1; }
                if (need_mask) {
#pragma unroll
                    for (int i = 0; i < 16; ++i) { const int k0 = kb0 + 16 * (i >> 3) + (i & 7), k1 = k0 + 32; const bool ok0 = k0 < qpos, ok1 = k1 < qpos;
                        lk0[i] = ok0 ? lk0[i] : 0.f; lk1[i] = ok1 ? lk1[i] : 0.f; s0[i] = ok0 ? s0[i] : -INFINITY; s1[i] = ok1 ? s1[i] : -INFINITY; } }
                f32x16 sf0, sf1; float gt[4];
#pragma unroll
                for (int a = 0; a < 2; ++a) { float r0 = 0.f, r1 = 0.f;
#pragma unroll
                    for (int e = 7; e >= 0; --e) { sf0[8 * a + e] = r0; r0 += lk0[8 * a + e]; sf1[8 * a + e] = r1; r1 += lk1[8 * a + e]; }
                    gt[a] = r0; gt[2 + a] = r1; }
                float pt[4], gs[4];
#pragma unroll
                for (int c = 0; c < 4; ++c) pt[c] = __shfl_xor(gt[c], 32);
                float later = 0.f;
#pragma unroll
                for (int c = 3; c >= 0; --c) { gs[c] = later + (hh == 0 ? pt[c] : 0.f); later += gt[c] + pt[c]; }
#pragma unroll
                for (int i = 0; i < 16; ++i) { s0[i] = __builtin_amdgcn_exp2f(s0[i] + sf0[i] + gs[i >> 3] + carry); s1[i] = __builtin_amdgcn_exp2f(s1[i] + sf1[i] + gs[2 + (i >> 3)] + carry); }
                carry += later;
                wdone = __all(carry < EXIT_LOG2);
            }
            bf16x8 pk[4]; pk[0] = pack8(s0, 0); pk[1] = pack8(s0, 8); pk[2] = pack8(s1, 0); pk[3] = pack8(s1, 8);
            {
#pragma unroll
                for (int d = 0; d < NDB; ++d) {
                    if (d + 1 < NDB) {
#pragma unroll
                        for (int ks = 0; ks < 4; ++ks) { vl[(d + 1) & 1][ks] = tr_rd(Vb + vrd + (16 * ks) * VP + 64 * (d + 1)); vh[(d + 1) & 1][ks] = tr_rd(Vb + vrd + (16 * ks + 4) * VP + 64 * (d + 1)); } }
                    __builtin_amdgcn_sched_barrier(0);

#pragma unroll
                    for (int ks = 0; ks < 4; ++ks) { const bf16x8 vf = __builtin_shufflevector(vl[d & 1][ks], vh[d & 1][ks], 0, 1, 2, 3, 4, 5, 6, 7); o[d] = MFMA32(vf, pk[ks], o[d]); }

                    __builtin_amdgcn_sched_barrier(0);
                }
            }
        }
        if (TYPE != 0 && lane == 0) flags[8 * (buf ^ 1) + wid] = wdone ? 1u : 0u;
        if (j > 0) ATT_STORE(buf ^ 1);
    }
    __syncthreads();
    if (wave_on) {
        float inv = 1.0f;
        if (TYPE != 2) { const float lt = half_swap_sum(lrun); inv = 1.0f / lt; }
        float ssq = 0.f;
#pragma unroll
        for (int d = 0; d < NDB; ++d)
#pragma unroll
            for (int i = 0; i < 16; ++i) { o[d][i] *= inv; ssq += o[d][i] * o[d][i]; }
        ssq = half_swap_sum(ssq);
        const bool rowok = 32 * wid + r32 < nq;
        if (rowok) {
            if (hh == 0) WSP(float, WS_SS)[(size_t)qrow * 12 + TYPE * 4 + h] = ssq;
            const int col0 = (TYPE == 0 ? 0 : TYPE == 1 ? 512 : 768) + h * DV + 4 * hh;
#pragma unroll
            for (int d = 0; d < NDB; ++d) { u32x2 gw[4];
#pragma unroll
                for (int g = 0; g < 4; ++g) gw[g] = *(const u32x2*)(WSP(const bf16_t, WS_GATE) + (size_t)qrow * D + col0 + 32 * d + 8 * g);
#pragma unroll
                for (int g = 0; g < 4; ++g) { u32x2 w; w.x = cvtpk(o[d][4 * g] * bf_lo(gw[g].x), o[d][4 * g + 1] * bf_hi(gw[g].x)); w.y = cvtpk(o[d][4 * g + 2] * bf_lo(gw[g].y), o[d][4 * g + 3] * bf_hi(gw[g].y));
                    *(u32x2*)(WSP(bf16_t, WS_OP) + (size_t)qrow * D + col0 + 32 * d + 8 * g) = w; } }
        }
    }
#undef ATT_LOAD
#undef ATT_STORE
}

template <int TYPE>
__device__ __forceinline__ void attn_pp(unsigned char* ws, LAS unsigned char* lds, int l, int qrow0, int krow0, int qpos0, int h) {
    constexpr int DQK = TYPE == 0 ? 96 : 64, DV = TYPE == 0 ? 128 : 64, NS = DQK / 16, NDB = DV / 32;
    constexpr int KP = TYPE == 0 ? 208 : 144, VP = TYPE == 0 ? 320 : 192;
    constexpr int KBYTES = 64 * KP, VBYTES = 64 * VP, OFF_V = 3 * KBYTES, OFF_F = OFF_V + 3 * VBYTES, OFF_FLAG = OFF_F + 3 * 256;
    const int tid = fresh_tid(), lane = tid & 63, wid = __builtin_amdgcn_readfirstlane(tid >> 6), r32 = lane & 31, hh = lane >> 5;
    const bool lag = wid >= 4;
    const int qrow = qrow0 + 32 * wid + r32, qpos = qpos0 + 32 * wid + r32, qp_lo = qpos0 + 32 * wid, qp_hi = qp_lo + 31;
    const int jmax = (qpos0 + 255) >> 6;
    const int wjmax = TYPE == 0 ? (qp_lo >> 6) : TYPE == 1 ? (qp_hi >> 6) : ((qp_hi - 1) >> 6);
    constexpr bool ASC = (TYPE == 0);
#define PP_T(i) (ASC ? (i) : jmax - (i))
    const size_t Kg = TYPE == 0 ? WS_KA : TYPE == 1 ? WS_KB : WS_KC, Vg = TYPE == 0 ? WS_VA : TYPE == 1 ? WS_VB : WS_VC;
    constexpr int NKC = TYPE == 0 ? 2 : 1, NVC = TYPE == 0 ? 2 : 1;
    unsigned ksrc[NKC]; int kdst[NKC]; unsigned vsrc[NVC]; int vdst[NVC];
#pragma unroll
    for (int r = 0; r < NKC; ++r) {
        if (TYPE == 0) {
            if (r == 0) { const int row = tid >> 3, c = tid & 7; ksrc[r] = (unsigned)(WS_KA + ((size_t)(krow0 + row) * 256 + h * 64 + c * 8) * 2); kdst[r] = row * KP + c * 16; }
            else { const int row = (tid & 255) >> 2, c = tid & 3; ksrc[r] = (unsigned)(kr_off(l) + ((size_t)(krow0 + row) * 32 + c * 8) * 2); kdst[r] = row * KP + 128 + c * 16; } }
        else { const int row = tid >> 3, c = tid & 7; ksrc[r] = (unsigned)(Kg + ((size_t)(krow0 + row) * 256 + h * 64 + c * 8) * 2); kdst[r] = row * KP + c * 16; }
    }
#pragma unroll
    for (int r = 0; r < NVC; ++r) {
        if (TYPE == 0) { const int row = tid >> 4, c = tid & 15; vsrc[r] = (unsigned)(WS_VA + ((size_t)(krow0 + row) * 512 + h * 128 + c * 8) * 2); vdst[r] = row * VP + c * 16; }
        else { const int row = tid >> 3, c = tid & 7; vsrc[r] = (unsigned)(Vg + ((size_t)(krow0 + row) * 256 + h * 64 + c * 8) * 2); vdst[r] = row * VP + c * 16; }
    }
    constexpr unsigned kstepA = 64u * 256u * 2u, kstepR = 64u * 32u * 2u, vstep = 64u * (TYPE == 0 ? 512u : 256u) * 2u;
    u32x4 kreg[NKC], vreg[NVC]; float freg = 0.f;
#define PP_KLOAD(j) do { _Pragma("unroll") for (int r_ = 0; r_ < NKC; ++r_) kreg[r_] = *(const u32x4*)(ws + (ksrc[r_] + (unsigned)(j) * (r_ == 1 ? kstepR : kstepA))); \
        if (TYPE == 1) freg = WSP(const float, WS_FB)[(size_t)(krow0 + 64 * (j) + lane) * 4 + h]; } while (0)
#define PP_VLOAD(j) do { _Pragma("unroll") for (int r_ = 0; r_ < NVC; ++r_) vreg[r_] = *(const u32x4*)((ws + (size_t)r_ * 32 * 1024) + (vsrc[0] + (unsigned)(j) * vstep)); } while (0)
#define PP_KSTORE(sl) do { LAS unsigned char* kb_ = lds + (sl) * KBYTES; \
        _Pragma("unroll") for (int r_ = 0; r_ < NKC; ++r_) *(LAS u32x4*)(kb_ + kdst[r_]) = kreg[r_]; \
        if (TYPE == 1) ((LAS float*)(lds + OFF_F))[(sl) * 64 + lane] = freg; } while (0)
#define PP_VSTORE(sl) do { LAS unsigned char* vb_ = lds + OFF_V + (sl) * VBYTES; \
        _Pragma("unroll") for (int r_ = 0; r_ < NVC; ++r_) *(LAS u32x4*)(vb_ + vdst[0] + r_ * 32 * VP) = vreg[r_]; } while (0)
    bf16x8 qf[NS];
    { const bf16_t* qp = TYPE == 0 ? WSP(const bf16_t, WS_QA) + (size_t)qrow * 384 + h * 96 : (TYPE == 1 ? WSP(const bf16_t, WS_QB) : WSP(const bf16_t, WS_QC)) + (size_t)qrow * 256 + h * 64;
#pragma unroll
      for (int s = 0; s < NS; ++s) qf[s] = *(const bf16x8*)(qp + 16 * s + 8 * hh); }
    float fq = 0.f; if (TYPE == 1) fq = WSP(const float, WS_FB)[(size_t)(krow0 + qpos) * 4 + h];
    float bound = INFINITY;
    if (TYPE == 1) {
        float qn = 0.f;
#pragma unroll
        for (int s = 0; s < NS; ++s)
#pragma unroll
            for (int e = 0; e < 8; ++e) { const float x = __uint_as_float((unsigned)(unsigned short)qf[s][e] << 16); qn += x * x; }
        qn = half_swap_sum(qn);
        const unsigned* km = WSP(const unsigned, WS_CTL) + CW_KMAX + ((l * 4 + krow0 / PT) * 4 + h) * 2;
        bound = sqrtf(qn * (__uint_as_float(km[0]) + __uint_as_float(km[1]))) * 1.02f + 1.0f;
    }
    f32x16 o[NDB];
#pragma unroll
    for (int d = 0; d < NDB; ++d)
#pragma unroll
        for (int i = 0; i < 16; ++i) o[d][i] = 0.f;
    float mrun = 0.f, lrun = 0.f, carry = 0.f; bool wdone = false, pend = false, brk = false;
    f32x16 negc;
#pragma unroll
    for (int i = 0; i < 16; ++i) negc[i] = (TYPE == 1) ? fq : 0.f;
    LAS unsigned* flags = (LAS unsigned*)(lds + OFF_FLAG);
    const int pir = (r32 & ~12) | ((r32 & 4) << 1) | ((r32 & 8) >> 1);
    const int krd = pir * KP + 16 * hh;
    const int vrd = (8 * hh + ((lane & 15) >> 2)) * VP + 32 * ((lane >> 4) & 1) + 8 * (lane & 3);
    f32x16 s0, s1; bf16x8 pk[4];
#pragma unroll
    for (int i = 0; i < 16; ++i) { s0[i] = 0.f; s1[i] = 0.f; }
#pragma unroll
    for (int i = 0; i < 4; ++i) pk[i] = (bf16x8){0, 0, 0, 0, 0, 0, 0, 0};
#define PP_KRD(sl) do { const LAS unsigned char* Kb_ = lds + (sl) * KBYTES; \
        _Pragma("unroll") for (int s = 0; s < NS; ++s) { kf0[s] = *(const LAS bf16x8*)(Kb_ + krd + 32 * s); kf1[s] = *(const LAS bf16x8*)(Kb_ + krd + 32 * KP + 32 * s); } } while (0)
#define PP_QKM() do { __builtin_amdgcn_sched_barrier(0); \
        _Pragma("unroll") for (int s = 0; s < NS; ++s) { if (s == 0) { s0 = MFMA32(kf0[0], qf[0], negc); s1 = MFMA32(kf1[0], qf[0], negc); } else { s0 = MFMA32(kf0[s], qf[s], s0); s1 = MFMA32(kf1[s], qf[s], s1); } } \
        __builtin_amdgcn_sched_barrier(0); } while (0)
#define PP_VRD(sl, d) do { const LAS unsigned char* Vb_ = lds + OFF_V + (sl) * VBYTES; \
        _Pragma("unroll") for (int ks = 0; ks < 4; ++ks) { vl[d][ks] = tr_rd(Vb_ + vrd + (16 * ks) * VP + 64 * (d)); vh[d][ks] = tr_rd(Vb_ + vrd + (16 * ks + 4) * VP + 64 * (d)); } } while (0)
#define PP_PVM(d) do { _Pragma("unroll") for (int ks = 0; ks < 4; ++ks) { const bf16x8 vf = __builtin_shufflevector(vl[d][ks], vh[d][ks], 0, 1, 2, 3, 4, 5, 6, 7); o[d] = MFMA32(vf, pk[ks], o[d]); } } while (0)
    PP_KLOAD(PP_T(0)); PP_VLOAD(PP_T(0)); PP_KSTORE(0); PP_VSTORE(0);
    PP_KLOAD(PP_T(1)); PP_KSTORE(1);
    PP_KLOAD(PP_T(2)); PP_VLOAD(PP_T(1));
    __syncthreads();
    if (PP_T(0) <= wjmax) { bf16x8 kf0[NS], kf1[NS]; PP_KRD(0); PP_QKM(); }
    if (lag) { __builtin_amdgcn_s_setprio(1); __syncthreads(); }
    int c = 0;
    for (int it = 0; it <= jmax; ++it) {
        const int j = PP_T(it), jn = PP_T(it + 1);
        const int c1 = c == 2 ? 0 : c + 1, c2 = c1 == 2 ? 0 : c1 + 1;
        bf16x8 kf0[NS], kf1[NS];
        s16x4 vl[NDB][4], vh[NDB][4];
        __syncthreads();
        if (TYPE != 0 && !lag && it > 0) { const u32x4 f0 = *(const LAS u32x4*)(flags + 8 * ((j + 1) & 1)), f1 = *(const LAS u32x4*)(flags + 8 * ((j + 1) & 1) + 4);
            const unsigned all = f0.x & f0.y & f0.z & f0.w & f1.x & f1.y & f1.z & f1.w; if (__builtin_amdgcn_readfirstlane(all)) { brk = true; break; } }
        PP_KSTORE(c2); PP_VSTORE(c1);
        const bool doq = it < jmax && jn <= wjmax && !wdone;
        PP_KRD(c1);
        { const int ik = it + 3 <= jmax ? it + 3 : jmax, iv = it + 2 <= jmax ? it + 2 : jmax; PP_KLOAD(PP_T(ik)); PP_VLOAD(PP_T(iv)); }
        if (j <= wjmax && !wdone) {
            const int kb0 = 64 * j + 8 * hh;
            const bool need_mask = TYPE == 0 ? false : TYPE == 1 ? (64 * j + 63 > qp_lo) : (64 * j + 63 >= qp_lo);
            if (TYPE != 2) {
                if (TYPE == 1) { const LAS float* F = (const LAS float*)(lds + OFF_F) + c * 64 + 8 * hh;
#pragma unroll
                    for (int a = 0; a < 2; ++a) { const f32x4 f0 = *(const LAS f32x4*)(F + 16 * a), f1 = *(const LAS f32x4*)(F + 16 * a + 4), g0 = *(const LAS f32x4*)(F + 32 + 16 * a), g1 = *(const LAS f32x4*)(F + 32 + 16 * a + 4);
#pragma unroll
                        for (int e = 0; e < 4; ++e) { s0[8 * a + e] -= f0[e]; s0[8 * a + 4 + e] -= f1[e]; s1[8 * a + e] -= g0[e]; s1[8 * a + 4 + e] -= g1[e]; } } }
                if (need_mask) {
#pragma unroll
                    for (int i = 0; i < 16; ++i) { const int k0 = kb0 + 16 * (i >> 3) + (i & 7), k1 = k0 + 32;
                        s0[i] = (k0 <= qpos) ? s0[i] : -INFINITY; s1[i] = (k1 <= qpos) ? s1[i] : -INFINITY; } }
#define MX3(a, b, c) __builtin_fmaxf(__builtin_fmaxf((a), (b)), (c))
                float rm;
                { const float t0 = MX3(s0[0], s0[1], s0[2]), t1 = MX3(s0[3], s0[4], s0[5]), t2 = MX3(s0[6], s0[7], s0[8]), t3 = MX3(s0[9], s0[10], s0[11]), t4 = MX3(s0[12], s0[13], s0[14]),
                              t5 = MX3(s1[0], s1[1], s1[2]), t6 = MX3(s1[3], s1[4], s1[5]), t7 = MX3(s1[6], s1[7], s1[8]), t8 = MX3(s1[9], s1[10], s1[11]), t9 = MX3(s1[12], s1[13], s1[14]);
                  const float u0 = MX3(t0, t1, t2), u1 = MX3(t3, t4, t5), u2 = MX3(t6, t7, t8), u3 = MX3(t9, s0[15], s1[15]); rm = __builtin_fmaxf(MX3(u0, u1, u2), u3); }
#undef MX3
                rm = half_swap_max(rm);
                const bool first = ASC ? (it == 0) : (j == wjmax);
                if (first || __any(rm > 8.0f)) {
                    const float dl = first ? rm : fmaxf(rm, 0.f);
                    mrun += dl;
#pragma unroll
                    for (int i = 0; i < 16; ++i) { s0[i] -= dl; s1[i] -= dl; }
                    { const float cin = (TYPE == 1 ? fq : 0.f) - mrun;
#pragma unroll
                      for (int i = 0; i < 16; ++i) negc[i] = cin; }
                    if (!first) { const float f = __builtin_amdgcn_exp2f(-dl); lrun *= f;
#pragma unroll
                        for (int d = 0; d < NDB; ++d)
#pragma unroll
                            for (int i = 0; i < 16; ++i) o[d][i] *= f; }
                }
                f32x2_t ls2 = {0.f, 0.f};
#pragma unroll
                for (int i = 0; i < 16; ++i) { s0[i] = __builtin_amdgcn_exp2f(s0[i]); s1[i] = __builtin_amdgcn_exp2f(s1[i]); }
#pragma unroll
                for (int i = 0; i < 16; i += 2) { ls2 += (f32x2_t){s0[i], s0[i + 1]}; ls2 += (f32x2_t){s1[i], s1[i + 1]}; }
                lrun += ls2[0] + ls2[1];
                if (TYPE == 1 && j > 0) { const float fnext = ((const LAS float*)(lds + OFF_F))[c1 * 64 + 63]; wdone = __all(bound + (fq - fnext) - mrun < EXIT_LOG2); }
            } else {
                f32x16 lk0, lk1;
#pragma unroll
                for (int i = 0; i < 16; ++i) {
                    const float z0 = s0[i], z1 = s1[i];
                    const float sp0 = fmaxf(z0, 0.f) + __builtin_amdgcn_logf(1.0f + __builtin_amdgcn_exp2f(-fabsf(z0))), sp1 = fmaxf(z1, 0.f) + __builtin_amdgcn_logf(1.0f + __builtin_amdgcn_exp2f(-fabsf(z1)));
                    lk0[i] = -sp0; lk1[i] = -sp1; s0[i] = z0 - sp0; s1[i] = z1 - sp1; }
                if (need_mask) {
#pragma unroll
                    for (int i = 0; i < 16; ++i) { const int k0 = kb0 + 16 * (i >> 3) + (i & 7), k1 = k0 + 32; const bool ok0 = k0 < qpos, ok1 = k1 < qpos;
                        lk0[i] = ok0 ? lk0[i] : 0.f; lk1[i] = ok1 ? lk1[i] : 0.f; s0[i] = ok0 ? s0[i] : -INFINITY; s1[i] = ok1 ? s1[i] : -INFINITY; } }
                f32x16 sf0, sf1; float gt[4];
#pragma unroll
                for (int a = 0; a < 2; ++a) { float r0 = 0.f, r1 = 0.f;
#pragma unroll
                    for (int e = 7; e >= 0; --e) { sf0[8 * a + e] = r0; r0 += lk0[8 * a + e]; sf1[8 * a + e] = r1; r1 += lk1[8 * a + e]; }
                    gt[a] = r0; gt[2 + a] = r1; }
                float pt[4], gs[4];
#pragma unroll
                for (int cc = 0; cc < 4; ++cc) pt[cc] = __shfl_xor(gt[cc], 32);
                float later = 0.f;
#pragma unroll
                for (int cc = 3; cc >= 0; --cc) { gs[cc] = later + (hh == 0 ? pt[cc] : 0.f); later += gt[cc] + pt[cc]; }
#pragma unroll
                for (int i = 0; i < 16; ++i) { s0[i] = __builtin_amdgcn_exp2f(s0[i] + sf0[i] + gs[i >> 3] + carry); s1[i] = __builtin_amdgcn_exp2f(s1[i] + sf1[i] + gs[2 + (i >> 3)] + carry); }
                carry += later;
                wdone = __all(carry < EXIT_LOG2);
            }
            pk[0] = pack8(s0, 0); pk[1] = pack8(s0, 8); pk[2] = pack8(s1, 0); pk[3] = pack8(s1, 8); pend = true;
        }
        if (TYPE != 0 && lane == 0) flags[8 * (j & 1) + wid] = wdone ? 1u : 0u;
        __syncthreads();
        bool allq = false;
        if (TYPE != 0 && lag) { const u32x4 f0 = *(const LAS u32x4*)(flags + 8 * (j & 1)), f1 = *(const LAS u32x4*)(flags + 8 * (j & 1) + 4);
            const unsigned all = f0.x & f0.y & f0.z & f0.w & f1.x & f1.y & f1.z & f1.w; allq = __builtin_amdgcn_readfirstlane(all) != 0u; }
        if (pend) PP_VRD(c, 0);
        if (doq && !wdone && !allq) PP_QKM();
        if (pend) {
            PP_VRD(c, 1); if (NDB > 2) { PP_VRD(c, 2); PP_VRD(c, 3); }
            __builtin_amdgcn_sched_barrier(0);
            PP_PVM(0); PP_PVM(1);
            if (NDB > 2) { PP_PVM(2); PP_PVM(3); }
            __builtin_amdgcn_sched_barrier(0);
            pend = false; }
        if (allq) { brk = true; break; }
        c = c1;
    }
    if (!lag && !brk) __syncthreads();
    __builtin_amdgcn_s_setprio(0);
    __syncthreads();
#undef PP_T
#undef PP_KLOAD
#undef PP_VLOAD
#undef PP_KSTORE
#undef PP_VSTORE
#undef PP_KRD
#undef PP_QKM
#undef PP_VRD
#undef PP_PVM
    {
        float inv = 1.0f;
        if (TYPE != 2) { const float lt = half_swap_sum(lrun); inv = 1.0f / lt; }
        float ssq = 0.f;
#pragma unroll
        for (int d = 0; d < NDB; ++d)
#pragma unroll
            for (int i = 0; i < 16; ++i) { o[d][i] *= inv; ssq += o[d][i] * o[d][i]; }
        ssq = half_swap_sum(ssq);
        if (hh == 0) WSP(float, WS_SS)[(size_t)qrow * 12 + TYPE * 4 + h] = ssq;
        const int col0 = (TYPE == 0 ? 0 : TYPE == 1 ? 512 : 768) + h * DV + 4 * hh;
#pragma unroll
        for (int d = 0; d < NDB; ++d) { u32x2 gw[4];
#pragma unroll
            for (int g = 0; g < 4; ++g) gw[g] = *(const u32x2*)(WSP(const bf16_t, WS_GATE) + (size_t)qrow * D + col0 + 32 * d + 8 * g);
#pragma unroll
            for (int g = 0; g < 4; ++g) { u32x2 w; w.x = cvtpk(o[d][4 * g] * bf_lo(gw[g].x), o[d][4 * g + 1] * bf_hi(gw[g].x)); w.y = cvtpk(o[d][4 * g + 2] * bf_lo(gw[g].y), o[d][4 * g + 3] * bf_hi(gw[g].y));
                *(u32x2*)(WSP(bf16_t, WS_OP) + (size_t)qrow * D + col0 + 32 * d + 8 * g) = w; } }
    }
}

template <int TYPE>
__device__ __forceinline__ void sample_octet(unsigned char* ws, float* out, LAS unsigned char* lds, int l, int oct) {
    constexpr int DQK = TYPE == 0 ? 96 : 64, DV = TYPE == 0 ? 128 : 64, NS = DQK / 16, NDB = DV / 32, VP = TYPE == 0 ? 320 : 192;
    constexpr int NT = 65;
    const int tid = fresh_tid(), lane = tid & 63, wid = __builtin_amdgcn_readfirstlane(tid >> 6), r32 = lane & 31, hh = lane >> 5;
    const int unit = oct * 8 + wid, sb = unit >> 2, h = unit & 3;
    LAS unsigned char* Vl = lds + wid * 10240;
    const int krow0 = MP + sb * SPITCH, qrow = MP + sb * STN + min(r32, STN - 1), qpos = PAST + r32;
    bf16x8 qf[NS];
    { const bf16_t* qp = TYPE == 0 ? WSP(const bf16_t, WS_QA) + (size_t)qrow * 384 + h * 96 : (TYPE == 1 ? WSP(const bf16_t, WS_QB) : WSP(const bf16_t, WS_QC)) + (size_t)qrow * 256 + h * 64;
#pragma unroll
      for (int s = 0; s < NS; ++s) qf[s] = *(const bf16x8*)(qp + 16 * s + 8 * hh); }
    float fq = 0.f; if (TYPE == 1) fq = WSP(const float, WS_FB)[(size_t)(krow0 + min(qpos, SKEYS - 1)) * 4 + h];
    const int pir = (r32 & ~12) | ((r32 & 4) << 1) | ((r32 & 8) >> 1);
    const float* kc = nullptr; const float* vc = nullptr; const float* kn = nullptr; const float* vn = nullptr;
    if (TYPE != 0) { const size_t cb = ((size_t)l * SBN + sb) * PAST * 256 + h * 64, nb = ((size_t)l * MS + sb * STN) * 256 + h * 64;
        kc = inp(lds, TYPE == 1 ? 4 : 7) + cb; vc = inp(lds, TYPE == 1 ? 5 : 8) + cb; kn = out + (TYPE == 1 ? O_SFK : O_SSK) + nb; vn = out + (TYPE == 1 ? O_SFV : O_SSV) + nb; }
    const bf16_t* KAp = WSP(const bf16_t, WS_KA) + (size_t)krow0 * 256 + h * 64; const bf16_t* KRp = (const bf16_t*)(ws + kr_off(l)) + (size_t)krow0 * 32; const bf16_t* VAp = WSP(const bf16_t, WS_VA) + (size_t)krow0 * 512 + h * 128;
    constexpr int NKR = TYPE == 0 ? NS : 2 * NS, NVR = 8;
    constexpr int PD = 1;
    u32x4 kraw[PD][NKR], vraw[PD][NVR]; float fkr[2][2] = {{0.f, 0.f}, {0.f, 0.f}};
#define SO_LOAD(t, S) do { \
        if (TYPE == 0) { const size_t kr_ = (size_t)(32 * (t) + pir); \
            _Pragma("unroll") for (int s_ = 0; s_ < NS; ++s_) kraw[S][s_] = s_ < 4 ? *(const u32x4*)(KAp + kr_ * 256 + 16 * s_ + 8 * hh) : *(const u32x4*)(KRp + kr_ * 32 + 16 * (s_ - 4) + 8 * hh); \
            _Pragma("unroll") for (int i_ = 0; i_ < 8; ++i_) { const int m_ = lane + 64 * i_; vraw[S][i_] = *(const u32x4*)(VAp + (size_t)(32 * (t) + (m_ >> 4)) * 512 + (m_ & 15) * 8); } \
        } else { const float* kb_ = (t) < 64 ? kc + (size_t)(t) * 32 * 256 : kn; const float* vb_ = (t) < 64 ? vc + (size_t)(t) * 32 * 256 : vn; \
            const int rcap_ = (t) < 64 ? 31 : STN - 1;         \
            _Pragma("unroll") for (int s_ = 0; s_ < NS; ++s_) { const float* p_ = kb_ + (size_t)min(pir, rcap_) * 256 + 16 * s_ + 8 * hh; kraw[S][2 * s_] = *(const u32x4*)p_; kraw[S][2 * s_ + 1] = *(const u32x4*)(p_ + 4); } \
            _Pragma("unroll") for (int i_ = 0; i_ < 4; ++i_) { const int m_ = lane + 64 * i_; const float* p_ = vb_ + (size_t)min(m_ >> 3, rcap_) * 256 + (m_ & 7) * 8; vraw[S][2 * i_] = *(const u32x4*)p_; vraw[S][2 * i_ + 1] = *(const u32x4*)(p_ + 4); } \
            if (TYPE == 1) { fkr[S][0] = WSP(const float, WS_FB)[(size_t)(krow0 + 32 * (t) + 8 * hh + (lane & 7)) * 4 + h]; fkr[S][1] = WSP(const float, WS_FB)[(size_t)(krow0 + 32 * (t) + 16 + 8 * hh + (lane & 7)) * 4 + h]; } } } while (0)
#define F2B(a, b) (u32x4){cvtpk(__uint_as_float((a).x), __uint_as_float((a).y)), cvtpk(__uint_as_float((a).z), __uint_as_float((a).w)), cvtpk(__uint_as_float((b).x), __uint_as_float((b).y)), cvtpk(__uint_as_float((b).z), __uint_as_float((b).w))}
    f32x16 o[NDB];
#pragma unroll
    for (int d = 0; d < NDB; ++d)
#pragma unroll
        for (int i = 0; i < 16; ++i) o[d][i] = 0.f;
    float mrun = 0.f, lrun = 0.f, carry = 0.f; bool done = false;
    f32x16 negc;
#pragma unroll
    for (int i = 0; i < 16; ++i) negc[i] = (TYPE == 1) ? fq : 0.f;
    const int vrd = (8 * hh + ((lane & 15) >> 2)) * VP + 32 * ((lane >> 4) & 1) + 8 * (lane & 3);
#define SO_BODY(t, S) do { \
        bf16x8 kf[NS]; const float fk0 = fkr[S][0], fk1 = fkr[S][1]; \
        _Pragma("unroll") for (int s = 0; s < NS; ++s) kf[s] = TYPE == 0 ? __builtin_bit_cast(bf16x8, kraw[S][s]) : __builtin_bit_cast(bf16x8, F2B(kraw[S][2 * s], kraw[S][2 * s + 1])); \
        if (TYPE == 0) { _Pragma("unroll") for (int i = 0; i < 8; ++i) { const int m = lane + 64 * i; *(LAS u32x4*)(Vl + (m >> 4) * VP + (m & 15) * 16) = vraw[S][i]; } } \
        else { _Pragma("unroll") for (int i = 0; i < 4; ++i) { const int m = lane + 64 * i; *(LAS u32x4*)(Vl + (m >> 3) * VP + (m & 7) * 16) = F2B(vraw[S][2 * i], vraw[S][2 * i + 1]); } } \
        if ((t) >= PD) SO_LOAD((t) - PD, S); \
        f32x16 s0; \
         \
        _Pragma("unroll") for (int s = 0; s < NS; ++s) s0 = MFMA32(kf[s], qf[s], s == 0 ? negc : s0); \
         \
        const int kb0 = 32 * (t) + 8 * hh;                                          \
        const bool need_mask = ((t) == NT - 1); \
        if (TYPE != 2) { \
            if (TYPE == 1) {     \
                _Pragma("unroll") for (int i = 0; i < 16; ++i) { const float f = __shfl(i < 8 ? fk0 : fk1, (lane & 32) | (i & 7)); s0[i] -= f; } } \
            if (need_mask) { \
                _Pragma("unroll") for (int i = 0; i < 16; ++i) { const int k0 = kb0 + 16 * (i >> 3) + (i & 7); const bool ok = TYPE == 0 ? (k0 < SKEYS) : (k0 <= qpos); s0[i] = ok ? s0[i] : -INFINITY; } } \
            float rm = s0[0]; \
            _Pragma("unroll") for (int i = 1; i < 16; ++i) rm = fmaxf(rm, s0[i]); \
            rm = half_swap_max(rm); \
            const bool first = ((t) == NT - 1); \
            if (first || __any(rm > 8.0f)) { \
                const float dl = first ? rm : fmaxf(rm, 0.f); \
                mrun += dl; \
                _Pragma("unroll") for (int i = 0; i < 16; ++i) s0[i] -= dl; \
                const float cin = (TYPE == 1 ? fq : 0.f) - mrun; \
                _Pragma("unroll") for (int i = 0; i < 16; ++i) negc[i] = cin; \
                if (!first) { const float f = __builtin_amdgcn_exp2f(-dl); lrun *= f; \
                    _Pragma("unroll") for (int d = 0; d < NDB; ++d) _Pragma("unroll") for (int i = 0; i < 16; ++i) o[d][i] *= f; } \
            } \
            float ls = 0.f; \
            _Pragma("unroll") for (int i = 0; i < 16; ++i) { s0[i] = __builtin_amdgcn_exp2f(s0[i]); ls += s0[i]; } \
            lrun += ls; \
        } else { \
            f32x16 lk0; \
            _Pragma("unroll") for (int i = 0; i < 16; ++i) { const float z0 = s0[i]; const float sp0 = fmaxf(z0, 0.f) + __builtin_amdgcn_logf(1.0f + __builtin_amdgcn_exp2f(-fabsf(z0))); lk0[i] = -sp0; s0[i] = z0 - sp0; } \
            if (need_mask) { \
                _Pragma("unroll") for (int i = 0; i < 16; ++i) { const int k0 = kb0 + 16 * (i >> 3) + (i & 7); const bool ok = k0 < qpos; lk0[i] = ok ? lk0[i] : 0.f; s0[i] = ok ? s0[i] : -INFINITY; } } \
            f32x16 sf0; float gt[2]; \
            _Pragma("unroll") for (int a = 0; a < 2; ++a) { float r0 = 0.f; \
                _Pragma("unroll") for (int e = 7; e >= 0; --e) { sf0[8 * a + e] = r0; r0 += lk0[8 * a + e]; } \
                gt[a] = r0; } \
            float pt[2], gs[2]; \
            _Pragma("unroll") for (int c = 0; c < 2; ++c) pt[c] = __shfl_xor(gt[c], 32); \
            float later = 0.f; \
            _Pragma("unroll") for (int c = 1; c >= 0; --c) { gs[c] = later + (hh == 0 ? pt[c] : 0.f); later += gt[c] + pt[c]; } \
            _Pragma("unroll") for (int i = 0; i < 16; ++i) s0[i] = __builtin_amdgcn_exp2f(s0[i] + sf0[i] + gs[i >> 3] + carry); \
            carry += later; \
        } \
        bf16x8 pk[2]; pk[0] = pack8(s0, 0); pk[1] = pack8(s0, 8); \
        {     \
            s16x4 vl[NDB][2], vh[NDB][2]; \
            _Pragma("unroll") for (int d = 0; d < NDB; ++d) _Pragma("unroll") for (int ks = 0; ks < 2; ++ks) { vl[d][ks] = tr_rd(Vl + vrd + (16 * ks) * VP + 64 * d); vh[d][ks] = tr_rd(Vl + vrd + (16 * ks + 4) * VP + 64 * d); } \
             \
            _Pragma("unroll") for (int d = 0; d < NDB; ++d) _Pragma("unroll") for (int ks = 0; ks < 2; ++ks) { const bf16x8 vf = __builtin_shufflevector(vl[d][ks], vh[d][ks], 0, 1, 2, 3, 4, 5, 6, 7); o[d] = MFMA32(vf, pk[ks], o[d]); } \
             \
        } \
        if (TYPE == 2) done = __all(carry < EXIT_LOG2);        \
    } while (0)
    if (PD == 1) {
        SO_LOAD(NT - 1, 0);
        for (int t = NT - 1; t >= 0; --t) { SO_BODY(t, 0); if (TYPE == 2 && done) break; }
    } else {
        SO_LOAD(NT - 1, 0); SO_LOAD(NT - 2, PD - 1);
        for (int t = NT - 1; t >= 0; t -= 2) {
            SO_BODY(t, 0); if (done) break;
            if (t >= 1) { SO_BODY(t - 1, PD - 1); if (done) break; }
        }
    }
#undef SO_BODY
#undef SO_LOAD
#undef F2B
    {
        float inv = 1.0f;
        if (TYPE != 2) { const float lt = half_swap_sum(lrun); inv = 1.0f / lt; }
        float ssq = 0.f;
#pragma unroll
        for (int d = 0; d < NDB; ++d)
#pragma unroll
            for (int i = 0; i < 16; ++i) { o[d][i] *= inv; ssq += o[d][i] * o[d][i]; }
        ssq = half_swap_sum(ssq);
        if (r32 < STN) {
            if (hh == 0) WSP(float, WS_SS)[(size_t)qrow * 12 + TYPE * 4 + h] = ssq;
            const int col0 = (TYPE == 0 ? 0 : TYPE == 1 ? 512 : 768) + h * DV + 4 * hh;
#pragma unroll
            for (int d = 0; d < NDB; ++d) { u32x2 gw[4];
#pragma unroll
                for (int g = 0; g < 4; ++g) gw[g] = *(const u32x2*)(WSP(const bf16_t, WS_GATE) + (size_t)qrow * D + col0 + 32 * d + 8 * g);
#pragma unroll
                for (int g = 0; g < 4; ++g) { u32x2 w; w.x = cvtpk(o[d][4 * g] * bf_lo(gw[g].x), o[d][4 * g + 1] * bf_hi(gw[g].x)); w.y = cvtpk(o[d][4 * g + 2] * bf_lo(gw[g].y), o[d][4 * g + 3] * bf_hi(gw[g].y));
                    *(u32x2*)(WSP(bf16_t, WS_OP) + (size_t)qrow * D + col0 + 32 * d + 8 * g) = w; } }
        }
    }
    __syncthreads();
}
constexpr int CV_CHUNKS = 4096, N_CV_CKV = SBN * PAST * 256 / 8 / CV_CHUNKS, N_CV_KPE = SBN * PAST * 32 / 8 / CV_CHUNKS, N_CV = N_CV_CKV + N_CV_KPE;
constexpr int P0_I0 = 16 * (NINP / 32), P0_I1 = 4 * 24, P0_I2 = 16 * 32, P0_IL = P0_I0 + P0_I1 + P0_I2, N_WT = P0_IL / 8;
static_assert(P0_IL % 8 == 0, "weight items per layer in units of 8");
__device__ __forceinline__ void conv_unit(unsigned char* ws, LAS unsigned char* lds, int ln, int u) {
    const int tid = fresh_tid();
    const bool ckv = u < N_CV_CKV; const int v = ckv ? u : u - N_CV_CKV;
    const float* src = ckv ? inp(lds, 2) + (size_t)ln * SBN * PAST * 256 : inp(lds, 3) + (size_t)ln * SBN * PAST * 32;
    f32x4 a[8], b[8];
#pragma unroll
    for (int k = 0; k < 8; ++k) { const size_t q = (size_t)v * CV_CHUNKS + tid + 512 * k; a[k] = *(const f32x4*)(src + q * 8); b[k] = *(const f32x4*)(src + q * 8 + 4); }
#pragma unroll
    for (int k = 0; k < 8; ++k) { const int q = v * CV_CHUNKS + tid + 512 * k;
        bf16_t* dst; if (ckv) dst = WSP(bf16_t, WS_CKVB) + (size_t)M * 256 + (size_t)q * 8; else { const int per_b = PAST * 32 / 8, sb = q / per_b, rem = q % per_b; dst = (bf16_t*)(ws + kr_off(ln)) + (size_t)MP * 32 + (size_t)sb * SPITCH * 32 + (size_t)rem * 8; }
        u32x4 o; o.x = cvtpk(a[k][0], a[k][1]); o.y = cvtpk(a[k][2], a[k][3]); o.z = cvtpk(b[k][0], b[k][1]); o.w = cvtpk(b[k][2], b[k][3]); *(u32x4*)dst = o; }
}
__device__ __forceinline__ void weight_unit(unsigned char* ws, LAS unsigned char* lds, int ln, int u) {
    const int tid = fresh_tid(), lane = tid & 63, wid = __builtin_amdgcn_readfirstlane(tid >> 6);
    LAS float* scr = (LAS float*)(lds + wid * 16384);
    int r = u * 8 + wid;
    if (r < P0_I0) p0_item(ws, lds, 0, ln, r, scr, lane);
    else if (r < P0_I0 + P0_I1) p0_item(ws, lds, 1, ln, r - P0_I0, scr, lane);
    else p0_item(ws, lds, 2, ln, r - P0_I0 - P0_I1, scr, lane);
}
constexpr int NU_P = 32 * 16, NU_S = SBN * 4 / 8, NU_T = NU_P + NU_S, NU_ALL = 3 * NU_T;
__device__ __forceinline__ int q_fetch(unsigned* head, LAS int* slot) {
    __syncthreads();
    if (threadIdx.x == 0) *slot = (int)__hip_atomic_fetch_add(head, 1u, __ATOMIC_RELAXED, __HIP_MEMORY_SCOPE_AGENT);
    __syncthreads();
    return __builtin_amdgcn_readfirstlane(*slot);
}
template <int TYPE>
__device__ __forceinline__ void attn_prompt(unsigned char* ws, LAS unsigned char* lds, int l, int xq, int v) {
    const int qb = 31 - (v >> 1), bh = 2 * xq + (v & 1), b = bh >> 2, h = bh & 3;
#ifndef PP_MASK
#define PP_MASK 7
#endif
    if ((PP_MASK >> TYPE) & 1) attn_pp<TYPE>(ws, lds, l, b * PT + qb * 256, b * PT, qb * 256, h);
    else attn_unit<TYPE, false>(ws, lds, l, b * PT + qb * 256, 256, b * PT, qb * 256, PT, h);
}
template <int TYPE>
__device__ __forceinline__ void prompt_queues(unsigned char* ws, LAS unsigned char* lds, int l, LAS int* slot) {
    const int x = (int)(xb_xcc_id() & 7u);
    unsigned* const hb = (unsigned*)(ws + WS_CTL) + CW_XQ + ((l * 3 + TYPE) * 8) * 16;
    int xq = x;
    int v = q_fetch(hb + xq * 16, slot);
    for (;;) {
        while (v < 64) { attn_prompt<TYPE>(ws, lds, l, xq, v); v = q_fetch(hb + xq * 16, slot); }
        __syncthreads();
        if (threadIdx.x == 0) { unsigned h[8];
#pragma unroll
            for (int i = 0; i < 8; ++i) h[i] = __hip_atomic_fetch_add(hb + ((x + i) & 7) * 16, 0u, __ATOMIC_RELAXED, __HIP_MEMORY_SCOPE_AGENT);
            int pick = -1;
#pragma unroll
            for (int i = 7; i >= 0; --i) pick = h[i] < 64u ? ((x + i) & 7) : pick;
            *slot = pick; }
        __syncthreads(); xq = __builtin_amdgcn_readfirstlane(*slot);
        if (xq < 0) break;
        v = q_fetch(hb + xq * 16, slot);
    }
}
__device__ __forceinline__ void p4_attention(unsigned char* ws, float* out, int l, LAS unsigned char* lds, int rep) {
    unsigned* head = (unsigned*)(ws + WS_CTL) + CW_QUEUE + 64 * l + 16 * rep; LAS int* slot = (LAS int*)(lds + MISC_OFF + 64);
#define NEXT_BEGIN() int nx_ = 0; if (threadIdx.x == 0) nx_ = (int)__hip_atomic_fetch_add(head, 1u, __ATOMIC_RELAXED, __HIP_MEMORY_SCOPE_AGENT)
#define NEXT_END() do { if (threadIdx.x == 0) *slot = nx_; __syncthreads(); u = __builtin_amdgcn_readfirstlane(*slot); } while (0)
    const int ncv = (l + 1 < NL) ? N_CV : 0, nwt = (l + 1 < NL) ? N_WT : 0;
    const int b0 = ncv, b1 = b0 + nwt, b2 = b1 + NU_S, b3 = b2 + NU_S, b4 = b3 + NU_S;
    int u = q_fetch(head, slot);
    while (u < b0) { NEXT_BEGIN(); conv_unit(ws, lds, l + 1, u); NEXT_END(); }
    while (u < b1) { NEXT_BEGIN(); weight_unit(ws, lds, l + 1, u - b0); NEXT_END(); }
    while (u < b2) { NEXT_BEGIN(); sample_octet<0>(ws, out, lds, l, u - b1); NEXT_END(); }
    while (u < b3) { NEXT_BEGIN(); sample_octet<1>(ws, out, lds, l, u - b2); NEXT_END(); }
    while (u < b4) { NEXT_BEGIN(); sample_octet<2>(ws, out, lds, l, u - b3); NEXT_END(); }
    prompt_queues<0>(ws, lds, l, slot);
    prompt_queues<1>(ws, lds, l, slot);
    prompt_queues<2>(ws, lds, l, slot);
#undef NEXT_BEGIN
#undef NEXT_END
}
constexpr int N_PHASES = 2 + 5 * NL;
__global__ void __launch_bounds__(512, 2) fwd(Params P) {
    extern __shared__ __attribute__((aligned(16))) unsigned char lds_raw[];
    LAS unsigned char* lds = (LAS unsigned char*)lds_raw;
    const int tid = threadIdx.x;
    if (tid < 64) ((LAS unsigned*)(lds + MISC_OFF))[tid] = 0u;
    if (tid < 18) ((LAS unsigned long long*)(lds + PTR_OFF))[tid] = (unsigned long long)P.in[tid];
    __syncthreads();
    unsigned char* const ws0 = P.ws; float* const out0 = P.out;
    unsigned* ctl = (unsigned*)(ws0 + WS_CTL);
    XcdBarrier bar = xcd_barrier_post(ctl + CW_BAR, (volatile LAS unsigned*)(lds + MISC_OFF + 32));
    const int lo = P.ph_lo, hi = P.ph_hi;
#ifndef PHM
#define PHM 0x7f
#endif
#ifndef REP_P1
#define REP_P1 1
#endif
#ifndef REP_P2
#define REP_P2 1
#endif
#ifndef REP_P3
#define REP_P3 1
#endif
#ifndef REP_P4
#define REP_P4 1
#endif
#ifndef REP_P5
#define REP_P5 1
#endif
#define IN(k) (lo <= (k) && (k) < hi)
#define SEAM(k) do { if (IN(k) && IN((k) + 1)) { XcdBarrier b2_ = bar; unsigned* bb_ = b2_.bar; asm volatile("" : "+s"(bb_)); b2_.bar = bb_; xcd_barrier(b2_); } } while (0)
#define FRESH() unsigned long long ws_i_ = (unsigned long long)ws0, out_i_ = (unsigned long long)out0; asm volatile("" : "+s"(ws_i_), "+s"(out_i_)); unsigned char* ws = (unsigned char*)(GAS unsigned char*)ws_i_; float* out = (float*)(GAS float*)out_i_; (void)out
    if ((PHM & 1) && IN(0)) { FRESH(); p0_prologue(ws, lds); }
    SEAM(0);
    for (int l = 0; l <= NL; ++l) {
        const int pb = 1 + 5 * l;
        if ((PHM & 2) && IN(pb)) { FRESH(); p1_norm(ws, out, lds, l); }
        if (l == NL) break;
        SEAM(pb);
        if ((PHM & 4) && IN(pb + 1)) { FRESH();
            pg8::Gemm g{(const pg8::bf16_t*)(ws + WS_XN), (const pg8::bf16_t*)(ws + WS_WIN + (size_t)l * NINP * D * 2), M, NINP, D};
            pg8::StaticOrder S; S.init(M, NINP, (int)gridDim.x, (int)blockIdx.x);
            EpiP2 E; E.ws = ws; E.out = out; E.kvnorm = inp(lds, 12) + l * 256; E.fbias = inp(lds, 15) + l * 4; E.l = l; E.scr = (LAS float*)(lds + SCR_OFF);
            _Pragma("nounroll") for (int rep = 0; rep < REP_P2; ++rep) pg8::gemm_phase<EpiP2, pg8::StaticOrder, true, true>(lds, g, S, E);
        }
        SEAM(pb + 1);
        if ((PHM & 8) && IN(pb + 2)) { FRESH();
            if (blockIdx.x < 36) cumsum_task(ws, l, (int)blockIdx.x, lds);
            int k3 = 256; asm volatile("" : "+s"(k3));
            pg8::Gemm g{(const pg8::bf16_t*)(ws + WS_CKVB), (const pg8::bf16_t*)(ws + WS_WUKV + (size_t)l * 768 * 256 * 2), M3, 768, k3};
            pg8::StaticOrder S; S.init(M3, 768, (int)gridDim.x, (int)blockIdx.x);
            EpiP3 E; E.ws = ws;
            _Pragma("nounroll") for (int rep = 0; rep < REP_P3; ++rep) pg8::gemm_phase<EpiP3, pg8::StaticOrder, true, true>(lds, g, S, E);
        }
        SEAM(pb + 2);
        if ((PHM & 16) && IN(pb + 3)) { FRESH(); _Pragma("nounroll") for (int rep = 0; rep < REP_P4; ++rep) p4_attention(ws, out, l, lds, rep); }
        SEAM(pb + 3);
        if ((PHM & 64) && IN(pb + 4)) { FRESH();
            pg8::Gemm g{(const pg8::bf16_t*)(ws + WS_OP), (const pg8::bf16_t*)(ws + WS_WOUT + (size_t)l * D * D * 2), M, D, D};
            pg8::StaticOrder S; S.init(M, D, (int)gridDim.x, (int)blockIdx.x);
            EpiP5 E; E.ws = ws; E.tab = (LAS float*)(lds + SCR_OFF);
            _Pragma("nounroll") for (int rep = 0; rep < REP_P5; ++rep) pg8::gemm_phase<EpiP5, pg8::StaticOrder, true, true>(lds, g, S, E);
        }
        SEAM(pb + 4);
    }
#undef IN
#undef SEAM
}

#ifndef MK_SPLIT
#define MK_SPLIT 0
#endif
extern "C" void kernel_launch(void* const* d_in, const int* in_sizes, int n_in, void* d_out, int out_size, void* d_ws, size_t ws_size, hipStream_t stream) {
    static int grid = 0;
    if (grid == 0) {
        if (n_in != 18 || (size_t)out_size != O_END || ws_size < WS_END) { fprintf(stderr, "kernel_launch: unexpected shapes: n_in %d out %d ws %zu\n", n_in, out_size, ws_size); grid = -1; return; }
        int dev = 0, cus = 0, per_cu = 0;
        if (hipGetDevice(&dev) != hipSuccess || hipDeviceGetAttribute(&cus, hipDeviceAttributeMultiprocessorCount, dev) != hipSuccess) { grid = -1; return; }
        if (hipFuncSetAttribute((const void*)fwd, hipFuncAttributeMaxDynamicSharedMemorySize, LDS_BYTES) != hipSuccess) { fprintf(stderr, "kernel_launch: hipFuncSetAttribute failed\n"); grid = -1; return; }
        if (hipOccupancyMaxActiveBlocksPerMultiprocessor(&per_cu, (const void*)fwd, 512, LDS_BYTES) != hipSuccess || per_cu < 1) { fprintf(stderr, "kernel_launch: occupancy query reports %d blocks per CU\n", per_cu); (void)hipGetLastError(); grid = -1; return; }
        grid = cus;
    }
    if (grid < 0) return;
    (void)hipMemsetAsync((char*)d_ws + WS_CTL, 0, CTL_ZERO_BYTES, stream);
    Params p{};
    for (int i = 0; i < 18; ++i) p.in[i] = (const float*)d_in[i];
    p.out = (float*)d_out; p.ws = (unsigned char*)d_ws;
#if MK_SPLIT
    for (int ph = 0; ph < N_PHASES; ++ph) { p.ph_lo = ph; p.ph_hi = ph + 1; hipLaunchKernelGGL(fwd, dim3(grid), dim3(512), LDS_BYTES, stream, p); }
#else
    p.ph_lo = 0; p.ph_hi = N_PHASES;
    hipLaunchKernelGGL(fwd, dim3(grid), dim3(512), LDS_BYTES, stream, p);
#endif
    const hipError_t le = hipPeekAtLastError();
    if (le != hipSuccess) fprintf(stderr, "kernel_launch: launch failed: %s\n", hipGetErrorName(le));
}
```

```cpp
#include <hip/hip_runtime.h>
#include <cstdio>
#include <cstdint>
namespace pg8 {
#define PG8_LAS __attribute__((address_space(3)))
typedef unsigned short bf16_t;
typedef short bf16x8 __attribute__((ext_vector_type(8)));
typedef float f32x4 __attribute__((ext_vector_type(4)));
typedef unsigned u32x4 __attribute__((ext_vector_type(4)));
constexpr int BM = 256, BK = 64, HALF = 128, HTB = HALF * BK * 2  , STAGE_BYTES = 8 * HTB, NXCD = 8, WGM = 8;

__host__ __device__ __forceinline__ int lds_byte(int r, int c) { const int st = (r >> 4) * 2 + (c >> 5), rr = r & 15, cc = c & 31, ob = rr * 64 + cc * 2; return st * 1024 + (ob ^ (((ob >> 9) & 1) << 5)); }
__host__ __device__ __forceinline__ void stage_rc(int b, int& R, int& C) { const int st = b / 1024, sb = b % 1024, swz = sb ^ (((sb >> 9) & 1) << 5); R = (st >> 1) * 16 + swz / 64; C = (st & 1) * 32 + (swz % 64) / 2; }
__host__ __device__ __forceinline__ int perm32(int rho) { const int n = rho >> 4, i = rho & 15; return 8 * (i >> 2) + 4 * n + (i & 3); }

struct Unit { int pm, pn; };
struct Gemm { const bf16_t* A; const bf16_t* Bt; int M, N, K; };

struct StaticOrder {
    int nM, nN, nwg, G, c;
    __host__ __device__ void init(int M, int N, int G_, int c_) { nM = M / BM; nN = N / BM; nwg = nM * nN; G = G_; c = c_; }
    __host__ __device__ bool next(int i, Unit& u) const {
        const long L = (long)i * G + c; if (L >= nwg) return false;
        int wgid = (int)L; { const int q = nwg / NXCD, r = nwg % NXCD, xcd = wgid % NXCD, off = wgid / NXCD; wgid = (xcd < r ? xcd * (q + 1) : r * (q + 1) + (xcd - r) * q) + off; }
        const int nig = WGM * nN, gid = wgid / nig, fm = gid * WGM, gsz = (nM - fm) < WGM ? (nM - fm) : WGM;
        u.pm = fm + ((wgid % nig) % gsz); u.pn = (wgid % nig) / gsz; return true;
    }
    __device__ __forceinline__ void a_ready(const Unit&) const {}
    __device__ __forceinline__ void done(const Unit&) const {}
};

struct OneUnit {
    int pm, pn;
    __host__ __device__ bool next(int i, Unit& u) const { if (i > 0) return false; u.pm = pm; u.pn = pn; return true; }
    __device__ __forceinline__ void a_ready(const Unit&) const {}
    __device__ __forceinline__ void done(const Unit&) const {}
};
__device__ __forceinline__ unsigned cvt_pk_bf16(float lo, float hi) { unsigned r; asm volatile("v_cvt_pk_bf16_f32 %0, %1, %2" : "=v"(r) : "v"(lo), "v"(hi)); return r; }
typedef float f32x2 __attribute__((ext_vector_type(2)));
template <class Epi, class Sched, bool ALIGN_EPI = false, bool SP2 = false>
__device__ __forceinline__ void gemm_phase(PG8_LAS unsigned char* lds, const Gemm g, const Sched& S, const Epi& E) {
    int tid_ = threadIdx.x; asm volatile("" : "+v"(tid_));
    const int tid = tid_, wid = __builtin_amdgcn_readfirstlane(tid >> 6), lane = tid & 63, wr = wid >> 2, wc = wid & 3, fr = lane & 15, fq = lane >> 4;
    const int K = g.K, nt = K / BK;
    unsigned voffA[2], voffB[2];
#pragma unroll
    for (int i = 0; i < 2; ++i) { int R, C; stage_rc(tid * 16 + i * 8192, R, C); const int Rb = Epi::PERM ? ((R & ~31) + perm32(R & 31)) : R;
        voffA[i] = (unsigned)(R * K + C) * 2u; voffB[i] = (unsigned)(Rb * K + C) * 2u; }
    const size_t kstep = (size_t)(BK * 2);
    const size_t hstep = (size_t)HALF * K * 2;
    const size_t tstep = 2 * hstep;
    const unsigned ldsw = (unsigned)wid * 1024u;
    const int aoff = lds_byte(wr * 64 + fr, fq * 8), boff = lds_byte(wc * 32 + fr, fq * 8);
#define PG8_SA(b, h) (((b) * 2 + (h)) * HTB)
#define PG8_SB(b, h) ((4 + (b) * 2 + (h)) * HTB)
#define PG8_STAGE(bufoff, gbase, voff) do { _Pragma("unroll") for (int _i = 0; _i < 2; ++_i) \
        __builtin_amdgcn_global_load_lds((const unsigned*)((const char*)(gbase) + (voff)[_i]), (PG8_LAS unsigned*)(lds + (bufoff) + ldsw + _i * 8192), 16, 0, 0); } while (0)
#define PG8_LDA(dst, b, h) do { _Pragma("unroll") for (int m = 0; m < 4; ++m) _Pragma("unroll") for (int k = 0; k < 2; ++k) dst[m][k] = *(const PG8_LAS bf16x8*)(lds + PG8_SA(b, h) + aoff + m * 2048 + k * 1024); } while (0)
#define PG8_LDB(dst, b, h) do { _Pragma("unroll") for (int n = 0; n < 2; ++n) _Pragma("unroll") for (int k = 0; k < 2; ++k) dst[n][k] = *(const PG8_LAS bf16x8*)(lds + PG8_SB(b, h) + boff + n * 2048 + k * 1024); } while (0)
#define PG8_MMA(ai, bj, At, Bt) do { __builtin_amdgcn_s_setprio(1); _Pragma("unroll") for (int m = 0; m < 4; ++m) _Pragma("unroll") for (int n = 0; n < 2; ++n) _Pragma("unroll") for (int k = 0; k < 2; ++k) \
        acc[ai][bj][m][n] = __builtin_amdgcn_mfma_f32_16x16x32_bf16(Bt[n][k], At[m][k], acc[ai][bj][m][n], 0, 0, 0); __builtin_amdgcn_s_setprio(0); } while (0)
#define PG8_WAIT_V(n) asm volatile("s_waitcnt vmcnt(" #n ")" ::: "memory")
#define PG8_WAIT_L(n) asm volatile("s_waitcnt lgkmcnt(" #n ")" ::: "memory")
#define PG8_BAR __builtin_amdgcn_s_barrier()
#define PG8_SCHED __builtin_amdgcn_sched_barrier(0)
    Unit cur, nxt; int ui = 0;
    if (!S.next(0, cur)) return;
    f32x4 acc[2][2][4][2];
#pragma unroll
    for (int a = 0; a < 2; ++a)
#pragma unroll
        for (int b = 0; b < 2; ++b)
#pragma unroll
            for (int m = 0; m < 4; ++m)
#pragma unroll
                for (int n = 0; n < 2; ++n) acc[a][b][m][n] = (f32x4){0.f, 0.f, 0.f, 0.f};
    bf16x8 At[4][2], B0[2][2], B1[2][2];
    const char* cA = (const char*)g.A + (size_t)cur.pm * tstep; const char* cB = (const char*)g.Bt + (size_t)cur.pn * tstep;
    S.a_ready(cur);
    if constexpr (Epi::MID) E.prep(cur, 0, tid);
    if constexpr (SP2) {
        PG8_STAGE(PG8_SB(0, 0), cB, voffB); PG8_STAGE(PG8_SB(0, 1), cB + hstep, voffB); PG8_STAGE(PG8_SA(0, 0), cA, voffA); PG8_STAGE(PG8_SA(0, 1), cA + hstep, voffA);
        if (wr == 1) PG8_BAR;
        PG8_WAIT_V(2); PG8_BAR;
        PG8_STAGE(PG8_SB(1, 0), cB + kstep, voffB); PG8_STAGE(PG8_SA(1, 0), cA + kstep, voffA); PG8_STAGE(PG8_SB(1, 1), cB + hstep + kstep, voffB);
        PG8_WAIT_V(6); PG8_BAR;
    } else {
        PG8_STAGE(PG8_SB(0, 0), cB, voffB); PG8_STAGE(PG8_SA(0, 0), cA, voffA); PG8_STAGE(PG8_SB(0, 1), cB + hstep, voffB); PG8_STAGE(PG8_SA(0, 1), cA + hstep, voffA);
        if (wr == 1) PG8_BAR;
        PG8_WAIT_V(4); PG8_BAR;
        PG8_STAGE(PG8_SB(1, 0), cB + kstep, voffB); PG8_STAGE(PG8_SA(1, 0), cA + kstep, voffA); PG8_STAGE(PG8_SB(1, 1), cB + hstep + kstep, voffB);
        PG8_WAIT_V(6); PG8_BAR;
    }
    for (;;) {
        const bool has_next = S.next(ui + 1, nxt);
        const char* nA = has_next ? (const char*)g.A + (size_t)nxt.pm * tstep : cA; const char* nB = has_next ? (const char*)g.Bt + (size_t)nxt.pn * tstep : cB;
        for (int t = 0; t < nt; t += 2) {
            if constexpr (Epi::MID) { if (t == Epi::MID_T0 || t == Epi::MID_T1) E.mid(acc, ui & 1, t == Epi::MID_T0 ? 0 : 1, wr, fr); }
            const bool last = (t == nt - 2);
            const char* a1 = cA + (size_t)(t + 1) * kstep;
            const char* a2 = last ? nA : cA + (size_t)(t + 2) * kstep; const char* b2 = last ? nB : cB + (size_t)(t + 2) * kstep;
            const char* a3 = a2 + kstep; const char* b3 = b2 + kstep;
            if (last && has_next) S.a_ready(nxt);
            if constexpr (SP2) {
            PG8_LDB(B0, 0, 0); PG8_LDB(B1, 0, 1); PG8_SCHED; PG8_LDA(At, 0, 0); PG8_STAGE(PG8_SA(1, 1), a1 + hstep, voffA);
            PG8_WAIT_V(8); PG8_WAIT_L(0); PG8_BAR; PG8_MMA(0, 0, At, B0); PG8_MMA(0, 1, At, B1); PG8_BAR; PG8_SCHED;
            PG8_LDA(At, 0, 1); PG8_STAGE(PG8_SB(0, 0), b2, voffB); PG8_STAGE(PG8_SB(0, 1), b2 + hstep, voffB); PG8_STAGE(PG8_SA(0, 0), a2, voffA);
            PG8_WAIT_V(8); PG8_WAIT_L(0); PG8_BAR; PG8_MMA(1, 0, At, B0); PG8_MMA(1, 1, At, B1); PG8_BAR; PG8_SCHED;
            PG8_LDB(B0, 1, 0); PG8_LDB(B1, 1, 1); PG8_SCHED; PG8_LDA(At, 1, 0); PG8_STAGE(PG8_SA(0, 1), a2 + hstep, voffA);
            PG8_WAIT_V(8); PG8_WAIT_L(0); PG8_BAR; PG8_MMA(0, 0, At, B0); PG8_MMA(0, 1, At, B1); PG8_BAR; PG8_SCHED;
            PG8_LDA(At, 1, 1); PG8_STAGE(PG8_SB(1, 0), b3, voffB); PG8_STAGE(PG8_SB(1, 1), b3 + hstep, voffB); PG8_STAGE(PG8_SA(1, 0), a3, voffA);
            PG8_WAIT_V(8); PG8_WAIT_L(0); PG8_BAR; PG8_MMA(1, 0, At, B0); PG8_MMA(1, 1, At, B1); PG8_BAR; PG8_SCHED;
            } else {
            PG8_LDB(B0, 0, 0); PG8_SCHED; PG8_LDA(At, 0, 0); PG8_STAGE(PG8_SA(1, 1), a1 + hstep, voffA);
            PG8_WAIT_L(8); PG8_BAR; PG8_WAIT_L(0); PG8_MMA(0, 0, At, B0); PG8_BAR; PG8_SCHED;
            PG8_LDB(B1, 0, 1); PG8_STAGE(PG8_SB(0, 0), b2, voffB);
            PG8_BAR; PG8_WAIT_L(0); PG8_MMA(0, 1, At, B1); PG8_BAR;
            PG8_LDA(At, 0, 1); PG8_STAGE(PG8_SA(0, 0), a2, voffA);
            PG8_BAR; PG8_WAIT_L(0); PG8_MMA(1, 0, At, B0); PG8_BAR; PG8_SCHED;
            PG8_STAGE(PG8_SB(0, 1), b2 + hstep, voffB);
            PG8_WAIT_V(6); PG8_BAR; PG8_MMA(1, 1, At, B1); PG8_BAR;
            PG8_LDB(B0, 1, 0); PG8_SCHED; PG8_LDA(At, 1, 0); PG8_STAGE(PG8_SA(0, 1), a2 + hstep, voffA);
            PG8_WAIT_L(8); PG8_BAR; PG8_WAIT_L(0); PG8_MMA(0, 0, At, B0); PG8_BAR; PG8_SCHED;
            PG8_LDB(B1, 1, 1); PG8_STAGE(PG8_SB(1, 0), b3, voffB);
            PG8_BAR; PG8_WAIT_L(0); PG8_MMA(0, 1, At, B1); PG8_BAR;
            PG8_LDA(At, 1, 1); PG8_STAGE(PG8_SA(1, 0), a3, voffA);
            PG8_BAR; PG8_WAIT_L(0); PG8_MMA(1, 0, At, B0); PG8_BAR; PG8_SCHED;
            PG8_STAGE(PG8_SB(1, 1), b3 + hstep, voffB);
            PG8_WAIT_V(6); PG8_BAR; PG8_MMA(1, 1, At, B1); PG8_BAR;
            }
        }
        if constexpr (ALIGN_EPI) { if (wr == 0) PG8_BAR; }
        if constexpr (Epi::MID) E.mid(acc, ui & 1, 2, wr, fr);
        if constexpr (!Epi::AFTER_DRAIN) { E(acc, cur, wr, wc, fr, fq); S.done(cur); }
        if constexpr (Epi::MID) { if (has_next) E.prep(nxt, (ui + 1) & 1, tid); }
        if (!has_next) break;
#pragma unroll
        for (int a = 0; a < 2; ++a)
#pragma unroll
            for (int b = 0; b < 2; ++b)
#pragma unroll
                for (int m = 0; m < 4; ++m)
#pragma unroll
                    for (int n = 0; n < 2; ++n) acc[a][b][m][n] = (f32x4){0.f, 0.f, 0.f, 0.f};
        cur = nxt; cA = nA; cB = nB; ++ui;
        if constexpr (ALIGN_EPI) { if (wr == 1) PG8_BAR; }
    }
    PG8_WAIT_V(0);
    if constexpr (!ALIGN_EPI) { if (wr == 0) PG8_BAR; }
    PG8_BAR;
    if constexpr (Epi::AFTER_DRAIN) { E.fused(acc, cur, wr, wc, fr, fq, lds, wid, lane); S.done(cur); }
#undef PG8_SA
#undef PG8_SB
#undef PG8_STAGE
#undef PG8_LDA
#undef PG8_LDB
#undef PG8_MMA
#undef PG8_WAIT_V
#undef PG8_WAIT_L
#undef PG8_BAR
#undef PG8_SCHED
}
}
#define GAS __attribute__((address_space(1)))
#define LAS __attribute__((address_space(3)))
#define XB_TMO      128
#define XB_XCNT(j)  (256  + 64 * (j))
#define XB_XSUB(j)  (1280 + 64 * (j))
#define XB_XGEN(j)  (2304 + 64 * (j))
#define XB_TOP      3328
#define XB_TOPGEN   3392
#define XCD_BAR_WORDS 3456
#define XB_SPIN_CAP (1u << 21)

__device__ __forceinline__ unsigned xb_ld(unsigned* p)              { return __hip_atomic_load(p, __ATOMIC_RELAXED, __HIP_MEMORY_SCOPE_AGENT); }
__device__ __forceinline__ unsigned xb_add(unsigned* p, unsigned v) { return __hip_atomic_fetch_add(p, v, __ATOMIC_RELAXED, __HIP_MEMORY_SCOPE_AGENT); }
__device__ __forceinline__ unsigned xb_xcc_id() { return (unsigned)__builtin_amdgcn_s_getreg((3 << 11) | 20) & 0xFu; }
#define XB_SPIN(cond, bar) do { unsigned _sp = 0; while (cond) { __builtin_amdgcn_s_sleep(1); \
    if ((++_sp & 255u) == 0u) { if (xb_ld(&(bar)[XB_TMO])) break; if (_sp > XB_SPIN_CAP) { atomicAdd(&(bar)[XB_TMO], 1u); break; } } } } while (0)

struct XcdBarrier {
    unsigned* bar; unsigned x;
    volatile LAS unsigned* st;
};

__device__ __forceinline__ XcdBarrier xcd_barrier_post(unsigned* bar, volatile LAS unsigned* st) {
    XcdBarrier b; b.bar = bar; b.x = xb_xcc_id(); b.st = st;
    if (threadIdx.x == 0) (void)xb_add(&bar[XB_XCNT(b.x)], 1u);
    return b;
}
__device__ __forceinline__ void xcd_barrier_complete(unsigned* bar, unsigned x, unsigned& nloc, unsigned& nx) {
    const unsigned G = gridDim.x * gridDim.y * gridDim.z;
    unsigned sum, cnt, mine, sp = 0u;
    for (;;) {
        sum = 0u; cnt = 0u; mine = 0u;
#pragma unroll
        for (unsigned j = 0; j < 16; ++j) { const unsigned c = xb_ld(&bar[XB_XCNT(j)]); sum += c; cnt += (c > 0u) ? 1u : 0u; mine = (j == x) ? c : mine; }
        if (sum == G) break;
        __builtin_amdgcn_s_sleep(1);
        if ((++sp & 255u) == 0u) { if (xb_ld(&bar[XB_TMO])) break; if (sp > XB_SPIN_CAP) { atomicAdd(&bar[XB_TMO], 1u); break; } }
    }
    nloc = mine > 0u ? mine : 1u; nx = cnt > 0u ? cnt : 1u;
}

__device__ __forceinline__ void xcd_barrier(const XcdBarrier& b) {
    asm volatile("s_waitcnt vmcnt(0)" ::: "memory");
    __syncthreads();
    if (threadIdx.x == 0) {
        unsigned* bar = b.bar;
        __builtin_amdgcn_s_waitcnt(0);
        unsigned nloc = b.st[0], nx = b.st[1];
        if (nloc == 0u) { xcd_barrier_complete(bar, b.x, nloc, nx); b.st[0] = nloc; b.st[1] = nx; }
        const unsigned old = xb_add(&bar[XB_XSUB(b.x)], 1u);
        const unsigned gen = old / nloc;
        if (old + 1u == (gen + 1u) * nloc) {
            __builtin_amdgcn_fence(__ATOMIC_RELEASE, "agent");
            asm volatile("s_waitcnt vmcnt(0)" ::: "memory");
            const unsigned og = xb_add(&bar[XB_TOP], 1u);
            const unsigned tg = og / nx;
            if (og + 1u == (tg + 1u) * nx) xb_add(&bar[XB_TOPGEN], 1u);
            else XB_SPIN(xb_ld(&bar[XB_TOPGEN]) == tg, bar);
            __builtin_amdgcn_fence(__ATOMIC_ACQUIRE, "agent");
            xb_add(&bar[XB_XGEN(b.x)], 1u);
            asm volatile("s_waitcnt vmcnt(0)" ::: "memory");
        } else {
            XB_SPIN(xb_ld(&bar[XB_XGEN(b.x)]) == gen, bar);
            __builtin_amdgcn_fence(__ATOMIC_ACQUIRE, "agent");
            asm volatile("s_waitcnt vmcnt(0)" ::: "memory");
        }
    }
    __syncthreads();
}

constexpr int D = 1024, NL = 4;
constexpr int PB = 4, PT = 8192, MP = PB * PT;
constexpr int SBN = 32, STN = 16, PAST = 2048, MS = SBN * STN;
constexpr int M = MP + MS;
constexpr int SKEYS = PAST + STN;
constexpr int SPITCH = 2112;
constexpr int KROWS = MP + SBN * SPITCH;
constexpr int M3 = M + SBN * PAST;
constexpr int NIN = 3236, NINP = 3328;
constexpr float EPS = 1e-6f;
constexpr float LOG2E = 1.4426950408889634f;
constexpr float EXIT_LOG2 = -40.0f;
constexpr float QA_SC = 0.10206207261596575f * LOG2E, QB_SC = 0.125f * LOG2E, QC_SC = 0.125f * LOG2E;

constexpr size_t O_YP = 0, O_YS = O_YP + (size_t)MP * D, O_PCKV = O_YS + (size_t)MS * D, O_PKPE = O_PCKV + (size_t)NL * MP * 256, O_PFK = O_PKPE + (size_t)NL * MP * 32,
                 O_PFV = O_PFK + (size_t)NL * MP * 256, O_PLF = O_PFV + (size_t)NL * MP * 256, O_PSK = O_PLF + (size_t)NL * MP * 4, O_PSV = O_PSK + (size_t)NL * MP * 256,
                 O_SCKV = O_PSV + (size_t)NL * MP * 256, O_SKPE = O_SCKV + (size_t)NL * MS * 256, O_SFK = O_SKPE + (size_t)NL * MS * 32, O_SFV = O_SFK + (size_t)NL * MS * 256,
                 O_SLF = O_SFV + (size_t)NL * MS * 256, O_SSK = O_SLF + (size_t)NL * MS * 4, O_SSV = O_SSK + (size_t)NL * MS * 256, O_END = O_SSV + (size_t)NL * MS * 256;
static_assert(O_END == 209264640ull, "output size");

constexpr size_t MiB = 1u << 20;
constexpr size_t WS_CTL = 0, CTL_ZERO_BYTES = 1 * MiB;
constexpr size_t WS_ROPE = 1 * MiB, WS_WIN = 2 * MiB, WS_WUKV = 28 * MiB, WS_WOUT = 30 * MiB, WS_XN = 38 * MiB, WS_QA = 103 * MiB, WS_QB = 128 * MiB, WS_QC = 145 * MiB,
                 WS_GATE = 162 * MiB, WS_OP = 227 * MiB, WS_Y = 292 * MiB, WS_CKVB = 357 * MiB, WS_KA = 406 * MiB, WS_KR = 455 * MiB, WS_VA = 462 * MiB, WS_KB = 560 * MiB,
                 WS_VB = 609 * MiB, WS_KC = 658 * MiB, WS_VC = 707 * MiB, WS_LOGF = 756 * MiB, WS_FB = 758 * MiB, WS_SS = 760 * MiB, WS_KR2 = 762 * MiB, WS_RSTD = 769 * MiB, WS_END = 770 * MiB;
static_assert(WS_WIN + (size_t)NL * NINP * D * 2 <= WS_WUKV && WS_WUKV + (size_t)NL * 768 * 256 * 2 <= WS_WOUT && WS_WOUT + (size_t)NL * D * D * 2 <= WS_XN, "ws map 1");
static_assert(WS_XN + (size_t)M * D * 2 <= WS_QA && WS_QA + (size_t)(M + 64) * 384 * 2 <= WS_QB && WS_QB + (size_t)(M + 64) * 256 * 2 <= WS_QC && WS_QC + (size_t)(M + 64) * 256 * 2 <= WS_GATE, "ws map 2");
static_assert(WS_GATE + (size_t)M * D * 2 <= WS_OP && WS_OP + (size_t)M * D * 2 <= WS_Y && WS_Y + (size_t)M * D * 2 <= WS_CKVB && WS_CKVB + (size_t)M3 * 256 * 2 <= WS_KA, "ws map 3");
static_assert(WS_KA + (size_t)KROWS * 256 * 2 <= WS_KR && WS_KR + (size_t)KROWS * 32 * 2 <= WS_VA && WS_VA + (size_t)KROWS * 512 * 2 <= WS_KB && WS_KB + (size_t)KROWS * 256 * 2 <= WS_VB, "ws map 4");
static_assert(WS_VB + (size_t)KROWS * 256 * 2 <= WS_KC && WS_KC + (size_t)KROWS * 256 * 2 <= WS_VC && WS_VC + (size_t)KROWS * 256 * 2 <= WS_LOGF && WS_LOGF + (size_t)KROWS * 16 <= WS_FB && WS_FB + (size_t)KROWS * 16 <= WS_SS && WS_SS + (size_t)M * 48 <= WS_END, "ws map 5");
constexpr int CW_QUEUE = 64;
constexpr int CW_XQ = 1024;
constexpr int CW_SDONE = 768;
constexpr int CW_KMAX = 512;
constexpr int CW_BAR = 4096;
constexpr int RING_BYTES = 131072, MISC_OFF = RING_BYTES, PTR_OFF = RING_BYTES + 256, SCR_OFF = RING_BYTES + 512, LDS_BYTES = 147456;

typedef unsigned short bf16_t;
typedef short bf16x8 __attribute__((ext_vector_type(8)));
typedef short s16x4 __attribute__((ext_vector_type(4)));
typedef float f32x4 __attribute__((ext_vector_type(4)));
typedef float f32x16 __attribute__((ext_vector_type(16)));
typedef unsigned u32x4 __attribute__((ext_vector_type(4)));
typedef unsigned u32x2 __attribute__((ext_vector_type(2)));
typedef float f32x2_t __attribute__((ext_vector_type(2)));
typedef __bf16 bf16x2_t __attribute__((ext_vector_type(2)));
__device__ __forceinline__ unsigned cvtpk(float lo, float hi) { f32x2_t v = {lo, hi}; bf16x2_t b = __builtin_convertvector(v, bf16x2_t); return __builtin_bit_cast(unsigned, b); }
__device__ __forceinline__ float bf_lo(unsigned w) { return __uint_as_float(w << 16); }
__device__ __forceinline__ float bf_hi(unsigned w) { return __uint_as_float(w & 0xffff0000u); }
__device__ __forceinline__ float wave_sum(float v) {
#pragma unroll
    for (int o = 1; o < 64; o <<= 1) v += __shfl_xor(v, o);
    return v;
}
__device__ __forceinline__ float half_swap_sum(float v) { auto rr = __builtin_amdgcn_permlane32_swap(__float_as_uint(v), __float_as_uint(v), false, false); return __uint_as_float(rr[0]) + __uint_as_float(rr[1]); }
__device__ __forceinline__ float half_swap_max(float v) { auto rr = __builtin_amdgcn_permlane32_swap(__float_as_uint(v), __float_as_uint(v), false, false); return fmaxf(__uint_as_float(rr[0]), __uint_as_float(rr[1])); }
__device__ __forceinline__ int fresh_tid() { int t = threadIdx.x; asm volatile("" : "+v"(t)); return t; }
__device__ __forceinline__ size_t kr_off(int l) { return (l & 1) ? WS_KR2 : WS_KR; }
__device__ __forceinline__ int krow_of(int m) { return m < MP ? m : MP + ((m - MP) >> 4) * SPITCH + PAST + ((m - MP) & 15); }
__device__ __forceinline__ int pos_of(int m) { return m < MP ? (m & (PT - 1)) : PAST + ((m - MP) & 15); }
__device__ __forceinline__ float* rows_out(float* out, size_t off_p, size_t off_s, int l, int m, int W) {
    return m < MP ? out + off_p + ((size_t)l * MP + m) * W : out + off_s + ((size_t)l * MS + (m - MP)) * W;
}

struct Params { const float* in[18]; float* out; unsigned char* ws; int ph_lo, ph_hi; };
__device__ __forceinline__ const float* inp(LAS unsigned char* lds, int i) {
    const unsigned long long v = ((const LAS unsigned long long*)(lds + PTR_OFF))[i];
    const unsigned lo = __builtin_amdgcn_readfirstlane((unsigned)v), hi = __builtin_amdgcn_readfirstlane((unsigned)(v >> 32));
    return (const float*)(const GAS float*)(((unsigned long long)hi << 32) | lo);
}
#define WSP(T, off) ((T*)(ws + (off)))

__device__ __forceinline__ int win_logical_col(int n) {
    const int tile = n >> 8, c = n & 255;
    switch (tile) {
        case 0: return c;
        case 1: { const int blk = c >> 5, p = c & 31, e = 16 * ((p >> 2) & 1) + 4 * (p >> 3) + (p & 3);
                  if (blk < 4) return 256 + 32 * blk + e; if (blk == 4) return 640 + e; if (blk == 5 && p < 4) return 1440 + p; return -1; }
        case 2: return 384 + c;
        case 3: return 672 + c;
        case 4: return 928 + c;
        case 5: return 1184 + c;
        case 6: return 1444 + c;
        case 7: return 1700 + c;
        case 8: return 1956 + c;
        default: return 2212 + 256 * (tile - 9) + c;
    }
}
__device__ __forceinline__ void p0_item(unsigned char* ws, LAS unsigned char* lds, int kind, int l, int item, LAS float* scr, int lane) {
    const int K = kind == 1 ? 256 : 1024, N = kind == 0 ? NINP : kind == 1 ? 768 : 1024;
    const int nblk = N / 32, kb = item / nblk, nb = item % nblk, k0 = 64 * kb, n0 = 32 * nb;
    const int n = n0 + (lane & 31);
    const float* src; int ld; int col;
    if (kind == 0) { src = inp(lds, 11) + (size_t)l * D * NIN; ld = NIN; col = win_logical_col(n); }
    else if (kind == 1) { if (n < 256) { src = inp(lds, 13) + (size_t)l * 256 * 256; ld = 256; col = n; } else { src = inp(lds, 14) + (size_t)l * 256 * 512; ld = 512; col = n - 256; } }
    else { src = inp(lds, 17) + (size_t)l * D * D; ld = D; col = n; }
    const float* gain = kind == 0 ? inp(lds, 9) + l * D : kind == 2 ? inp(lds, 16) + l * D : nullptr;
#pragma unroll 8
    for (int i = 0; i < 32; ++i) { const int kk = 2 * i + (lane >> 5); float v = 0.f;
        if (col >= 0) { v = src[(size_t)(k0 + kk) * ld + col]; if (gain) v *= gain[k0 + kk]; }
        scr[kk * 33 + (lane & 31)] = v; }
    asm volatile("s_waitcnt lgkmcnt(0)" ::: "memory");
    bf16_t* WT = (bf16_t*)(ws + (kind == 0 ? WS_WIN + (size_t)l * NINP * D * 2 : kind == 1 ? WS_WUKV + (size_t)l * 768 * 256 * 2 : WS_WOUT + (size_t)l * D * D * 2));
    const int c = lane & 7;
#pragma unroll
    for (int j = 0; j < 4; ++j) { const int nn = (lane >> 3) + 8 * j; const LAS float* s = scr + (8 * c) * 33 + nn;
        u32x4 o; o.x = cvtpk(s[0 * 33], s[1 * 33]); o.y = cvtpk(s[2 * 33], s[3 * 33]); o.z = cvtpk(s[4 * 33], s[5 * 33]); o.w = cvtpk(s[6 * 33], s[7 * 33]);
        *(u32x4*)(WT + (size_t)(n0 + nn) * K + k0 + 8 * c) = o; }
    asm volatile("s_waitcnt lgkmcnt(0)" ::: "memory");
}
__device__ __forceinline__ void p0_prologue(unsigned char* ws, LAS unsigned char* lds) {
    const int tid = fresh_tid(), lane = tid & 63, wid = __builtin_amdgcn_readfirstlane(tid >> 6);
    LAS float* scr = (LAS float*)(lds + wid * 16384);
    const int gw = blockIdx.x * 8 + wid, NGW = gridDim.x * 8;
    constexpr int I0 = 16 * (NINP / 32), I1 = 4 * 24, I2 = 16 * 32, IL = I0 + I1 + I2;
    for (int it = gw; it < IL; it += NGW) {
        const int l = it / IL; int r = it % IL;
        if (r < I0) { p0_item(ws, lds, 0, l, r, scr, lane); continue; } r -= I0;
        if (r < I1) { p0_item(ws, lds, 1, l, r, scr, lane); continue; } r -= I1;
        p0_item(ws, lds, 2, l, r, scr, lane);
    }
    float* rope = (float*)(ws + WS_ROPE);
    for (int e = blockIdx.x * 512 + tid; e < PT * 16; e += gridDim.x * 512) {
        const int pos = e >> 4, i = e & 15;
        double inv = 1.0; for (int k = 0; k < i; ++k) inv *= 0.5623413251903491;
        const double rev = (double)pos * inv * 0.15915494309189535;
        const float fr = (float)(rev - __builtin_rint(rev));
        rope[pos * 32 + i] = __builtin_amdgcn_cosf(fr); rope[pos * 32 + 16 + i] = __builtin_amdgcn_sinf(fr);
    }
}

__device__ __forceinline__ void cvt_rows(const float* src, bf16_t* dst, int W, size_t dst_bstride, int gtid, int nthr) {
    const int per_b = PAST * W / 8, total = SBN * per_b;
    for (int q0 = gtid; q0 < total; q0 += 4 * nthr) {
        f32x4 a[4], b[4];
#pragma unroll
        for (int u = 0; u < 4; ++u) { const int q = q0 + u * nthr; if (q < total) { a[u] = *(const f32x4*)(src + (size_t)q * 8); b[u] = *(const f32x4*)(src + (size_t)q * 8 + 4); } }
#pragma unroll
        for (int u = 0; u < 4; ++u) { const int q = q0 + u * nthr; if (q < total) { const int sb = q / per_b, rem = q % per_b;
            u32x4 o; o.x = cvtpk(a[u][0], a[u][1]); o.y = cvtpk(a[u][2], a[u][3]); o.z = cvtpk(b[u][0], b[u][1]); o.w = cvtpk(b[u][2], b[u][3]);
            *(u32x4*)(dst + (size_t)sb * dst_bstride + (size_t)rem * 8) = o; } }
    }
}
__device__ __forceinline__ void p1_norm(unsigned char* ws, float* out, LAS unsigned char* lds, int l) {
    const int tid = fresh_tid(), lane = tid & 63, wid = __builtin_amdgcn_readfirstlane(tid >> 6);
    const int gw = blockIdx.x * 8 + wid, NGW = gridDim.x * 8;
    bf16_t* XB = (bf16_t*)(ws + WS_XN); const bf16_t* Y = (const bf16_t*)(ws + WS_Y); float* RSTD = (float*)(ws + WS_RSTD);
    const float* xp = inp(lds, 0); const float* xs = inp(lds, 1); const float* gpost = inp(lds, 10);
    constexpr int RU = 4;
    f32x4 g[4];
    if (l > 0) {
#pragma unroll
        for (int j = 0; j < 4; ++j) g[j] = *(const f32x4*)(gpost + (l - 1) * D + 256 * j + 4 * lane);
    }
    for (int m0 = gw; m0 < M; m0 += RU * NGW) {
        f32x4 v[RU][4]; u32x2 yw[RU][4];
#pragma unroll
        for (int r = 0; r < RU; ++r) { const int m = m0 + r * NGW; if (m < M) {
            if (l == 0) { const float* base = m < MP ? xp + (size_t)m * D : xs + (size_t)(m - MP) * D;
#pragma unroll
                for (int j = 0; j < 4; ++j) v[r][j] = *(const f32x4*)(base + 256 * j + 4 * lane); }
            else {
#pragma unroll
                for (int j = 0; j < 4; ++j) { const u32x2 w = *(const u32x2*)(XB + (size_t)m * D + 256 * j + 4 * lane); v[r][j] = (f32x4){bf_lo(w.x), bf_hi(w.x), bf_lo(w.y), bf_hi(w.y)}; }
#pragma unroll
                for (int j = 0; j < 4; ++j) yw[r][j] = *(const u32x2*)(Y + (size_t)m * D + 256 * j + 4 * lane); } } }
#pragma unroll
        for (int r = 0; r < RU; ++r) { const int m = m0 + r * NGW; if (m < M) {
            if (l > 0) {
                f32x4 y[4]; float s = 0.f;
#pragma unroll
                for (int j = 0; j < 4; ++j) { const u32x2 w = yw[r][j]; y[j] = (f32x4){bf_lo(w.x), bf_hi(w.x), bf_lo(w.y), bf_hi(w.y)}; s += (y[j][0] * y[j][0] + y[j][1] * y[j][1]) + (y[j][2] * y[j][2] + y[j][3] * y[j][3]); }
                const float rr = 1.0f / sqrtf(wave_sum(s) * (1.0f / D) + EPS);
#pragma unroll
                for (int j = 0; j < 4; ++j) v[r][j] = v[r][j] + y[j] * rr * g[j];
            }
            if (l < NL) {
                float s = 0.f;
#pragma unroll
                for (int j = 0; j < 4; ++j) s += (v[r][j][0] * v[r][j][0] + v[r][j][1] * v[r][j][1]) + (v[r][j][2] * v[r][j][2] + v[r][j][3] * v[r][j][3]);
                const float rr = 1.0f / sqrtf(wave_sum(s) * (1.0f / D) + EPS);
                if (lane == 0) RSTD[m] = rr;
#pragma unroll
                for (int j = 0; j < 4; ++j) { u32x2 w; w.x = cvtpk(v[r][j][0], v[r][j][1]); w.y = cvtpk(v[r][j][2], v[r][j][3]); *(u32x2*)(XB + (size_t)m * D + 256 * j + 4 * lane) = w; }
            } else {
                float* xres = out + (size_t)m * D;
#pragma unroll
                for (int j = 0; j < 4; ++j) *(f32x4*)(xres + 256 * j + 4 * lane) = v[r][j];
            } } }
    }
    if (l == 0) {
        const int gtid = blockIdx.x * 512 + tid, nthr = gridDim.x * 512;
        cvt_rows(inp(lds, 2) + (size_t)l * SBN * PAST * 256, (bf16_t*)(ws + WS_CKVB) + (size_t)M * 256, 256, (size_t)PAST * 256, gtid, nthr);
        cvt_rows(inp(lds, 3) + (size_t)l * SBN * PAST * 32, (bf16_t*)(ws + WS_KR) + (size_t)MP * 32, 32, (size_t)SPITCH * 32, gtid, nthr);
    }
}

__device__ __forceinline__ void st8(bf16_t* p, const f32x4 a, const f32x4 b, float sc) {
    u32x4 w; w.x = cvtpk(a[0] * sc, a[1] * sc); w.y = cvtpk(a[2] * sc, a[3] * sc); w.z = cvtpk(b[0] * sc, b[1] * sc); w.w = cvtpk(b[2] * sc, b[3] * sc); *(u32x4*)p = w;
}
__device__ __forceinline__ float silu_f(float x) { return x * __builtin_amdgcn_rcpf(1.0f + __builtin_amdgcn_exp2f(-x * LOG2E)); }
struct EpiP2 {
    static constexpr bool PERM = true, AFTER_DRAIN = false, MID = false;
    unsigned char* ws; float* out; const float* kvnorm; const float* fbias; int l; LAS float* scr;
    __device__ __forceinline__ void operator()(pg8::f32x4 (&acc)[2][2][4][2], const pg8::Unit& u, int wr, int wc, int fr, int fq) const {
        int pn = u.pn, rbase = u.pm * 256 + wr * 64 + fr, cw = wc * 32 + 8 * fq;
        asm volatile("" : "+s"(pn), "+v"(rbase), "+v"(cw));
        {
            const float* const RSTD = WSP(const float, WS_RSTD); float rs[2][4];
#pragma unroll
            for (int ai = 0; ai < 2; ++ai)
#pragma unroll
                for (int m = 0; m < 4; ++m) rs[ai][m] = RSTD[rbase + ai * 128 + m * 16];
#pragma unroll
            for (int ai = 0; ai < 2; ++ai)
#pragma unroll
                for (int m = 0; m < 4; ++m)
#pragma unroll
                    for (int bj = 0; bj < 2; ++bj)
#pragma unroll
                        for (int n = 0; n < 2; ++n) acc[ai][bj][m][n] = acc[ai][bj][m][n] * rs[ai][m];
        }
        bf16_t* const QA = WSP(bf16_t, WS_QA); bf16_t* const QB = WSP(bf16_t, WS_QB); bf16_t* const QC = WSP(bf16_t, WS_QC); bf16_t* const KR = (bf16_t*)(ws + kr_off(l)); bf16_t* const KB = WSP(bf16_t, WS_KB); bf16_t* const VB = WSP(bf16_t, WS_VB);
        bf16_t* const KC = WSP(bf16_t, WS_KC); bf16_t* const VC = WSP(bf16_t, WS_VC); bf16_t* const CKVB = WSP(bf16_t, WS_CKVB); bf16_t* const GATE = WSP(bf16_t, WS_GATE); float* const LOGF = WSP(float, WS_LOGF); const float* const rope = WSP(const float, WS_ROPE);
        if (pn == 0 || pn == 3 || pn == 6) {
            const float sc = pn == 0 ? QA_SC : pn == 3 ? QB_SC : QC_SC;
#pragma unroll
            for (int ai = 0; ai < 2; ++ai)
#pragma unroll
                for (int m = 0; m < 4; ++m) { const int row = rbase + ai * 128 + m * 16;
#pragma unroll
                    for (int bj = 0; bj < 2; ++bj) {
                        bf16_t* d = pn == 0 ? QA + (size_t)row * 384 + (2 * bj + (wc >> 1)) * 96 + 32 * (wc & 1) + 8 * fq : (pn == 3 ? QB : QC) + (size_t)row * 256 + 128 * bj + cw;
                        st8(d, acc[ai][bj][m][0], acc[ai][bj][m][1], sc); } }
        } else if (pn >= 9) {
#pragma unroll
            for (int ai = 0; ai < 2; ++ai)
#pragma unroll
                for (int m = 0; m < 4; ++m) { const int row = rbase + ai * 128 + m * 16;
#pragma unroll
                    for (int bj = 0; bj < 2; ++bj) { f32x4 a = acc[ai][bj][m][0], b = acc[ai][bj][m][1];
#pragma unroll
                        for (int j = 0; j < 4; ++j) { a[j] = silu_f(a[j]); b[j] = silu_f(b[j]); }
                        st8(GATE + (size_t)row * D + 256 * (pn - 9) + 128 * bj + cw, a, b, 1.0f); } }
        } else if (pn == 4 || pn == 5 || pn == 7 || pn == 8) {
            bf16_t* buf = pn == 4 ? KB : pn == 5 ? VB : pn == 7 ? KC : VC;
            const size_t offp = pn == 4 ? O_PFK : pn == 5 ? O_PFV : pn == 7 ? O_PSK : O_PSV, offs = pn == 4 ? O_SFK : pn == 5 ? O_SFV : pn == 7 ? O_SSK : O_SSV;
#pragma unroll
            for (int ai = 0; ai < 2; ++ai)
#pragma unroll
                for (int m = 0; m < 4; ++m) { const int row = rbase + ai * 128 + m * 16; const int kr = krow_of(row); float* o = rows_out(out, offp, offs, l, row, 256);
#pragma unroll
                    for (int bj = 0; bj < 2; ++bj) { const int c0 = 128 * bj + cw;
                        st8(buf + (size_t)kr * 256 + c0, acc[ai][bj][m][0], acc[ai][bj][m][1], 1.0f);
                        *(f32x4*)(o + c0) = acc[ai][bj][m][0]; *(f32x4*)(o + c0 + 4) = acc[ai][bj][m][1]; } }
            if (pn == 4 && u.pm < MP / 256) {
                float mx[2] = {0.f, 0.f};
#pragma unroll
                for (int ai = 0; ai < 2; ++ai)
#pragma unroll
                    for (int m = 0; m < 4; ++m)
#pragma unroll
                        for (int bj = 0; bj < 2; ++bj) { const f32x4 x = acc[ai][bj][m][0], y = acc[ai][bj][m][1];
                            float sq = ((x[0] * x[0] + x[1] * x[1]) + (x[2] * x[2] + x[3] * x[3])) + ((y[0] * y[0] + y[1] * y[1]) + (y[2] * y[2] + y[3] * y[3]));
                            sq += __shfl_xor(sq, 16); sq += __shfl_xor(sq, 32); mx[bj] = fmaxf(mx[bj], sq); }
#pragma unroll
                for (int bj = 0; bj < 2; ++bj) { float v = mx[bj];
                    v = fmaxf(v, __shfl_xor(v, 1)); v = fmaxf(v, __shfl_xor(v, 2)); v = fmaxf(v, __shfl_xor(v, 4)); v = fmaxf(v, __shfl_xor(v, 8));
                    if (fr == 0 && fq == 0) __hip_atomic_fetch_max(WSP(unsigned, WS_CTL) + CW_KMAX + ((l * 4 + (u.pm >> 5)) * 4 + 2 * bj + (wc >> 1)) * 2 + (wc & 1), __float_as_uint(v), __ATOMIC_RELAXED, __HIP_MEMORY_SCOPE_AGENT); }
            }
        } else if (pn == 1) {
#pragma unroll
            for (int ai = 0; ai < 2; ++ai)
#pragma unroll
                for (int m = 0; m < 4; ++m) { const int row = rbase + ai * 128 + m * 16; const int pos = pos_of(row);
                    const f32x4 cs = *(const f32x4*)(rope + pos * 32 + 4 * fq), sn = *(const f32x4*)(rope + pos * 32 + 16 + 4 * fq);
                    {
                        const f32x4 x1 = acc[ai][0][m][0], x2 = acc[ai][0][m][1]; const f32x4 y1 = (x1 * cs - x2 * sn) * QA_SC, y2 = (x1 * sn + x2 * cs) * QA_SC;
                        bf16_t* d = QA + (size_t)row * 384 + wc * 96 + 64 + 4 * fq;
                        u32x2 w1, w2; w1.x = cvtpk(y1[0], y1[1]); w1.y = cvtpk(y1[2], y1[3]); w2.x = cvtpk(y2[0], y2[1]); w2.y = cvtpk(y2[2], y2[3]);
                        *(u32x2*)d = w1; *(u32x2*)(d + 16) = w2; }
                    if (wc == 0) {
                        const f32x4 x1 = acc[ai][1][m][0], x2 = acc[ai][1][m][1]; const f32x4 y1 = x1 * cs - x2 * sn, y2 = x1 * sn + x2 * cs;
                        bf16_t* d = KR + (size_t)krow_of(row) * 32 + 4 * fq;
                        u32x2 w1, w2; w1.x = cvtpk(y1[0], y1[1]); w1.y = cvtpk(y1[2], y1[3]); w2.x = cvtpk(y2[0], y2[1]); w2.y = cvtpk(y2[2], y2[3]);
                        *(u32x2*)d = w1; *(u32x2*)(d + 16) = w2;
                        float* o = rows_out(out, O_PKPE, O_SKPE, l, row, 32) + 4 * fq; *(f32x4*)o = y1; *(f32x4*)(o + 16) = y2;
                    } else if (wc == 1 && fq == 0) {
                        f32x4 v = acc[ai][1][m][0] + *(const f32x4*)fbias; f32x4 lf;
#pragma unroll
                        for (int j = 0; j < 4; ++j) lf[j] = fminf(v[j], 0.f) - __logf(1.0f + __expf(-fabsf(v[j])));
                        *(f32x4*)rows_out(out, O_PLF, O_SLF, l, row, 4) = lf; *(f32x4*)(LOGF + (size_t)krow_of(row) * 4) = lf;
                    } }
        } else {
            float ssq[2][4];
#pragma unroll
            for (int ai = 0; ai < 2; ++ai)
#pragma unroll
                for (int m = 0; m < 4; ++m) { float s = 0.f;
#pragma unroll
                    for (int bj = 0; bj < 2; ++bj)
#pragma unroll
                        for (int n = 0; n < 2; ++n) { const f32x4 x = acc[ai][bj][m][n]; s += (x[0] * x[0] + x[1] * x[1]) + (x[2] * x[2] + x[3] * x[3]); }
                    s += __shfl_xor(s, 16); s += __shfl_xor(s, 32);
                    if (fq == 0) scr[(ai * 128 + wr * 64 + m * 16 + fr) * 4 + wc] = s; }
            asm volatile("s_waitcnt lgkmcnt(0)" ::: "memory"); __builtin_amdgcn_s_barrier(); asm volatile("" ::: "memory");
#pragma unroll
            for (int ai = 0; ai < 2; ++ai)
#pragma unroll
                for (int m = 0; m < 4; ++m) { const f32x4 p4 = *(const LAS f32x4*)(scr + (ai * 128 + wr * 64 + m * 16 + fr) * 4); ssq[ai][m] = (p4[0] + p4[1]) + (p4[2] + p4[3]); }
#pragma unroll
            for (int ai = 0; ai < 2; ++ai)
#pragma unroll
                for (int m = 0; m < 4; ++m) { const int row = rbase + ai * 128 + m * 16; const float r = 1.0f / sqrtf(ssq[ai][m] * (1.0f / 256.0f) + EPS); float* o = rows_out(out, O_PCKV, O_SCKV, l, row, 256);
#pragma unroll
                    for (int bj = 0; bj < 2; ++bj) { const int c0 = 128 * bj + cw;
                        const f32x4 a = acc[ai][bj][m][0] * r * *(const f32x4*)(kvnorm + c0), b = acc[ai][bj][m][1] * r * *(const f32x4*)(kvnorm + c0 + 4);
                        st8(CKVB + (size_t)row * 256 + c0, a, b, 1.0f); *(f32x4*)(o + c0) = a; *(f32x4*)(o + c0 + 4) = b; } }
        }
    }
};
struct EpiP3 {
    static constexpr bool PERM = true, AFTER_DRAIN = false, MID = false;
    unsigned char* ws;
    __device__ __forceinline__ void operator()(const pg8::f32x4 (&acc)[2][2][4][2], const pg8::Unit& u, int wr, int wc, int fr, int fq) const {
        int pn = u.pn, rbase = u.pm * 256 + wr * 64 + fr, cw = wc * 32 + 8 * fq;
        asm volatile("" : "+s"(pn), "+v"(rbase), "+v"(cw));
        bf16_t* const KA = WSP(bf16_t, WS_KA); bf16_t* const VA = WSP(bf16_t, WS_VA);
#pragma unroll
        for (int ai = 0; ai < 2; ++ai)
#pragma unroll
            for (int m = 0; m < 4; ++m) { const int row = rbase + ai * 128 + m * 16;
                const int dest = row < M ? krow_of(row) : MP + ((row - M) >> 11) * SPITCH + ((row - M) & 2047);
#pragma unroll
                for (int bj = 0; bj < 2; ++bj) { bf16_t* d = pn == 0 ? KA + (size_t)dest * 256 + 128 * bj + cw : VA + (size_t)dest * 512 + 256 * (pn - 1) + 128 * bj + cw;
                    st8(d, acc[ai][bj][m][0], acc[ai][bj][m][1], 1.0f); } }
    }
};
struct EpiP5 {
    static constexpr bool PERM = true, AFTER_DRAIN = false, MID = true; static constexpr int MID_T0 = 8, MID_T1 = 12;
    unsigned char* ws; LAS float* tab;
    __device__ __forceinline__ void prep(const pg8::Unit& u, int par, int tid) const {
        if (tid < 256) { const float* ss = WSP(const float, WS_SS) + (size_t)(u.pm * 256 + tid) * 12;
            const f32x4 a = *(const f32x4*)ss, b = *(const f32x4*)(ss + 4), c = *(const f32x4*)(ss + 8);
            const float ra = 1.0f / sqrtf(((a[0] + a[1]) + (a[2] + a[3])) * (1.0f / 512.0f) + EPS), rb = 1.0f / sqrtf(((b[0] + b[1]) + (b[2] + b[3])) * (1.0f / 256.0f) + EPS), rc = 1.0f / sqrtf(((c[0] + c[1]) + (c[2] + c[3])) * (1.0f / 256.0f) + EPS);
            *(LAS f32x4*)(tab + (par * 256 + tid) * 4) = (f32x4){ra / rb, rb / rc, rc, 0.f}; }
    }
    __device__ __forceinline__ void mid(pg8::f32x4 (&acc)[2][2][4][2], int par, int which, int wr, int fr) const {
#pragma unroll
        for (int ai = 0; ai < 2; ++ai)
#pragma unroll
            for (int m = 0; m < 4; ++m) { const f32x4 t4 = *(const LAS f32x4*)(tab + (par * 256 + ai * 128 + wr * 64 + m * 16 + fr) * 4); const float f = which == 0 ? t4[0] : which == 1 ? t4[1] : t4[2];
#pragma unroll
                for (int bj = 0; bj < 2; ++bj)
#pragma unroll
                    for (int n = 0; n < 2; ++n) acc[ai][bj][m][n] = acc[ai][bj][m][n] * f; }
    }
    __device__ __forceinline__ void operator()(const pg8::f32x4 (&acc)[2][2][4][2], const pg8::Unit& u, int wr, int wc, int fr, int fq) const {
        int rbase = u.pm * 256 + wr * 64 + fr, cw = u.pn * 256 + wc * 32 + 8 * fq; bf16_t* const Y = WSP(bf16_t, WS_Y);
        asm volatile("" : "+v"(rbase), "+v"(cw));
#pragma unroll
        for (int ai = 0; ai < 2; ++ai)
#pragma unroll
            for (int m = 0; m < 4; ++m) { const int row = rbase + ai * 128 + m * 16;
#pragma unroll
                for (int bj = 0; bj < 2; ++bj) st8(Y + (size_t)row * D + 128 * bj + cw, acc[ai][bj][m][0], acc[ai][bj][m][1], 1.0f); }
    }
};

__device__ __forceinline__ void cumsum_task(unsigned char* ws, int l, int task, LAS unsigned char* lds) {
    const int tid = fresh_tid(), lane = tid & 63, wid = tid >> 6;
    const float* LOGF = (const float*)(ws + WS_LOGF); float* FB = (float*)(ws + WS_FB);
    const bool prompt = task < 4; const int sb = task - 4;
    const int n = prompt ? PT : SKEYS, CH = prompt ? 16 : 5;
    const int krow0 = prompt ? task * PT : MP + sb * SPITCH;
    const float* cache = inp(lds, 6) + ((size_t)l * SBN + (prompt ? 0 : sb)) * PAST * 4;
    const int t0 = tid * CH;
    f32x4 s = {0.f, 0.f, 0.f, 0.f};
    for (int i = 0; i < CH; ++i) { const int t = t0 + i; if (t < n) { const f32x4 v = (!prompt && t < PAST) ? *(const f32x4*)(cache + (size_t)t * 4) : *(const f32x4*)(LOGF + (size_t)(krow0 + t) * 4); s = s + v; } }
    const f32x4 own = s;
#pragma unroll
    for (int off = 1; off < 64; off <<= 1) {
#pragma unroll
        for (int c = 0; c < 4; ++c) { const float t = __shfl_up(s[c], off); if (lane >= off) s[c] += t; } }
    LAS f32x4* wt = (LAS f32x4*)lds;
    if (lane == 63) wt[wid] = s;
    __syncthreads();
    f32x4 pre = s - own;
    for (int w = 0; w < wid; ++w) pre = pre + wt[w];
    for (int i = 0; i < CH; ++i) { const int t = t0 + i; if (t < n) { const f32x4 v = (!prompt && t < PAST) ? *(const f32x4*)(cache + (size_t)t * 4) : *(const f32x4*)(LOGF + (size_t)(krow0 + t) * 4); pre = pre + v;
        *(f32x4*)(FB + (size_t)(krow0 + t) * 4) = pre * LOG2E; } }
    __syncthreads();
}

#define MFMA32(a, b, c) __builtin_amdgcn_mfma_f32_32x32x16_bf16((a), (b), (c), 0, 0, 0)
__device__ __forceinline__ s16x4 tr_rd(const LAS unsigned char* p) { typedef short v4i16_t __attribute__((ext_vector_type(4))); return __builtin_bit_cast(s16x4, __builtin_amdgcn_ds_read_tr16_b64_v4i16((LAS v4i16_t*)p)); }
__device__ __forceinline__ bf16x8 pack8(const f32x16& p, int b) {
    u32x4 w; w.x = cvtpk(p[b], p[b + 1]); w.y = cvtpk(p[b + 2], p[b + 3]); w.z = cvtpk(p[b + 4], p[b + 5]); w.w = cvtpk(p[b + 6], p[b + 7]); return __builtin_bit_cast(bf16x8, w);
}
template <int TYPE, bool SAMP>
__device__ __forceinline__ void attn_unit(unsigned char* ws, LAS unsigned char* lds, int l, int qrow0, int nq, int krow0, int qpos0, int nkeys, int h) {
    constexpr int DQK = TYPE == 0 ? 96 : 64, DV = TYPE == 0 ? 128 : 64, NS = DQK / 16, NDB = DV / 32;
    constexpr int KP = TYPE == 0 ? 208 : 144, VP = TYPE == 0 ? 320 : 192;
    constexpr int KBYTES = 64 * KP, VBYTES = 64 * VP, BUFB = KBYTES + VBYTES, OFF_F = 2 * BUFB, OFF_FLAG = OFF_F + 512;
    const int tid = fresh_tid(), lane = tid & 63, wid = __builtin_amdgcn_readfirstlane(tid >> 6), r32 = lane & 31, hh = lane >> 5;
    const bool wave_on = 32 * wid < nq;
    const int qloc = min(32 * wid + r32, nq - 1);
    const int qrow = qrow0 + qloc;
    const int qpos = qpos0 + 32 * wid + r32;
    const int qp_lo = qpos0 + 32 * wid, qp_hi = qp_lo + 31;
    const int jmax = (qpos0 + nq - 1) >> 6;
    const int wjmax = TYPE == 0 ? (qp_lo >> 6) : TYPE == 1 ? (qp_hi >> 6) : ((qp_hi - 1) >> 6);
    const bf16_t* Kg = TYPE == 0 ? WSP(const bf16_t, WS_KA) : TYPE == 1 ? WSP(const bf16_t, WS_KB) : WSP(const bf16_t, WS_KC); const bf16_t* Vg = TYPE == 0 ? WSP(const bf16_t, WS_VA) : TYPE == 1 ? WSP(const bf16_t, WS_VB) : WSP(const bf16_t, WS_VC);
    constexpr int NKC = TYPE == 0 ? 2 : 1, NVC = TYPE == 0 ? 2 : 1;
    const bf16_t* ksrc[NKC]; int kdst[NKC]; bool kval[NKC]; const bf16_t* vsrc[NVC]; int vdst[NVC];
#pragma unroll
    for (int r = 0; r < NKC; ++r) {
        if (TYPE == 0) { const int n = tid + 512 * r; kval[r] = n < 768; const int nn = kval[r] ? n : 0; const int row = nn / 12, c = nn % 12;
            ksrc[r] = c < 8 ? WSP(const bf16_t, WS_KA) + (size_t)(krow0 + row) * 256 + h * 64 + c * 8 : (const bf16_t*)(ws + kr_off(l)) + (size_t)(krow0 + row) * 32 + (c - 8) * 8; kdst[r] = row * KP + c * 16; }
        else { const int row = tid >> 3, c = tid & 7; kval[r] = true; ksrc[r] = Kg + (size_t)(krow0 + row) * 256 + h * 64 + c * 8; kdst[r] = row * KP + c * 16; }
    }
#pragma unroll
    for (int r = 0; r < NVC; ++r) {
        if (TYPE == 0) { const int n = tid + 512 * r; const int row = n >> 4, c = n & 15; vsrc[r] = WSP(const bf16_t, WS_VA) + (size_t)(krow0 + row) * 512 + h * 128 + c * 8; vdst[r] = row * VP + c * 16; }
        else { const int row = tid >> 3, c = tid & 7; vsrc[r] = Vg + (size_t)(krow0 + row) * 256 + h * 64 + c * 8; vdst[r] = row * VP + c * 16; }
    }
    const size_t kstepA = (size_t)64 * 256, kstepR = (size_t)64 * 32, vstep = (size_t)64 * (TYPE == 0 ? 512 : 256);
    u32x4 kreg[NKC], vreg[NVC]; float freg = 0.f;
    constexpr bool F32C = SAMP && TYPE != 0;
    const float* kc32 = nullptr; const float* vc32 = nullptr; u32x4 kx[2], vx[2]; bool ld32 = false;
    if (F32C) { const int sb = (krow0 - MP) / SPITCH; const size_t o32 = (((size_t)l * SBN + sb) * PAST + (tid >> 3)) * 256 + h * 64 + (tid & 7) * 8;
        kc32 = inp(lds, TYPE == 1 ? 4 : 7) + o32; vc32 = inp(lds, TYPE == 1 ? 5 : 8) + o32; }
#define ATT_LOAD(j) do { if (F32C && (j) < PAST / 64) { ld32 = true; const size_t t_ = (size_t)(j) * 64 * 256; \
            kx[0] = *(const u32x4*)(kc32 + t_); kx[1] = *(const u32x4*)(kc32 + t_ + 4); vx[0] = *(const u32x4*)(vc32 + t_); vx[1] = *(const u32x4*)(vc32 + t_ + 4); } else { ld32 = false; \
        _Pragma("unroll") for (int r_ = 0; r_ < NKC; ++r_) { const bool rope_ = (TYPE == 0) && (((tid + 512 * r_) % 12) >= 8); \
            if (kval[r_]) kreg[r_] = *(const u32x4*)(ksrc[r_] + (size_t)(j) * (rope_ ? kstepR : kstepA)); } \
        _Pragma("unroll") for (int r_ = 0; r_ < NVC; ++r_) vreg[r_] = *(const u32x4*)(vsrc[r_] + (size_t)(j) * vstep); } \
        if (TYPE == 1 && tid < 64) freg = WSP(const float, WS_FB)[(size_t)(krow0 + 64 * (j) + tid) * 4 + h]; } while (0)
#define ATT_STORE(b) do { LAS unsigned char* kb_ = lds + (b) * BUFB; \
        if (F32C && ld32) { kreg[0] = (u32x4){cvtpk(__uint_as_float(kx[0].x), __uint_as_float(kx[0].y)), cvtpk(__uint_as_float(kx[0].z), __uint_as_float(kx[0].w)), cvtpk(__uint_as_float(kx[1].x), __uint_as_float(kx[1].y)), cvtpk(__uint_as_float(kx[1].z), __uint_as_float(kx[1].w))}; \
            vreg[0] = (u32x4){cvtpk(__uint_as_float(vx[0].x), __uint_as_float(vx[0].y)), cvtpk(__uint_as_float(vx[0].z), __uint_as_float(vx[0].w)), cvtpk(__uint_as_float(vx[1].x), __uint_as_float(vx[1].y)), cvtpk(__uint_as_float(vx[1].z), __uint_as_float(vx[1].w))}; } \
        _Pragma("unroll") for (int r_ = 0; r_ < NKC; ++r_) if (kval[r_]) *(LAS u32x4*)(kb_ + kdst[r_]) = kreg[r_]; \
        _Pragma("unroll") for (int r_ = 0; r_ < NVC; ++r_) *(LAS u32x4*)(kb_ + KBYTES + vdst[r_]) = vreg[r_]; \
        if (TYPE == 1 && tid < 64) ((LAS float*)(lds + OFF_F))[(b) * 64 + tid] = freg; } while (0)
    bf16x8 qf[NS];
    { const bf16_t* qp = TYPE == 0 ? WSP(const bf16_t, WS_QA) + (size_t)qrow * 384 + h * 96 : (TYPE == 1 ? WSP(const bf16_t, WS_QB) : WSP(const bf16_t, WS_QC)) + (size_t)qrow * 256 + h * 64;
#pragma unroll
      for (int s = 0; s < NS; ++s) qf[s] = *(const bf16x8*)(qp + 16 * s + 8 * hh); }
    float fq = 0.f; if (TYPE == 1) fq = WSP(const float, WS_FB)[(size_t)(krow0 + min(qpos, nkeys - 1)) * 4 + h];
    float bound = INFINITY;
    if (TYPE == 1 && nq == 256) {
        float qn = 0.f;
#pragma unroll
        for (int s = 0; s < NS; ++s)
#pragma unroll
            for (int e = 0; e < 8; ++e) { const float x = __uint_as_float((unsigned)(unsigned short)qf[s][e] << 16); qn += x * x; }
        qn = half_swap_sum(qn);
        const unsigned* km = WSP(const unsigned, WS_CTL) + CW_KMAX + ((l * 4 + krow0 / PT) * 4 + h) * 2;
        bound = sqrtf(qn * (__uint_as_float(km[0]) + __uint_as_float(km[1]))) * 1.02f + 1.0f;
    }
    f32x16 o[NDB];
#pragma unroll
    for (int d = 0; d < NDB; ++d)
#pragma unroll
        for (int i = 0; i < 16; ++i) o[d][i] = 0.f;
    float mrun = 0.f, lrun = 0.f, carry = 0.f; bool wdone = !wave_on;
    f32x16 negc;
#pragma unroll
    for (int i = 0; i < 16; ++i) negc[i] = (TYPE == 1) ? fq : 0.f;
    LAS unsigned* flags = (LAS unsigned*)(lds + OFF_FLAG);
    if (TYPE != 0 && lane == 0) { flags[wid] = wave_on ? 0u : 1u; flags[8 + wid] = wave_on ? 0u : 1u; }
    const int pir = (r32 & ~12) | ((r32 & 4) << 1) | ((r32 & 8) >> 1);
    const int krd = pir * KP + 16 * hh;
    const int vrd = (8 * hh + ((lane & 15) >> 2)) * VP + 32 * ((lane >> 4) & 1) + 8 * (lane & 3);
    ATT_LOAD(jmax); ATT_STORE(0);
    for (int j = jmax; j >= 0; --j) {
        const int buf = (jmax - j) & 1;
        if (j > 0) ATT_LOAD(j - 1);
        __syncthreads();
        if (TYPE != 0) { const u32x4 f0 = *(const LAS u32x4*)(flags + 8 * buf), f1 = *(const LAS u32x4*)(flags + 8 * buf + 4);
            const unsigned all = f0.x & f0.y & f0.z & f0.w & f1.x & f1.y & f1.z & f1.w; if (__builtin_amdgcn_readfirstlane(all)) break; }
        if (wave_on && !wdone && j <= wjmax) {
            const LAS unsigned char* Kb = lds + buf * BUFB; const LAS unsigned char* Vb = Kb + KBYTES;
            f32x16 s0, s1;
            {
                bf16x8 kf0[NS], kf1[NS];
#pragma unroll
                for (int s = 0; s < NS; ++s) { kf0[s] = *(const LAS bf16x8*)(Kb + krd + 32 * s); kf1[s] = *(const LAS bf16x8*)(Kb + krd + 32 * KP + 32 * s); }
                __builtin_amdgcn_sched_barrier(0);

#pragma unroll
                for (int s = 0; s < NS; ++s) { if (s == 0) { s0 = MFMA32(kf0[0], qf[0], negc); s1 = MFMA32(kf1[0], qf[0], negc); } else { s0 = MFMA32(kf0[s], qf[s], s0); s1 = MFMA32(kf1[s], qf[s], s1); } }

                __builtin_amdgcn_sched_barrier(0);
            }
            s16x4 vl[2][4], vh[2][4];
#pragma unroll
            for (int ks = 0; ks < 4; ++ks) { vl[0][ks] = tr_rd(Vb + vrd + (16 * ks) * VP); vh[0][ks] = tr_rd(Vb + vrd + (16 * ks + 4) * VP); }
            __builtin_amdgcn_sched_barrier(0);
            const int kb0 = 64 * j + 8 * hh;
            const bool need_mask = TYPE == 0 ? (64 * j + 63 >= nkeys) : TYPE == 1 ? (64 * j + 63 > qp_lo) : (64 * j + 63 >= qp_lo);
            if (TYPE != 2) {
                if (TYPE == 1) { const LAS float* F = (const LAS float*)(lds + OFF_F) + buf * 64 + 8 * hh;
#pragma unroll
                    for (int a = 0; a < 2; ++a) { const f32x4 f0 = *(const LAS f32x4*)(F + 16 * a), f1 = *(const LAS f32x4*)(F + 16 * a + 4), g0 = *(const LAS f32x4*)(F + 32 + 16 * a), g1 = *(const LAS f32x4*)(F + 32 + 16 * a + 4);
#pragma unroll
                        for (int e = 0; e < 4; ++e) { s0[8 * a + e] -= f0[e]; s0[8 * a + 4 + e] -= f1[e]; s1[8 * a + e] -= g0[e]; s1[8 * a + 4 + e] -= g1[e]; } } }
                if (need_mask) {
#pragma unroll
                    for (int i = 0; i < 16; ++i) { const int k0 = kb0 + 16 * (i >> 3) + (i & 7), k1 = k0 + 32;
                        const bool ok0 = TYPE == 0 ? (k0 < nkeys) : (k0 <= qpos), ok1 = TYPE == 0 ? (k1 < nkeys) : (k1 <= qpos);
                        s0[i] = ok0 ? s0[i] : -INFINITY; s1[i] = ok1 ? s1[i] : -INFINITY; } }
#define MX3(a, b, c) __builtin_fmaxf(__builtin_fmaxf((a), (b)), (c))
                float rm;
                { const float t0 = MX3(s0[0], s0[1], s0[2]), t1 = MX3(s0[3], s0[4], s0[5]), t2 = MX3(s0[6], s0[7], s0[8]), t3 = MX3(s0[9], s0[10], s0[11]), t4 = MX3(s0[12], s0[13], s0[14]),
                              t5 = MX3(s1[0], s1[1], s1[2]), t6 = MX3(s1[3], s1[4], s1[5]), t7 = MX3(s1[6], s1[7], s1[8]), t8 = MX3(s1[9], s1[10], s1[11]), t9 = MX3(s1[12], s1[13], s1[14]);
                  const float u0 = MX3(t0, t1, t2), u1 = MX3(t3, t4, t5), u2 = MX3(t6, t7, t8), u3 = MX3(t9, s0[15], s1[15]); rm = __builtin_fmaxf(MX3(u0, u1, u2), u3); }
#undef MX3
                rm = half_swap_max(rm);
                const bool first = (j == wjmax);
                if (first || __any(rm > 8.0f)) {
                    const float dl = first ? rm : fmaxf(rm, 0.f);
                    mrun += dl;
#pragma unroll
                    for (int i = 0; i < 16; ++i) { s0[i] -= dl; s1[i] -= dl; }
                    const float cin = (TYPE == 1 ? fq : 0.f) - mrun;
#pragma unroll
                    for (int i = 0; i < 16; ++i) negc[i] = cin;
                    if (!first) { const float f = __builtin_amdgcn_exp2f(-dl); lrun *= f;
#pragma unroll
                        for (int d = 0; d < NDB; ++d)
#pragma unroll
                            for (int i = 0; i < 16; ++i) o[d][i] *= f; }
                }
                f32x2_t ls2 = {0.f, 0.f};
#pragma unroll
                for (int i = 0; i < 16; ++i) { s0[i] = __builtin_amdgcn_exp2f(s0[i]); s1[i] = __builtin_amdgcn_exp2f(s1[i]); }
#pragma unroll
                for (int i = 0; i < 16; i += 2) { ls2 += (f32x2_t){s0[i], s0[i + 1]}; ls2 += (f32x2_t){s1[i], s1[i + 1]}; }
                lrun += ls2[0] + ls2[1];
                if (TYPE == 1 && j > 0) { const float fnext = WSP(const float, WS_FB)[(size_t)(krow0 + 64 * j - 1) * 4 + h]; wdone = __all(bound + (fq - fnext) - mrun < EXIT_LOG2); }
            } else {
                f32x16 lk0, lk1;
#pragma unroll
                for (int i = 0; i < 16; ++i) {
                    const float z0 = s0[i], z1 = s1[i];
                    const float sp0 = fmaxf(z0, 0.f) + __builtin_amdgcn_logf(1.0f + __builtin_amdgcn_exp2f(-fabsf(z0))), sp1 = fmaxf(z1, 0.f) + __builtin_amdgcn_logf(1.0f + __builtin_amdgcn_exp2f(-fabsf(z1)));
                    lk0[i] = -sp0; lk1[i] = -sp1; s0[i] = z0 - sp0; s1[i] = z1 - sp1; }
                if (need_mask) {
#pragma unroll
                    for (int i = 0; i < 16; ++i) { const int k0 = kb0 + 16 * (i >> 3) + (i & 7), k1 = k0 + 32; const bool ok0 = k0 < qpos, ok1 = k1 < qpos;
                        lk0[i] = ok0 ? lk0[i] : 0.f; lk1[i] = ok1 ? lk1[i] : 0.f; s0[i] = ok0 ? s0[i] : -INFINITY; s1[i] = ok1 ? s1[i] : -INFINITY; } }
                f32x16 sf0, sf1; float gt[4];
#pragma unroll
                for (int a = 0; a < 2; ++a) { float r0 = 0.f, r1 = 0.f;
#pragma unroll
                    for (int e = 7; e >= 0; --e) { sf0[8 * a + e] = r0; r0 += lk0[8 * a + e]; sf1[8 * a + e] = r1; r1 += lk1[8 * a + e]; }
                    gt[a] = r0; gt[2 + a] = r1; }
                float pt[4], gs[4];
#pragma unroll
                for (int c = 0; c < 4; ++c) pt[c] = __shfl_xor(gt[c], 32);
                float later = 0.f;
#pragma unroll
                for (int c = 3; c >= 0; --c) { gs[c] = later + (hh == 0 ? pt[c] : 0.f); later += gt[c] + pt[c]; }
#pragma unroll
                for (int i = 0; i < 16; ++i) { s0[i] = __builtin_amdgcn_exp2f(s0[i] + sf0[i] + gs[i >> 3] + carry); s1[i] = __builtin_amdgcn_exp2f(s1[i] + sf1[i] + gs[2 + (i >> 3)] + carry); }
                carry += later;
                wdone = __all(carry < EXIT_LOG2);
            }
            bf16x8 pk[4]; pk[0] = pack8(s0, 0); pk[1] = pack8(s0, 8); pk[2] = pack8(s1, 0); pk[3] = pack8(s1, 8);
            {
#pragma unroll
                for (int d = 0; d < NDB; ++d) {
                    if (d + 1 < NDB) {
#pragma unroll
                        for (int ks = 0; ks < 4; ++ks) { vl[(d + 1) & 1][ks] = tr_rd(Vb + vrd + (16 * ks) * VP + 64 * (d + 1)); vh[(d + 1) & 1][ks] = tr_rd(Vb + vrd + (16 * ks + 4) * VP + 64 * (d + 1)); } }
                    __builtin_amdgcn_sched_barrier(0);

#pragma unroll
                    for (int ks = 0; ks < 4; ++ks) { const bf16x8 vf = __builtin_shufflevector(vl[d & 1][ks], vh[d & 1][ks], 0, 1, 2, 3, 4, 5, 6, 7); o[d] = MFMA32(vf, pk[ks], o[d]); }

                    __builtin_amdgcn_sched_barrier(0);
                }
            }
        }
        if (TYPE != 0 && lane == 0) flags[8 * (buf ^ 1) + wid] = wdone ? 1u : 0u;
        if (j > 0) ATT_STORE(buf ^ 1);
    }
    __syncthreads();
    if (wave_on) {
        float inv = 1.0f;
        if (TYPE != 2) { const float lt = half_swap_sum(lrun); inv = 1.0f / lt; }
        float ssq = 0.f;
#pragma unroll
        for (int d = 0; d < NDB; ++d)
#pragma unroll
            for (int i = 0; i < 16; ++i) { o[d][i] *= inv; ssq += o[d][i] * o[d][i]; }
        ssq = half_swap_sum(ssq);
        const bool rowok = 32 * wid + r32 < nq;
        if (rowok) {
            if (hh == 0) WSP(float, WS_SS)[(size_t)qrow * 12 + TYPE * 4 + h] = ssq;
            const int col0 = (TYPE == 0 ? 0 : TYPE == 1 ? 512 : 768) + h * DV + 4 * hh;
#pragma unroll
            for (int d = 0; d < NDB; ++d) { u32x2 gw[4];
#pragma unroll
                for (int g = 0; g < 4; ++g) gw[g] = *(const u32x2*)(WSP(const bf16_t, WS_GATE) + (size_t)qrow * D + col0 + 32 * d + 8 * g);
#pragma unroll
                for (int g = 0; g < 4; ++g) { u32x2 w; w.x = cvtpk(o[d][4 * g] * bf_lo(gw[g].x), o[d][4 * g + 1] * bf_hi(gw[g].x)); w.y = cvtpk(o[d][4 * g + 2] * bf_lo(gw[g].y), o[d][4 * g + 3] * bf_hi(gw[g].y));
                    *(u32x2*)(WSP(bf16_t, WS_OP) + (size_t)qrow * D + col0 + 32 * d + 8 * g) = w; } }
        }
    }
#undef ATT_LOAD
#undef ATT_STORE
}

template <int TYPE>
__device__ __forceinline__ void attn_pp(unsigned char* ws, LAS unsigned char* lds, int l, int qrow0, int krow0, int qpos0, int h) {
    constexpr int DQK = TYPE == 0 ? 96 : 64, DV = TYPE == 0 ? 128 : 64, NS = DQK / 16, NDB = DV / 32;
    constexpr int KP = TYPE == 0 ? 208 : 144, VP = TYPE == 0 ? 320 : 192;
    constexpr int KBYTES = 64 * KP, VBYTES = 64 * VP, OFF_V = 3 * KBYTES, OFF_F = OFF_V + 3 * VBYTES, OFF_FLAG = OFF_F + 3 * 256;
    const int tid = fresh_tid(), lane = tid & 63, wid = __builtin_amdgcn_readfirstlane(tid >> 6), r32 = lane & 31, hh = lane >> 5;
    const bool lag = wid >= 4;
    const int qrow = qrow0 + 32 * wid + r32, qpos = qpos0 + 32 * wid + r32, qp_lo = qpos0 + 32 * wid, qp_hi = qp_lo + 31;
    const int jmax = (qpos0 + 255) >> 6;
    const int wjmax = TYPE == 0 ? (qp_lo >> 6) : TYPE == 1 ? (qp_hi >> 6) : ((qp_hi - 1) >> 6);
    constexpr bool ASC = (TYPE == 0);
#define PP_T(i) (ASC ? (i) : jmax - (i))
    const size_t Kg = TYPE == 0 ? WS_KA : TYPE == 1 ? WS_KB : WS_KC, Vg = TYPE == 0 ? WS_VA : TYPE == 1 ? WS_VB : WS_VC;
    constexpr int NKC = TYPE == 0 ? 2 : 1, NVC = TYPE == 0 ? 2 : 1;
    unsigned ksrc[NKC]; int kdst[NKC]; unsigned vsrc[NVC]; int vdst[NVC];
#pragma unroll
    for (int r = 0; r < NKC; ++r) {
        if (TYPE == 0) {
            if (r == 0) { const int row = tid >> 3, c = tid & 7; ksrc[r] = (unsigned)(WS_KA + ((size_t)(krow0 + row) * 256 + h * 64 + c * 8) * 2); kdst[r] = row * KP + c * 16; }
            else { const int row = (tid & 255) >> 2, c = tid & 3; ksrc[r] = (unsigned)(kr_off(l) + ((size_t)(krow0 + row) * 32 + c * 8) * 2); kdst[r] = row * KP + 128 + c * 16; } }
        else { const int row = tid >> 3, c = tid & 7; ksrc[r] = (unsigned)(Kg + ((size_t)(krow0 + row) * 256 + h * 64 + c * 8) * 2); kdst[r] = row * KP + c * 16; }
    }
#pragma unroll
    for (int r = 0; r < NVC; ++r) {
        if (TYPE == 0) { const int row = tid >> 4, c = tid & 15; vsrc[r] = (unsigned)(WS_VA + ((size_t)(krow0 + row) * 512 + h * 128 + c * 8) * 2); vdst[r] = row * VP + c * 16; }
        else { const int row = tid >> 3, c = tid & 7; vsrc[r] = (unsigned)(Vg + ((size_t)(krow0 + row) * 256 + h * 64 + c * 8) * 2); vdst[r] = row * VP + c * 16; }
    }
    constexpr unsigned kstepA = 64u * 256u * 2u, kstepR = 64u * 32u * 2u, vstep = 64u * (TYPE == 0 ? 512u : 256u) * 2u;
    u32x4 kreg[NKC], vreg[NVC]; float freg = 0.f;
#define PP_KLOAD(j) do { _Pragma("unroll") for (int r_ = 0; r_ < NKC; ++r_) kreg[r_] = *(const u32x4*)(ws + (ksrc[r_] + (unsigned)(j) * (r_ == 1 ? kstepR : kstepA))); \
        if (TYPE == 1) freg = WSP(const float, WS_FB)[(size_t)(krow0 + 64 * (j) + lane) * 4 + h]; } while (0)
#define PP_VLOAD(j) do { _Pragma("unroll") for (int r_ = 0; r_ < NVC; ++r_) vreg[r_] = *(const u32x4*)((ws + (size_t)r_ * 32 * 1024) + (vsrc[0] + (unsigned)(j) * vstep)); } while (0)
#define PP_KSTORE(sl) do { LAS unsigned char* kb_ = lds + (sl) * KBYTES; \
        _Pragma("unroll") for (int r_ = 0; r_ < NKC; ++r_) *(LAS u32x4*)(kb_ + kdst[r_]) = kreg[r_]; \
        if (TYPE == 1) ((LAS float*)(lds + OFF_F))[(sl) * 64 + lane] = freg; } while (0)
#define PP_VSTORE(sl) do { LAS unsigned char* vb_ = lds + OFF_V + (sl) * VBYTES; \
        _Pragma("unroll") for (int r_ = 0; r_ < NVC; ++r_) *(LAS u32x4*)(vb_ + vdst[0] + r_ * 32 * VP) = vreg[r_]; } while (0)
    bf16x8 qf[NS];
    { const bf16_t* qp = TYPE == 0 ? WSP(const bf16_t, WS_QA) + (size_t)qrow * 384 + h * 96 : (TYPE == 1 ? WSP(const bf16_t, WS_QB) : WSP(const bf16_t, WS_QC)) + (size_t)qrow * 256 + h * 64;
#pragma unroll
      for (int s = 0; s < NS; ++s) qf[s] = *(const bf16x8*)(qp + 16 * s + 8 * hh); }
    float fq = 0.f; if (TYPE == 1) fq = WSP(const float, WS_FB)[(size_t)(krow0 + qpos) * 4 + h];
    float bound = INFINITY;
    if (TYPE == 1) {
        float qn = 0.f;
#pragma unroll
        for (int s = 0; s < NS; ++s)
#pragma unroll
            for (int e = 0; e < 8; ++e) { const float x = __uint_as_float((unsigned)(unsigned short)qf[s][e] << 16); qn += x * x; }
        qn = half_swap_sum(qn);
        const unsigned* km = WSP(const unsigned, WS_CTL) + CW_KMAX + ((l * 4 + krow0 / PT) * 4 + h) * 2;
        bound = sqrtf(qn * (__uint_as_float(km[0]) + __uint_as_float(km[1]))) * 1.02f + 1.0f;
    }
    f32x16 o[NDB];
#pragma unroll
    for (int d = 0; d < NDB; ++d)
#pragma unroll
        for (int i = 0; i < 16; ++i) o[d][i] = 0.f;
    float mrun = 0.f, lrun = 0.f, carry = 0.f; bool wdone = false, pend = false, brk = false;
    f32x16 negc;
#pragma unroll
    for (int i = 0; i < 16; ++i) negc[i] = (TYPE == 1) ? fq : 0.f;
    LAS unsigned* flags = (LAS unsigned*)(lds + OFF_FLAG);
    const int pir = (r32 & ~12) | ((r32 & 4) << 1) | ((r32 & 8) >> 1);
    const int krd = pir * KP + 16 * hh;
    const int vrd = (8 * hh + ((lane & 15) >> 2)) * VP + 32 * ((lane >> 4) & 1) + 8 * (lane & 3);
    f32x16 s0, s1; bf16x8 pk[4];
#pragma unroll
    for (int i = 0; i < 16; ++i) { s0[i] = 0.f; s1[i] = 0.f; }
#pragma unroll
    for (int i = 0; i < 4; ++i) pk[i] = (bf16x8){0, 0, 0, 0, 0, 0, 0, 0};
#define PP_KRD(sl) do { const LAS unsigned char* Kb_ = lds + (sl) * KBYTES; \
        _Pragma("unroll") for (int s = 0; s < NS; ++s) { kf0[s] = *(const LAS bf16x8*)(Kb_ + krd + 32 * s); kf1[s] = *(const LAS bf16x8*)(Kb_ + krd + 32 * KP + 32 * s); } } while (0)
#define PP_QKM() do { __builtin_amdgcn_sched_barrier(0); \
        _Pragma("unroll") for (int s = 0; s < NS; ++s) { if (s == 0) { s0 = MFMA32(kf0[0], qf[0], negc); s1 = MFMA32(kf1[0], qf[0], negc); } else { s0 = MFMA32(kf0[s], qf[s], s0); s1 = MFMA32(kf1[s], qf[s], s1); } } \
        __builtin_amdgcn_sched_barrier(0); } while (0)
#define PP_VRD(sl, d) do { const LAS unsigned char* Vb_ = lds + OFF_V + (sl) * VBYTES; \
        _Pragma("unroll") for (int ks = 0; ks < 4; ++ks) { vl[d][ks] = tr_rd(Vb_ + vrd + (16 * ks) * VP + 64 * (d)); vh[d][ks] = tr_rd(Vb_ + vrd + (16 * ks + 4) * VP + 64 * (d)); } } while (0)
#define PP_PVM(d) do { _Pragma("unroll") for (int ks = 0; ks < 4; ++ks) { const bf16x8 vf = __builtin_shufflevector(vl[d][ks], vh[d][ks], 0, 1, 2, 3, 4, 5, 6, 7); o[d] = MFMA32(vf, pk[ks], o[d]); } } while (0)
    PP_KLOAD(PP_T(0)); PP_VLOAD(PP_T(0)); PP_KSTORE(0); PP_VSTORE(0);
    PP_KLOAD(PP_T(1)); PP_KSTORE(1);
    PP_KLOAD(PP_T(2)); PP_VLOAD(PP_T(1));
    __syncthreads();
    if (PP_T(0) <= wjmax) { bf16x8 kf0[NS], kf1[NS]; PP_KRD(0); PP_QKM(); }
    if (lag) { __builtin_amdgcn_s_setprio(1); __syncthreads(); }
    int c = 0;
    for (int it = 0; it <= jmax; ++it) {
        const int j = PP_T(it), jn = PP_T(it + 1);
        const int c1 = c == 2 ? 0 : c + 1, c2 = c1 == 2 ? 0 : c1 + 1;
        bf16x8 kf0[NS], kf1[NS];
        s16x4 vl[NDB][4], vh[NDB][4];
        __syncthreads();
        if (TYPE != 0 && !lag && it > 0) { const u32x4 f0 = *(const LAS u32x4*)(flags + 8 * ((j + 1) & 1)), f1 = *(const LAS u32x4*)(flags + 8 * ((j + 1) & 1) + 4);
            const unsigned all = f0.x & f0.y & f0.z & f0.w & f1.x & f1.y & f1.z & f1.w; if (__builtin_amdgcn_readfirstlane(all)) { brk = true; break; } }
        PP_KSTORE(c2); PP_VSTORE(c1);
        const bool doq = it < jmax && jn <= wjmax && !wdone;
        PP_KRD(c1);
        { const int ik = it + 3 <= jmax ? it + 3 : jmax, iv = it + 2 <= jmax ? it + 2 : jmax; PP_KLOAD(PP_T(ik)); PP_VLOAD(PP_T(iv)); }
        if (j <= wjmax && !wdone) {
            const int kb0 = 64 * j + 8 * hh;
            const bool need_mask = TYPE == 0 ? false : TYPE == 1 ? (64 * j + 63 > qp_lo) : (64 * j + 63 >= qp_lo);
            if (TYPE != 2) {
                if (TYPE == 1) { const LAS float* F = (const LAS float*)(lds + OFF_F) + c * 64 + 8 * hh;
#pragma unroll
                    for (int a = 0; a < 2; ++a) { const f32x4 f0 = *(const LAS f32x4*)(F + 16 * a), f1 = *(const LAS f32x4*)(F + 16 * a + 4), g0 = *(const LAS f32x4*)(F + 32 + 16 * a), g1 = *(const LAS f32x4*)(F + 32 + 16 * a + 4);
#pragma unroll
                        for (int e = 0; e < 4; ++e) { s0[8 * a + e] -= f0[e]; s0[8 * a + 4 + e] -= f1[e]; s1[8 * a + e] -= g0[e]; s1[8 * a + 4 + e] -= g1[e]; } } }
                if (need_mask) {
#pragma unroll
                    for (int i = 0; i < 16; ++i) { const int k0 = kb0 + 16 * (i >> 3) + (i & 7), k1 = k0 + 32;
                        s0[i] = (k0 <= qpos) ? s0[i] : -INFINITY; s1[i] = (k1 <= qpos) ? s1[i] : -INFINITY; } }
#define MX3(a, b, c) __builtin_fmaxf(__builtin_fmaxf((a), (b)), (c))
                float rm;
                { const float t0 = MX3(s0[0], s0[1], s0[2]), t1 = MX3(s0[3], s0[4], s0[5]), t2 = MX3(s0[6], s0[7], s0[8]), t3 = MX3(s0[9], s0[10], s0[11]), t4 = MX3(s0[12], s0[13], s0[14]),
                              t5 = MX3(s1[0], s1[1], s1[2]), t6 = MX3(s1[3], s1[4], s1[5]), t7 = MX3(s1[6], s1[7], s1[8]), t8 = MX3(s1[9], s1[10], s1[11]), t9 = MX3(s1[12], s1[13], s1[14]);
                  const float u0 = MX3(t0, t1, t2), u1 = MX3(t3, t4, t5), u2 = MX3(t6, t7, t8), u3 = MX3(t9, s0[15], s1[15]); rm = __builtin_fmaxf(MX3(u0, u1, u2), u3); }
#undef MX3
                rm = half_swap_max(rm);
                const bool first = ASC ? (it == 0) : (j == wjmax);
                if (first || __any(rm > 8.0f)) {
                    const float dl = first ? rm : fmaxf(rm, 0.f);
                    mrun += dl;
#pragma unroll
                    for (int i = 0; i < 16; ++i) { s0[i] -= dl; s1[i] -= dl; }
                    { const float cin = (TYPE == 1 ? fq : 0.f) - mrun;
#pragma unroll
                      for (int i = 0; i < 16; ++i) negc[i] = cin; }
                    if (!first) { const float f = __builtin_amdgcn_exp2f(-dl); lrun *= f;
#pragma unroll
                        for (int d = 0; d < NDB; ++d)
#pragma unroll
                            for (int i = 0; i < 16; ++i) o[d][i] *= f; }
                }
                f32x2_t ls2 = {0.f, 0.f};
#pragma unroll
                for (int i = 0; i < 16; ++i) { s0[i] = __builtin_amdgcn_exp2f(s0[i]); s1[i] = __builtin_amdgcn_exp2f(s1[i]); }
#pragma unroll
                for (int i = 0; i < 16; i += 2) { ls2 += (f32x2_t){s0[i], s0[i + 1]}; ls2 += (f32x2_t){s1[i], s1[i + 1]}; }
                lrun += ls2[0] + ls2[1];
                if (TYPE == 1 && j > 0) { const float fnext = ((const LAS float*)(lds + OFF_F))[c1 * 64 + 63]; wdone = __all(bound + (fq - fnext) - mrun < EXIT_LOG2); }
            } else {
                f32x16 lk0, lk1;
#pragma unroll
                for (int i = 0; i < 16; ++i) {
                    const float z0 = s0[i], z1 = s1[i];
                    const float sp0 = fmaxf(z0, 0.f) + __builtin_amdgcn_logf(1.0f + __builtin_amdgcn_exp2f(-fabsf(z0))), sp1 = fmaxf(z1, 0.f) + __builtin_amdgcn_logf(1.0f + __builtin_amdgcn_exp2f(-fabsf(z1)));
                    lk0[i] = -sp0; lk1[i] = -sp1; s0[i] = z0 - sp0; s1[i] = z1 - sp1; }
                if (need_mask) {
#pragma unroll
                    for (int i = 0; i < 16; ++i) { const int k0 = kb0 + 16 * (i >> 3) + (i & 7), k1 = k0 + 32; const bool ok0 = k0 < qpos, ok1 = k1 < qpos;
                        lk0[i] = ok0 ? lk0[i] : 0.f; lk1[i] = ok1 ? lk1[i] : 0.f; s0[i] = ok0 ? s0[i] : -INFINITY; s1[i] = ok1 ? s1[i] : -INFINITY; } }
                f32x16 sf0, sf1; float gt[4];
#pragma unroll
                for (int a = 0; a < 2; ++a) { float r0 = 0.f, r1 = 0.f;
#pragma unroll
                    for (int e = 7; e >= 0; --e) { sf0[8 * a + e] = r0; r0 += lk0[8 * a + e]; sf1[8 * a + e] = r1; r1 += lk1[8 * a + e]; }
                    gt[a] = r0; gt[2 + a] = r1; }
                float pt[4], gs[4];
#pragma unroll
                for (int cc = 0; cc < 4; ++cc) pt[cc] = __shfl_xor(gt[cc], 32);
                float later = 0.f;
#pragma unroll
                for (int cc = 3; cc >= 0; --cc) { gs[cc] = later + (hh == 0 ? pt[cc] : 0.f); later += gt[cc] + pt[cc]; }
#pragma unroll
                for (int i = 0; i < 16; ++i) { s0[i] = __builtin_amdgcn_exp2f(s0[i] + sf0[i] + gs[i >> 3] + carry); s1[i] = __builtin_amdgcn_exp2f(s1[i] + sf1[i] + gs[2 + (i >> 3)] + carry); }
                carry += later;
                wdone = __all(carry < EXIT_LOG2);
            }
            pk[0] = pack8(s0, 0); pk[1] = pack8(s0, 8); pk[2] = pack8(s1, 0); pk[3] = pack8(s1, 8); pend = true;
        }
        if (TYPE != 0 && lane == 0) flags[8 * (j & 1) + wid] = wdone ? 1u : 0u;
        __syncthreads();
        bool allq = false;
        if (TYPE != 0 && lag) { const u32x4 f0 = *(const LAS u32x4*)(flags + 8 * (j & 1)), f1 = *(const LAS u32x4*)(flags + 8 * (j & 1) + 4);
            const unsigned all = f0.x & f0.y & f0.z & f0.w & f1.x & f1.y & f1.z & f1.w; allq = __builtin_amdgcn_readfirstlane(all) != 0u; }
        if (pend) PP_VRD(c, 0);
        if (doq && !wdone && !allq) PP_QKM();
        if (pend) {
            PP_VRD(c, 1); if (NDB > 2) { PP_VRD(c, 2); PP_VRD(c, 3); }
            __builtin_amdgcn_sched_barrier(0);
            PP_PVM(0); PP_PVM(1);
            if (NDB > 2) { PP_PVM(2); PP_PVM(3); }
            __builtin_amdgcn_sched_barrier(0);
            pend = false; }
        if (allq) { brk = true; break; }
        c = c1;
    }
    if (!lag && !brk) __syncthreads();
    __builtin_amdgcn_s_setprio(0);
    __syncthreads();
#undef PP_T
#undef PP_KLOAD
#undef PP_VLOAD
#undef PP_KSTORE
#undef PP_VSTORE
#undef PP_KRD
#undef PP_QKM
#undef PP_VRD
#undef PP_PVM
    {
        float inv = 1.0f;
        if (TYPE != 2) { const float lt = half_swap_sum(lrun); inv = 1.0f / lt; }
        float ssq = 0.f;
#pragma unroll
        for (int d = 0; d < NDB; ++d)
#pragma unroll
            for (int i = 0; i < 16; ++i) { o[d][i] *= inv; ssq += o[d][i] * o[d][i]; }
        ssq = half_swap_sum(ssq);
        if (hh == 0) WSP(float, WS_SS)[(size_t)qrow * 12 + TYPE * 4 + h] = ssq;
        const int col0 = (TYPE == 0 ? 0 : TYPE == 1 ? 512 : 768) + h * DV + 4 * hh;
#pragma unroll
        for (int d = 0; d < NDB; ++d) { u32x2 gw[4];
#pragma unroll
            for (int g = 0; g < 4; ++g) gw[g] = *(const u32x2*)(WSP(const bf16_t, WS_GATE) + (size_t)qrow * D + col0 + 32 * d + 8 * g);
#pragma unroll
            for (int g = 0; g < 4; ++g) { u32x2 w; w.x = cvtpk(o[d][4 * g] * bf_lo(gw[g].x), o[d][4 * g + 1] * bf_hi(gw[g].x)); w.y = cvtpk(o[d][4 * g + 2] * bf_lo(gw[g].y), o[d][4 * g + 3] * bf_hi(gw[g].y));
                *(u32x2*)(WSP(bf16_t, WS_OP) + (size_t)qrow * D + col0 + 32 * d + 8 * g) = w; } }
    }
}

template <int TYPE>
__device__ __forceinline__ void sample_octet(unsigned char* ws, float* out, LAS unsigned char* lds, int l, int oct) {
    constexpr int DQK = TYPE == 0 ? 96 : 64, DV = TYPE == 0 ? 128 : 64, NS = DQK / 16, NDB = DV / 32, VP = TYPE == 0 ? 320 : 192;
    constexpr int NT = 65;
    const int tid = fresh_tid(), lane = tid & 63, wid = __builtin_amdgcn_readfirstlane(tid >> 6), r32 = lane & 31, hh = lane >> 5;
    const int unit = oct * 8 + wid, sb = unit >> 2, h = unit & 3;
    LAS unsigned char* Vl = lds + wid * 10240;
    const int krow0 = MP + sb * SPITCH, qrow = MP + sb * STN + min(r32, STN - 1), qpos = PAST + r32;
    bf16x8 qf[NS];
    { const bf16_t* qp = TYPE == 0 ? WSP(const bf16_t, WS_QA) + (size_t)qrow * 384 + h * 96 : (TYPE == 1 ? WSP(const bf16_t, WS_QB) : WSP(const bf16_t, WS_QC)) + (size_t)qrow * 256 + h * 64;
#pragma unroll
      for (int s = 0; s < NS; ++s) qf[s] = *(const bf16x8*)(qp + 16 * s + 8 * hh); }
    float fq = 0.f; if (TYPE == 1) fq = WSP(const float, WS_FB)[(size_t)(krow0 + min(qpos, SKEYS - 1)) * 4 + h];
    const int pir = (r32 & ~12) | ((r32 & 4) << 1) | ((r32 & 8) >> 1);
    const float* kc = nullptr; const float* vc = nullptr; const float* kn = nullptr; const float* vn = nullptr;
    if (TYPE != 0) { const size_t cb = ((size_t)l * SBN + sb) * PAST * 256 + h * 64, nb = ((size_t)l * MS + sb * STN) * 256 + h * 64;
        kc = inp(lds, TYPE == 1 ? 4 : 7) + cb; vc = inp(lds, TYPE == 1 ? 5 : 8) + cb; kn = out + (TYPE == 1 ? O_SFK : O_SSK) + nb; vn = out + (TYPE == 1 ? O_SFV : O_SSV) + nb; }
    const bf16_t* KAp = WSP(const bf16_t, WS_KA) + (size_t)krow0 * 256 + h * 64; const bf16_t* KRp = (const bf16_t*)(ws + kr_off(l)) + (size_t)krow0 * 32; const bf16_t* VAp = WSP(const bf16_t, WS_VA) + (size_t)krow0 * 512 + h * 128;
    constexpr int NKR = TYPE == 0 ? NS : 2 * NS, NVR = 8;
    constexpr int PD = 1;
    u32x4 kraw[PD][NKR], vraw[PD][NVR]; float fkr[2][2] = {{0.f, 0.f}, {0.f, 0.f}};
#define SO_LOAD(t, S) do { \
        if (TYPE == 0) { const size_t kr_ = (size_t)(32 * (t) + pir); \
            _Pragma("unroll") for (int s_ = 0; s_ < NS; ++s_) kraw[S][s_] = s_ < 4 ? *(const u32x4*)(KAp + kr_ * 256 + 16 * s_ + 8 * hh) : *(const u32x4*)(KRp + kr_ * 32 + 16 * (s_ - 4) + 8 * hh); \
            _Pragma("unroll") for (int i_ = 0; i_ < 8; ++i_) { const int m_ = lane + 64 * i_; vraw[S][i_] = *(const u32x4*)(VAp + (size_t)(32 * (t) + (m_ >> 4)) * 512 + (m_ & 15) * 8); } \
        } else { const float* kb_ = (t) < 64 ? kc + (size_t)(t) * 32 * 256 : kn; const float* vb_ = (t) < 64 ? vc + (size_t)(t) * 32 * 256 : vn; \
            const int rcap_ = (t) < 64 ? 31 : STN - 1;         \
            _Pragma("unroll") for (int s_ = 0; s_ < NS; ++s_) { const float* p_ = kb_ + (size_t)min(pir, rcap_) * 256 + 16 * s_ + 8 * hh; kraw[S][2 * s_] = *(const u32x4*)p_; kraw[S][2 * s_ + 1] = *(const u32x4*)(p_ + 4); } \
            _Pragma("unroll") for (int i_ = 0; i_ < 4; ++i_) { const int m_ = lane + 64 * i_; const float* p_ = vb_ + (size_t)min(m_ >> 3, rcap_) * 256 + (m_ & 7) * 8; vraw[S][2 * i_] = *(const u32x4*)p_; vraw[S][2 * i_ + 1] = *(const u32x4*)(p_ + 4); } \
            if (TYPE == 1) { fkr[S][0] = WSP(const float, WS_FB)[(size_t)(krow0 + 32 * (t) + 8 * hh + (lane & 7)) * 4 + h]; fkr[S][1] = WSP(const float, WS_FB)[(size_t)(krow0 + 32 * (t) + 16 + 8 * hh + (lane & 7)) * 4 + h]; } } } while (0)
#define F2B(a, b) (u32x4){cvtpk(__uint_as_float((a).x), __uint_as_float((a).y)), cvtpk(__uint_as_float((a).z), __uint_as_float((a).w)), cvtpk(__uint_as_float((b).x), __uint_as_float((b).y)), cvtpk(__uint_as_float((b).z), __uint_as_float((b).w))}
    f32x16 o[NDB];
#pragma unroll
    for (int d = 0; d < NDB; ++d)
#pragma unroll
        for (int i = 0; i < 16; ++i) o[d][i] = 0.f;
    float mrun = 0.f, lrun = 0.f, carry = 0.f; bool done = false;
    f32x16 negc;
#pragma unroll
    for (int i = 0; i < 16; ++i) negc[i] = (TYPE == 1) ? fq : 0.f;
    const int vrd = (8 * hh + ((lane & 15) >> 2)) * VP + 32 * ((lane >> 4) & 1) + 8 * (lane & 3);
#define SO_BODY(t, S) do { \
        bf16x8 kf[NS]; const float fk0 = fkr[S][0], fk1 = fkr[S][1]; \
        _Pragma("unroll") for (int s = 0; s < NS; ++s) kf[s] = TYPE == 0 ? __builtin_bit_cast(bf16x8, kraw[S][s]) : __builtin_bit_cast(bf16x8, F2B(kraw[S][2 * s], kraw[S][2 * s + 1])); \
        if (TYPE == 0) { _Pragma("unroll") for (int i = 0; i < 8; ++i) { const int m = lane + 64 * i; *(LAS u32x4*)(Vl + (m >> 4) * VP + (m & 15) * 16) = vraw[S][i]; } } \
        else { _Pragma("unroll") for (int i = 0; i < 4; ++i) { const int m = lane + 64 * i; *(LAS u32x4*)(Vl + (m >> 3) * VP + (m & 7) * 16) = F2B(vraw[S][2 * i], vraw[S][2 * i + 1]); } } \
        if ((t) >= PD) SO_LOAD((t) - PD, S); \
        f32x16 s0; \
         \
        _Pragma("unroll") for (int s = 0; s < NS; ++s) s0 = MFMA32(kf[s], qf[s], s == 0 ? negc : s0); \
         \
        const int kb0 = 32 * (t) + 8 * hh;                                          \
        const bool need_mask = ((t) == NT - 1); \
        if (TYPE != 2) { \
            if (TYPE == 1) {     \
                _Pragma("unroll") for (int i = 0; i < 16; ++i) { const float f = __shfl(i < 8 ? fk0 : fk1, (lane & 32) | (i & 7)); s0[i] -= f; } } \
            if (need_mask) { \
                _Pragma("unroll") for (int i = 0; i < 16; ++i) { const int k0 = kb0 + 16 * (i >> 3) + (i & 7); const bool ok = TYPE == 0 ? (k0 < SKEYS) : (k0 <= qpos); s0[i] = ok ? s0[i] : -INFINITY; } } \
            float rm = s0[0]; \
            _Pragma("unroll") for (int i = 1; i < 16; ++i) rm = fmaxf(rm, s0[i]); \
            rm = half_swap_max(rm); \
            const bool first = ((t) == NT - 1); \
            if (first || __any(rm > 8.0f)) { \
                const float dl = first ? rm : fmaxf(rm, 0.f); \
                mrun += dl; \
                _Pragma("unroll") for (int i = 0; i < 16; ++i) s0[i] -= dl; \
                const float cin = (TYPE == 1 ? fq : 0.f) - mrun; \
                _Pragma("unroll") for (int i = 0; i < 16; ++i) negc[i] = cin; \
                if (!first) { const float f = __builtin_amdgcn_exp2f(-dl); lrun *= f; \
                    _Pragma("unroll") for (int d = 0; d < NDB; ++d) _Pragma("unroll") for (int i = 0; i < 16; ++i) o[d][i] *= f; } \
            } \
            float ls = 0.f; \
            _Pragma("unroll") for (int i = 0; i < 16; ++i) { s0[i] = __builtin_amdgcn_exp2f(s0[i]); ls += s0[i]; } \
            lrun += ls; \
        } else { \
            f32x16 lk0; \
            _Pragma("unroll") for (int i = 0; i < 16; ++i) { const float z0 = s0[i]; const float sp0 = fmaxf(z0, 0.f) + __builtin_amdgcn_logf(1.0f + __builtin_amdgcn_exp2f(-fabsf(z0))); lk0[i] = -sp0; s0[i] = z0 - sp0; } \
            if (need_mask) { \
                _Pragma("unroll") for (int i = 0; i < 16; ++i) { const int k0 = kb0 + 16 * (i >> 3) + (i & 7); const bool ok = k0 < qpos; lk0[i] = ok ? lk0[i] : 0.f; s0[i] = ok ? s0[i] : -INFINITY; } } \
            f32x16 sf0; float gt[2]; \
            _Pragma("unroll") for (int a = 0; a < 2; ++a) { float r0 = 0.f; \
                _Pragma("unroll") for (int e = 7; e >= 0; --e) { sf0[8 * a + e] = r0; r0 += lk0[8 * a + e]; } \
                gt[a] = r0; } \
            float pt[2], gs[2]; \
            _Pragma("unroll") for (int c = 0; c < 2; ++c) pt[c] = __shfl_xor(gt[c], 32); \
            float later = 0.f; \
            _Pragma("unroll") for (int c = 1; c >= 0; --c) { gs[c] = later + (hh == 0 ? pt[c] : 0.f); later += gt[c] + pt[c]; } \
            _Pragma("unroll") for (int i = 0; i < 16; ++i) s0[i] = __builtin_amdgcn_exp2f(s0[i] + sf0[i] + gs[i >> 3] + carry); \
            carry += later; \
        } \
        bf16x8 pk[2]; pk[0] = pack8(s0, 0); pk[1] = pack8(s0, 8); \
        {     \
            s16x4 vl[NDB][2], vh[NDB][2]; \
            _Pragma("unroll") for (int d = 0; d < NDB; ++d) _Pragma("unroll") for (int ks = 0; ks < 2; ++ks) { vl[d][ks] = tr_rd(Vl + vrd + (16 * ks) * VP + 64 * d); vh[d][ks] = tr_rd(Vl + vrd + (16 * ks + 4) * VP + 64 * d); } \
             \
            _Pragma("unroll") for (int d = 0; d < NDB; ++d) _Pragma("unroll") for (int ks = 0; ks < 2; ++ks) { const bf16x8 vf = __builtin_shufflevector(vl[d][ks], vh[d][ks], 0, 1, 2, 3, 4, 5, 6, 7); o[d] = MFMA32(vf, pk[ks], o[d]); } \
             \
        } \
        if (TYPE == 2) done = __all(carry < EXIT_LOG2);        \
    } while (0)
    if (PD == 1) {
        SO_LOAD(NT - 1, 0);
        for (int t = NT - 1; t >= 0; --t) { SO_BODY(t, 0); if (TYPE == 2 && done) break; }
    } else {
        SO_LOAD(NT - 1, 0); SO_LOAD(NT - 2, PD - 1);
        for (int t = NT - 1; t >= 0; t -= 2) {
            SO_BODY(t, 0); if (done) break;
            if (t >= 1) { SO_BODY(t - 1, PD - 1); if (done) break; }
        }
    }
#undef SO_BODY
#undef SO_LOAD
#undef F2B
    {
        float inv = 1.0f;
        if (TYPE != 2) { const float lt = half_swap_sum(lrun); inv = 1.0f / lt; }
        float ssq = 0.f;
#pragma unroll
        for (int d = 0; d < NDB; ++d)
#pragma unroll
            for (int i = 0; i < 16; ++i) { o[d][i] *= inv; ssq += o[d][i] * o[d][i]; }
        ssq = half_swap_sum(ssq);
        if (r32 < STN) {
            if (hh == 0) WSP(float, WS_SS)[(size_t)qrow * 12 + TYPE * 4 + h] = ssq;
            const int col0 = (TYPE == 0 ? 0 : TYPE == 1 ? 512 : 768) + h * DV + 4 * hh;
#pragma unroll
            for (int d = 0; d < NDB; ++d) { u32x2 gw[4];
#pragma unroll
                for (int g = 0; g < 4; ++g) gw[g] = *(const u32x2*)(WSP(const bf16_t, WS_GATE) + (size_t)qrow * D + col0 + 32 * d + 8 * g);
#pragma unroll
                for (int g = 0; g < 4; ++g) { u32x2 w; w.x = cvtpk(o[d][4 * g] * bf_lo(gw[g].x), o[d][4 * g + 1] * bf_hi(gw[g].x)); w.y = cvtpk(o[d][4 * g + 2] * bf_lo(gw[g].y), o[d][4 * g + 3] * bf_hi(gw[g].y));
                    *(u32x2*)(WSP(bf16_t, WS_OP) + (size_t)qrow * D + col0 + 32 * d + 8 * g) = w; } }
        }
    }
    asm volatile("s_waitcnt vmcnt(0)" ::: "memory");
    __syncthreads();
    if (tid == 0) { __builtin_amdgcn_fence(__ATOMIC_RELEASE, "agent"); asm volatile("s_waitcnt vmcnt(0)" ::: "memory");
        __hip_atomic_fetch_add(WSP(unsigned, WS_CTL) + CW_SDONE + 16 * l, 1u, __ATOMIC_RELAXED, __HIP_MEMORY_SCOPE_AGENT); }
}
constexpr int CV_CHUNKS = 4096, N_CV_CKV = SBN * PAST * 256 / 8 / CV_CHUNKS, N_CV_KPE = SBN * PAST * 32 / 8 / CV_CHUNKS, N_CV = N_CV_CKV + N_CV_KPE;
constexpr int P0_I0 = 16 * (NINP / 32), P0_I1 = 4 * 24, P0_I2 = 16 * 32, P0_IL = P0_I0 + P0_I1 + P0_I2, N_WT = P0_IL / 8;
static_assert(P0_IL % 8 == 0, "weight items per layer in units of 8");
__device__ __forceinline__ void conv_unit(unsigned char* ws, LAS unsigned char* lds, int ln, int u) {
    const int tid = fresh_tid();
    const bool ckv = u < N_CV_CKV; const int v = ckv ? u : u - N_CV_CKV;
    const float* src = ckv ? inp(lds, 2) + (size_t)ln * SBN * PAST * 256 : inp(lds, 3) + (size_t)ln * SBN * PAST * 32;
    f32x4 a[8], b[8];
#pragma unroll
    for (int k = 0; k < 8; ++k) { const size_t q = (size_t)v * CV_CHUNKS + tid + 512 * k; a[k] = *(const f32x4*)(src + q * 8); b[k] = *(const f32x4*)(src + q * 8 + 4); }
#pragma unroll
    for (int k = 0; k < 8; ++k) { const int q = v * CV_CHUNKS + tid + 512 * k;
        bf16_t* dst; if (ckv) dst = WSP(bf16_t, WS_CKVB) + (size_t)M * 256 + (size_t)q * 8; else { const int per_b = PAST * 32 / 8, sb = q / per_b, rem = q % per_b; dst = (bf16_t*)(ws + kr_off(ln)) + (size_t)MP * 32 + (size_t)sb * SPITCH * 32 + (size_t)rem * 8; }
        u32x4 o; o.x = cvtpk(a[k][0], a[k][1]); o.y = cvtpk(a[k][2], a[k][3]); o.z = cvtpk(b[k][0], b[k][1]); o.w = cvtpk(b[k][2], b[k][3]); *(u32x4*)dst = o; }
}
__device__ __forceinline__ void weight_unit(unsigned char* ws, LAS unsigned char* lds, int ln, int u) {
    const int tid = fresh_tid(), lane = tid & 63, wid = __builtin_amdgcn_readfirstlane(tid >> 6);
    LAS float* scr = (LAS float*)(lds + wid * 16384);
    int r = u * 8 + wid;
    if (r < P0_I0) p0_item(ws, lds, 0, ln, r, scr, lane);
    else if (r < P0_I0 + P0_I1) p0_item(ws, lds, 1, ln, r - P0_I0, scr, lane);
    else p0_item(ws, lds, 2, ln, r - P0_I0 - P0_I1, scr, lane);
}
constexpr int NU_P = 32 * 16, NU_S = SBN * 4 / 8, NU_T = NU_P + NU_S, NU_ALL = 3 * NU_T;
__device__ __forceinline__ int q_fetch(unsigned* head, LAS int* slot) {
    __syncthreads();
    if (threadIdx.x == 0) *slot = (int)__hip_atomic_fetch_add(head, 1u, __ATOMIC_RELAXED, __HIP_MEMORY_SCOPE_AGENT);
    __syncthreads();
    return __builtin_amdgcn_readfirstlane(*slot);
}
template <int TYPE>
__device__ __forceinline__ void attn_prompt(unsigned char* ws, LAS unsigned char* lds, int l, int xq, int v) {
    const int qb = 31 - (v >> 1), bh = 2 * xq + (v & 1), b = bh >> 2, h = bh & 3;
#ifndef PP_MASK
#define PP_MASK 7
#endif
    if ((PP_MASK >> TYPE) & 1) attn_pp<TYPE>(ws, lds, l, b * PT + qb * 256, b * PT, qb * 256, h);
    else attn_unit<TYPE, false>(ws, lds, l, b * PT + qb * 256, 256, b * PT, qb * 256, PT, h);
}
template <int TYPE>
__device__ __forceinline__ void prompt_queues(unsigned char* ws, LAS unsigned char* lds, int l, LAS int* slot) {
    const int x = (int)(xb_xcc_id() & 7u);
    unsigned* const hb = (unsigned*)(ws + WS_CTL) + CW_XQ + ((l * 3 + TYPE) * 8) * 16;
    int xq = x;
    int v = q_fetch(hb + xq * 16, slot);
    for (;;) {
        while (v < 64) { attn_prompt<TYPE>(ws, lds, l, xq, v); v = q_fetch(hb + xq * 16, slot); }
        __syncthreads();
        if (threadIdx.x == 0) { unsigned h[8];
#pragma unroll
            for (int i = 0; i < 8; ++i) h[i] = __hip_atomic_fetch_add(hb + ((x + i) & 7) * 16, 0u, __ATOMIC_RELAXED, __HIP_MEMORY_SCOPE_AGENT);
            int pick = -1;
#pragma unroll
            for (int i = 7; i >= 0; --i) pick = h[i] < 64u ? ((x + i) & 7) : pick;
            *slot = pick; }
        __syncthreads(); xq = __builtin_amdgcn_readfirstlane(*slot);
        if (xq < 0) break;
        v = q_fetch(hb + xq * 16, slot);
    }
}
__device__ __forceinline__ void sample_outproj(unsigned char* ws, LAS unsigned char* lds, int l, LAS int* slot) {
    unsigned* const ctl = WSP(unsigned, WS_CTL) + CW_SDONE + 16 * l;
    int u = q_fetch(ctl + 8, slot);
    while (u < 8) {
        if (threadIdx.x == 0) { unsigned sp = 0;
            while (__hip_atomic_fetch_add(ctl, 0u, __ATOMIC_RELAXED, __HIP_MEMORY_SCOPE_AGENT) < 3u * NU_S) { __builtin_amdgcn_s_sleep(8); if (++sp > (1u << 18)) break; }
            __builtin_amdgcn_fence(__ATOMIC_ACQUIRE, "agent"); asm volatile("s_waitcnt vmcnt(0)" ::: "memory"); }
        __syncthreads();
        pg8::Gemm g{(const pg8::bf16_t*)(ws + WS_OP), (const pg8::bf16_t*)(ws + WS_WOUT + (size_t)l * D * D * 2), M, D, D};
        pg8::OneUnit S; S.pm = MP / 256 + (u >> 2); S.pn = u & 3;
        EpiP5 E; E.ws = ws; E.tab = (LAS float*)(lds + SCR_OFF);
        pg8::gemm_phase<EpiP5, pg8::OneUnit, true, true>(lds, g, S, E);
        u = q_fetch(ctl + 8, slot);
    }
}
__device__ __forceinline__ void p4_attention(unsigned char* ws, float* out, int l, LAS unsigned char* lds, int rep) {
    unsigned* head = (unsigned*)(ws + WS_CTL) + CW_QUEUE + 64 * l + 16 * rep; LAS int* slot = (LAS int*)(lds + MISC_OFF + 64);
#define NEXT_BEGIN() int nx_ = 0; if (threadIdx.x == 0) nx_ = (int)__hip_atomic_fetch_add(head, 1u, __ATOMIC_RELAXED, __HIP_MEMORY_SCOPE_AGENT)
#define NEXT_END() do { if (threadIdx.x == 0) *slot = nx_; __syncthreads(); u = __builtin_amdgcn_readfirstlane(*slot); } while (0)
    const int ncv = (l + 1 < NL) ? N_CV : 0, nwt = (l + 1 < NL) ? N_WT : 0;
    const int b0 = ncv, b1 = b0 + nwt, b2 = b1 + NU_S, b3 = b2 + NU_S, b4 = b3 + NU_S;
    int u = q_fetch(head, slot);
    while (u < b0) { NEXT_BEGIN(); conv_unit(ws, lds, l + 1, u); NEXT_END(); }
    while (u < b1) { NEXT_BEGIN(); weight_unit(ws, lds, l + 1, u - b0); NEXT_END(); }
    while (u < b2) { NEXT_BEGIN(); sample_octet<0>(ws, out, lds, l, u - b1); NEXT_END(); }
    while (u < b3) { NEXT_BEGIN(); sample_octet<1>(ws, out, lds, l, u - b2); NEXT_END(); }
    while (u < b4) { NEXT_BEGIN(); sample_octet<2>(ws, out, lds, l, u - b3); NEXT_END(); }
    prompt_queues<0>(ws, lds, l, slot);
    sample_outproj(ws, lds, l, slot);
    prompt_queues<1>(ws, lds, l, slot);
    prompt_queues<2>(ws, lds, l, slot);
#undef NEXT_BEGIN
#undef NEXT_END
}
constexpr int N_PHASES = 2 + 5 * NL;
__global__ void __launch_bounds__(512, 2) fwd(Params P) {
    extern __shared__ __attribute__((aligned(16))) unsigned char lds_raw[];
    LAS unsigned char* lds = (LAS unsigned char*)lds_raw;
    const int tid = threadIdx.x;
    if (tid < 64) ((LAS unsigned*)(lds + MISC_OFF))[tid] = 0u;
    if (tid < 18) ((LAS unsigned long long*)(lds + PTR_OFF))[tid] = (unsigned long long)P.in[tid];
    __syncthreads();
    unsigned char* const ws0 = P.ws; float* const out0 = P.out;
    unsigned* ctl = (unsigned*)(ws0 + WS_CTL);
    XcdBarrier bar = xcd_barrier_post(ctl + CW_BAR, (volatile LAS unsigned*)(lds + MISC_OFF + 32));
    const int lo = P.ph_lo, hi = P.ph_hi;
#ifndef PHM
#define PHM 0x7f
#endif
#ifndef REP_P1
#define REP_P1 1
#endif
#ifndef REP_P2
#define REP_P2 1
#endif
#ifndef REP_P3
#define REP_P3 1
#endif
#ifndef REP_P4
#define REP_P4 1
#endif
#ifndef REP_P5
#define REP_P5 1
#endif
#define IN(k) (lo <= (k) && (k) < hi)
#define SEAM(k) do { if (IN(k) && IN((k) + 1)) { XcdBarrier b2_ = bar; unsigned* bb_ = b2_.bar; asm volatile("" : "+s"(bb_)); b2_.bar = bb_; xcd_barrier(b2_); } } while (0)
#define FRESH() unsigned long long ws_i_ = (unsigned long long)ws0, out_i_ = (unsigned long long)out0; asm volatile("" : "+s"(ws_i_), "+s"(out_i_)); unsigned char* ws = (unsigned char*)(GAS unsigned char*)ws_i_; float* out = (float*)(GAS float*)out_i_; (void)out
    if ((PHM & 1) && IN(0)) { FRESH(); p0_prologue(ws, lds); }
    if (!(IN(0) && IN(1))) SEAM(0);
    for (int l = 0; l <= NL; ++l) {
        const int pb = 1 + 5 * l;
        if ((PHM & 2) && IN(pb)) { FRESH(); p1_norm(ws, out, lds, l); }
        if (l == NL) break;
        SEAM(pb);
        if ((PHM & 4) && IN(pb + 1)) { FRESH();
            pg8::Gemm g{(const pg8::bf16_t*)(ws + WS_XN), (const pg8::bf16_t*)(ws + WS_WIN + (size_t)l * NINP * D * 2), M, NINP, D};
            pg8::StaticOrder S; S.init(M, NINP, (int)gridDim.x, (int)blockIdx.x);
            EpiP2 E; E.ws = ws; E.out = out; E.kvnorm = inp(lds, 12) + l * 256; E.fbias = inp(lds, 15) + l * 4; E.l = l; E.scr = (LAS float*)(lds + SCR_OFF);
            _Pragma("nounroll") for (int rep = 0; rep < REP_P2; ++rep) pg8::gemm_phase<EpiP2, pg8::StaticOrder, true, true>(lds, g, S, E);
        }
        SEAM(pb + 1);
        if ((PHM & 8) && IN(pb + 2)) { FRESH();
            if (blockIdx.x < 36) cumsum_task(ws, l, (int)blockIdx.x, lds);
            int k3 = 256; asm volatile("" : "+s"(k3));
            pg8::Gemm g{(const pg8::bf16_t*)(ws + WS_CKVB), (const pg8::bf16_t*)(ws + WS_WUKV + (size_t)l * 768 * 256 * 2), M3, 768, k3};
            pg8::StaticOrder S; S.init(M3, 768, (int)gridDim.x, (int)blockIdx.x);
            EpiP3 E; E.ws = ws;
            _Pragma("nounroll") for (int rep = 0; rep < REP_P3; ++rep) pg8::gemm_phase<EpiP3, pg8::StaticOrder, true, true>(lds, g, S, E);
        }
        SEAM(pb + 2);
        if ((PHM & 16) && IN(pb + 3)) { FRESH(); _Pragma("nounroll") for (int rep = 0; rep < REP_P4; ++rep) p4_attention(ws, out, l, lds, rep); }
        SEAM(pb + 3);
        if ((PHM & 64) && IN(pb + 4)) { FRESH();
            pg8::Gemm g{(const pg8::bf16_t*)(ws + WS_OP), (const pg8::bf16_t*)(ws + WS_WOUT + (size_t)l * D * D * 2), M, D, D};
            pg8::StaticOrder S; S.init(MP, D, (int)gridDim.x, (int)blockIdx.x);
            EpiP5 E; E.ws = ws; E.tab = (LAS float*)(lds + SCR_OFF);
            _Pragma("nounroll") for (int rep = 0; rep < REP_P5; ++rep) pg8::gemm_phase<EpiP5, pg8::StaticOrder, true, true>(lds, g, S, E);
        }
        SEAM(pb + 4);
    }
#undef IN
#undef SEAM
}

#ifndef MK_SPLIT
#define MK_SPLIT 0
#endif
extern "C" void kernel_launch(void* const* d_in, const int* in_sizes, int n_in, void* d_out, int out_size, void* d_ws, size_t ws_size, hipStream_t stream) {
    static int grid = 0;
    if (grid == 0) {
        if (n_in != 18 || (size_t)out_size != O_END || ws_size < WS_END) { fprintf(stderr, "kernel_launch: unexpected shapes: n_in %d out %d ws %zu\n", n_in, out_size, ws_size); grid = -1; return; }
        int dev = 0, cus = 0, per_cu = 0;
        if (hipGetDevice(&dev) != hipSuccess || hipDeviceGetAttribute(&cus, hipDeviceAttributeMultiprocessorCount, dev) != hipSuccess) { grid = -1; return; }
        if (hipFuncSetAttribute((const void*)fwd, hipFuncAttributeMaxDynamicSharedMemorySize, LDS_BYTES) != hipSuccess) { fprintf(stderr, "kernel_launch: hipFuncSetAttribute failed\n"); grid = -1; return; }
        if (hipOccupancyMaxActiveBlocksPerMultiprocessor(&per_cu, (const void*)fwd, 512, LDS_BYTES) != hipSuccess || per_cu < 1) { fprintf(stderr, "kernel_launch: occupancy query reports %d blocks per CU\n", per_cu); (void)hipGetLastError(); grid = -1; return; }
        grid = cus;
    }
    if (grid < 0) return;
    (void)hipMemsetAsync((char*)d_ws + WS_CTL, 0, CTL_ZERO_BYTES, stream);
    Params p{};
    for (int i = 0; i < 18; ++i) p.in[i] = (const float*)d_in[i];
    p.out = (float*)d_out; p.ws = (unsigned char*)d_ws;
#if MK_SPLIT
    for (int ph = 0; ph < N_PHASES; ++ph) { p.ph_lo = ph; p.ph_hi = ph + 1; hipLaunchKernelGGL(fwd, dim3(grid), dim3(512), LDS_BYTES, stream, p); }
#else
    p.ph_lo = 0; p.ph_hi = N_PHASES;
    hipLaunchKernelGGL(fwd, dim3(grid), dim3(512), LDS_BYTES, stream, p);
#endif
    const hipError_t le = hipPeekAtLastError();
    if (le != hipSuccess) fprintf(stderr, "kernel_launch: launch failed: %s\n", hipGetErrorName(le));
}
```

```cpp
#include <hip/hip_runtime.h>
#include <cstdio>
#include <cstdint>
namespace pg8 {
#define PG8_LAS __attribute__((address_space(3)))
typedef unsigned short bf16_t;
typedef short bf16x8 __attribute__((ext_vector_type(8)));
typedef float f32x4 __attribute__((ext_vector_type(4)));
typedef unsigned u32x4 __attribute__((ext_vector_type(4)));
constexpr int BM = 256, BK = 64, HALF = 128, HTB = HALF * BK * 2  , STAGE_BYTES = 8 * HTB, NXCD = 8, WGM = 8;

__host__ __device__ __forceinline__ int lds_byte(int r, int c) { const int st = (r >> 4) * 2 + (c >> 5), rr = r & 15, cc = c & 31, ob = rr * 64 + cc * 2; return st * 1024 + (ob ^ (((ob >> 9) & 1) << 5)); }
__host__ __device__ __forceinline__ void stage_rc(int b, int& R, int& C) { const int st = b / 1024, sb = b % 1024, swz = sb ^ (((sb >> 9) & 1) << 5); R = (st >> 1) * 16 + swz / 64; C = (st & 1) * 32 + (swz % 64) / 2; }
__host__ __device__ __forceinline__ int perm32(int rho) { const int n = rho >> 4, i = rho & 15; return 8 * (i >> 2) + 4 * n + (i & 3); }

struct Unit { int pm, pn; };
struct Gemm { const bf16_t* A; const bf16_t* Bt; int M, N, K; };

struct StaticOrder {
    int nM, nN, nwg, G, c;
    __host__ __device__ void init(int M, int N, int G_, int c_) { nM = M / BM; nN = N / BM; nwg = nM * nN; G = G_; c = c_; }
    __host__ __device__ bool next(int i, Unit& u) const {
        const long L = (long)i * G + c; if (L >= nwg) return false;
        int wgid = (int)L; { const int q = nwg / NXCD, r = nwg % NXCD, xcd = wgid % NXCD, off = wgid / NXCD; wgid = (xcd < r ? xcd * (q + 1) : r * (q + 1) + (xcd - r) * q) + off; }
        const int nig = WGM * nN, gid = wgid / nig, fm = gid * WGM, gsz = (nM - fm) < WGM ? (nM - fm) : WGM;
        u.pm = fm + ((wgid % nig) % gsz); u.pn = (wgid % nig) / gsz; return true;
    }
    __device__ __forceinline__ void a_ready(const Unit&) const {}
    __device__ __forceinline__ void done(const Unit&) const {}
};

struct OneUnit {
    int pm, pn;
    __host__ __device__ bool next(int i, Unit& u) const { if (i > 0) return false; u.pm = pm; u.pn = pn; return true; }
    __device__ __forceinline__ void a_ready(const Unit&) const {}
    __device__ __forceinline__ void done(const Unit&) const {}
};
__device__ __forceinline__ unsigned cvt_pk_bf16(float lo, float hi) { unsigned r; asm volatile("v_cvt_pk_bf16_f32 %0, %1, %2" : "=v"(r) : "v"(lo), "v"(hi)); return r; }
typedef float f32x2 __attribute__((ext_vector_type(2)));
template <class Epi, class Sched, bool ALIGN_EPI = false, bool SP2 = false>
__device__ __forceinline__ void gemm_phase(PG8_LAS unsigned char* lds, const Gemm g, const Sched& S, const Epi& E) {
    int tid_ = threadIdx.x; asm volatile("" : "+v"(tid_));
    const int tid = tid_, wid = __builtin_amdgcn_readfirstlane(tid >> 6), lane = tid & 63, wr = wid >> 2, wc = wid & 3, fr = lane & 15, fq = lane >> 4;
    const int K = g.K, nt = K / BK;
    unsigned voffA[2], voffB[2];
#pragma unroll
    for (int i = 0; i < 2; ++i) { int R, C; stage_rc(tid * 16 + i * 8192, R, C); const int Rb = Epi::PERM ? ((R & ~31) + perm32(R & 31)) : R;
        voffA[i] = (unsigned)(R * K + C) * 2u; voffB[i] = (unsigned)(Rb * K + C) * 2u; }
    const size_t kstep = (size_t)(BK * 2);
    const size_t hstep = (size_t)HALF * K * 2;
    const size_t tstep = 2 * hstep;
    const unsigned ldsw = (unsigned)wid * 1024u;
    const int aoff = lds_byte(wr * 64 + fr, fq * 8), boff = lds_byte(wc * 32 + fr, fq * 8);
#define PG8_SA(b, h) (((b) * 2 + (h)) * HTB)
#define PG8_SB(b, h) ((4 + (b) * 2 + (h)) * HTB)
#define PG8_STAGE(bufoff, gbase, voff) do { _Pragma("unroll") for (int _i = 0; _i < 2; ++_i) \
        __builtin_amdgcn_global_load_lds((const unsigned*)((const char*)(gbase) + (voff)[_i]), (PG8_LAS unsigned*)(lds + (bufoff) + ldsw + _i * 8192), 16, 0, 0); } while (0)
#define PG8_LDA(dst, b, h) do { _Pragma("unroll") for (int m = 0; m < 4; ++m) _Pragma("unroll") for (int k = 0; k < 2; ++k) dst[m][k] = *(const PG8_LAS bf16x8*)(lds + PG8_SA(b, h) + aoff + m * 2048 + k * 1024); } while (0)
#define PG8_LDB(dst, b, h) do { _Pragma("unroll") for (int n = 0; n < 2; ++n) _Pragma("unroll") for (int k = 0; k < 2; ++k) dst[n][k] = *(const PG8_LAS bf16x8*)(lds + PG8_SB(b, h) + boff + n * 2048 + k * 1024); } while (0)
#define PG8_MMA(ai, bj, At, Bt) do { __builtin_amdgcn_s_setprio(1); _Pragma("unroll") for (int m = 0; m < 4; ++m) _Pragma("unroll") for (int n = 0; n < 2; ++n) _Pragma("unroll") for (int k = 0; k < 2; ++k) \
        acc[ai][bj][m][n] = __builtin_amdgcn_mfma_f32_16x16x32_bf16(Bt[n][k], At[m][k], acc[ai][bj][m][n], 0, 0, 0); __builtin_amdgcn_s_setprio(0); } while (0)
#define PG8_WAIT_V(n) asm volatile("s_waitcnt vmcnt(" #n ")" ::: "memory")
#define PG8_WAIT_L(n) asm volatile("s_waitcnt lgkmcnt(" #n ")" ::: "memory")
#define PG8_BAR __builtin_amdgcn_s_barrier()
#define PG8_SCHED __builtin_amdgcn_sched_barrier(0)
    Unit cur, nxt; int ui = 0;
    if (!S.next(0, cur)) return;
    f32x4 acc[2][2][4][2];
#pragma unroll
    for (int a = 0; a < 2; ++a)
#pragma unroll
        for (int b = 0; b < 2; ++b)
#pragma unroll
            for (int m = 0; m < 4; ++m)
#pragma unroll
                for (int n = 0; n < 2; ++n) acc[a][b][m][n] = (f32x4){0.f, 0.f, 0.f, 0.f};
    bf16x8 At[4][2], B0[2][2], B1[2][2];
    const char* cA = (const char*)g.A + (size_t)cur.pm * tstep; const char* cB = (const char*)g.Bt + (size_t)cur.pn * tstep;
    S.a_ready(cur);
    if constexpr (Epi::MID) E.prep(cur, 0, tid);
    if constexpr (SP2) {
        PG8_STAGE(PG8_SB(0, 0), cB, voffB); PG8_STAGE(PG8_SB(0, 1), cB + hstep, voffB); PG8_STAGE(PG8_SA(0, 0), cA, voffA); PG8_STAGE(PG8_SA(0, 1), cA + hstep, voffA);
        if (wr == 1) PG8_BAR;
        PG8_WAIT_V(2); PG8_BAR;
        PG8_STAGE(PG8_SB(1, 0), cB + kstep, voffB); PG8_STAGE(PG8_SA(1, 0), cA + kstep, voffA); PG8_STAGE(PG8_SB(1, 1), cB + hstep + kstep, voffB);
        PG8_WAIT_V(6); PG8_BAR;
    } else {
        PG8_STAGE(PG8_SB(0, 0), cB, voffB); PG8_STAGE(PG8_SA(0, 0), cA, voffA); PG8_STAGE(PG8_SB(0, 1), cB + hstep, voffB); PG8_STAGE(PG8_SA(0, 1), cA + hstep, voffA);
        if (wr == 1) PG8_BAR;
        PG8_WAIT_V(4); PG8_BAR;
        PG8_STAGE(PG8_SB(1, 0), cB + kstep, voffB); PG8_STAGE(PG8_SA(1, 0), cA + kstep, voffA); PG8_STAGE(PG8_SB(1, 1), cB + hstep + kstep, voffB);
        PG8_WAIT_V(6); PG8_BAR;
    }
    for (;;) {
        const bool has_next = S.next(ui + 1, nxt);
        const char* nA = has_next ? (const char*)g.A + (size_t)nxt.pm * tstep : cA; const char* nB = has_next ? (const char*)g.Bt + (size_t)nxt.pn * tstep : cB;
        for (int t = 0; t < nt; t += 2) {
            if constexpr (Epi::MID) { if (t == Epi::MID_T0 || t == Epi::MID_T1) E.mid(acc, ui & 1, t == Epi::MID_T0 ? 0 : 1, wr, fr); }
            const bool last = (t == nt - 2);
            const char* a1 = cA + (size_t)(t + 1) * kstep;
            const char* a2 = last ? nA : cA + (size_t)(t + 2) * kstep; const char* b2 = last ? nB : cB + (size_t)(t + 2) * kstep;
            const char* a3 = a2 + kstep; const char* b3 = b2 + kstep;
            if (last && has_next) S.a_ready(nxt);
            if constexpr (SP2) {
            PG8_LDB(B0, 0, 0); PG8_LDB(B1, 0, 1); PG8_SCHED; PG8_LDA(At, 0, 0); PG8_STAGE(PG8_SA(1, 1), a1 + hstep, voffA);
            PG8_WAIT_V(8); PG8_WAIT_L(0); PG8_BAR; PG8_MMA(0, 0, At, B0); PG8_MMA(0, 1, At, B1); PG8_BAR; PG8_SCHED;
            PG8_LDA(At, 0, 1); PG8_STAGE(PG8_SB(0, 0), b2, voffB); PG8_STAGE(PG8_SB(0, 1), b2 + hstep, voffB); PG8_STAGE(PG8_SA(0, 0), a2, voffA);
            PG8_WAIT_V(8); PG8_WAIT_L(0); PG8_BAR; PG8_MMA(1, 0, At, B0); PG8_MMA(1, 1, At, B1); PG8_BAR; PG8_SCHED;
            PG8_LDB(B0, 1, 0); PG8_LDB(B1, 1, 1); PG8_SCHED; PG8_LDA(At, 1, 0); PG8_STAGE(PG8_SA(0, 1), a2 + hstep, voffA);
            PG8_WAIT_V(8); PG8_WAIT_L(0); PG8_BAR; PG8_MMA(0, 0, At, B0); PG8_MMA(0, 1, At, B1); PG8_BAR; PG8_SCHED;
            PG8_LDA(At, 1, 1); PG8_STAGE(PG8_SB(1, 0), b3, voffB); PG8_STAGE(PG8_SB(1, 1), b3 + hstep, voffB); PG8_STAGE(PG8_SA(1, 0), a3, voffA);
            PG8_WAIT_V(8); PG8_WAIT_L(0); PG8_BAR; PG8_MMA(1, 0, At, B0); PG8_MMA(1, 1, At, B1); PG8_BAR; PG8_SCHED;
            } else {
            PG8_LDB(B0, 0, 0); PG8_SCHED; PG8_LDA(At, 0, 0); PG8_STAGE(PG8_SA(1, 1), a1 + hstep, voffA);
            PG8_WAIT_L(8); PG8_BAR; PG8_WAIT_L(0); PG8_MMA(0, 0, At, B0); PG8_BAR; PG8_SCHED;
            PG8_LDB(B1, 0, 1); PG8_STAGE(PG8_SB(0, 0), b2, voffB);
            PG8_BAR; PG8_WAIT_L(0); PG8_MMA(0, 1, At, B1); PG8_BAR;
            PG8_LDA(At, 0, 1); PG8_STAGE(PG8_SA(0, 0), a2, voffA);
            PG8_BAR; PG8_WAIT_L(0); PG8_MMA(1, 0, At, B0); PG8_BAR; PG8_SCHED;
            PG8_STAGE(PG8_SB(0, 1), b2 + hstep, voffB);
            PG8_WAIT_V(6); PG8_BAR; PG8_MMA(1, 1, At, B1); PG8_BAR;
            PG8_LDB(B0, 1, 0); PG8_SCHED; PG8_LDA(At, 1, 0); PG8_STAGE(PG8_SA(0, 1), a2 + hstep, voffA);
            PG8_WAIT_L(8); PG8_BAR; PG8_WAIT_L(0); PG8_MMA(0, 0, At, B0); PG8_BAR; PG8_SCHED;
            PG8_LDB(B1, 1, 1); PG8_STAGE(PG8_SB(1, 0), b3, voffB);
            PG8_BAR; PG8_WAIT_L(0); PG8_MMA(0, 1, At, B1); PG8_BAR;
            PG8_LDA(At, 1, 1); PG8_STAGE(PG8_SA(1, 0), a3, voffA);
            PG8_BAR; PG8_WAIT_L(0); PG8_MMA(1, 0, At, B0); PG8_BAR; PG8_SCHED;
            PG8_STAGE(PG8_SB(1, 1), b3 + hstep, voffB);
            PG8_WAIT_V(6); PG8_BAR; PG8_MMA(1, 1, At, B1); PG8_BAR;
            }
        }
        if constexpr (ALIGN_EPI) { if (wr == 0) PG8_BAR; }
        if constexpr (Epi::MID) E.mid(acc, ui & 1, 2, wr, fr);
        if constexpr (!Epi::AFTER_DRAIN) { E(acc, cur, wr, wc, fr, fq); S.done(cur); }
        if constexpr (Epi::MID) { if (has_next) E.prep(nxt, (ui + 1) & 1, tid); }
        if (!has_next) break;
#pragma unroll
        for (int a = 0; a < 2; ++a)
#pragma unroll
            for (int b = 0; b < 2; ++b)
#pragma unroll
                for (int m = 0; m < 4; ++m)
#pragma unroll
                    for (int n = 0; n < 2; ++n) acc[a][b][m][n] = (f32x4){0.f, 0.f, 0.f, 0.f};
        cur = nxt; cA = nA; cB = nB; ++ui;
        if constexpr (ALIGN_EPI) { if (wr == 1) PG8_BAR; }
    }
    PG8_WAIT_V(0);
    if constexpr (!ALIGN_EPI) { if (wr == 0) PG8_BAR; }
    PG8_BAR;
    if constexpr (Epi::AFTER_DRAIN) { E.fused(acc, cur, wr, wc, fr, fq, lds, wid, lane); S.done(cur); }
#undef PG8_SA
#undef PG8_SB
#undef PG8_STAGE
#undef PG8_LDA
#undef PG8_LDB
#undef PG8_MMA
#undef PG8_WAIT_V
#undef PG8_WAIT_L
#undef PG8_BAR
#undef PG8_SCHED
}
}
#define GAS __attribute__((address_space(1)))
#define LAS __attribute__((address_space(3)))
#define XB_TMO      128
#define XB_XCNT(j)  (256  + 64 * (j))
#define XB_XSUB(j)  (1280 + 64 * (j))
#define XB_XGEN(j)  (2304 + 64 * (j))
#define XB_TOP      3328
#define XB_TOPGEN   3392
#define XCD_BAR_WORDS 3456
#define XB_SPIN_CAP (1u << 21)

__device__ __forceinline__ unsigned xb_ld(unsigned* p)              { return __hip_atomic_load(p, __ATOMIC_RELAXED, __HIP_MEMORY_SCOPE_AGENT); }
__device__ __forceinline__ unsigned xb_add(unsigned* p, unsigned v) { return __hip_atomic_fetch_add(p, v, __ATOMIC_RELAXED, __HIP_MEMORY_SCOPE_AGENT); }
__device__ __forceinline__ unsigned xb_xcc_id() { return (unsigned)__builtin_amdgcn_s_getreg((3 << 11) | 20) & 0xFu; }
#define XB_SPIN(cond, bar) do { unsigned _sp = 0; while (cond) { __builtin_amdgcn_s_sleep(1); \
    if ((++_sp & 255u) == 0u) { if (xb_ld(&(bar)[XB_TMO])) break; if (_sp > XB_SPIN_CAP) { atomicAdd(&(bar)[XB_TMO], 1u); break; } } } } while (0)

struct XcdBarrier {
    unsigned* bar; unsigned x;
    volatile LAS unsigned* st;
};

__device__ __forceinline__ XcdBarrier xcd_barrier_post(unsigned* bar, volatile LAS unsigned* st) {
    XcdBarrier b; b.bar = bar; b.x = xb_xcc_id(); b.st = st;
    if (threadIdx.x == 0) (void)xb_add(&bar[XB_XCNT(b.x)], 1u);
    return b;
}
__device__ __forceinline__ void xcd_barrier_complete(unsigned* bar, unsigned x, unsigned& nloc, unsigned& nx) {
    const unsigned G = gridDim.x * gridDim.y * gridDim.z;
    unsigned sum, cnt, mine, sp = 0u;
    for (;;) {
        sum = 0u; cnt = 0u; mine = 0u;
#pragma unroll
        for (unsigned j = 0; j < 16; ++j) { const unsigned c = xb_ld(&bar[XB_XCNT(j)]); sum += c; cnt += (c > 0u) ? 1u : 0u; mine = (j == x) ? c : mine; }
        if (sum == G) break;
        __builtin_amdgcn_s_sleep(1);
        if ((++sp & 255u) == 0u) { if (xb_ld(&bar[XB_TMO])) break; if (sp > XB_SPIN_CAP) { atomicAdd(&bar[XB_TMO], 1u); break; } }
    }
    nloc = mine > 0u ? mine : 1u; nx = cnt > 0u ? cnt : 1u;
}

__device__ __forceinline__ void xcd_barrier(const XcdBarrier& b) {
    asm volatile("s_waitcnt vmcnt(0)" ::: "memory");
    __syncthreads();
    if (threadIdx.x == 0) {
        unsigned* bar = b.bar;
        __builtin_amdgcn_s_waitcnt(0);
        unsigned nloc = b.st[0], nx = b.st[1];
        if (nloc == 0u) { xcd_barrier_complete(bar, b.x, nloc, nx); b.st[0] = nloc; b.st[1] = nx; }
        const unsigned old = xb_add(&bar[XB_XSUB(b.x)], 1u);
        const unsigned gen = old / nloc;
        if (old + 1u == (gen + 1u) * nloc) {
            __builtin_amdgcn_fence(__ATOMIC_RELEASE, "agent");
            asm volatile("s_waitcnt vmcnt(0)" ::: "memory");
            const unsigned og = xb_add(&bar[XB_TOP], 1u);
            const unsigned tg = og / nx;
            if (og + 1u == (tg + 1u) * nx) xb_add(&bar[XB_TOPGEN], 1u);
            else XB_SPIN(xb_ld(&bar[XB_TOPGEN]) == tg, bar);
            __builtin_amdgcn_fence(__ATOMIC_ACQUIRE, "agent");
            xb_add(&bar[XB_XGEN(b.x)], 1u);
            asm volatile("s_waitcnt vmcnt(0)" ::: "memory");
        } else {
            XB_SPIN(xb_ld(&bar[XB_XGEN(b.x)]) == gen, bar);
            __builtin_amdgcn_fence(__ATOMIC_ACQUIRE, "agent");
            asm volatile("s_waitcnt vmcnt(0)" ::: "memory");
        }
    }
    __syncthreads();
}

constexpr int D = 1024, NL = 4;
constexpr int PB = 4, PT = 8192, MP = PB * PT;
constexpr int SBN = 32, STN = 16, PAST = 2048, MS = SBN * STN;
constexpr int M = MP + MS;
constexpr int SKEYS = PAST + STN;
constexpr int SPITCH = 2112;
constexpr int KROWS = MP + SBN * SPITCH;
constexpr int M3 = M + SBN * PAST;
constexpr int NIN = 3236, NINP = 3328;
constexpr float EPS = 1e-6f;
constexpr float LOG2E = 1.4426950408889634f;
constexpr float EXIT_LOG2 = -40.0f;
constexpr float QA_SC = 0.10206207261596575f * LOG2E, QB_SC = 0.125f * LOG2E, QC_SC = 0.125f * LOG2E;

constexpr size_t O_YP = 0, O_YS = O_YP + (size_t)MP * D, O_PCKV = O_YS + (size_t)MS * D, O_PKPE = O_PCKV + (size_t)NL * MP * 256, O_PFK = O_PKPE + (size_t)NL * MP * 32,
                 O_PFV = O_PFK + (size_t)NL * MP * 256, O_PLF = O_PFV + (size_t)NL * MP * 256, O_PSK = O_PLF + (size_t)NL * MP * 4, O_PSV = O_PSK + (size_t)NL * MP * 256,
                 O_SCKV = O_PSV + (size_t)NL * MP * 256, O_SKPE = O_SCKV + (size_t)NL * MS * 256, O_SFK = O_SKPE + (size_t)NL * MS * 32, O_SFV = O_SFK + (size_t)NL * MS * 256,
                 O_SLF = O_SFV + (size_t)NL * MS * 256, O_SSK = O_SLF + (size_t)NL * MS * 4, O_SSV = O_SSK + (size_t)NL * MS * 256, O_END = O_SSV + (size_t)NL * MS * 256;
static_assert(O_END == 209264640ull, "output size");

constexpr size_t MiB = 1u << 20;
constexpr size_t WS_CTL = 0, CTL_ZERO_BYTES = 1 * MiB;
constexpr size_t WS_ROPE = 1 * MiB, WS_WIN = 2 * MiB, WS_WUKV = 28 * MiB, WS_WOUT = 30 * MiB, WS_XN = 38 * MiB, WS_QA = 103 * MiB, WS_QB = 128 * MiB, WS_QC = 145 * MiB,
                 WS_GATE = 162 * MiB, WS_OP = 227 * MiB, WS_Y = 292 * MiB, WS_CKVB = 357 * MiB, WS_KA = 406 * MiB, WS_KR = 455 * MiB, WS_VA = 462 * MiB, WS_KB = 560 * MiB,
                 WS_VB = 609 * MiB, WS_KC = 658 * MiB, WS_VC = 707 * MiB, WS_LOGF = 756 * MiB, WS_FB = 758 * MiB, WS_SS = 760 * MiB, WS_KR2 = 762 * MiB, WS_RSTD = 769 * MiB, WS_END = 770 * MiB;
static_assert(WS_WIN + (size_t)NL * NINP * D * 2 <= WS_WUKV && WS_WUKV + (size_t)NL * 768 * 256 * 2 <= WS_WOUT && WS_WOUT + (size_t)NL * D * D * 2 <= WS_XN, "ws map 1");
static_assert(WS_XN + (size_t)M * D * 2 <= WS_QA && WS_QA + (size_t)(M + 64) * 384 * 2 <= WS_QB && WS_QB + (size_t)(M + 64) * 256 * 2 <= WS_QC && WS_QC + (size_t)(M + 64) * 256 * 2 <= WS_GATE, "ws map 2");
static_assert(WS_GATE + (size_t)M * D * 2 <= WS_OP && WS_OP + (size_t)M * D * 2 <= WS_Y && WS_Y + (size_t)M * D * 2 <= WS_CKVB && WS_CKVB + (size_t)M3 * 256 * 2 <= WS_KA, "ws map 3");
static_assert(WS_KA + (size_t)KROWS * 256 * 2 <= WS_KR && WS_KR + (size_t)KROWS * 32 * 2 <= WS_VA && WS_VA + (size_t)KROWS * 512 * 2 <= WS_KB && WS_KB + (size_t)KROWS * 256 * 2 <= WS_VB, "ws map 4");
static_assert(WS_VB + (size_t)KROWS * 256 * 2 <= WS_KC && WS_KC + (size_t)KROWS * 256 * 2 <= WS_VC && WS_VC + (size_t)KROWS * 256 * 2 <= WS_LOGF && WS_LOGF + (size_t)KROWS * 16 <= WS_FB && WS_FB + (size_t)KROWS * 16 <= WS_SS && WS_SS + (size_t)M * 48 <= WS_END, "ws map 5");
constexpr int CW_QUEUE = 64;
constexpr int CW_XQ = 1024;
constexpr int CW_SDONE = 768;
constexpr int CW_KMAX = 512;
constexpr int CW_BAR = 4096;
constexpr int RING_BYTES = 131072, MISC_OFF = RING_BYTES, PTR_OFF = RING_BYTES + 256, SCR_OFF = RING_BYTES + 512, LDS_BYTES = 147456;

typedef unsigned short bf16_t;
typedef short bf16x8 __attribute__((ext_vector_type(8)));
typedef short s16x4 __attribute__((ext_vector_type(4)));
typedef float f32x4 __attribute__((ext_vector_type(4)));
typedef float f32x16 __attribute__((ext_vector_type(16)));
typedef unsigned u32x4 __attribute__((ext_vector_type(4)));
typedef unsigned u32x2 __attribute__((ext_vector_type(2)));
typedef float f32x2_t __attribute__((ext_vector_type(2)));
typedef __bf16 bf16x2_t __attribute__((ext_vector_type(2)));
__device__ __forceinline__ unsigned cvtpk(float lo, float hi) { f32x2_t v = {lo, hi}; bf16x2_t b = __builtin_convertvector(v, bf16x2_t); return __builtin_bit_cast(unsigned, b); }
__device__ __forceinline__ float bf_lo(unsigned w) { return __uint_as_float(w << 16); }
__device__ __forceinline__ float bf_hi(unsigned w) { return __uint_as_float(w & 0xffff0000u); }
__device__ __forceinline__ float wave_sum(float v) {
#pragma unroll
    for (int o = 1; o < 64; o <<= 1) v += __shfl_xor(v, o);
    return v;
}
__device__ __forceinline__ float half_swap_sum(float v) { auto rr = __builtin_amdgcn_permlane32_swap(__float_as_uint(v), __float_as_uint(v), false, false); return __uint_as_float(rr[0]) + __uint_as_float(rr[1]); }
__device__ __forceinline__ float half_swap_max(float v) { auto rr = __builtin_amdgcn_permlane32_swap(__float_as_uint(v), __float_as_uint(v), false, false); return fmaxf(__uint_as_float(rr[0]), __uint_as_float(rr[1])); }
__device__ __forceinline__ int fresh_tid() { int t = threadIdx.x; asm volatile("" : "+v"(t)); return t; }
__device__ __forceinline__ size_t kr_off(int l) { return (l & 1) ? WS_KR2 : WS_KR; }
__device__ __forceinline__ int krow_of(int m) { return m < MP ? m : MP + ((m - MP) >> 4) * SPITCH + PAST + ((m - MP) & 15); }
__device__ __forceinline__ int pos_of(int m) { return m < MP ? (m & (PT - 1)) : PAST + ((m - MP) & 15); }
__device__ __forceinline__ float* rows_out(float* out, size_t off_p, size_t off_s, int l, int m, int W) {
    return m < MP ? out + off_p + ((size_t)l * MP + m) * W : out + off_s + ((size_t)l * MS + (m - MP)) * W;
}

struct Params { const float* in[18]; float* out; unsigned char* ws; int ph_lo, ph_hi; };
__device__ __forceinline__ const float* inp(LAS unsigned char* lds, int i) {
    const unsigned long long v = ((const LAS unsigned long long*)(lds + PTR_OFF))[i];
    const unsigned lo = __builtin_amdgcn_readfirstlane((unsigned)v), hi = __builtin_amdgcn_readfirstlane((unsigned)(v >> 32));
    return (const float*)(const GAS float*)(((unsigned long long)hi << 32) | lo);
}
#define WSP(T, off) ((T*)(ws + (off)))

__device__ __forceinline__ int win_logical_col(int n) {
    const int tile = n >> 8, c = n & 255;
    switch (tile) {
        case 0: return c;
        case 1: { const int blk = c >> 5, p = c & 31, e = 16 * ((p >> 2) & 1) + 4 * (p >> 3) + (p & 3);
                  if (blk < 4) return 256 + 32 * blk + e; if (blk == 4) return 640 + e; if (blk == 5 && p < 4) return 1440 + p; return -1; }
        case 2: return 384 + c;
        case 3: return 672 + c;
        case 4: return 928 + c;
        case 5: return 1184 + c;
        case 6: return 1444 + c;
        case 7: return 1700 + c;
        case 8: return 1956 + c;
        default: return 2212 + 256 * (tile - 9) + c;
    }
}
__device__ __forceinline__ void p0_item(unsigned char* ws, LAS unsigned char* lds, int kind, int l, int item, LAS float* scr, int lane) {
    const int K = kind == 1 ? 256 : 1024, N = kind == 0 ? NINP : kind == 1 ? 768 : 1024;
    const int nblk = N / 32, kb = item / nblk, nb = item % nblk, k0 = 64 * kb, n0 = 32 * nb;
    const int n = n0 + (lane & 31);
    const float* src; int ld; int col;
    if (kind == 0) { src = inp(lds, 11) + (size_t)l * D * NIN; ld = NIN; col = win_logical_col(n); }
    else if (kind == 1) { if (n < 256) { src = inp(lds, 13) + (size_t)l * 256 * 256; ld = 256; col = n; } else { src = inp(lds, 14) + (size_t)l * 256 * 512; ld = 512; col = n - 256; } }
    else { src = inp(lds, 17) + (size_t)l * D * D; ld = D; col = n; }
    const float* gain = kind == 0 ? inp(lds, 9) + l * D : kind == 2 ? inp(lds, 16) + l * D : nullptr;
#pragma unroll 8
    for (int i = 0; i < 32; ++i) { const int kk = 2 * i + (lane >> 5); float v = 0.f;
        if (col >= 0) { v = src[(size_t)(k0 + kk) * ld + col]; if (gain) v *= gain[k0 + kk]; }
        scr[kk * 33 + (lane & 31)] = v; }
    asm volatile("s_waitcnt lgkmcnt(0)" ::: "memory");
    bf16_t* WT = (bf16_t*)(ws + (kind == 0 ? WS_WIN + (size_t)l * NINP * D * 2 : kind == 1 ? WS_WUKV + (size_t)l * 768 * 256 * 2 : WS_WOUT + (size_t)l * D * D * 2));
    const int c = lane & 7;
#pragma unroll
    for (int j = 0; j < 4; ++j) { const int nn = (lane >> 3) + 8 * j; const LAS float* s = scr + (8 * c) * 33 + nn;
        u32x4 o; o.x = cvtpk(s[0 * 33], s[1 * 33]); o.y = cvtpk(s[2 * 33], s[3 * 33]); o.z = cvtpk(s[4 * 33], s[5 * 33]); o.w = cvtpk(s[6 * 33], s[7 * 33]);
        *(u32x4*)(WT + (size_t)(n0 + nn) * K + k0 + 8 * c) = o; }
    asm volatile("s_waitcnt lgkmcnt(0)" ::: "memory");
}
__device__ __forceinline__ void p0_prologue(unsigned char* ws, LAS unsigned char* lds) {
    const int tid = fresh_tid(), lane = tid & 63, wid = __builtin_amdgcn_readfirstlane(tid >> 6);
    LAS float* scr = (LAS float*)(lds + wid * 16384);
    const int gw = blockIdx.x * 8 + wid, NGW = gridDim.x * 8;
    constexpr int I0 = 16 * (NINP / 32), I1 = 4 * 24, I2 = 16 * 32, IL = I0 + I1 + I2;
    for (int it = gw; it < IL; it += NGW) {
        const int l = it / IL; int r = it % IL;
        if (r < I0) { p0_item(ws, lds, 0, l, r, scr, lane); continue; } r -= I0;
        if (r < I1) { p0_item(ws, lds, 1, l, r, scr, lane); continue; } r -= I1;
        p0_item(ws, lds, 2, l, r, scr, lane);
    }
    float* rope = (float*)(ws + WS_ROPE);
    for (int e = blockIdx.x * 512 + tid; e < PT * 16; e += gridDim.x * 512) {
        const int pos = e >> 4, i = e & 15;
        double inv = 1.0; for (int k = 0; k < i; ++k) inv *= 0.5623413251903491;
        const double rev = (double)pos * inv * 0.15915494309189535;
        const float fr = (float)(rev - __builtin_rint(rev));
        rope[pos * 32 + i] = __builtin_amdgcn_cosf(fr); rope[pos * 32 + 16 + i] = __builtin_amdgcn_sinf(fr);
    }
}

__device__ __forceinline__ void cvt_rows(const float* src, bf16_t* dst, int W, size_t dst_bstride, int gtid, int nthr) {
    const int per_b = PAST * W / 8, total = SBN * per_b;
    for (int q0 = gtid; q0 < total; q0 += 4 * nthr) {
        f32x4 a[4], b[4];
#pragma unroll
        for (int u = 0; u < 4; ++u) { const int q = q0 + u * nthr; if (q < total) { a[u] = *(const f32x4*)(src + (size_t)q * 8); b[u] = *(const f32x4*)(src + (size_t)q * 8 + 4); } }
#pragma unroll
        for (int u = 0; u < 4; ++u) { const int q = q0 + u * nthr; if (q < total) { const int sb = q / per_b, rem = q % per_b;
            u32x4 o; o.x = cvtpk(a[u][0], a[u][1]); o.y = cvtpk(a[u][2], a[u][3]); o.z = cvtpk(b[u][0], b[u][1]); o.w = cvtpk(b[u][2], b[u][3]);
            *(u32x4*)(dst + (size_t)sb * dst_bstride + (size_t)rem * 8) = o; } }
    }
}
__device__ __forceinline__ void p1_norm(unsigned char* ws, float* out, LAS unsigned char* lds, int l) {
    const int tid = fresh_tid(), lane = tid & 63, wid = __builtin_amdgcn_readfirstlane(tid >> 6);
    const int gw = blockIdx.x * 8 + wid, NGW = gridDim.x * 8;
    bf16_t* XB = (bf16_t*)(ws + WS_XN); const bf16_t* Y = (const bf16_t*)(ws + WS_Y); float* RSTD = (float*)(ws + WS_RSTD);
    const float* xp = inp(lds, 0); const float* xs = inp(lds, 1); const float* gpost = inp(lds, 10);
    constexpr int RU = 4;
    f32x4 g[4];
    if (l > 0) {
#pragma unroll
        for (int j = 0; j < 4; ++j) g[j] = *(const f32x4*)(gpost + (l - 1) * D + 256 * j + 4 * lane);
    }
    for (int m0 = gw; m0 < M; m0 += RU * NGW) {
        f32x4 v[RU][4]; u32x2 yw[RU][4];
#pragma unroll
        for (int r = 0; r < RU; ++r) { const int m = m0 + r * NGW; if (m < M) {
            if (l == 0) { const float* base = m < MP ? xp + (size_t)m * D : xs + (size_t)(m - MP) * D;
#pragma unroll
                for (int j = 0; j < 4; ++j) v[r][j] = *(const f32x4*)(base + 256 * j + 4 * lane); }
            else {
#pragma unroll
                for (int j = 0; j < 4; ++j) { const u32x2 w = *(const u32x2*)(XB + (size_t)m * D + 256 * j + 4 * lane); v[r][j] = (f32x4){bf_lo(w.x), bf_hi(w.x), bf_lo(w.y), bf_hi(w.y)}; }
#pragma unroll
                for (int j = 0; j < 4; ++j) yw[r][j] = *(const u32x2*)(Y + (size_t)m * D + 256 * j + 4 * lane); } } }
#pragma unroll
        for (int r = 0; r < RU; ++r) { const int m = m0 + r * NGW; if (m < M) {
            if (l > 0) {
                f32x4 y[4]; float s = 0.f;
#pragma unroll
                for (int j = 0; j < 4; ++j) { const u32x2 w = yw[r][j]; y[j] = (f32x4){bf_lo(w.x), bf_hi(w.x), bf_lo(w.y), bf_hi(w.y)}; s += (y[j][0] * y[j][0] + y[j][1] * y[j][1]) + (y[j][2] * y[j][2] + y[j][3] * y[j][3]); }
                const float rr = 1.0f / sqrtf(wave_sum(s) * (1.0f / D) + EPS);
#pragma unroll
                for (int j = 0; j < 4; ++j) v[r][j] = v[r][j] + y[j] * rr * g[j];
            }
            if (l < NL) {
                float s = 0.f;
#pragma unroll
                for (int j = 0; j < 4; ++j) s += (v[r][j][0] * v[r][j][0] + v[r][j][1] * v[r][j][1]) + (v[r][j][2] * v[r][j][2] + v[r][j][3] * v[r][j][3]);
                const float rr = 1.0f / sqrtf(wave_sum(s) * (1.0f / D) + EPS);
                if (lane == 0) RSTD[m] = rr;
#pragma unroll
                for (int j = 0; j < 4; ++j) { u32x2 w; w.x = cvtpk(v[r][j][0], v[r][j][1]); w.y = cvtpk(v[r][j][2], v[r][j][3]); *(u32x2*)(XB + (size_t)m * D + 256 * j + 4 * lane) = w; }
            } else {
                float* xres = out + (size_t)m * D;
#pragma unroll
                for (int j = 0; j < 4; ++j) *(f32x4*)(xres + 256 * j + 4 * lane) = v[r][j];
            } } }
    }
    if (l == 0) {
        const int gtid = blockIdx.x * 512 + tid, nthr = gridDim.x * 512;
        cvt_rows(inp(lds, 2) + (size_t)l * SBN * PAST * 256, (bf16_t*)(ws + WS_CKVB) + (size_t)M * 256, 256, (size_t)PAST * 256, gtid, nthr);
        cvt_rows(inp(lds, 3) + (size_t)l * SBN * PAST * 32, (bf16_t*)(ws + WS_KR) + (size_t)MP * 32, 32, (size_t)SPITCH * 32, gtid, nthr);
    }
}

__device__ __forceinline__ void st8(bf16_t* p, const f32x4 a, const f32x4 b, float sc) {
    u32x4 w; w.x = cvtpk(a[0] * sc, a[1] * sc); w.y = cvtpk(a[2] * sc, a[3] * sc); w.z = cvtpk(b[0] * sc, b[1] * sc); w.w = cvtpk(b[2] * sc, b[3] * sc); *(u32x4*)p = w;
}
__device__ __forceinline__ float silu_f(float x) { return x * __builtin_amdgcn_rcpf(1.0f + __builtin_amdgcn_exp2f(-x * LOG2E)); }
struct EpiP2 {
    static constexpr bool PERM = true, AFTER_DRAIN = false, MID = false;
    unsigned char* ws; float* out; const float* kvnorm; const float* fbias; int l; LAS float* scr;
    __device__ __forceinline__ void operator()(pg8::f32x4 (&acc)[2][2][4][2], const pg8::Unit& u, int wr, int wc, int fr, int fq) const {
        int pn = u.pn, rbase = u.pm * 256 + wr * 64 + fr, cw = wc * 32 + 8 * fq;
        asm volatile("" : "+s"(pn), "+v"(rbase), "+v"(cw));
        {
            const float* const RSTD = WSP(const float, WS_RSTD); float rs[2][4];
#pragma unroll
            for (int ai = 0; ai < 2; ++ai)
#pragma unroll
                for (int m = 0; m < 4; ++m) rs[ai][m] = RSTD[rbase + ai * 128 + m * 16];
#pragma unroll
            for (int ai = 0; ai < 2; ++ai)
#pragma unroll
                for (int m = 0; m < 4; ++m)
#pragma unroll
                    for (int bj = 0; bj < 2; ++bj)
#pragma unroll
                        for (int n = 0; n < 2; ++n) acc[ai][bj][m][n] = acc[ai][bj][m][n] * rs[ai][m];
        }
        bf16_t* const QA = WSP(bf16_t, WS_QA); bf16_t* const QB = WSP(bf16_t, WS_QB); bf16_t* const QC = WSP(bf16_t, WS_QC); bf16_t* const KR = (bf16_t*)(ws + kr_off(l)); bf16_t* const KB = WSP(bf16_t, WS_KB); bf16_t* const VB = WSP(bf16_t, WS_VB);
        bf16_t* const KC = WSP(bf16_t, WS_KC); bf16_t* const VC = WSP(bf16_t, WS_VC); bf16_t* const CKVB = WSP(bf16_t, WS_CKVB); bf16_t* const GATE = WSP(bf16_t, WS_GATE); float* const LOGF = WSP(float, WS_LOGF); const float* const rope = WSP(const float, WS_ROPE);
        if (pn == 0 || pn == 3 || pn == 6) {
            const float sc = pn == 0 ? QA_SC : pn == 3 ? QB_SC : QC_SC;
#pragma unroll
            for (int ai = 0; ai < 2; ++ai)
#pragma unroll
                for (int m = 0; m < 4; ++m) { const int row = rbase + ai * 128 + m * 16;
#pragma unroll
                    for (int bj = 0; bj < 2; ++bj) {
                        bf16_t* d = pn == 0 ? QA + (size_t)row * 384 + (2 * bj + (wc >> 1)) * 96 + 32 * (wc & 1) + 8 * fq : (pn == 3 ? QB : QC) + (size_t)row * 256 + 128 * bj + cw;
                        st8(d, acc[ai][bj][m][0], acc[ai][bj][m][1], sc); } }
        } else if (pn >= 9) {
#pragma unroll
            for (int ai = 0; ai < 2; ++ai)
#pragma unroll
                for (int m = 0; m < 4; ++m) { const int row = rbase + ai * 128 + m * 16;
#pragma unroll
                    for (int bj = 0; bj < 2; ++bj) { f32x4 a = acc[ai][bj][m][0], b = acc[ai][bj][m][1];
#pragma unroll
                        for (int j = 0; j < 4; ++j) { a[j] = silu_f(a[j]); b[j] = silu_f(b[j]); }
                        st8(GATE + (size_t)row * D + 256 * (pn - 9) + 128 * bj + cw, a, b, 1.0f); } }
        } else if (pn == 4 || pn == 5 || pn == 7 || pn == 8) {
            bf16_t* buf = pn == 4 ? KB : pn == 5 ? VB : pn == 7 ? KC : VC;
            const size_t offp = pn == 4 ? O_PFK : pn == 5 ? O_PFV : pn == 7 ? O_PSK : O_PSV, offs = pn == 4 ? O_SFK : pn == 5 ? O_SFV : pn == 7 ? O_SSK : O_SSV;
#pragma unroll
            for (int ai = 0; ai < 2; ++ai)
#pragma unroll
                for (int m = 0; m < 4; ++m) { const int row = rbase + ai * 128 + m * 16; const int kr = krow_of(row); float* o = rows_out(out, offp, offs, l, row, 256);
#pragma unroll
                    for (int bj = 0; bj < 2; ++bj) { const int c0 = 128 * bj + cw;
                        st8(buf + (size_t)kr * 256 + c0, acc[ai][bj][m][0], acc[ai][bj][m][1], 1.0f);
                        *(f32x4*)(o + c0) = acc[ai][bj][m][0]; *(f32x4*)(o + c0 + 4) = acc[ai][bj][m][1]; } }
            if (pn == 4 && u.pm < MP / 256) {
                float mx[2] = {0.f, 0.f};
#pragma unroll
                for (int ai = 0; ai < 2; ++ai)
#pragma unroll
                    for (int m = 0; m < 4; ++m)
#pragma unroll
                        for (int bj = 0; bj < 2; ++bj) { const f32x4 x = acc[ai][bj][m][0], y = acc[ai][bj][m][1];
                            float sq = ((x[0] * x[0] + x[1] * x[1]) + (x[2] * x[2] + x[3] * x[3])) + ((y[0] * y[0] + y[1] * y[1]) + (y[2] * y[2] + y[3] * y[3]));
                            sq += __shfl_xor(sq, 16); sq += __shfl_xor(sq, 32); mx[bj] = fmaxf(mx[bj], sq); }
#pragma unroll
                for (int bj = 0; bj < 2; ++bj) { float v = mx[bj];
                    v = fmaxf(v, __shfl_xor(v, 1)); v = fmaxf(v, __shfl_xor(v, 2)); v = fmaxf(v, __shfl_xor(v, 4)); v = fmaxf(v, __shfl_xor(v, 8));
                    if (fr == 0 && fq == 0) __hip_atomic_fetch_max(WSP(unsigned, WS_CTL) + CW_KMAX + ((l * 4 + (u.pm >> 5)) * 4 + 2 * bj + (wc >> 1)) * 2 + (wc & 1), __float_as_uint(v), __ATOMIC_RELAXED, __HIP_MEMORY_SCOPE_AGENT); }
            }
        } else if (pn == 1) {
#pragma unroll
            for (int ai = 0; ai < 2; ++ai)
#pragma unroll
                for (int m = 0; m < 4; ++m) { const int row = rbase + ai * 128 + m * 16; const int pos = pos_of(row);
                    const f32x4 cs = *(const f32x4*)(rope + pos * 32 + 4 * fq), sn = *(const f32x4*)(rope + pos * 32 + 16 + 4 * fq);
                    {
                        const f32x4 x1 = acc[ai][0][m][0], x2 = acc[ai][0][m][1]; const f32x4 y1 = (x1 * cs - x2 * sn) * QA_SC, y2 = (x1 * sn + x2 * cs) * QA_SC;
                        bf16_t* d = QA + (size_t)row * 384 + wc * 96 + 64 + 4 * fq;
                        u32x2 w1, w2; w1.x = cvtpk(y1[0], y1[1]); w1.y = cvtpk(y1[2], y1[3]); w2.x = cvtpk(y2[0], y2[1]); w2.y = cvtpk(y2[2], y2[3]);
                        *(u32x2*)d = w1; *(u32x2*)(d + 16) = w2; }
                    if (wc == 0) {
                        const f32x4 x1 = acc[ai][1][m][0], x2 = acc[ai][1][m][1]; const f32x4 y1 = x1 * cs - x2 * sn, y2 = x1 * sn + x2 * cs;
                        bf16_t* d = KR + (size_t)krow_of(row) * 32 + 4 * fq;
                        u32x2 w1, w2; w1.x = cvtpk(y1[0], y1[1]); w1.y = cvtpk(y1[2], y1[3]); w2.x = cvtpk(y2[0], y2[1]); w2.y = cvtpk(y2[2], y2[3]);
                        *(u32x2*)d = w1; *(u32x2*)(d + 16) = w2;
                        float* o = rows_out(out, O_PKPE, O_SKPE, l, row, 32) + 4 * fq; *(f32x4*)o = y1; *(f32x4*)(o + 16) = y2;
                    } else if (wc == 1 && fq == 0) {
                        f32x4 v = acc[ai][1][m][0] + *(const f32x4*)fbias; f32x4 lf;
#pragma unroll
                        for (int j = 0; j < 4; ++j) lf[j] = fminf(v[j], 0.f) - __logf(1.0f + __expf(-fabsf(v[j])));
                        *(f32x4*)rows_out(out, O_PLF, O_SLF, l, row, 4) = lf; *(f32x4*)(LOGF + (size_t)krow_of(row) * 4) = lf;
                    } }
        } else {
            float ssq[2][4];
#pragma unroll
            for (int ai = 0; ai < 2; ++ai)
#pragma unroll
                for (int m = 0; m < 4; ++m) { float s = 0.f;
#pragma unroll
                    for (int bj = 0; bj < 2; ++bj)
#pragma unroll
                        for (int n = 0; n < 2; ++n) { const f32x4 x = acc[ai][bj][m][n]; s += (x[0] * x[0] + x[1] * x[1]) + (x[2] * x[2] + x[3] * x[3]); }
                    s += __shfl_xor(s, 16); s += __shfl_xor(s, 32);
                    if (fq == 0) scr[(ai * 128 + wr * 64 + m * 16 + fr) * 4 + wc] = s; }
            asm volatile("s_waitcnt lgkmcnt(0)" ::: "memory"); __builtin_amdgcn_s_barrier(); asm volatile("" ::: "memory");
#pragma unroll
            for (int ai = 0; ai < 2; ++ai)
#pragma unroll
                for (int m = 0; m < 4; ++m) { const f32x4 p4 = *(const LAS f32x4*)(scr + (ai * 128 + wr * 64 + m * 16 + fr) * 4); ssq[ai][m] = (p4[0] + p4[1]) + (p4[2] + p4[3]); }
#pragma unroll
            for (int ai = 0; ai < 2; ++ai)
#pragma unroll
                for (int m = 0; m < 4; ++m) { const int row = rbase + ai * 128 + m * 16; const float r = 1.0f / sqrtf(ssq[ai][m] * (1.0f / 256.0f) + EPS); float* o = rows_out(out, O_PCKV, O_SCKV, l, row, 256);
#pragma unroll
                    for (int bj = 0; bj < 2; ++bj) { const int c0 = 128 * bj + cw;
                        const f32x4 a = acc[ai][bj][m][0] * r * *(const f32x4*)(kvnorm + c0), b = acc[ai][bj][m][1] * r * *(const f32x4*)(kvnorm + c0 + 4);
                        st8(CKVB + (size_t)row * 256 + c0, a, b, 1.0f); *(f32x4*)(o + c0) = a; *(f32x4*)(o + c0 + 4) = b; } }
        }
    }
};
struct EpiP3 {
    static constexpr bool PERM = true, AFTER_DRAIN = false, MID = false;
    unsigned char* ws;
    __device__ __forceinline__ void operator()(const pg8::f32x4 (&acc)[2][2][4][2], const pg8::Unit& u, int wr, int wc, int fr, int fq) const {
        int pn = u.pn, rbase = u.pm * 256 + wr * 64 + fr, cw = wc * 32 + 8 * fq;
        asm volatile("" : "+s"(pn), "+v"(rbase), "+v"(cw));
        bf16_t* const KA = WSP(bf16_t, WS_KA); bf16_t* const VA = WSP(bf16_t, WS_VA);
#pragma unroll
        for (int ai = 0; ai < 2; ++ai)
#pragma unroll
            for (int m = 0; m < 4; ++m) { const int row = rbase + ai * 128 + m * 16;
                const int dest = row < M ? krow_of(row) : MP + ((row - M) >> 11) * SPITCH + ((row - M) & 2047);
#pragma unroll
                for (int bj = 0; bj < 2; ++bj) { bf16_t* d = pn == 0 ? KA + (size_t)dest * 256 + 128 * bj + cw : VA + (size_t)dest * 512 + 256 * (pn - 1) + 128 * bj + cw;
                    st8(d, acc[ai][bj][m][0], acc[ai][bj][m][1], 1.0f); } }
    }
};
struct EpiP5 {
    static constexpr bool PERM = true, AFTER_DRAIN = false, MID = true; static constexpr int MID_T0 = 8, MID_T1 = 12;
    unsigned char* ws; LAS float* tab;
    __device__ __forceinline__ void prep(const pg8::Unit& u, int par, int tid) const {
        if (tid < 256) { const float* ss = WSP(const float, WS_SS) + (size_t)(u.pm * 256 + tid) * 12;
            const f32x4 a = *(const f32x4*)ss, b = *(const f32x4*)(ss + 4), c = *(const f32x4*)(ss + 8);
            const float ra = 1.0f / sqrtf(((a[0] + a[1]) + (a[2] + a[3])) * (1.0f / 512.0f) + EPS), rb = 1.0f / sqrtf(((b[0] + b[1]) + (b[2] + b[3])) * (1.0f / 256.0f) + EPS), rc = 1.0f / sqrtf(((c[0] + c[1]) + (c[2] + c[3])) * (1.0f / 256.0f) + EPS);
            *(LAS f32x4*)(tab + (par * 256 + tid) * 4) = (f32x4){ra / rb, rb / rc, rc, 0.f}; }
    }
    __device__ __forceinline__ void mid(pg8::f32x4 (&acc)[2][2][4][2], int par, int which, int wr, int fr) const {
#pragma unroll
        for (int ai = 0; ai < 2; ++ai)
#pragma unroll
            for (int m = 0; m < 4; ++m) { const f32x4 t4 = *(const LAS f32x4*)(tab + (par * 256 + ai * 128 + wr * 64 + m * 16 + fr) * 4); const float f = which == 0 ? t4[0] : which == 1 ? t4[1] : t4[2];
#pragma unroll
                for (int bj = 0; bj < 2; ++bj)
#pragma unroll
                    for (int n = 0; n < 2; ++n) acc[ai][bj][m][n] = acc[ai][bj][m][n] * f; }
    }
    __device__ __forceinline__ void operator()(const pg8::f32x4 (&acc)[2][2][4][2], const pg8::Unit& u, int wr, int wc, int fr, int fq) const {
        int rbase = u.pm * 256 + wr * 64 + fr, cw = u.pn * 256 + wc * 32 + 8 * fq; bf16_t* const Y = WSP(bf16_t, WS_Y);
        asm volatile("" : "+v"(rbase), "+v"(cw));
#pragma unroll
        for (int ai = 0; ai < 2; ++ai)
#pragma unroll
            for (int m = 0; m < 4; ++m) { const int row = rbase + ai * 128 + m * 16;
#pragma unroll
                for (int bj = 0; bj < 2; ++bj) st8(Y + (size_t)row * D + 128 * bj + cw, acc[ai][bj][m][0], acc[ai][bj][m][1], 1.0f); }
    }
};

__device__ __forceinline__ void cumsum_task(unsigned char* ws, int l, int task, LAS unsigned char* lds) {
    const int tid = fresh_tid(), lane = tid & 63, wid = tid >> 6;
    const float* LOGF = (const float*)(ws + WS_LOGF); float* FB = (float*)(ws + WS_FB);
    const bool prompt = task < 4; const int sb = task - 4;
    const int n = prompt ? PT : SKEYS, CH = prompt ? 16 : 5;
    const int krow0 = prompt ? task * PT : MP + sb * SPITCH;
    const float* cache = inp(lds, 6) + ((size_t)l * SBN + (prompt ? 0 : sb)) * PAST * 4;
    const int t0 = tid * CH;
    f32x4 s = {0.f, 0.f, 0.f, 0.f};
    for (int i = 0; i < CH; ++i) { const int t = t0 + i; if (t < n) { const f32x4 v = (!prompt && t < PAST) ? *(const f32x4*)(cache + (size_t)t * 4) : *(const f32x4*)(LOGF + (size_t)(krow0 + t) * 4); s = s + v; } }
    const f32x4 own = s;
#pragma unroll
    for (int off = 1; off < 64; off <<= 1) {
#pragma unroll
        for (int c = 0; c < 4; ++c) { const float t = __shfl_up(s[c], off); if (lane >= off) s[c] += t; } }
    LAS f32x4* wt = (LAS f32x4*)lds;
    if (lane == 63) wt[wid] = s;
    __syncthreads();
    f32x4 pre = s - own;
    for (int w = 0; w < wid; ++w) pre = pre + wt[w];
    for (int i = 0; i < CH; ++i) { const int t = t0 + i; if (t < n) { const f32x4 v = (!prompt && t < PAST) ? *(const f32x4*)(cache + (size_t)t * 4) : *(const f32x4*)(LOGF + (size_t)(krow0 + t) * 4); pre = pre + v;
        *(f32x4*)(FB + (size_t)(krow0 + t) * 4) = pre * LOG2E; } }
    __syncthreads();
}

#define MFMA32(a, b, c) __builtin_amdgcn_mfma_f32_32x32x16_bf16((a), (b), (c), 0, 0, 0)
__device__ __forceinline__ s16x4 tr_rd(const LAS unsigned char* p) { typedef short v4i16_t __attribute__((ext_vector_type(4))); return __builtin_bit_cast(s16x4, __builtin_amdgcn_ds_read_tr16_b64_v4i16((LAS v4i16_t*)p)); }
__device__ __forceinline__ bf16x8 pack8(const f32x16& p, int b) {
    u32x4 w; w.x = cvtpk(p[b], p[b + 1]); w.y = cvtpk(p[b + 2], p[b + 3]); w.z = cvtpk(p[b + 4], p[b + 5]); w.w = cvtpk(p[b + 6], p[b + 7]); return __builtin_bit_cast(bf16x8, w);
}
template <int TYPE, bool SAMP>
__device__ __forceinline__ void attn_unit(unsigned char* ws, LAS unsigned char* lds, int l, int qrow0, int nq, int krow0, int qpos0, int nkeys, int h) {
    constexpr int DQK = TYPE == 0 ? 96 : 64, DV = TYPE == 0 ? 128 : 64, NS = DQK / 16, NDB = DV / 32;
    constexpr int KP = TYPE == 0 ? 208 : 144, VP = TYPE == 0 ? 320 : 192;
    constexpr int KBYTES = 64 * KP, VBYTES = 64 * VP, BUFB = KBYTES + VBYTES, OFF_F = 2 * BUFB, OFF_FLAG = OFF_F + 512;
    const int tid = fresh_tid(), lane = tid & 63, wid = __builtin_amdgcn_readfirstlane(tid >> 6), r32 = lane & 31, hh = lane >> 5;
    const bool wave_on = 32 * wid < nq;
    const int qloc = min(32 * wid + r32, nq - 1);
    const int qrow = qrow0 + qloc;
    const int qpos = qpos0 + 32 * wid + r32;
    const int qp_lo = qpos0 + 32 * wid, qp_hi = qp_lo + 31;
    const int jmax = (qpos0 + nq - 1) >> 6;
    const int wjmax = TYPE == 0 ? (qp_lo >> 6) : TYPE == 1 ? (qp_hi >> 6) : ((qp_hi - 1) >> 6);
    const bf16_t* Kg = TYPE == 0 ? WSP(const bf16_t, WS_KA) : TYPE == 1 ? WSP(const bf16_t, WS_KB) : WSP(const bf16_t, WS_KC); const bf16_t* Vg = TYPE == 0 ? WSP(const bf16_t, WS_VA) : TYPE == 1 ? WSP(const bf16_t, WS_VB) : WSP(const bf16_t, WS_VC);
    constexpr int NKC = TYPE == 0 ? 2 : 1, NVC = TYPE == 0 ? 2 : 1;
    const bf16_t* ksrc[NKC]; int kdst[NKC]; bool kval[NKC]; const bf16_t* vsrc[NVC]; int vdst[NVC];
#pragma unroll
    for (int r = 0; r < NKC; ++r) {
        if (TYPE == 0) { const int n = tid + 512 * r; kval[r] = n < 768; const int nn = kval[r] ? n : 0; const int row = nn / 12, c = nn % 12;
            ksrc[r] = c < 8 ? WSP(const bf16_t, WS_KA) + (size_t)(krow0 + row) * 256 + h * 64 + c * 8 : (const bf16_t*)(ws + kr_off(l)) + (size_t)(krow0 + row) * 32 + (c - 8) * 8; kdst[r] = row * KP + c * 16; }
        else { const int row = tid >> 3, c = tid & 7; kval[r] = true; ksrc[r] = Kg + (size_t)(krow0 + row) * 256 + h * 64 + c * 8; kdst[r] = row * KP + c * 16; }
    }
#pragma unroll
    for (int r = 0; r < NVC; ++r) {
        if (TYPE == 0) { const int n = tid + 512 * r; const int row = n >> 4, c = n & 15; vsrc[r] = WSP(const bf16_t, WS_VA) + (size_t)(krow0 + row) * 512 + h * 128 + c * 8; vdst[r] = row * VP + c * 16; }
        else { const int row = tid >> 3, c = tid & 7; vsrc[r] = Vg + (size_t)(krow0 + row) * 256 + h * 64 + c * 8; vdst[r] = row * VP + c * 16; }
    }
    const size_t kstepA = (size_t)64 * 256, kstepR = (size_t)64 * 32, vstep = (size_t)64 * (TYPE == 0 ? 512 : 256);
    u32x4 kreg[NKC], vreg[NVC]; float freg = 0.f;
    constexpr bool F32C = SAMP && TYPE != 0;
    const float* kc32 = nullptr; const float* vc32 = nullptr; u32x4 kx[2], vx[2]; bool ld32 = false;
    if (F32C) { const int sb = (krow0 - MP) / SPITCH; const size_t o32 = (((size_t)l * SBN + sb) * PAST + (tid >> 3)) * 256 + h * 64 + (tid & 7) * 8;
        kc32 = inp(lds, TYPE == 1 ? 4 : 7) + o32; vc32 = inp(lds, TYPE == 1 ? 5 : 8) + o32; }
#define ATT_LOAD(j) do { if (F32C && (j) < PAST / 64) { ld32 = true; const size_t t_ = (size_t)(j) * 64 * 256; \
            kx[0] = *(const u32x4*)(kc32 + t_); kx[1] = *(const u32x4*)(kc32 + t_ + 4); vx[0] = *(const u32x4*)(vc32 + t_); vx[1] = *(const u32x4*)(vc32 + t_ + 4); } else { ld32 = false; \
        _Pragma("unroll") for (int r_ = 0; r_ < NKC; ++r_) { const bool rope_ = (TYPE == 0) && (((tid + 512 * r_) % 12) >= 8); \
            if (kval[r_]) kreg[r_] = *(const u32x4*)(ksrc[r_] + (size_t)(j) * (rope_ ? kstepR : kstepA)); } \
        _Pragma("unroll") for (int r_ = 0; r_ < NVC; ++r_) vreg[r_] = *(const u32x4*)(vsrc[r_] + (size_t)(j) * vstep); } \
        if (TYPE == 1 && tid < 64) freg = WSP(const float, WS_FB)[(size_t)(krow0 + 64 * (j) + tid) * 4 + h]; } while (0)
#define ATT_STORE(b) do { LAS unsigned char* kb_ = lds + (b) * BUFB; \
        if (F32C && ld32) { kreg[0] = (u32x4){cvtpk(__uint_as_float(kx[0].x), __uint_as_float(kx[0].y)), cvtpk(__uint_as_float(kx[0].z), __uint_as_float(kx[0].w)), cvtpk(__uint_as_float(kx[1].x), __uint_as_float(kx[1].y)), cvtpk(__uint_as_float(kx[1].z), __uint_as_float(kx[1].w))}; \
            vreg[0] = (u32x4){cvtpk(__uint_as_float(vx[0].x), __uint_as_float(vx[0].y)), cvtpk(__uint_as_float(vx[0].z), __uint_as_float(vx[0].w)), cvtpk(__uint_as_float(vx[1].x), __uint_as_float(vx[1].y)), cvtpk(__uint_as_float(vx[1].z), __uint_as_float(vx[1].w))}; } \
        _Pragma("unroll") for (int r_ = 0; r_ < NKC; ++r_) if (kval[r_]) *(LAS u32x4*)(kb_ + kdst[r_]) = kreg[r_]; \
        _Pragma("unroll") for (int r_ = 0; r_ < NVC; ++r_) *(LAS u32x4*)(kb_ + KBYTES + vdst[r_]) = vreg[r_]; \
        if (TYPE == 1 && tid < 64) ((LAS float*)(lds + OFF_F))[(b) * 64 + tid] = freg; } while (0)
    bf16x8 qf[NS];
    { const bf16_t* qp = TYPE == 0 ? WSP(const bf16_t, WS_QA) + (size_t)qrow * 384 + h * 96 : (TYPE == 1 ? WSP(const bf16_t, WS_QB) : WSP(const bf16_t, WS_QC)) + (size_t)qrow * 256 + h * 64;
#pragma unroll
      for (int s = 0; s < NS; ++s) qf[s] = *(const bf16x8*)(qp + 16 * s + 8 * hh); }
    float fq = 0.f; if (TYPE == 1) fq = WSP(const float, WS_FB)[(size_t)(krow0 + min(qpos, nkeys - 1)) * 4 + h];
    float bound = INFINITY;
    if (TYPE == 1 && nq == 256) {
        float qn = 0.f;
#pragma unroll
        for (int s = 0; s < NS; ++s)
#pragma unroll
            for (int e = 0; e < 8; ++e) { const float x = __uint_as_float((unsigned)(unsigned short)qf[s][e] << 16); qn += x * x; }
        qn = half_swap_sum(qn);
        const unsigned* km = WSP(const unsigned, WS_CTL) + CW_KMAX + ((l * 4 + krow0 / PT) * 4 + h) * 2;
        bound = sqrtf(qn * (__uint_as_float(km[0]) + __uint_as_float(km[1]))) * 1.02f + 1.0f;
    }
    f32x16 o[NDB];
#pragma unroll
    for (int d = 0; d < NDB; ++d)
#pragma unroll
        for (int i = 0; i < 16; ++i) o[d][i] = 0.f;
    float mrun = 0.f, lrun = 0.f, carry = 0.f; bool wdone = !wave_on;
    f32x16 negc;
#pragma unroll
    for (int i = 0; i < 16; ++i) negc[i] = (TYPE == 1) ? fq : 0.f;
    LAS unsigned* flags = (LAS unsigned*)(lds + OFF_FLAG);
    if (TYPE != 0 && lane == 0) { flags[wid] = wave_on ? 0u : 1u; flags[8 + wid] = wave_on ? 0u : 1u; }
    const int pir = (r32 & ~12) | ((r32 & 4) << 1) | ((r32 & 8) >> 1);
    const int krd = pir * KP + 16 * hh;
    const int vrd = (8 * hh + ((lane & 15) >> 2)) * VP + 32 * ((lane >> 4) & 1) + 8 * (lane & 3);
    ATT_LOAD(jmax); ATT_STORE(0);
    for (int j = jmax; j >= 0; --j) {
        const int buf = (jmax - j) & 1;
        if (j > 0) ATT_LOAD(j - 1);
        __syncthreads();
        if (TYPE != 0) { const u32x4 f0 = *(const LAS u32x4*)(flags + 8 * buf), f1 = *(const LAS u32x4*)(flags + 8 * buf + 4);
            const unsigned all = f0.x & f0.y & f0.z & f0.w & f1.x & f1.y & f1.z & f1.w; if (__builtin_amdgcn_readfirstlane(all)) break; }
        if (wave_on && !wdone && j <= wjmax) {
            const LAS unsigned char* Kb = lds + buf * BUFB; const LAS unsigned char* Vb = Kb + KBYTES;
            f32x16 s0, s1;
            {
                bf16x8 kf0[NS], kf1[NS];
#pragma unroll
                for (int s = 0; s < NS; ++s) { kf0[s] = *(const LAS bf16x8*)(Kb + krd + 32 * s); kf1[s] = *(const LAS bf16x8*)(Kb + krd + 32 * KP + 32 * s); }
                __builtin_amdgcn_sched_barrier(0);

#pragma unroll
                for (int s = 0; s < NS; ++s) { if (s == 0) { s0 = MFMA32(kf0[0], qf[0], negc); s1 = MFMA32(kf1[0], qf[0], negc); } else { s0 = MFMA32(kf0[s], qf[s], s0); s1 = MFMA32(kf1[s], qf[s], s1); } }

                __builtin_amdgcn_sched_barrier(0);
            }
            s16x4 vl[2][4], vh[2][4];
#pragma unroll
            for (int ks = 0; ks < 4; ++ks) { vl[0][ks] = tr_rd(Vb + vrd + (16 * ks) * VP); vh[0][ks] = tr_rd(Vb + vrd + (16 * ks + 4) * VP); }
            __builtin_amdgcn_sched_barrier(0);
            const int kb0 = 64 * j + 8 * hh;
            const bool need_mask = TYPE == 0 ? (64 * j + 63 >= nkeys) : TYPE == 1 ? (64 * j + 63 > qp_lo) : (64 * j + 63 >= qp_lo);
            if (TYPE != 2) {
                if (TYPE == 1) { const LAS float* F = (const LAS float*)(lds + OFF_F) + buf * 64 + 8 * hh;
#pragma unroll
                    for (int a = 0; a < 2; ++a) { const f32x4 f0 = *(const LAS f32x4*)(F + 16 * a), f1 = *(const LAS f32x4*)(F + 16 * a + 4), g0 = *(const LAS f32x4*)(F + 32 + 16 * a), g1 = *(const LAS f32x4*)(F + 32 + 16 * a + 4);
#pragma unroll
                        for (int e = 0; e < 4; ++e) { s0[8 * a + e] -= f0[e]; s0[8 * a + 4 + e] -= f1[e]; s1[8 * a + e] -= g0[e]; s1[8 * a + 4 + e] -= g1[e]; } } }
                if (need_mask) {
#pragma unroll
                    for (int i = 0; i < 16; ++i) { const int k0 = kb0 + 16 * (i >> 3) + (i & 7), k1 = k0 + 32;
                        const bool ok0 = TYPE == 0 ? (k0 < nkeys) : (k0 <= qpos), ok1 = TYPE == 0 ? (k1 < nkeys) : (k1 <= qpos);
                        s0[i] = ok0 ? s0[i] : -INFINITY; s1[i] = ok1 ? s1[i] : -INFINITY; } }
#define MX3(a, b, c) __builtin_fmaxf(__builtin_fmaxf((a), (b)), (c))
                float rm;
                { const float t0 = MX3(s0[0], s0[1], s0[2]), t1 = MX3(s0[3], s0[4], s0[5]), t2 = MX3(s0[6], s0[7], s0[8]), t3 = MX3(s0[9], s0[10], s0[11]), t4 = MX3(s0[12], s0[13], s0[14]),
                              t5 = MX3(s1[0], s1[1], s1[2]), t6 = MX3(s1[3], s1[4], s1[5]), t7 = MX3(s1[6], s1[7], s1[8]), t8 = MX3(s1[9], s1[10], s1[11]), t9 = MX3(s1[12], s1[13], s1[14]);
                  const float u0 = MX3(t0, t1, t2), u1 = MX3(t3, t4, t5), u2 = MX3(t6, t7, t8), u3 = MX3(t9, s0[15], s1[15]); rm = __builtin_fmaxf(MX3(u0, u1, u2), u3); }
#undef MX3
                rm = half_swap_max(rm);
                const bool first = (j == wjmax);
                if (first || __any(rm > 8.0f)) {
                    const float dl = first ? rm : fmaxf(rm, 0.f);
                    mrun += dl;
#pragma unroll
                    for (int i = 0; i < 16; ++i) { s0[i] -= dl; s1[i] -= dl; }
                    const float cin = (TYPE == 1 ? fq : 0.f) - mrun;
#pragma unroll
                    for (int i = 0; i < 16; ++i) negc[i] = cin;
                    if (!first) { const float f = __builtin_amdgcn_exp2f(-dl); lrun *= f;
#pragma unroll
                        for (int d = 0; d < NDB; ++d)
#pragma unroll
                            for (int i = 0; i < 16; ++i) o[d][i] *= f; }
                }
                f32x2_t ls2 = {0.f, 0.f};
#pragma unroll
                for (int i = 0; i < 16; ++i) { s0[i] = __builtin_amdgcn_exp2f(s0[i]); s1[i] = __builtin_amdgcn_exp2f(s1[i]); }
#pragma unroll
                for (int i = 0; i < 16; i += 2) { ls2 += (f32x2_t){s0[i], s0[i + 1]}; ls2 += (f32x2_t){s1[i], s1[i + 1]}; }
                lrun += ls2[0] + ls2[1];
                if (TYPE == 1 && j > 0) { const float fnext = WSP(const float, WS_FB)[(size_t)(krow0 + 64 * j - 1) * 4 + h]; wdone = __all(bound + (fq - fnext) - mrun < EXIT_LOG2); }
            } else {
                f32x16 lk0, lk1;
#pragma unroll
                for (int i = 0; i < 16; ++i) {
                    const float z0 = s0[i], z1 = s1[i];
                    const float sp0 = fmaxf(z0, 0.f) + __builtin_amdgcn_logf(1.0f + __builtin_amdgcn_exp2f(-fabsf(z0))), sp1 = fmaxf(z1, 0.f) + __builtin_amdgcn_logf(1.0f + __builtin_amdgcn_exp2f(-fabsf(z1)));
                    lk0[i] = -sp0; lk1[i] = -sp1; s0[i] = z0 - sp0; s1[i] = z1 - sp1; }
                if (need_mask) {
#pragma unroll
                    for (int i = 0; i < 16; ++i) { const int k0 = kb0 + 16 * (i >> 3) + (i & 7), k1 = k0 + 32; const bool ok0 = k0 < qpos, ok1 = k1 < qpos;
                        lk0[i] = ok0 ? lk0[i] : 0.f; lk1[i] = ok1 ? lk1[i] : 0.f; s0[i] = ok0 ? s0[i] : -INFINITY; s1[i] = ok1 ? s1[i] : -INFINITY; } }
                f32x16 sf0, sf1; float gt[4];
#pragma unroll
                for (int a = 0; a < 2; ++a) { float r0 = 0.f, r1 = 0.f;
#pragma unroll
                    for (int e = 7; e >= 0; --e) { sf0[8 * a + e] = r0; r0 += lk0[8 * a + e]; sf1[8 * a + e] = r1; r1 += lk1[8 * a + e]; }
                    gt[a] = r0; gt[2 + a] = r1; }
                float pt[4], gs[4];
#pragma unroll
                for (int c = 0; c < 4; ++c) pt[c] = __shfl_xor(gt[c], 32);
                float later = 0.f;
#pragma unroll
                for (int c = 3; c >= 0; --c) { gs[c] = later + (hh == 0 ? pt[c] : 0.f); later += gt[c] + pt[c]; }
#pragma unroll
                for (int i = 0; i < 16; ++i) { s0[i] = __builtin_amdgcn_exp2f(s0[i] + sf0[i] + gs[i >> 3] + carry); s1[i] = __builtin_amdgcn_exp2f(s1[i] + sf1[i] + gs[2 + (i >> 3)] + carry); }
                carry += later;
                wdone = __all(carry < EXIT_LOG2);
            }
            bf16x8 pk[4]; pk[0] = pack8(s0, 0); pk[1] = pack8(s0, 8); pk[2] = pack8(s1, 0); pk[3] = pack8(s1, 8);
            {
#pragma unroll
                for (int d = 0; d < NDB; ++d) {
                    if (d + 1 < NDB) {
#pragma unroll
                        for (int ks = 0; ks < 4; ++ks) { vl[(d + 1) & 1][ks] = tr_rd(Vb + vrd + (16 * ks) * VP + 64 * (d + 1)); vh[(d + 1) & 1][ks] = tr_rd(Vb + vrd + (16 * ks + 4) * VP + 64 * (d + 1)); } }
                    __builtin_amdgcn_sched_barrier(0);

#pragma unroll
                    for (int ks = 0; ks < 4; ++ks) { const bf16x8 vf = __builtin_shufflevector(vl[d & 1][ks], vh[d & 1][ks], 0, 1, 2, 3, 4, 5, 6, 7); o[d] = MFMA32(vf, pk[ks], o[d]); }

                    __builtin_amdgcn_sched_barrier(0);
                }
            }
        }
        if (TYPE != 0 && lane == 0) flags[8 * (buf ^ 1) + wid] = wdone ? 1u : 0u;
        if (j > 0) ATT_STORE(buf ^ 1);
    }
    __syncthreads();
    if (wave_on) {
        float inv = 1.0f;
        if (TYPE != 2) { const float lt = half_swap_sum(lrun); inv = 1.0f / lt; }
        float ssq = 0.f;
#pragma unroll
        for (int d = 0; d < NDB; ++d)
#pragma unroll
            for (int i = 0; i < 16; ++i) { o[d][i] *= inv; ssq += o[d][i] * o[d][i]; }
        ssq = half_swap_sum(ssq);
        const bool rowok = 32 * wid + r32 < nq;
        if (rowok) {
            if (hh == 0) WSP(float, WS_SS)[(size_t)qrow * 12 + TYPE * 4 + h] = ssq;
            const int col0 = (TYPE == 0 ? 0 : TYPE == 1 ? 512 : 768) + h * DV + 4 * hh;
#pragma unroll
            for (int d = 0; d < NDB; ++d) { u32x2 gw[4];
#pragma unroll
                for (int g = 0; g < 4; ++g) gw[g] = *(const u32x2*)(WSP(const bf16_t, WS_GATE) + (size_t)qrow * D + col0 + 32 * d + 8 * g);
#pragma unroll
                for (int g = 0; g < 4; ++g) { u32x2 w; w.x = cvtpk(o[d][4 * g] * bf_lo(gw[g].x), o[d][4 * g + 1] * bf_hi(gw[g].x)); w.y = cvtpk(o[d][4 * g + 2] * bf_lo(gw[g].y), o[d][4 * g + 3] * bf_hi(gw[g].y));
                    *(u32x2*)(WSP(bf16_t, WS_OP) + (size_t)qrow * D + col0 + 32 * d + 8 * g) = w; } }
        }
    }
#undef ATT_LOAD
#undef ATT_STORE
}

template <int TYPE>
__device__ __forceinline__ void attn_pp(unsigned char* ws, LAS unsigned char* lds, int l, int qrow0, int krow0, int qpos0, int h) {
    constexpr int DQK = TYPE == 0 ? 96 : 64, DV = TYPE == 0 ? 128 : 64, NS = DQK / 16, NDB = DV / 32;
    constexpr int KP = TYPE == 0 ? 208 : 144, VP = TYPE == 0 ? 320 : 192;
    constexpr int KBYTES = 64 * KP, VBYTES = 64 * VP, OFF_V = 3 * KBYTES, OFF_F = OFF_V + 3 * VBYTES, OFF_FLAG = OFF_F + 3 * 256;
    const int tid = fresh_tid(), lane = tid & 63, wid = __builtin_amdgcn_readfirstlane(tid >> 6), r32 = lane & 31, hh = lane >> 5;
    const bool lag = wid >= 4;
    const int qrow = qrow0 + 32 * wid + r32, qpos = qpos0 + 32 * wid + r32, qp_lo = qpos0 + 32 * wid, qp_hi = qp_lo + 31;
    const int jmax = (qpos0 + 255) >> 6;
    const int wjmax = TYPE == 0 ? (qp_lo >> 6) : TYPE == 1 ? (qp_hi >> 6) : ((qp_hi - 1) >> 6);
    constexpr bool ASC = (TYPE == 0);
#define PP_T(i) (ASC ? (i) : jmax - (i))
    const size_t Kg = TYPE == 0 ? WS_KA : TYPE == 1 ? WS_KB : WS_KC, Vg = TYPE == 0 ? WS_VA : TYPE == 1 ? WS_VB : WS_VC;
    constexpr int NKC = TYPE == 0 ? 2 : 1, NVC = TYPE == 0 ? 2 : 1;
    unsigned ksrc[NKC]; int kdst[NKC]; unsigned vsrc[NVC]; int vdst[NVC];
#pragma unroll
    for (int r = 0; r < NKC; ++r) {
        if (TYPE == 0) {
            if (r == 0) { const int row = tid >> 3, c = tid & 7; ksrc[r] = (unsigned)(WS_KA + ((size_t)(krow0 + row) * 256 + h * 64 + c * 8) * 2); kdst[r] = row * KP + c * 16; }
            else { const int row = (tid & 255) >> 2, c = tid & 3; ksrc[r] = (unsigned)(kr_off(l) + ((size_t)(krow0 + row) * 32 + c * 8) * 2); kdst[r] = row * KP + 128 + c * 16; } }
        else { const int row = tid >> 3, c = tid & 7; ksrc[r] = (unsigned)(Kg + ((size_t)(krow0 + row) * 256 + h * 64 + c * 8) * 2); kdst[r] = row * KP + c * 16; }
    }
#pragma unroll
    for (int r = 0; r < NVC; ++r) {
        if (TYPE == 0) { const int row = tid >> 4, c = tid & 15; vsrc[r] = (unsigned)(WS_VA + ((size_t)(krow0 + row) * 512 + h * 128 + c * 8) * 2); vdst[r] = row * VP + c * 16; }
        else { const int row = tid >> 3, c = tid & 7; vsrc[r] = (unsigned)(Vg + ((size_t)(krow0 + row) * 256 + h * 64 + c * 8) * 2); vdst[r] = row * VP + c * 16; }
    }
    constexpr unsigned kstepA = 64u * 256u * 2u, kstepR = 64u * 32u * 2u, vstep = 64u * (TYPE == 0 ? 512u : 256u) * 2u;
    u32x4 kreg[NKC], vreg[NVC]; float freg = 0.f;
#define PP_KLOAD(j) do { _Pragma("unroll") for (int r_ = 0; r_ < NKC; ++r_) kreg[r_] = *(const u32x4*)(ws + (ksrc[r_] + (unsigned)(j) * (r_ == 1 ? kstepR : kstepA))); \
        if (TYPE == 1) freg = WSP(const float, WS_FB)[(size_t)(krow0 + 64 * (j) + lane) * 4 + h]; } while (0)
#define PP_VLOAD(j) do { _Pragma("unroll") for (int r_ = 0; r_ < NVC; ++r_) vreg[r_] = *(const u32x4*)((ws + (size_t)r_ * 32 * 1024) + (vsrc[0] + (unsigned)(j) * vstep)); } while (0)
#define PP_KSTORE(sl) do { LAS unsigned char* kb_ = lds + (sl) * KBYTES; \
        _Pragma("unroll") for (int r_ = 0; r_ < NKC; ++r_) *(LAS u32x4*)(kb_ + kdst[r_]) = kreg[r_]; \
        if (TYPE == 1) ((LAS float*)(lds + OFF_F))[(sl) * 64 + lane] = freg; } while (0)
#define PP_VSTORE(sl) do { LAS unsigned char* vb_ = lds + OFF_V + (sl) * VBYTES; \
        _Pragma("unroll") for (int r_ = 0; r_ < NVC; ++r_) *(LAS u32x4*)(vb_ + vdst[0] + r_ * 32 * VP) = vreg[r_]; } while (0)
    bf16x8 qf[NS];
    { const bf16_t* qp = TYPE == 0 ? WSP(const bf16_t, WS_QA) + (size_t)qrow * 384 + h * 96 : (TYPE == 1 ? WSP(const bf16_t, WS_QB) : WSP(const bf16_t, WS_QC)) + (size_t)qrow * 256 + h * 64;
#pragma unroll
      for (int s = 0; s < NS; ++s) qf[s] = *(const bf16x8*)(qp + 16 * s + 8 * hh); }
    float fq = 0.f; if (TYPE == 1) fq = WSP(const float, WS_FB)[(size_t)(krow0 + qpos) * 4 + h];
    float bound = INFINITY;
    if (TYPE == 1) {
        float qn = 0.f;
#pragma unroll
        for (int s = 0; s < NS; ++s)
#pragma unroll
            for (int e = 0; e < 8; ++e) { const float x = __uint_as_float((unsigned)(unsigned short)qf[s][e] << 16); qn += x * x; }
        qn = half_swap_sum(qn);
        const unsigned* km = WSP(const unsigned, WS_CTL) + CW_KMAX + ((l * 4 + krow0 / PT) * 4 + h) * 2;
        bound = sqrtf(qn * (__uint_as_float(km[0]) + __uint_as_float(km[1]))) * 1.02f + 1.0f;
    }
    f32x16 o[NDB];
#pragma unroll
    for (int d = 0; d < NDB; ++d)
#pragma unroll
        for (int i = 0; i < 16; ++i) o[d][i] = 0.f;
    float mrun = 0.f, lrun = 0.f, carry = 0.f; bool wdone = false, pend = false, brk = false;
    f32x16 negc;
#pragma unroll
    for (int i = 0; i < 16; ++i) negc[i] = (TYPE == 1) ? fq : 0.f;
    LAS unsigned* flags = (LAS unsigned*)(lds + OFF_FLAG);
    const int pir = (r32 & ~12) | ((r32 & 4) << 1) | ((r32 & 8) >> 1);
    const int krd = pir * KP + 16 * hh;
    const int vrd = (8 * hh + ((lane & 15) >> 2)) * VP + 32 * ((lane >> 4) & 1) + 8 * (lane & 3);
    f32x16 s0, s1; bf16x8 pk[4];
#pragma unroll
    for (int i = 0; i < 16; ++i) { s0[i] = 0.f; s1[i] = 0.f; }
#pragma unroll
    for (int i = 0; i < 4; ++i) pk[i] = (bf16x8){0, 0, 0, 0, 0, 0, 0, 0};
#define PP_KRD(sl) do { const LAS unsigned char* Kb_ = lds + (sl) * KBYTES; \
        _Pragma("unroll") for (int s = 0; s < NS; ++s) { kf0[s] = *(const LAS bf16x8*)(Kb_ + krd + 32 * s); kf1[s] = *(const LAS bf16x8*)(Kb_ + krd + 32 * KP + 32 * s); } } while (0)
#define PP_QKM() do { __builtin_amdgcn_sched_barrier(0); \
        _Pragma("unroll") for (int s = 0; s < NS; ++s) { if (s == 0) { s0 = MFMA32(kf0[0], qf[0], negc); s1 = MFMA32(kf1[0], qf[0], negc); } else { s0 = MFMA32(kf0[s], qf[s], s0); s1 = MFMA32(kf1[s], qf[s], s1); } } \
        __builtin_amdgcn_sched_barrier(0); } while (0)
#define PP_VRD(sl, d) do { const LAS unsigned char* Vb_ = lds + OFF_V + (sl) * VBYTES; \
        _Pragma("unroll") for (int ks = 0; ks < 4; ++ks) { vl[d][ks] = tr_rd(Vb_ + vrd + (16 * ks) * VP + 64 * (d)); vh[d][ks] = tr_rd(Vb_ + vrd + (16 * ks + 4) * VP + 64 * (d)); } } while (0)
#define PP_PVM(d) do { _Pragma("unroll") for (int ks = 0; ks < 4; ++ks) { const bf16x8 vf = __builtin_shufflevector(vl[d][ks], vh[d][ks], 0, 1, 2, 3, 4, 5, 6, 7); o[d] = MFMA32(vf, pk[ks], o[d]); } } while (0)
    PP_KLOAD(PP_T(0)); PP_VLOAD(PP_T(0)); PP_KSTORE(0); PP_VSTORE(0);
    PP_KLOAD(PP_T(1)); PP_KSTORE(1);
    PP_KLOAD(PP_T(2)); PP_VLOAD(PP_T(1));
    __syncthreads();
    if (PP_T(0) <= wjmax) { bf16x8 kf0[NS], kf1[NS]; PP_KRD(0); PP_QKM(); }
    if (lag) { __builtin_amdgcn_s_setprio(1); __syncthreads(); }
    int c = 0;
    for (int it = 0; it <= jmax; ++it) {
        const int j = PP_T(it), jn = PP_T(it + 1);
        const int c1 = c == 2 ? 0 : c + 1, c2 = c1 == 2 ? 0 : c1 + 1;
        bf16x8 kf0[NS], kf1[NS];
        s16x4 vl[NDB][4], vh[NDB][4];
        __syncthreads();
        if (TYPE != 0 && !lag && it > 0) { const u32x4 f0 = *(const LAS u32x4*)(flags + 8 * ((j + 1) & 1)), f1 = *(const LAS u32x4*)(flags + 8 * ((j + 1) & 1) + 4);
            const unsigned all = f0.x & f0.y & f0.z & f0.w & f1.x & f1.y & f1.z & f1.w; if (__builtin_amdgcn_readfirstlane(all)) { brk = true; break; } }
        PP_KSTORE(c2); PP_VSTORE(c1);
        const bool doq = it < jmax && jn <= wjmax && !wdone;
        PP_KRD(c1);
        { const int ik = it + 3 <= jmax ? it + 3 : jmax, iv = it + 2 <= jmax ? it + 2 : jmax; PP_KLOAD(PP_T(ik)); PP_VLOAD(PP_T(iv)); }
        if (j <= wjmax && !wdone) {
            const int kb0 = 64 * j + 8 * hh;
            const bool need_mask = TYPE == 0 ? false : TYPE == 1 ? (64 * j + 63 > qp_lo) : (64 * j + 63 >= qp_lo);
            if (TYPE != 2) {
                if (TYPE == 1) { const LAS float* F = (const LAS float*)(lds + OFF_F) + c * 64 + 8 * hh;
#pragma unroll
                    for (int a = 0; a < 2; ++a) { const f32x4 f0 = *(const LAS f32x4*)(F + 16 * a), f1 = *(const LAS f32x4*)(F + 16 * a + 4), g0 = *(const LAS f32x4*)(F + 32 + 16 * a), g1 = *(const LAS f32x4*)(F + 32 + 16 * a + 4);
#pragma unroll
                        for (int e = 0; e < 4; ++e) { s0[8 * a + e] -= f0[e]; s0[8 * a + 4 + e] -= f1[e]; s1[8 * a + e] -= g0[e]; s1[8 * a + 4 + e] -= g1[e]; } } }
                if (need_mask) {
#pragma unroll
                    for (int i = 0; i < 16; ++i) { const int k0 = kb0 + 16 * (i >> 3) + (i & 7), k1 = k0 + 32;
                        s0[i] = (k0 <= qpos) ? s0[i] : -INFINITY; s1[i] = (k1 <= qpos) ? s1[i] : -INFINITY; } }
#define MX3(a, b, c) __builtin_fmaxf(__builtin_fmaxf((a), (b)), (c))
                float rm;
                { const float t0 = MX3(s0[0], s0[1], s0[2]), t1 = MX3(s0[3], s0[4], s0[5]), t2 = MX3(s0[6], s0[7], s0[8]), t3 = MX3(s0[9], s0[10], s0[11]), t4 = MX3(s0[12], s0[13], s0[14]),
                              t5 = MX3(s1[0], s1[1], s1[2]), t6 = MX3(s1[3], s1[4], s1[5]), t7 = MX3(s1[6], s1[7], s1[8]), t8 = MX3(s1[9], s1[10], s1[11]), t9 = MX3(s1[12], s1[13], s1[14]);
                  const float u0 = MX3(t0, t1, t2), u1 = MX3(t3, t4, t5), u2 = MX3(t6, t7, t8), u3 = MX3(t9, s0[15], s1[15]); rm = __builtin_fmaxf(MX3(u0, u1, u2), u3); }
#undef MX3
                rm = half_swap_max(rm);
                const bool first = ASC ? (it == 0) : (j == wjmax);
                if (first || __any(rm > 8.0f)) {
                    const float dl = first ? rm : fmaxf(rm, 0.f);
                    mrun += dl;
#pragma unroll
                    for (int i = 0; i < 16; ++i) { s0[i] -= dl; s1[i] -= dl; }
                    { const float cin = (TYPE == 1 ? fq : 0.f) - mrun;
#pragma unroll
                      for (int i = 0; i < 16; ++i) negc[i] = cin; }
                    if (!first) { const float f = __builtin_amdgcn_exp2f(-dl); lrun *= f;
#pragma unroll
                        for (int d = 0; d < NDB; ++d)
#pragma unroll
                            for (int i = 0; i < 16; ++i) o[d][i] *= f; }
                }
#pragma unroll
                for (int i = 0; i < 16; ++i) { s0[i] = __builtin_amdgcn_exp2f(s0[i]); s1[i] = __builtin_amdgcn_exp2f(s1[i]); }
                {
                    float a0 = s0[0], a1 = s1[0];
#pragma unroll
                    for (int i = 1; i < 16; ++i) { a0 += s0[i]; asm("" : "+v"(a0)); a1 += s1[i]; asm("" : "+v"(a1)); }
                    lrun += a0 + a1; }
                if (TYPE == 1 && j > 0) { const float fnext = ((const LAS float*)(lds + OFF_F))[c1 * 64 + 63]; wdone = __all(bound + (fq - fnext) - mrun < EXIT_LOG2); }
            } else {
                f32x16 lk0, lk1;
#pragma unroll
                for (int i = 0; i < 16; ++i) {
                    const float z0 = s0[i], z1 = s1[i];
                    const float sp0 = fmaxf(z0, 0.f) + __builtin_amdgcn_logf(1.0f + __builtin_amdgcn_exp2f(-fabsf(z0))), sp1 = fmaxf(z1, 0.f) + __builtin_amdgcn_logf(1.0f + __builtin_amdgcn_exp2f(-fabsf(z1)));
                    lk0[i] = -sp0; lk1[i] = -sp1; s0[i] = z0 - sp0; s1[i] = z1 - sp1; }
                if (need_mask) {
#pragma unroll
                    for (int i = 0; i < 16; ++i) { const int k0 = kb0 + 16 * (i >> 3) + (i & 7), k1 = k0 + 32; const bool ok0 = k0 < qpos, ok1 = k1 < qpos;
                        lk0[i] = ok0 ? lk0[i] : 0.f; lk1[i] = ok1 ? lk1[i] : 0.f; s0[i] = ok0 ? s0[i] : -INFINITY; s1[i] = ok1 ? s1[i] : -INFINITY; } }
                f32x16 sf0, sf1; float gt[4];
#pragma unroll
                for (int a = 0; a < 2; ++a) { float r0 = 0.f, r1 = 0.f;
#pragma unroll
                    for (int e = 7; e >= 0; --e) { sf0[8 * a + e] = r0; r0 += lk0[8 * a + e]; sf1[8 * a + e] = r1; r1 += lk1[8 * a + e]; }
                    gt[a] = r0; gt[2 + a] = r1; }
                float pt[4], gs[4];
#pragma unroll
                for (int cc = 0; cc < 4; ++cc) pt[cc] = __shfl_xor(gt[cc], 32);
                float later = 0.f;
#pragma unroll
                for (int cc = 3; cc >= 0; --cc) { gs[cc] = later + (hh == 0 ? pt[cc] : 0.f); later += gt[cc] + pt[cc]; }
#pragma unroll
                for (int i = 0; i < 16; ++i) { s0[i] = __builtin_amdgcn_exp2f(s0[i] + sf0[i] + gs[i >> 3] + carry); s1[i] = __builtin_amdgcn_exp2f(s1[i] + sf1[i] + gs[2 + (i >> 3)] + carry); }
                carry += later;
                wdone = __all(carry < EXIT_LOG2);
            }
            pk[0] = pack8(s0, 0); pk[1] = pack8(s0, 8); pk[2] = pack8(s1, 0); pk[3] = pack8(s1, 8); pend = true;
        }
        if (TYPE != 0 && lane == 0) flags[8 * (j & 1) + wid] = wdone ? 1u : 0u;
        __syncthreads();
        bool allq = false;
        if (TYPE != 0 && lag) { const u32x4 f0 = *(const LAS u32x4*)(flags + 8 * (j & 1)), f1 = *(const LAS u32x4*)(flags + 8 * (j & 1) + 4);
            const unsigned all = f0.x & f0.y & f0.z & f0.w & f1.x & f1.y & f1.z & f1.w; allq = __builtin_amdgcn_readfirstlane(all) != 0u; }
        if (pend) PP_VRD(c, 0);
        if (doq && !wdone && !allq) PP_QKM();
        if (pend) {
            PP_VRD(c, 1); if (NDB > 2) { PP_VRD(c, 2); PP_VRD(c, 3); }
            __builtin_amdgcn_sched_barrier(0);
            PP_PVM(0); PP_PVM(1);
            if (NDB > 2) { PP_PVM(2); PP_PVM(3); }
            __builtin_amdgcn_sched_barrier(0);
            pend = false; }
        if (allq) { brk = true; break; }
        c = c1;
    }
    if (!lag && !brk) __syncthreads();
    __builtin_amdgcn_s_setprio(0);
    __syncthreads();
#undef PP_T
#undef PP_KLOAD
#undef PP_VLOAD
#undef PP_KSTORE
#undef PP_VSTORE
#undef PP_KRD
#undef PP_QKM
#undef PP_VRD
#undef PP_PVM
    {
        float inv = 1.0f;
        if (TYPE != 2) { const float lt = half_swap_sum(lrun); inv = 1.0f / lt; }
        float ssq = 0.f;
#pragma unroll
        for (int d = 0; d < NDB; ++d)
#pragma unroll
            for (int i = 0; i < 16; ++i) { o[d][i] *= inv; ssq += o[d][i] * o[d][i]; }
        ssq = half_swap_sum(ssq);
        if (hh == 0) WSP(float, WS_SS)[(size_t)qrow * 12 + TYPE * 4 + h] = ssq;
        const int col0 = (TYPE == 0 ? 0 : TYPE == 1 ? 512 : 768) + h * DV + 4 * hh;
#pragma unroll
        for (int d = 0; d < NDB; ++d) { u32x2 gw[4];
#pragma unroll
            for (int g = 0; g < 4; ++g) gw[g] = *(const u32x2*)(WSP(const bf16_t, WS_GATE) + (size_t)qrow * D + col0 + 32 * d + 8 * g);
#pragma unroll
            for (int g = 0; g < 4; ++g) { u32x2 w; w.x = cvtpk(o[d][4 * g] * bf_lo(gw[g].x), o[d][4 * g + 1] * bf_hi(gw[g].x)); w.y = cvtpk(o[d][4 * g + 2] * bf_lo(gw[g].y), o[d][4 * g + 3] * bf_hi(gw[g].y));
                *(u32x2*)(WSP(bf16_t, WS_OP) + (size_t)qrow * D + col0 + 32 * d + 8 * g) = w; } }
    }
}

template <int TYPE>
__device__ __forceinline__ void sample_octet(unsigned char* ws, float* out, LAS unsigned char* lds, int l, int oct) {
    constexpr int DQK = TYPE == 0 ? 96 : 64, DV = TYPE == 0 ? 128 : 64, NS = DQK / 16, NDB = DV / 32, VP = TYPE == 0 ? 320 : 192;
    constexpr int NT = 65;
    const int tid = fresh_tid(), lane = tid & 63, wid = __builtin_amdgcn_readfirstlane(tid >> 6), r32 = lane & 31, hh = lane >> 5;
    const int unit = oct * 8 + wid, sb = unit >> 2, h = unit & 3;
    LAS unsigned char* Vl = lds + wid * 10240;
    const int krow0 = MP + sb * SPITCH, qrow = MP + sb * STN + min(r32, STN - 1), qpos = PAST + r32;
    bf16x8 qf[NS];
    { const bf16_t* qp = TYPE == 0 ? WSP(const bf16_t, WS_QA) + (size_t)qrow * 384 + h * 96 : (TYPE == 1 ? WSP(const bf16_t, WS_QB) : WSP(const bf16_t, WS_QC)) + (size_t)qrow * 256 + h * 64;
#pragma unroll
      for (int s = 0; s < NS; ++s) qf[s] = *(const bf16x8*)(qp + 16 * s + 8 * hh); }
    float fq = 0.f; if (TYPE == 1) fq = WSP(const float, WS_FB)[(size_t)(krow0 + min(qpos, SKEYS - 1)) * 4 + h];
    const int pir = (r32 & ~12) | ((r32 & 4) << 1) | ((r32 & 8) >> 1);
    const float* kc = nullptr; const float* vc = nullptr; const float* kn = nullptr; const float* vn = nullptr;
    if (TYPE != 0) { const size_t cb = ((size_t)l * SBN + sb) * PAST * 256 + h * 64, nb = ((size_t)l * MS + sb * STN) * 256 + h * 64;
        kc = inp(lds, TYPE == 1 ? 4 : 7) + cb; vc = inp(lds, TYPE == 1 ? 5 : 8) + cb; kn = out + (TYPE == 1 ? O_SFK : O_SSK) + nb; vn = out + (TYPE == 1 ? O_SFV : O_SSV) + nb; }
    const bf16_t* KAp = WSP(const bf16_t, WS_KA) + (size_t)krow0 * 256 + h * 64; const bf16_t* KRp = (const bf16_t*)(ws + kr_off(l)) + (size_t)krow0 * 32; const bf16_t* VAp = WSP(const bf16_t, WS_VA) + (size_t)krow0 * 512 + h * 128;
    constexpr int NKR = TYPE == 0 ? NS : 2 * NS, NVR = 8;
    constexpr int PD = 1;
    u32x4 kraw[PD][NKR], vraw[PD][NVR]; float fkr[2][2] = {{0.f, 0.f}, {0.f, 0.f}};
#define SO_LOAD(t, S) do { \
        if (TYPE == 0) { const size_t kr_ = (size_t)(32 * (t) + pir); \
            _Pragma("unroll") for (int s_ = 0; s_ < NS; ++s_) kraw[S][s_] = s_ < 4 ? *(const u32x4*)(KAp + kr_ * 256 + 16 * s_ + 8 * hh) : *(const u32x4*)(KRp + kr_ * 32 + 16 * (s_ - 4) + 8 * hh); \
            _Pragma("unroll") for (int i_ = 0; i_ < 8; ++i_) { const int m_ = lane + 64 * i_; vraw[S][i_] = *(const u32x4*)(VAp + (size_t)(32 * (t) + (m_ >> 4)) * 512 + (m_ & 15) * 8); } \
        } else { const float* kb_ = (t) < 64 ? kc + (size_t)(t) * 32 * 256 : kn; const float* vb_ = (t) < 64 ? vc + (size_t)(t) * 32 * 256 : vn; \
            const int rcap_ = (t) < 64 ? 31 : STN - 1;         \
            _Pragma("unroll") for (int s_ = 0; s_ < NS; ++s_) { const float* p_ = kb_ + (size_t)min(pir, rcap_) * 256 + 16 * s_ + 8 * hh; kraw[S][2 * s_] = *(const u32x4*)p_; kraw[S][2 * s_ + 1] = *(const u32x4*)(p_ + 4); } \
            _Pragma("unroll") for (int i_ = 0; i_ < 4; ++i_) { const int m_ = lane + 64 * i_; const float* p_ = vb_ + (size_t)min(m_ >> 3, rcap_) * 256 + (m_ & 7) * 8; vraw[S][2 * i_] = *(const u32x4*)p_; vraw[S][2 * i_ + 1] = *(const u32x4*)(p_ + 4); } \
            if (TYPE == 1) { fkr[S][0] = WSP(const float, WS_FB)[(size_t)(krow0 + 32 * (t) + 8 * hh + (lane & 7)) * 4 + h]; fkr[S][1] = WSP(const float, WS_FB)[(size_t)(krow0 + 32 * (t) + 16 + 8 * hh + (lane & 7)) * 4 + h]; } } } while (0)
#define F2B(a, b) (u32x4){cvtpk(__uint_as_float((a).x), __uint_as_float((a).y)), cvtpk(__uint_as_float((a).z), __uint_as_float((a).w)), cvtpk(__uint_as_float((b).x), __uint_as_float((b).y)), cvtpk(__uint_as_float((b).z), __uint_as_float((b).w))}
    f32x16 o[NDB];
#pragma unroll
    for (int d = 0; d < NDB; ++d)
#pragma unroll
        for (int i = 0; i < 16; ++i) o[d][i] = 0.f;
    float mrun = 0.f, lrun = 0.f, carry = 0.f; bool done = false;
    f32x16 negc;
#pragma unroll
    for (int i = 0; i < 16; ++i) negc[i] = (TYPE == 1) ? fq : 0.f;
    const int vrd = (8 * hh + ((lane & 15) >> 2)) * VP + 32 * ((lane >> 4) & 1) + 8 * (lane & 3);
#define SO_BODY(t, S) do { \
        bf16x8 kf[NS]; const float fk0 = fkr[S][0], fk1 = fkr[S][1]; \
        _Pragma("unroll") for (int s = 0; s < NS; ++s) kf[s] = TYPE == 0 ? __builtin_bit_cast(bf16x8, kraw[S][s]) : __builtin_bit_cast(bf16x8, F2B(kraw[S][2 * s], kraw[S][2 * s + 1])); \
        if (TYPE == 0) { _Pragma("unroll") for (int i = 0; i < 8; ++i) { const int m = lane + 64 * i; *(LAS u32x4*)(Vl + (m >> 4) * VP + (m & 15) * 16) = vraw[S][i]; } } \
        else { _Pragma("unroll") for (int i = 0; i < 4; ++i) { const int m = lane + 64 * i; *(LAS u32x4*)(Vl + (m >> 3) * VP + (m & 7) * 16) = F2B(vraw[S][2 * i], vraw[S][2 * i + 1]); } } \
        if ((t) >= PD) SO_LOAD((t) - PD, S); \
        f32x16 s0; \
         \
        _Pragma("unroll") for (int s = 0; s < NS; ++s) s0 = MFMA32(kf[s], qf[s], s == 0 ? negc : s0); \
         \
        const int kb0 = 32 * (t) + 8 * hh;                                          \
        const bool need_mask = ((t) == NT - 1); \
        if (TYPE != 2) { \
            if (TYPE == 1) {     \
                _Pragma("unroll") for (int i = 0; i < 16; ++i) { const float f = __shfl(i < 8 ? fk0 : fk1, (lane & 32) | (i & 7)); s0[i] -= f; } } \
            if (need_mask) { \
                _Pragma("unroll") for (int i = 0; i < 16; ++i) { const int k0 = kb0 + 16 * (i >> 3) + (i & 7); const bool ok = TYPE == 0 ? (k0 < SKEYS) : (k0 <= qpos); s0[i] = ok ? s0[i] : -INFINITY; } } \
            float rm = s0[0]; \
            _Pragma("unroll") for (int i = 1; i < 16; ++i) rm = fmaxf(rm, s0[i]); \
            rm = half_swap_max(rm); \
            const bool first = ((t) == NT - 1); \
            if (first || __any(rm > 8.0f)) { \
                const float dl = first ? rm : fmaxf(rm, 0.f); \
                mrun += dl; \
                _Pragma("unroll") for (int i = 0; i < 16; ++i) s0[i] -= dl; \
                const float cin = (TYPE == 1 ? fq : 0.f) - mrun; \
                _Pragma("unroll") for (int i = 0; i < 16; ++i) negc[i] = cin; \
                if (!first) { const float f = __builtin_amdgcn_exp2f(-dl); lrun *= f; \
                    _Pragma("unroll") for (int d = 0; d < NDB; ++d) _Pragma("unroll") for (int i = 0; i < 16; ++i) o[d][i] *= f; } \
            } \
            float ls = 0.f; \
            _Pragma("unroll") for (int i = 0; i < 16; ++i) { s0[i] = __builtin_amdgcn_exp2f(s0[i]); ls += s0[i]; } \
            lrun += ls; \
        } else { \
            f32x16 lk0; \
            _Pragma("unroll") for (int i = 0; i < 16; ++i) { const float z0 = s0[i]; const float sp0 = fmaxf(z0, 0.f) + __builtin_amdgcn_logf(1.0f + __builtin_amdgcn_exp2f(-fabsf(z0))); lk0[i] = -sp0; s0[i] = z0 - sp0; } \
            if (need_mask) { \
                _Pragma("unroll") for (int i = 0; i < 16; ++i) { const int k0 = kb0 + 16 * (i >> 3) + (i & 7); const bool ok = k0 < qpos; lk0[i] = ok ? lk0[i] : 0.f; s0[i] = ok ? s0[i] : -INFINITY; } } \
            f32x16 sf0; float gt[2]; \
            _Pragma("unroll") for (int a = 0; a < 2; ++a) { float r0 = 0.f; \
                _Pragma("unroll") for (int e = 7; e >= 0; --e) { sf0[8 * a + e] = r0; r0 += lk0[8 * a + e]; } \
                gt[a] = r0; } \
            float pt[2], gs[2]; \
            _Pragma("unroll") for (int c = 0; c < 2; ++c) pt[c] = __shfl_xor(gt[c], 32); \
            float later = 0.f; \
            _Pragma("unroll") for (int c = 1; c >= 0; --c) { gs[c] = later + (hh == 0 ? pt[c] : 0.f); later += gt[c] + pt[c]; } \
            _Pragma("unroll") for (int i = 0; i < 16; ++i) s0[i] = __builtin_amdgcn_exp2f(s0[i] + sf0[i] + gs[i >> 3] + carry); \
            carry += later; \
        } \
        bf16x8 pk[2]; pk[0] = pack8(s0, 0); pk[1] = pack8(s0, 8); \
        {     \
            s16x4 vl[NDB][2], vh[NDB][2]; \
            _Pragma("unroll") for (int d = 0; d < NDB; ++d) _Pragma("unroll") for (int ks = 0; ks < 2; ++ks) { vl[d][ks] = tr_rd(Vl + vrd + (16 * ks) * VP + 64 * d); vh[d][ks] = tr_rd(Vl + vrd + (16 * ks + 4) * VP + 64 * d); } \
             \
            _Pragma("unroll") for (int d = 0; d < NDB; ++d) _Pragma("unroll") for (int ks = 0; ks < 2; ++ks) { const bf16x8 vf = __builtin_shufflevector(vl[d][ks], vh[d][ks], 0, 1, 2, 3, 4, 5, 6, 7); o[d] = MFMA32(vf, pk[ks], o[d]); } \
             \
        } \
        if (TYPE == 2) done = __all(carry < EXIT_LOG2);        \
    } while (0)
    if (PD == 1) {
        SO_LOAD(NT - 1, 0);
        for (int t = NT - 1; t >= 0; --t) { SO_BODY(t, 0); if (TYPE == 2 && done) break; }
    } else {
        SO_LOAD(NT - 1, 0); SO_LOAD(NT - 2, PD - 1);
        for (int t = NT - 1; t >= 0; t -= 2) {
            SO_BODY(t, 0); if (done) break;
            if (t >= 1) { SO_BODY(t - 1, PD - 1); if (done) break; }
        }
    }
#undef SO_BODY
#undef SO_LOAD
#undef F2B
    {
        float inv = 1.0f;
        if (TYPE != 2) { const float lt = half_swap_sum(lrun); inv = 1.0f / lt; }
        float ssq = 0.f;
#pragma unroll
        for (int d = 0; d < NDB; ++d)
#pragma unroll
            for (int i = 0; i < 16; ++i) { o[d][i] *= inv; ssq += o[d][i] * o[d][i]; }
        ssq = half_swap_sum(ssq);
        if (r32 < STN) {
            if (hh == 0) WSP(float, WS_SS)[(size_t)qrow * 12 + TYPE * 4 + h] = ssq;
            const int col0 = (TYPE == 0 ? 0 : TYPE == 1 ? 512 : 768) + h * DV + 4 * hh;
#pragma unroll
            for (int d = 0; d < NDB; ++d) { u32x2 gw[4];
#pragma unroll
                for (int g = 0; g < 4; ++g) gw[g] = *(const u32x2*)(WSP(const bf16_t, WS_GATE) + (size_t)qrow * D + col0 + 32 * d + 8 * g);
#pragma unroll
                for (int g = 0; g < 4; ++g) { u32x2 w; w.x = cvtpk(o[d][4 * g] * bf_lo(gw[g].x), o[d][4 * g + 1] * bf_hi(gw[g].x)); w.y = cvtpk(o[d][4 * g + 2] * bf_lo(gw[g].y), o[d][4 * g + 3] * bf_hi(gw[g].y));
                    *(u32x2*)(WSP(bf16_t, WS_OP) + (size_t)qrow * D + col0 + 32 * d + 8 * g) = w; } }
        }
    }
    asm volatile("s_waitcnt vmcnt(0)" ::: "memory");
    __syncthreads();
    if (tid == 0) { __builtin_amdgcn_fence(__ATOMIC_RELEASE, "agent"); asm volatile("s_waitcnt vmcnt(0)" ::: "memory");
        __hip_atomic_fetch_add(WSP(unsigned, WS_CTL) + CW_SDONE + 16 * l, 1u, __ATOMIC_RELAXED, __HIP_MEMORY_SCOPE_AGENT); }
}
constexpr int CV_CHUNKS = 4096, N_CV_CKV = SBN * PAST * 256 / 8 / CV_CHUNKS, N_CV_KPE = SBN * PAST * 32 / 8 / CV_CHUNKS, N_CV = N_CV_CKV + N_CV_KPE;
constexpr int P0_I0 = 16 * (NINP / 32), P0_I1 = 4 * 24, P0_I2 = 16 * 32, P0_IL = P0_I0 + P0_I1 + P0_I2, N_WT = P0_IL / 8;
static_assert(P0_IL % 8 == 0, "weight items per layer in units of 8");
__device__ __forceinline__ void conv_unit(unsigned char* ws, LAS unsigned char* lds, int ln, int u) {
    const int tid = fresh_tid();
    const bool ckv = u < N_CV_CKV; const int v = ckv ? u : u - N_CV_CKV;
    const float* src = ckv ? inp(lds, 2) + (size_t)ln * SBN * PAST * 256 : inp(lds, 3) + (size_t)ln * SBN * PAST * 32;
    f32x4 a[8], b[8];
#pragma unroll
    for (int k = 0; k < 8; ++k) { const size_t q = (size_t)v * CV_CHUNKS + tid + 512 * k; a[k] = *(const f32x4*)(src + q * 8); b[k] = *(const f32x4*)(src + q * 8 + 4); }
#pragma unroll
    for (int k = 0; k < 8; ++k) { const int q = v * CV_CHUNKS + tid + 512 * k;
        bf16_t* dst; if (ckv) dst = WSP(bf16_t, WS_CKVB) + (size_t)M * 256 + (size_t)q * 8; else { const int per_b = PAST * 32 / 8, sb = q / per_b, rem = q % per_b; dst = (bf16_t*)(ws + kr_off(ln)) + (size_t)MP * 32 + (size_t)sb * SPITCH * 32 + (size_t)rem * 8; }
        u32x4 o; o.x = cvtpk(a[k][0], a[k][1]); o.y = cvtpk(a[k][2], a[k][3]); o.z = cvtpk(b[k][0], b[k][1]); o.w = cvtpk(b[k][2], b[k][3]); *(u32x4*)dst = o; }
}
__device__ __forceinline__ void weight_unit(unsigned char* ws, LAS unsigned char* lds, int ln, int u) {
    const int tid = fresh_tid(), lane = tid & 63, wid = __builtin_amdgcn_readfirstlane(tid >> 6);
    LAS float* scr = (LAS float*)(lds + wid * 16384);
    int r = u * 8 + wid;
    if (r < P0_I0) p0_item(ws, lds, 0, ln, r, scr, lane);
    else if (r < P0_I0 + P0_I1) p0_item(ws, lds, 1, ln, r - P0_I0, scr, lane);
    else p0_item(ws, lds, 2, ln, r - P0_I0 - P0_I1, scr, lane);
}
constexpr int NU_P = 32 * 16, NU_S = SBN * 4 / 8, NU_T = NU_P + NU_S, NU_ALL = 3 * NU_T;
__device__ __forceinline__ int q_fetch(unsigned* head, LAS int* slot) {
    __syncthreads();
    if (threadIdx.x == 0) *slot = (int)__hip_atomic_fetch_add(head, 1u, __ATOMIC_RELAXED, __HIP_MEMORY_SCOPE_AGENT);
    __syncthreads();
    return __builtin_amdgcn_readfirstlane(*slot);
}
template <int TYPE>
__device__ __forceinline__ void attn_prompt(unsigned char* ws, LAS unsigned char* lds, int l, int xq, int v) {
    const int qb = 31 - (v >> 1), bh = 2 * xq + (v & 1), b = bh >> 2, h = bh & 3;
#ifndef PP_MASK
#define PP_MASK 7
#endif
    if ((PP_MASK >> TYPE) & 1) attn_pp<TYPE>(ws, lds, l, b * PT + qb * 256, b * PT, qb * 256, h);
    else attn_unit<TYPE, false>(ws, lds, l, b * PT + qb * 256, 256, b * PT, qb * 256, PT, h);
}
template <int TYPE>
__device__ __forceinline__ void prompt_queues(unsigned char* ws, LAS unsigned char* lds, int l, LAS int* slot) {
    const int x = (int)(xb_xcc_id() & 7u);
    unsigned* const hb = (unsigned*)(ws + WS_CTL) + CW_XQ + ((l * 3 + TYPE) * 8) * 16;
    int xq = x;
    int v = q_fetch(hb + xq * 16, slot);
    for (;;) {
        while (v < 64) { attn_prompt<TYPE>(ws, lds, l, xq, v); v = q_fetch(hb + xq * 16, slot); }
        __syncthreads();
        if (threadIdx.x == 0) { unsigned h[8];
#pragma unroll
            for (int i = 0; i < 8; ++i) h[i] = __hip_atomic_fetch_add(hb + ((x + i) & 7) * 16, 0u, __ATOMIC_RELAXED, __HIP_MEMORY_SCOPE_AGENT);
            int pick = -1;
#pragma unroll
            for (int i = 7; i >= 0; --i) pick = h[i] < 64u ? ((x + i) & 7) : pick;
            *slot = pick; }
        __syncthreads(); xq = __builtin_amdgcn_readfirstlane(*slot);
        if (xq < 0) break;
        v = q_fetch(hb + xq * 16, slot);
    }
}
__device__ __forceinline__ void sample_outproj(unsigned char* ws, LAS unsigned char* lds, int l, LAS int* slot) {
    unsigned* const ctl = WSP(unsigned, WS_CTL) + CW_SDONE + 16 * l;
    int u = q_fetch(ctl + 8, slot);
    while (u < 8) {
        if (threadIdx.x == 0) { unsigned sp = 0;
            while (__hip_atomic_fetch_add(ctl, 0u, __ATOMIC_RELAXED, __HIP_MEMORY_SCOPE_AGENT) < 3u * NU_S) { __builtin_amdgcn_s_sleep(8); if (++sp > (1u << 18)) break; }
            __builtin_amdgcn_fence(__ATOMIC_ACQUIRE, "agent"); asm volatile("s_waitcnt vmcnt(0)" ::: "memory"); }
        __syncthreads();
        pg8::Gemm g{(const pg8::bf16_t*)(ws + WS_OP), (const pg8::bf16_t*)(ws + WS_WOUT + (size_t)l * D * D * 2), M, D, D};
        pg8::OneUnit S; S.pm = MP / 256 + (u >> 2); S.pn = u & 3;
        EpiP5 E; E.ws = ws; E.tab = (LAS float*)(lds + SCR_OFF);
        pg8::gemm_phase<EpiP5, pg8::OneUnit, true, true>(lds, g, S, E);
        u = q_fetch(ctl + 8, slot);
    }
}
__device__ __forceinline__ void p4_attention(unsigned char* ws, float* out, int l, LAS unsigned char* lds, int rep) {
    unsigned* head = (unsigned*)(ws + WS_CTL) + CW_QUEUE + 64 * l + 16 * rep; LAS int* slot = (LAS int*)(lds + MISC_OFF + 64);
#define NEXT_BEGIN() int nx_ = 0; if (threadIdx.x == 0) nx_ = (int)__hip_atomic_fetch_add(head, 1u, __ATOMIC_RELAXED, __HIP_MEMORY_SCOPE_AGENT)
#define NEXT_END() do { if (threadIdx.x == 0) *slot = nx_; __syncthreads(); u = __builtin_amdgcn_readfirstlane(*slot); } while (0)
    const int ncv = (l + 1 < NL) ? N_CV : 0, nwt = (l + 1 < NL) ? N_WT : 0;
    const int b0 = ncv, b1 = b0 + nwt, b2 = b1 + NU_S, b3 = b2 + NU_S, b4 = b3 + NU_S;
    int u = q_fetch(head, slot);
    while (u < b0) { NEXT_BEGIN(); conv_unit(ws, lds, l + 1, u); NEXT_END(); }
    while (u < b1) { NEXT_BEGIN(); weight_unit(ws, lds, l + 1, u - b0); NEXT_END(); }
    while (u < b2) { NEXT_BEGIN(); sample_octet<0>(ws, out, lds, l, u - b1); NEXT_END(); }
    while (u < b3) { NEXT_BEGIN(); sample_octet<1>(ws, out, lds, l, u - b2); NEXT_END(); }
    while (u < b4) { NEXT_BEGIN(); sample_octet<2>(ws, out, lds, l, u - b3); NEXT_END(); }
    prompt_queues<0>(ws, lds, l, slot);
    sample_outproj(ws, lds, l, slot);
    prompt_queues<1>(ws, lds, l, slot);
    prompt_queues<2>(ws, lds, l, slot);
#undef NEXT_BEGIN
#undef NEXT_END
}
constexpr int N_PHASES = 2 + 5 * NL;
__global__ void __launch_bounds__(512, 2) fwd(Params P) {
    extern __shared__ __attribute__((aligned(16))) unsigned char lds_raw[];
    LAS unsigned char* lds = (LAS unsigned char*)lds_raw;
    const int tid = threadIdx.x;
    if (tid < 64) ((LAS unsigned*)(lds + MISC_OFF))[tid] = 0u;
    if (tid < 18) ((LAS unsigned long long*)(lds + PTR_OFF))[tid] = (unsigned long long)P.in[tid];
    __syncthreads();
    unsigned char* const ws0 = P.ws; float* const out0 = P.out;
    unsigned* ctl = (unsigned*)(ws0 + WS_CTL);
    XcdBarrier bar = xcd_barrier_post(ctl + CW_BAR, (volatile LAS unsigned*)(lds + MISC_OFF + 32));
    const int lo = P.ph_lo, hi = P.ph_hi;
#ifndef PHM
#define PHM 0x7f
#endif
#ifndef REP_P1
#define REP_P1 1
#endif
#ifndef REP_P2
#define REP_P2 1
#endif
#ifndef REP_P3
#define REP_P3 1
#endif
#ifndef REP_P4
#define REP_P4 1
#endif
#ifndef REP_P5
#define REP_P5 1
#endif
#define IN(k) (lo <= (k) && (k) < hi)
#define SEAM(k) do { if (IN(k) && IN((k) + 1)) { XcdBarrier b2_ = bar; unsigned* bb_ = b2_.bar; asm volatile("" : "+s"(bb_)); b2_.bar = bb_; xcd_barrier(b2_); } } while (0)
#define FRESH() unsigned long long ws_i_ = (unsigned long long)ws0, out_i_ = (unsigned long long)out0; asm volatile("" : "+s"(ws_i_), "+s"(out_i_)); unsigned char* ws = (unsigned char*)(GAS unsigned char*)ws_i_; float* out = (float*)(GAS float*)out_i_; (void)out
    if ((PHM & 1) && IN(0)) { FRESH(); p0_prologue(ws, lds); }
    if (!(IN(0) && IN(1))) SEAM(0);
    for (int l = 0; l <= NL; ++l) {
        const int pb = 1 + 5 * l;
        if ((PHM & 2) && IN(pb)) { FRESH(); p1_norm(ws, out, lds, l); }
        if (l == NL) break;
        SEAM(pb);
        if ((PHM & 4) && IN(pb + 1)) { FRESH();
            pg8::Gemm g{(const pg8::bf16_t*)(ws + WS_XN), (const pg8::bf16_t*)(ws + WS_WIN + (size_t)l * NINP * D * 2), M, NINP, D};
            pg8::StaticOrder S; S.init(M, NINP, (int)gridDim.x, (int)blockIdx.x);
            EpiP2 E; E.ws = ws; E.out = out; E.kvnorm = inp(lds, 12) + l * 256; E.fbias = inp(lds, 15) + l * 4; E.l = l; E.scr = (LAS float*)(lds + SCR_OFF);
            _Pragma("nounroll") for (int rep = 0; rep < REP_P2; ++rep) pg8::gemm_phase<EpiP2, pg8::StaticOrder, true, true>(lds, g, S, E);
        }
        SEAM(pb + 1);
        if ((PHM & 8) && IN(pb + 2)) { FRESH();
            if (blockIdx.x < 36) cumsum_task(ws, l, (int)blockIdx.x, lds);
            int k3 = 256; asm volatile("" : "+s"(k3));
            pg8::Gemm g{(const pg8::bf16_t*)(ws + WS_CKVB), (const pg8::bf16_t*)(ws + WS_WUKV + (size_t)l * 768 * 256 * 2), M3, 768, k3};
            pg8::StaticOrder S; S.init(M3, 768, (int)gridDim.x, (int)blockIdx.x);
            EpiP3 E; E.ws = ws;
            _Pragma("nounroll") for (int rep = 0; rep < REP_P3; ++rep) pg8::gemm_phase<EpiP3, pg8::StaticOrder, true, true>(lds, g, S, E);
        }
        SEAM(pb + 2);
        if ((PHM & 16) && IN(pb + 3)) { FRESH(); _Pragma("nounroll") for (int rep = 0; rep < REP_P4; ++rep) p4_attention(ws, out, l, lds, rep); }
        SEAM(pb + 3);
        if ((PHM & 64) && IN(pb + 4)) { FRESH();
            pg8::Gemm g{(const pg8::bf16_t*)(ws + WS_OP), (const pg8::bf16_t*)(ws + WS_WOUT + (size_t)l * D * D * 2), M, D, D};
            pg8::StaticOrder S; S.init(MP, D, (int)gridDim.x, (int)blockIdx.x);
            EpiP5 E; E.ws = ws; E.tab = (LAS float*)(lds + SCR_OFF);
            _Pragma("nounroll") for (int rep = 0; rep < REP_P5; ++rep) pg8::gemm_phase<EpiP5, pg8::StaticOrder, true, true>(lds, g, S, E);
        }
        SEAM(pb + 4);
    }
#undef IN
#undef SEAM
}

#ifndef MK_SPLIT
#define MK_SPLIT 0
#endif
extern "C" void kernel_launch(void* const* d_in, const int* in_sizes, int n_in, void* d_out, int out_size, void* d_ws, size_t ws_size, hipStream_t stream) {
    static int grid = 0;
    if (grid == 0) {
        if (n_in != 18 || (size_t)out_size != O_END || ws_size < WS_END) { fprintf(stderr, "kernel_launch: unexpected shapes: n_in %d out %d ws %zu\n", n_in, out_size, ws_size); grid = -1; return; }
        int dev = 0, cus = 0, per_cu = 0;
        if (hipGetDevice(&dev) != hipSuccess || hipDeviceGetAttribute(&cus, hipDeviceAttributeMultiprocessorCount, dev) != hipSuccess) { grid = -1; return; }
        if (hipFuncSetAttribute((const void*)fwd, hipFuncAttributeMaxDynamicSharedMemorySize, LDS_BYTES) != hipSuccess) { fprintf(stderr, "kernel_launch: hipFuncSetAttribute failed\n"); grid = -1; return; }
        if (hipOccupancyMaxActiveBlocksPerMultiprocessor(&per_cu, (const void*)fwd, 512, LDS_BYTES) != hipSuccess || per_cu < 1) { fprintf(stderr, "kernel_launch: occupancy query reports %d blocks per CU\n", per_cu); (void)hipGetLastError(); grid = -1; return; }
        grid = cus;
    }
    if (grid < 0) return;
    (void)hipMemsetAsync((char*)d_ws + WS_CTL, 0, CTL_ZERO_BYTES, stream);
    Params p{};
    for (int i = 0; i < 18; ++i) p.in[i] = (const float*)d_in[i];
    p.out = (float*)d_out; p.ws = (unsigned char*)d_ws;
#if MK_SPLIT
    for (int ph = 0; ph < N_PHASES; ++ph) { p.ph_lo = ph; p.ph_hi = ph + 1; hipLaunchKernelGGL(fwd, dim3(grid), dim3(512), LDS_BYTES, stream, p); }
#else
    p.ph_lo = 0; p.ph_hi = N_PHASES;
    hipLaunchKernelGGL(fwd, dim3(grid), dim3(512), LDS_BYTES, stream, p);
#endif
    const hipError_t le = hipPeekAtLastError();
    if (le != hipSuccess) fprintf(stderr, "kernel_launch: launch failed: %s\n", hipGetErrorName(le));
}
```
